# Optimizing an MI355X kernel written in HIP

```python
import math
import jax, jax.numpy as jnp
from jax import lax
import numpy as np

D_MODEL = 1024
BATCH = 32
SEQ = 256
DEPTH = 2
DEC_BATCH = 2
DEC_SEQ = 2048
PAST_LEN = 512

GRID_W = 64
N_AH_LAYERS = (DEPTH + 1) // 2
N_ML_LAYERS = DEPTH // 2
A_HEADS = 4
A_KV_HEADS = 2
A_GROUP = A_HEADS // A_KV_HEADS
A_HEAD_DIM = 128
A_Q = A_HEADS * A_HEAD_DIM
A_KV = A_KV_HEADS * A_HEAD_DIM
Q_BLOCK = 128
ROPE_THETA = 10000.0
HY_CH = D_MODEL // 2
HY_BANDS = 8
HY_EMB = 1 + 2 * HY_BANDS
HY_W = 64
HY_TARGET = 1e-2
HY_FAST_PCT = 0.3
HY_SLOW_PCT = 1.5
HY_MAX_DECAY = math.log(HY_TARGET) / HY_FAST_PCT
HY_MIN_DECAY = math.log(HY_TARGET) / HY_SLOW_PCT
AH_IN = A_Q + 2 * A_KV + 3 * HY_CH
AH_OUT = A_Q + HY_CH
ML_HEADS = 8
ML_HEAD_DIM = D_MODEL // ML_HEADS
ML_W = ML_HEADS * ML_HEAD_DIM
ML_IN = 4 * ML_W + 4 * ML_HEADS
ML_CHUNK = 64
D_FF = 2816
NORM_EPS = 1e-6
NEG_BIG = -1e30

kernel_name = 'hybrid_diffusion_step'


def rms_norm(x, g):
    xf = x.astype(jnp.float32)
    y = xf * lax.rsqrt(jnp.mean(xf * xf, axis=-1, keepdims=True) + NORM_EPS)
    return (y * g.astype(jnp.float32)).astype(x.dtype)


def modulate(x, g, shift, scale):
    return rms_norm(x, g) * (1.0 + scale) + shift


def dwconv3(x, w, b):
    L = x.shape[1]
    xp = jnp.pad(x, ((0, 0), (1, 1), (0, 0)))
    return xp[:, :L] * w[0] + xp[:, 1:L + 1] * w[1] + xp[:, 2:] * w[2] + b


def axial_rope(L):
    rows = L // GRID_W
    row = jnp.repeat(jnp.arange(rows, dtype=jnp.float32), GRID_W)
    col = jnp.tile(jnp.arange(GRID_W, dtype=jnp.float32), rows)
    n_freq = A_HEAD_DIM // 4
    inv = ROPE_THETA ** (-jnp.arange(n_freq, dtype=jnp.float32) / n_freq)
    ang = jnp.concatenate([row[:, None] * inv, col[:, None] * inv], axis=-1)
    return jnp.cos(ang), jnp.sin(ang)


def apply_rope(x, cos, sin):
    half = x.shape[-1] // 2
    xf = x.astype(jnp.float32)
    x1, x2 = xf[..., :half], xf[..., half:]
    c, s = cos[None, :, None, :], sin[None, :, None, :]
    return jnp.concatenate([x1 * c - x2 * s, x1 * s + x2 * c], axis=-1).astype(x.dtype)


def block_attention(q, k, v):
    B, Lq = q.shape[0], q.shape[1]
    nb = Lq // Q_BLOCK
    qb = q.astype(jnp.float32).reshape(B, nb, Q_BLOCK, A_KV_HEADS, A_GROUP, A_HEAD_DIM)
    qb = jnp.moveaxis(qb, 1, 0)
    kf, vf = k.astype(jnp.float32), v.astype(jnp.float32)
    scale = A_HEAD_DIM ** -0.5

    def one_block(qi):
        s = jnp.einsum('bqkgd,bskd->bkgqs', qi, kf) * scale
        p = jax.nn.softmax(s, axis=-1)
        return jnp.einsum('bkgqs,bskd->bqkgd', p, vf)

    o = lax.map(one_block, qb)
    return jnp.moveaxis(o, 0, 1).reshape(B, Lq, A_Q).astype(q.dtype)


def hyena_filters(L, w1, b1, w2, b2, w3, b3, sin_freq):
    t = jnp.linspace(0.0, 1.0, L, dtype=jnp.float32)
    bands = jnp.arange(1, HY_BANDS + 1, dtype=jnp.float32)
    ang = 2.0 * jnp.pi * t[:, None] * bands
    z = jnp.concatenate([t[:, None], jnp.cos(ang), jnp.sin(ang)], axis=-1)
    h = jnp.sin(sin_freq[0] * (z @ w1 + b1))
    h = jnp.sin(sin_freq[1] * (h @ w2 + b2))
    filt = (h @ w3 + b3).astype(jnp.float32)
    deltas = jnp.abs(jnp.linspace(HY_MIN_DECAY, HY_MAX_DECAY, HY_CH, dtype=jnp.float32))
    window = jnp.exp(-t[:, None] * deltas)
    filt = filt.reshape(L, 2, HY_CH) * window[:, None, :]
    return filt[:, 0], filt[:, 1]


def long_conv(v, h):
    L = v.shape[1]
    n = 2 * L
    V = jnp.fft.rfft(v, n=n, axis=1)
    Hf = jnp.fft.rfft(h, n=n, axis=0)
    return jnp.fft.irfft(V * Hf[None], n=n, axis=1)[:, :L]


def hyena_mixer(u, conv_w, conv_b, w1, b1, w2, b2, w3, b3, sin_freq, skip):
    L = u.shape[1]
    uc = dwconv3(u, conv_w, conv_b)
    x0, x1, v = uc[..., :HY_CH], uc[..., HY_CH:2 * HY_CH], uc[..., 2 * HY_CH:]
    v = (v * x1).astype(jnp.float32)
    h_f, h_b = hyena_filters(L, w1, b1, w2, b2, w3, b3, sin_freq)
    y = long_conv(v, h_f) + jnp.flip(long_conv(jnp.flip(v, axis=1), h_b), axis=1) + skip * v
    return (y * x0).astype(u.dtype)


def attn_hyena_mixer(x, lat, w_in, w_out, q_norm, k_norm, hy):
    B, L, _ = x.shape
    proj = x @ w_in
    q = rms_norm(proj[..., :A_Q].reshape(B, L, A_HEADS, A_HEAD_DIM), q_norm)
    k = rms_norm(proj[..., A_Q:A_Q + A_KV].reshape(B, L, A_KV_HEADS, A_HEAD_DIM), k_norm)
    v = proj[..., A_Q + A_KV:A_Q + 2 * A_KV].reshape(B, L, A_KV_HEADS, A_HEAD_DIM)
    u = proj[..., A_Q + 2 * A_KV:]
    if lat is None:
        k_all, v_all = k, v
    else:
        (cos, sin), ctx_k, ctx_v = lat
        q = apply_rope(q, cos, sin)
        k_all = jnp.concatenate([apply_rope(k, cos, sin), ctx_k.astype(k.dtype)], axis=1)
        v_all = jnp.concatenate([v, ctx_v.astype(v.dtype)], axis=1)
    attn = block_attention(q, k_all, v_all)
    hyo = hyena_mixer(u, *hy)
    out = jnp.concatenate([attn, hyo], axis=-1) @ w_out
    return out, k, v


def mlstm_chunked(q, k, v, ig, fg, C0, n0, m0):
    B, H, L, dh = q.shape
    nc = L // ML_CHUNK

    def chunks(a):
        return jnp.moveaxis(a.reshape(B, H, nc, ML_CHUNK, *a.shape[3:]), 2, 0)

    lower = jnp.tril(jnp.ones((ML_CHUNK, ML_CHUNK), dtype=bool))

    def step(carry, inp):
        C, n, m = carry
        qc, kc, vc, ic, lfc = inp
        b = jnp.cumsum(lfc, axis=-1)
        dmat = jnp.where(lower, b[..., :, None] - b[..., None, :] + ic[..., None, :], NEG_BIG)
        inter = b + m[..., None]
        mt = jnp.maximum(inter, jnp.max(dmat, axis=-1))
        w_intra = jnp.exp(dmat - mt[..., None])
        w_inter = jnp.exp(inter - mt)
        s = jnp.einsum('bhtd,bhsd->bhts', qc, kc) * w_intra
        num = w_inter[..., None] * jnp.einsum('bhvk,bhtk->bhtv', C, qc) + jnp.einsum('bhts,bhsv->bhtv', s, vc)
        den = w_inter * jnp.einsum('bhk,bhtk->bht', n, qc) + jnp.sum(s, axis=-1)
        h = num / jnp.maximum(jnp.abs(den), jnp.exp(-mt))[..., None]
        m_new = mt[..., -1]
        w_state = jnp.exp(b[..., -1] + m - m_new)
        w_tok = jnp.exp(b[..., -1:] - b + ic - m_new[..., None])
        C_new = w_state[..., None, None] * C + jnp.einsum('bhs,bhsv,bhsk->bhvk', w_tok, vc, kc)
        n_new = w_state[..., None] * n + jnp.einsum('bhs,bhsk->bhk', w_tok, kc)
        return (C_new, n_new, m_new), h

    (C, n, m), h = lax.scan(step, (C0, n0, m0),
                            (chunks(q), chunks(k), chunks(v), chunks(ig), chunks(jax.nn.log_sigmoid(fg))))
    h = jnp.moveaxis(h, 0, 2).reshape(B, H, L, dh)
    return h, (C, n, m)


def mlstm_mixer(x, C0, n0, m0, w_in, b_gates, conv_w, conv_b, head_norm, w_out):
    B, L, _ = x.shape
    proj = x @ w_in
    qk = jax.nn.silu(dwconv3(proj[..., :2 * ML_W], conv_w, conv_b))
    v = proj[..., 2 * ML_W:3 * ML_W]
    o = proj[..., 3 * ML_W:4 * ML_W]
    gates = (proj[..., 4 * ML_W:] + b_gates).astype(jnp.float32)
    gates = gates.reshape(B, L, 4, ML_HEADS).transpose(2, 0, 3, 1)

    def heads(a):
        return a.reshape(B, L, ML_HEADS, ML_HEAD_DIM).transpose(0, 2, 1, 3).astype(jnp.float32)

    q = heads(qk[..., :ML_W])
    k = heads(qk[..., ML_W:]) * (ML_HEAD_DIM ** -0.5)
    vh = heads(v)
    C0, n0, m0 = C0.astype(jnp.float32), n0.astype(jnp.float32), m0.astype(jnp.float32)
    h_f, (Cf, nf, mf) = mlstm_chunked(q, k, vh, gates[0], gates[2], C0[:, 0], n0[:, 0], m0[:, 0])

    def rev(a):
        return jnp.flip(a, axis=2)

    h_b, (Cb, nb, mb) = mlstm_chunked(rev(q), rev(k), rev(vh), rev(gates[1]), rev(gates[3]),
                                      C0[:, 1], n0[:, 1], m0[:, 1])
    h = (h_f + rev(h_b)).transpose(0, 2, 1, 3)
    h = rms_norm(h, head_norm.reshape(ML_HEADS, ML_HEAD_DIM)).reshape(B, L, ML_W).astype(x.dtype)
    out = (h * jax.nn.sigmoid(o)) @ w_out
    state = (jnp.stack([Cf, Cb], axis=1), jnp.stack([nf, nb], axis=1), jnp.stack([mf, mb], axis=1))
    return out, state


def conv_ffn(x, w_up, conv_w, conv_b, w_down):
    h = dwconv3(x @ w_up, conv_w, conv_b)
    return (jax.nn.gelu(h[..., :D_FF], approximate=False) * h[..., D_FF:]) @ w_down


def setup_inputs(seed: int = 0) -> dict:
    key = jax.random.key(seed)
    keys = iter(jax.random.split(key, 64))

    def nrm(shape, scale):
        return scale * jax.random.normal(next(keys), shape, jnp.float32)

    def gain(shape):
        return 1.0 + nrm(shape, 0.05)

    LA, LM = N_AH_LAYERS, N_ML_LAYERS
    inp = {}
    inp['x_prompt'] = nrm((BATCH, SEQ, D_MODEL), 1.0)
    inp['x_sample'] = nrm((DEC_BATCH, DEC_SEQ, D_MODEL), 1.0)
    inp['cache_attn_k'] = nrm((DEC_BATCH, LA, PAST_LEN, A_KV_HEADS, A_HEAD_DIM), 1.0)
    inp['cache_attn_v'] = nrm((DEC_BATCH, LA, PAST_LEN, A_KV_HEADS, A_HEAD_DIM), 1.0)
    inp['state_mlstm_C'] = nrm((DEC_BATCH, LM, 2, ML_HEADS, ML_HEAD_DIM, ML_HEAD_DIM), 0.3)
    inp['state_mlstm_n'] = nrm((DEC_BATCH, LM, 2, ML_HEADS, ML_HEAD_DIM), 0.3)
    inp['state_mlstm_m'] = jax.random.uniform(next(keys), (DEC_BATCH, LM, 2, ML_HEADS), jnp.float32, 0.0, 3.0)
    inp['c'] = nrm((DEC_BATCH, D_MODEL), 1.0)
    inp['c_ctx'] = nrm((D_MODEL,), 1.0)
    inp['w_mod'] = nrm((DEPTH, D_MODEL, 6 * D_MODEL), 0.5 * D_MODEL ** -0.5)
    inp['b_mod'] = nrm((DEPTH, 6 * D_MODEL), 0.1)
    inp['norm_mix_pre'] = gain((DEPTH, D_MODEL))
    inp['norm_mix_post'] = gain((DEPTH, D_MODEL))
    inp['norm_ffn_pre'] = gain((DEPTH, D_MODEL))
    inp['norm_ffn_post'] = gain((DEPTH, D_MODEL))
    inp['ffn_w_up'] = nrm((DEPTH, D_MODEL, 2 * D_FF), D_MODEL ** -0.5)
    inp['ffn_conv_w'] = nrm((DEPTH, 3, 2 * D_FF), 0.5)
    inp['ffn_conv_b'] = nrm((DEPTH, 2 * D_FF), 0.02)
    inp['ffn_w_down'] = nrm((DEPTH, D_FF, D_MODEL), D_FF ** -0.5)
    inp['ah_w_in'] = nrm((LA, D_MODEL, AH_IN), D_MODEL ** -0.5)
    inp['ah_w_out'] = nrm((LA, AH_OUT, D_MODEL), AH_OUT ** -0.5)
    inp['attn_q_norm'] = gain((LA, A_HEAD_DIM))
    inp['attn_k_norm'] = gain((LA, A_HEAD_DIM))
    inp['hy_conv_w'] = nrm((LA, 3, 3 * HY_CH), 0.5)
    inp['hy_conv_b'] = nrm((LA, 3 * HY_CH), 0.02)
    inp['hy_w1'] = nrm((LA, HY_EMB, HY_W), HY_EMB ** -0.5)
    inp['hy_b1'] = nrm((LA, HY_W), 0.1)
    inp['hy_w2'] = nrm((LA, HY_W, HY_W), HY_W ** -0.5)
    inp['hy_b2'] = nrm((LA, HY_W), 0.1)
    inp['hy_w3'] = nrm((LA, HY_W, 2 * HY_CH), 0.1 * HY_W ** -0.5)
    inp['hy_b3'] = nrm((LA, 2 * HY_CH), 0.01)
    inp['hy_sin_freq'] = gain((LA, 2, HY_W))
    inp['hy_skip'] = nrm((LA, HY_CH), 0.5)
    inp['ml_w_in'] = nrm((LM, D_MODEL, ML_IN), D_MODEL ** -0.5)
    b_i = nrm((LM, 2 * ML_HEADS), 0.1)
    b_f = jnp.tile(jnp.linspace(3.0, 6.0, ML_HEADS, dtype=jnp.float32), 2)[None] + nrm((LM, 2 * ML_HEADS), 0.1)
    inp['ml_b_gates'] = jnp.concatenate([b_i, b_f], axis=-1)
    inp['ml_conv_w'] = nrm((LM, 3, 2 * ML_W), 0.5)
    inp['ml_conv_b'] = nrm((LM, 2 * ML_W), 0.02)
    inp['ml_head_norm'] = gain((LM, ML_W))
    inp['ml_w_out'] = nrm((LM, ML_W, D_MODEL), ML_W ** -0.5)
    return inp


def reference(x_prompt, x_sample, cache_attn_k, cache_attn_v, state_mlstm_C, state_mlstm_n, state_mlstm_m,
              c, c_ctx, w_mod, b_mod, norm_mix_pre, norm_mix_post, norm_ffn_pre, norm_ffn_post,
              ffn_w_up, ffn_conv_w, ffn_conv_b, ffn_w_down,
              ah_w_in, ah_w_out, attn_q_norm, attn_k_norm,
              hy_conv_w, hy_conv_b, hy_w1, hy_b1, hy_w2, hy_b2, hy_w3, hy_b3, hy_sin_freq, hy_skip,
              ml_w_in, ml_b_gates, ml_conv_w, ml_conv_b, ml_head_norm, ml_w_out):
    xp, xs = x_prompt, x_sample
    B = xp.shape[0]
    rope = axial_rope(xs.shape[1])
    ks, vs, Cs, ns, ms = [], [], [], [], []
    for l in range(DEPTH):
        j = l // 2
        mod_p = jnp.split(jax.nn.silu(c_ctx) @ w_mod[l] + b_mod[l], 6, axis=-1)
        mod_s = [m[:, None, :] for m in jnp.split(jax.nn.silu(c) @ w_mod[l] + b_mod[l], 6, axis=-1)]
        hp = modulate(xp, norm_mix_pre[l], mod_p[0], mod_p[1])
        hs = modulate(xs, norm_mix_pre[l], mod_s[0], mod_s[1])
        if l % 2 == 0:
            hy = (hy_conv_w[j], hy_conv_b[j], hy_w1[j], hy_b1[j], hy_w2[j], hy_b2[j],
                  hy_w3[j], hy_b3[j], hy_sin_freq[j], hy_skip[j])
            out_p, k_ctx, v_ctx = attn_hyena_mixer(hp, None, ah_w_in[j], ah_w_out[j],
                                                   attn_q_norm[j], attn_k_norm[j], hy)
            out_s, _, _ = attn_hyena_mixer(hs, (rope, cache_attn_k[:, j], cache_attn_v[:, j]),
                                           ah_w_in[j], ah_w_out[j], attn_q_norm[j], attn_k_norm[j], hy)
            ks.append(k_ctx)
            vs.append(v_ctx)
        else:
            zC = jnp.zeros((B, 2, ML_HEADS, ML_HEAD_DIM, ML_HEAD_DIM), jnp.float32)
            zn = jnp.zeros((B, 2, ML_HEADS, ML_HEAD_DIM), jnp.float32)
            zm = jnp.zeros((B, 2, ML_HEADS), jnp.float32)
            out_p, st = mlstm_mixer(hp, zC, zn, zm, ml_w_in[j], ml_b_gates[j], ml_conv_w[j], ml_conv_b[j],
                                    ml_head_norm[j], ml_w_out[j])
            out_s, _ = mlstm_mixer(hs, state_mlstm_C[:, j], state_mlstm_n[:, j], state_mlstm_m[:, j],
                                   ml_w_in[j], ml_b_gates[j], ml_conv_w[j], ml_conv_b[j],
                                   ml_head_norm[j], ml_w_out[j])
            Cs.append(st[0].astype(xp.dtype))
            ns.append(st[1].astype(xp.dtype))
            ms.append(st[2].astype(xp.dtype))
        xp = xp + mod_p[2] * rms_norm(out_p, norm_mix_post[l])
        xs = xs + mod_s[2] * rms_norm(out_s, norm_mix_post[l])
        hp = modulate(xp, norm_ffn_pre[l], mod_p[3], mod_p[4])
        hs = modulate(xs, norm_ffn_pre[l], mod_s[3], mod_s[4])
        xp = xp + mod_p[5] * rms_norm(conv_ffn(hp, ffn_w_up[l], ffn_conv_w[l], ffn_conv_b[l], ffn_w_down[l]),
                                      norm_ffn_post[l])
        xs = xs + mod_s[5] * rms_norm(conv_ffn(hs, ffn_w_up[l], ffn_conv_w[l], ffn_conv_b[l], ffn_w_down[l]),
                                      norm_ffn_post[l])
    new_attn_k = jnp.stack(ks, axis=1)
    new_attn_v = jnp.stack(vs, axis=1)
    new_mlstm_C = jnp.stack(Cs, axis=1)
    new_mlstm_n = jnp.stack(ns, axis=1)
    new_mlstm_m = jnp.stack(ms, axis=1)
    return (xp, xs, new_attn_k, new_attn_v, new_mlstm_C, new_mlstm_n, new_mlstm_m)
```

```cpp
#include <hip/hip_runtime.h>
#include <hip/hip_cooperative_groups.h>
#include <cstdio>
#include <cstdint>
namespace cg = cooperative_groups;

typedef unsigned short bf16_t;
typedef short bf16x8 __attribute__((ext_vector_type(8)));
typedef short s16x4 __attribute__((ext_vector_type(4)));
typedef float f32x4 __attribute__((ext_vector_type(4)));
typedef float f32x8 __attribute__((ext_vector_type(8)));
typedef float f32x16 __attribute__((ext_vector_type(16)));
typedef unsigned u32x4 __attribute__((ext_vector_type(4)));
typedef unsigned u32x2 __attribute__((ext_vector_type(2)));

constexpr int T_TOK = 12288, TPR = 8192;
constexpr int LDS_BYTES = 131072;
constexpr int NPH = 21;

constexpr size_t OFF_WIN0 = 0, OFF_WOUT0 = 5242880, OFF_WUP0 = 7340032, OFF_WUP1 = 18874368, OFF_WDN0 = 30408704,
                 OFF_WDN1 = 36175872, OFF_WIN1 = 41943040, OFF_WOUT1 = 50855936, OFF_MOD = 52953088, OFF_P = 53100544,
                 OFF_G = 191512576, WS_END = 260718592;
constexpr size_t P_QA = 62914560, P_KA = 75497472, P_VA = 82313216, P_X0 = 89128960;
constexpr size_t P_GT = 100663296, P_A2 = 102236160;
constexpr size_t G_VV = 25165824, G_HB = 25165824;
constexpr size_t O_K = 12582912, O_V = 14680064, O_C = 16777216, O_N = 25165824, O_M = 25231360;

struct Params { const float* in[39]; float* out; char* ws; };

__device__ __forceinline__ unsigned cvtpk(float lo, float hi) {
  unsigned r; asm("v_cvt_pk_bf16_f32 %0, %1, %2" : "=v"(r) : "v"(lo), "v"(hi)); return r;
}
__device__ __forceinline__ bf16_t f2bf(float f) { return (bf16_t)(cvtpk(f, 0.f) & 0xffffu); }
__device__ __forceinline__ float bf2f(bf16_t h) { return __uint_as_float(((unsigned)h) << 16); }
__device__ __forceinline__ float bflo(unsigned w) { return __uint_as_float(w << 16); }
__device__ __forceinline__ float bfhi(unsigned w) { return __uint_as_float(w & 0xffff0000u); }
__device__ __forceinline__ float wave_sum(float v) {
#pragma unroll
  for (int o = 32; o > 0; o >>= 1) v += __shfl_xor(v, o);
  return v;
}
__device__ __forceinline__ int llane() { int l; asm volatile("v_mbcnt_lo_u32_b32 %0, -1, 0\n\tv_mbcnt_hi_u32_b32 %0, -1, %0" : "=v"(l)); return l; }
__device__ __forceinline__ int ltid(int wv) { return (wv << 6) | llane(); }
__device__ __forceinline__ int opq() { int z; asm volatile("s_mov_b32 %0, 0" : "=s"(z)); return z; }
__device__ __forceinline__ float silu_f(float x) { return x / (1.f + __expf(-x)); }
__device__ __forceinline__ int crow(int r, int hi) { return (r & 3) + 8 * (r >> 2) + 4 * hi; }
__device__ __forceinline__ void unpack8(u32x4 w, float* f) {
  f[0] = bflo(w[0]); f[1] = bfhi(w[0]); f[2] = bflo(w[1]); f[3] = bfhi(w[1]);
  f[4] = bflo(w[2]); f[5] = bfhi(w[2]); f[6] = bflo(w[3]); f[7] = bfhi(w[3]);
}
__device__ __forceinline__ u32x4 pack8(const float* f) {
  u32x4 w = {cvtpk(f[0], f[1]), cvtpk(f[2], f[3]), cvtpk(f[4], f[5]), cvtpk(f[6], f[7])}; return w;
}

__device__ __forceinline__ void conv_w(const int wv, const float* __restrict__ W, bf16_t* __restrict__ Wt, int K, int N, int NP) {
  const int tidx = ltid(wv);
  extern __shared__ __attribute__((aligned(16))) char shm_raw[];
  float* tl = (float*)shm_raw;
  const int tid = tidx;
  const int ntn = NP / 64, ntiles = (K / 64) * ntn;
  for (int tile = blockIdx.x; tile < ntiles; tile += gridDim.x) {
    const int k0 = (tile / ntn) * 64, n0 = (tile % ntn) * 64;
    __syncthreads();
#pragma unroll
    for (int i = 0; i < 2; ++i) {
      int kr = (tid >> 4) + 32 * i, nc = (tid & 15) * 4;
      float4 v = make_float4(0.f, 0.f, 0.f, 0.f);
      if (n0 + nc < N) v = *(const float4*)(W + (long)(k0 + kr) * N + n0 + nc);
      float* d = tl + kr * 65 + nc; d[0] = v.x; d[1] = v.y; d[2] = v.z; d[3] = v.w;
    }
    __syncthreads();
    {
      int n = tid >> 3, kg = (tid & 7) * 8;
      u32x4 w;
      w[0] = cvtpk(tl[(kg + 0) * 65 + n], tl[(kg + 1) * 65 + n]);
      w[1] = cvtpk(tl[(kg + 2) * 65 + n], tl[(kg + 3) * 65 + n]);
      w[2] = cvtpk(tl[(kg + 4) * 65 + n], tl[(kg + 5) * 65 + n]);
      w[3] = cvtpk(tl[(kg + 6) * 65 + n], tl[(kg + 7) * 65 + n]);
      *(u32x4*)(Wt + (long)(n0 + n) * K + k0 + kg) = w;
    }
  }
  __syncthreads();
}

__device__ __forceinline__ void mod_phase(const int wv, const Params& p, const int zq, float* modv) {
  const int tidx = ltid(wv);
  extern __shared__ __attribute__((aligned(16))) char shm_raw[];
  float* red = (float*)shm_raw;
  const int tid = tidx;
  const float* cvec = p.in[zq + 7]; const float* cctx = p.in[zq + 8]; const float* bmod = p.in[zq + 10];
  for (int item = blockIdx.x; item < 192; item += gridDim.x) {
    const int l = item / 96, cb = (item % 96) * 64;
    const float* W = p.in[zq + 9] + (long)l * 1024 * 6144;
    const int cl = tid & 15, kg = tid >> 4;
    float a0[4] = {0, 0, 0, 0}, a1[4] = {0, 0, 0, 0}, a2[4] = {0, 0, 0, 0};
#pragma unroll 4
    for (int i = 0; i < 32; ++i) {
      int k = kg + 32 * i;
      float4 w = *(const float4*)(W + (long)k * 6144 + cb + cl * 4);
      float s0 = silu_f(cctx[k]), s1 = silu_f(cvec[k]), s2 = silu_f(cvec[1024 + k]);
      a0[0] += s0 * w.x; a0[1] += s0 * w.y; a0[2] += s0 * w.z; a0[3] += s0 * w.w;
      a1[0] += s1 * w.x; a1[1] += s1 * w.y; a1[2] += s1 * w.z; a1[3] += s1 * w.w;
      a2[0] += s2 * w.x; a2[1] += s2 * w.y; a2[2] += s2 * w.z; a2[3] += s2 * w.w;
    }
    __syncthreads();
#pragma unroll
    for (int j = 0; j < 4; ++j) {
      red[kg * 192 + 0 * 64 + cl * 4 + j] = a0[j];
      red[kg * 192 + 1 * 64 + cl * 4 + j] = a1[j];
      red[kg * 192 + 2 * 64 + cl * 4 + j] = a2[j];
    }
    __syncthreads();
    if (tid < 192) {
      float s = 0.f;
#pragma unroll 8
      for (int q = 0; q < 32; ++q) s += red[q * 192 + tid];
      int g = tid / 64, col = cb + (tid % 64);
      modv[(l * 3 + g) * 6144 + col] = s + bmod[l * 6144 + col];
    }
  }
  __syncthreads();
}

__device__ __forceinline__ void filt_phase(const int wv, const Params& p, const int zq, float* F256, float* F2048) {
  const int tidx = ltid(wv);
  extern __shared__ __attribute__((aligned(16))) char shm_raw[];
  float* z = (float*)shm_raw; float* h1 = z + 32; float* h2 = h1 + 64;
  const int tid = tidx;
  const float *w1 = p.in[zq + 25], *b1 = p.in[zq + 26], *w2 = p.in[zq + 27], *b2 = p.in[zq + 28], *w3 = p.in[zq + 29], *b3 = p.in[zq + 30], *sf = p.in[zq + 31], *skip = p.in[zq + 32];
  const float DMAX = -15.350567286626973f, DMIN = -3.0701134573253946f;
  for (int item = blockIdx.x; item < 2304; item += gridDim.x) {
    const int L = item < 256 ? 256 : 2048; const int i = item < 256 ? item : item - 256;
    float* F = item < 256 ? F256 : F2048;
    const float t = (float)i / (float)(L - 1);
    __syncthreads();
    if (tid < 17) {
      float v;
      if (tid == 0) v = t;
      else if (tid <= 8) v = cosf(6.283185307179586f * t * (float)tid);
      else v = sinf(6.283185307179586f * t * (float)(tid - 8));
      z[tid] = v;
    }
    __syncthreads();
    if (tid < 64) { float s = b1[tid];
#pragma unroll 1
      for (int j = 0; j < 17; ++j) s += z[j] * w1[j * 64 + tid]; h1[tid] = sinf(sf[tid] * s); }
    __syncthreads();
    if (tid < 64) { float s = b2[tid];
#pragma unroll 8
      for (int j = 0; j < 64; ++j) s += h1[j] * w2[j * 64 + tid]; h2[tid] = sinf(sf[64 + tid] * s); }
    __syncthreads();
    {
      const int ch = tid; float sfw = b3[ch], sbw = b3[512 + ch];
#pragma unroll 8
      for (int j = 0; j < 64; ++j) { float hh = h2[j]; sfw += hh * w3[j * 1024 + ch]; sbw += hh * w3[j * 1024 + 512 + ch]; }
      float delta = fabsf(DMIN + (DMAX - DMIN) * ((float)ch / 511.f));
      float win = expf(-t * delta); sfw *= win; sbw *= win;
      if (i == 0) F[(long)(L - 1) * 512 + ch] = sfw + sbw + skip[ch];
      else { F[(long)(L - 1 + i) * 512 + ch] = sfw; F[(long)(L - 1 - i) * 512 + ch] = sbw; }
    }
  }
  __syncthreads();
}

template <bool FROM_IN, bool HAS_R, bool HAS_A>
__device__ __forceinline__ void row_phase(const int wv, const Params& p, const int zq, const float* __restrict__ R, const float* __restrict__ postg,
                                          const float* __restrict__ modg, int gate_m, float* X,
                                          const float* __restrict__ preg, const float* __restrict__ mods, int shift_m, bf16_t* __restrict__ A) {
  const int tidx = ltid(wv);
  const int wid = wv, lane = tidx & 63;
  for (int row = blockIdx.x * 8 + wid; row < T_TOK; row += gridDim.x * 8) {
    const int g = row < TPR ? 0 : 1 + (row - TPR) / 2048;
    const float* mg = modg + g * 6144;
    const float* ms = mods + g * 6144;
    const float* xin = FROM_IN ? (row < TPR ? p.in[zq + 0] + (long)row * 1024 : p.in[zq + 1] + (long)(row - TPR) * 1024) : (const float*)X + (long)row * 1024;
    float4 x[4];
#pragma unroll
    for (int j = 0; j < 4; ++j) x[j] = *(const float4*)(xin + j * 256 + lane * 4);
    if (HAS_R) {
      float4 r[4]; float ss = 0.f;
#pragma unroll
      for (int j = 0; j < 4; ++j) { r[j] = *(const float4*)(R + (long)row * 1024 + j * 256 + lane * 4); ss += r[j].x * r[j].x + r[j].y * r[j].y + r[j].z * r[j].z + r[j].w * r[j].w; }
      ss = wave_sum(ss); const float rs = rsqrtf(ss * (1.f / 1024.f) + 1e-6f);
#pragma unroll
      for (int j = 0; j < 4; ++j) {
        float4 pg = *(const float4*)(postg + j * 256 + lane * 4);
        float4 gt = *(const float4*)(mg + gate_m * 1024 + j * 256 + lane * 4);
        x[j].x += gt.x * (r[j].x * rs * pg.x); x[j].y += gt.y * (r[j].y * rs * pg.y);
        x[j].z += gt.z * (r[j].z * rs * pg.z); x[j].w += gt.w * (r[j].w * rs * pg.w);
        *(float4*)(X + (long)row * 1024 + j * 256 + lane * 4) = x[j];
      }
    }
    if (HAS_A) {
      float ss = 0.f;
#pragma unroll
      for (int j = 0; j < 4; ++j) ss += x[j].x * x[j].x + x[j].y * x[j].y + x[j].z * x[j].z + x[j].w * x[j].w;
      ss = wave_sum(ss); const float rs = rsqrtf(ss * (1.f / 1024.f) + 1e-6f);
#pragma unroll
      for (int j = 0; j < 4; ++j) {
        float4 pg = *(const float4*)(preg + j * 256 + lane * 4);
        float4 sh = *(const float4*)(ms + shift_m * 1024 + j * 256 + lane * 4);
        float4 sc = *(const float4*)(ms + (shift_m + 1) * 1024 + j * 256 + lane * 4);
        float y0 = x[j].x * rs * pg.x * (1.f + sc.x) + sh.x, y1 = x[j].y * rs * pg.y * (1.f + sc.y) + sh.y;
        float y2 = x[j].z * rs * pg.z * (1.f + sc.z) + sh.z, y3 = x[j].w * rs * pg.w * (1.f + sc.w) + sh.w;
        u32x2 w = {cvtpk(y0, y1), cvtpk(y2, y3)};
        *(u32x2*)(A + (long)row * 1024 + j * 256 + lane * 4) = w;
      }
    }
  }
}

constexpr int BM = 256, BK = 64, HALF = 128, WGM = 8, HT = HALF * BK;
__device__ __forceinline__ int lds_byte(int r, int c) {
  int st = (r >> 4) * 2 + (c >> 5), rr = r & 15, cc = c & 31, ob = rr * 64 + cc * 2;
  return st * 1024 + (ob ^ (((ob >> 9) & 1) << 5));
}
__device__ __forceinline__ void stage_rc(int b, int& R, int& C) {
  int st = b / 1024, sb = b % 1024, swz = sb ^ (((sb >> 9) & 1) << 5);
  R = (st >> 1) * 16 + swz / 64; C = (st & 1) * 32 + (swz % 64) / 2;
}

template <int MODE, int LDC>
__device__ __forceinline__ void gemm_phase(const int wv, const bf16_t* __restrict__ A, const bf16_t* __restrict__ Bt, int N, int K,
                                           void* Cout, float* GT) {
  const int tidx = ltid(wv);
  extern __shared__ __attribute__((aligned(16))) char shm_raw[];
  bf16_t* shm = (bf16_t*)shm_raw;
#define SA(b, h) (shm + ((b) * 2 + (h)) * HT)
#define SB(b, h) (shm + (4 + (b) * 2 + (h)) * HT)
#define STAGE(P, BASE, br, kt) do { const bf16_t* _gb = (BASE) + ((long)(br) * K + (long)(kt) * BK); \
    __builtin_amdgcn_global_load_lds((const unsigned*)(_gb + soff0), (unsigned*)((char*)(P) + sl0), 16, 0, 0); \
    __builtin_amdgcn_global_load_lds((const unsigned*)(_gb + soff1), (unsigned*)((char*)(P) + sl0 + 8192), 16, 0, 0); } while (0)
#define LDA(dst, b, h) _Pragma("unroll") for (int m = 0; m < 4; ++m) _Pragma("unroll") for (int k = 0; k < 2; ++k) \
    dst[m][k] = *reinterpret_cast<const bf16x8*>((char*)SA(b, h) + lds_byte(wr * 64 + m * 16 + fr, k * 32 + fq * 8))
#define LDB(dst, b, h) _Pragma("unroll") for (int n = 0; n < 2; ++n) _Pragma("unroll") for (int k = 0; k < 2; ++k) \
    dst[n][k] = *reinterpret_cast<const bf16x8*>((char*)SB(b, h) + lds_byte(wc * 32 + n * 16 + fr, k * 32 + fq * 8))
#define MMA(ai, bj, At, Bt_) do { __builtin_amdgcn_s_setprio(1); \
    _Pragma("unroll") for (int m = 0; m < 4; ++m) _Pragma("unroll") for (int n = 0; n < 2; ++n) _Pragma("unroll") for (int k = 0; k < 2; ++k) \
      acc[ai][bj][m][n] = __builtin_amdgcn_mfma_f32_16x16x32_bf16(At[m][k], Bt_[n][k], acc[ai][bj][m][n], 0, 0, 0); \
    __builtin_amdgcn_s_setprio(0); } while (0)
#define WAIT_V(n) asm volatile("s_waitcnt vmcnt(" #n ")" ::: "memory")
#define WAIT_L(n) asm volatile("s_waitcnt lgkmcnt(" #n ")" ::: "memory")
#define BAR __builtin_amdgcn_s_barrier()
#define SCHED __builtin_amdgcn_sched_barrier(0)
  const int nM = T_TOK / BM, nN = N / BM, nwg = nM * nN;
  const int wid = wv, lane = tidx & 63, wr = wid >> 2, wc = wid & 3, fr = lane & 15, fq = lane >> 4;
  const int nt = K / BK;
  unsigned soff0, soff1; const int sl0 = tidx * 16;
  { int _r, _c; stage_rc(sl0, _r, _c); soff0 = (unsigned)(_r * K + _c); stage_rc(sl0 + 8192, _r, _c); soff1 = (unsigned)(_r * K + _c); }
  for (int tile = blockIdx.x; tile < nwg; tile += gridDim.x) {
    const int nig = WGM * nN, gid = tile / nig, fm = gid * WGM, gsz = min(nM - fm, WGM);
    const int pm = fm + ((tile % nig) % gsz), pn = (tile % nig) / gsz, brow = pm * BM, bcol = pn * BM;
    f32x4 acc[2][2][4][2] = {};
    bf16x8 At[4][2], B0[2][2], B1[2][2];
    STAGE(SB(0, 0), Bt, bcol, 0); STAGE(SA(0, 0), A, brow, 0);
    STAGE(SB(0, 1), Bt, bcol + HALF, 0); STAGE(SA(0, 1), A, brow + HALF, 0);
    if (wr == 1) BAR;
    WAIT_V(4); BAR;
    STAGE(SB(1, 0), Bt, bcol, 1); STAGE(SA(1, 0), A, brow, 1); STAGE(SB(1, 1), Bt, bcol + HALF, 1);
    WAIT_V(6); BAR;
    for (int t = 0; t < nt - 2; t += 2) {
      LDB(B0, 0, 0); SCHED; LDA(At, 0, 0); STAGE(SA(1, 1), A, brow + HALF, t + 1);
      WAIT_L(8); BAR; WAIT_L(0); MMA(0, 0, At, B0); BAR; SCHED;
      LDB(B1, 0, 1); STAGE(SB(0, 0), Bt, bcol, t + 2);
      BAR; WAIT_L(0); MMA(0, 1, At, B1); BAR;
      LDA(At, 0, 1); STAGE(SA(0, 0), A, brow, t + 2);
      BAR; WAIT_L(0); MMA(1, 0, At, B0); BAR; SCHED;
      STAGE(SB(0, 1), Bt, bcol + HALF, t + 2);
      WAIT_V(6); BAR; MMA(1, 1, At, B1); BAR;
      LDB(B0, 1, 0); SCHED; LDA(At, 1, 0); STAGE(SA(0, 1), A, brow + HALF, t + 2);
      WAIT_L(8); BAR; WAIT_L(0); MMA(0, 0, At, B0); BAR; SCHED;
      LDB(B1, 1, 1); STAGE(SB(1, 0), Bt, bcol, t + 3);
      BAR; WAIT_L(0); MMA(0, 1, At, B1); BAR;
      LDA(At, 1, 1); STAGE(SA(1, 0), A, brow, t + 3);
      BAR; WAIT_L(0); MMA(1, 0, At, B0); BAR; SCHED;
      STAGE(SB(1, 1), Bt, bcol + HALF, t + 3);
      WAIT_V(6); BAR; MMA(1, 1, At, B1); BAR;
    }
    { LDB(B0, 0, 0); LDA(At, 0, 0); STAGE(SA(1, 1), A, brow + HALF, nt - 1);
      BAR; WAIT_L(0); MMA(0, 0, At, B0); BAR;
      LDB(B1, 0, 1); BAR; WAIT_L(0); MMA(0, 1, At, B1); BAR;
      LDA(At, 0, 1); WAIT_V(4); BAR; WAIT_L(0); MMA(1, 0, At, B0); MMA(1, 1, At, B1); BAR; }
    { LDB(B0, 1, 0); LDA(At, 1, 0); WAIT_V(2); BAR; WAIT_L(0); MMA(0, 0, At, B0); BAR;
      LDB(B1, 1, 1); WAIT_V(0); BAR; WAIT_L(0); MMA(0, 1, At, B1); BAR;
      LDA(At, 1, 1); BAR; WAIT_L(0); MMA(1, 0, At, B0); MMA(1, 1, At, B1); BAR; }
    if (wr == 0) BAR;
    {
      const int le = llane();
      const int fr = le & 15, fq = le >> 4;
      const long base = (long)(brow + wr * 64) * LDC + bcol + wc * 32 + (unsigned)(fq * 4 * LDC + fr);
      if (MODE == 0 || (MODE == 2 && pn < 16)) {
        bf16_t* cp = (bf16_t*)Cout + base;
#pragma unroll
        for (int ai = 0; ai < 2; ++ai)
#pragma unroll
          for (int m = 0; m < 4; ++m)
#pragma unroll
            for (int j = 0; j < 4; ++j) {
              bf16_t* rp = cp + (ai * HALF + m * 16 + j) * LDC;
#pragma unroll
              for (int bj = 0; bj < 2; ++bj)
#pragma unroll
                for (int n = 0; n < 2; ++n) rp[bj * HALF + n * 16] = f2bf(acc[ai][bj][m][n][j]);
            }
      } else if (MODE == 1) {
        float* cp = (float*)Cout + base;
#pragma unroll
        for (int ai = 0; ai < 2; ++ai)
#pragma unroll
          for (int m = 0; m < 4; ++m)
#pragma unroll
            for (int j = 0; j < 4; ++j) {
              float* rp = cp + (ai * HALF + m * 16 + j) * LDC;
#pragma unroll
              for (int bj = 0; bj < 2; ++bj)
#pragma unroll
                for (int n = 0; n < 2; ++n) rp[bj * HALF + n * 16] = acc[ai][bj][m][n][j];
            }
      } else {
        if (wc == 0) {
          float* gp = GT + (long)(brow + wr * 64) * 32 + (unsigned)(fq * 4 * 32 + fr);
#pragma unroll
          for (int ai = 0; ai < 2; ++ai)
#pragma unroll
            for (int m = 0; m < 4; ++m)
#pragma unroll
              for (int j = 0; j < 4; ++j)
#pragma unroll
                for (int n = 0; n < 2; ++n) gp[(ai * HALF + m * 16 + j) * 32 + n * 16] = acc[ai][0][m][n][j];
        }
      }
    }
    __syncthreads();
  }
#undef SA
#undef SB
#undef STAGE
#undef LDA
#undef LDB
#undef MMA
}

__device__ __forceinline__ void post_inproj0(const int wv, const Params& p, const int zq, const bf16_t* __restrict__ P0, bf16_t* __restrict__ QA, bf16_t* __restrict__ KA,
                                             bf16_t* __restrict__ VA, float* __restrict__ VV, bf16_t* __restrict__ X0) {
  const int tidx = ltid(wv);
  const int wid = wv, lane = tidx & 63;
  const float* qn = p.in[zq + 21]; const float* kn = p.in[zq + 22]; const float* cw = p.in[zq + 23]; const float* cb = p.in[zq + 24];
  float* outK = p.out + O_K; float* outV = p.out + O_V;
  for (int i = blockIdx.x * 512 + tidx; i < 2 * 512 * 256 / 4; i += gridDim.x * 512) {
    int e = i * 4; int b = e / (512 * 256), rem = e % (512 * 256);
    float4 kk = *(const float4*)(p.in[zq + 2] + e); float4 vv = *(const float4*)(p.in[zq + 3] + e);
    long d = (long)(8192 + b * 2560 + 2048) * 256 + rem;
    u32x2 wk = {cvtpk(kk.x, kk.y), cvtpk(kk.z, kk.w)}; u32x2 wv = {cvtpk(vv.x, vv.y), cvtpk(vv.z, vv.w)};
    *(u32x2*)(KA + d) = wk; *(u32x2*)(VA + d) = wv;
  }
  const int fi = lane & 31;
  const float inv = exp2f(-(float)fi * (13.287712379549449f / 32.f));
  for (int row = blockIdx.x * 8 + wid; row < T_TOK; row += gridDim.x * 8) {
    const bool samp = row >= TPR;
    const int L = samp ? 2048 : 256;
    const int tl = samp ? (row - TPR) % 2048 : row % 256;
    const long krow = samp ? (long)(8192 + ((row - TPR) / 2048) * 2560 + tl) : (long)row;
    const bf16_t* base = P0 + (long)row * 2560;
    float cs = 1.f, sn = 0.f;
    if (samp) { float pos = (lane < 32) ? (float)(tl / 64) : (float)(tl % 64); float ang = pos * inv; cs = cosf(ang); sn = sinf(ang); }
#pragma unroll
    for (int hh = 0; hh < 6; ++hh) {
      float x1 = bf2f(base[hh * 128 + lane]), x2 = bf2f(base[hh * 128 + 64 + lane]);
      float ss = wave_sum(x1 * x1 + x2 * x2);
      float rs = rsqrtf(ss * (1.f / 128.f) + 1e-6f);
      const float* gw = hh < 4 ? qn : kn;
      float y1 = x1 * rs * gw[lane], y2 = x2 * rs * gw[64 + lane];
      if (hh >= 4 && !samp) { outK[(long)row * 256 + (hh - 4) * 128 + lane] = y1; outK[(long)row * 256 + (hh - 4) * 128 + 64 + lane] = y2; }
      float o1 = y1 * cs - y2 * sn, o2 = y1 * sn + y2 * cs;
      if (hh < 4) { QA[(long)row * 512 + hh * 128 + lane] = f2bf(o1); QA[(long)row * 512 + hh * 128 + 64 + lane] = f2bf(o2); }
      else { KA[krow * 256 + (hh - 4) * 128 + lane] = f2bf(o1); KA[krow * 256 + (hh - 4) * 128 + 64 + lane] = f2bf(o2); }
    }
    {
      u32x2 w = *(const u32x2*)(base + 768 + lane * 4);
      *(u32x2*)(VA + krow * 256 + lane * 4) = w;
      if (!samp) { float4 f = make_float4(bflo(w[0]), bfhi(w[0]), bflo(w[1]), bfhi(w[1])); *(float4*)(outV + (long)row * 256 + lane * 4) = f; }
    }
    {
      const int c8 = lane * 8;
      float uc[3][8];
#pragma unroll
      for (int g = 0; g < 3; ++g) {
        const int col = g * 512 + c8;
        float um[8], u0[8], up[8];
        u32x4 z4 = {0u, 0u, 0u, 0u};
        u32x4 wm = (tl > 0) ? *(const u32x4*)(base - 2560 + 1024 + col) : z4;
        u32x4 w0 = *(const u32x4*)(base + 1024 + col);
        u32x4 wp = (tl < L - 1) ? *(const u32x4*)(base + 2560 + 1024 + col) : z4;
        unpack8(wm, um); unpack8(w0, u0); unpack8(wp, up);
#pragma unroll
        for (int e = 0; e < 8; ++e)
          uc[g][e] = cw[col + e] * um[e] + cw[1536 + col + e] * u0[e] + cw[3072 + col + e] * up[e] + cb[col + e];
      }
      float vvv[8];
#pragma unroll
      for (int e = 0; e < 8; ++e) vvv[e] = uc[2][e] * uc[1][e];
      *(float4*)(VV + (long)row * 512 + c8) = make_float4(vvv[0], vvv[1], vvv[2], vvv[3]);
      *(float4*)(VV + (long)row * 512 + c8 + 4) = make_float4(vvv[4], vvv[5], vvv[6], vvv[7]);
      *(u32x4*)(X0 + (long)row * 512 + c8) = pack8(uc[0]);
    }
  }
}

constexpr int AD = 128, ANW = 8, QBLK = 32, KVBLK = 64;
constexpr float ASCALE = 0.088388347648318440f;
constexpr float ATHR = 8.f;
constexpr int LDQ = 512, LDK = 256, LDO = 1024;
constexpr size_t SHM_V = KVBLK * AD * 2, SHM_K = KVBLK * AD * 2;
#define KSWZ(row, colB) ((row) * 256 + ((colB) ^ (((row) & 7) << 4)))
#define SBAR() __builtin_amdgcn_sched_barrier(0)

__device__ __forceinline__ void partialSM(f32x16& p0, f32x16& p1, float& m_reg, float& mn, float& alpha) {
  constexpr float C = ASCALE * 1.4426950408889634f;
  float pmax = p0[0];
#pragma unroll
  for (int r = 1; r < 16; ++r) pmax = fmaxf(pmax, p0[r]);
#pragma unroll
  for (int r = 0; r < 16; ++r) pmax = fmaxf(pmax, p1[r]);
  { auto rr = __builtin_amdgcn_permlane32_swap(__float_as_uint(pmax), __float_as_uint(pmax), false, false);
    pmax = fmaxf(__uint_as_float(rr[0]), __uint_as_float(rr[1])); }
  if (__builtin_expect(__all(pmax - m_reg <= ATHR / ASCALE), 1)) { mn = m_reg; alpha = 1.f; }
  else { mn = fmaxf(m_reg, pmax); alpha = __builtin_amdgcn_exp2f((m_reg - mn) * C); m_reg = mn; }
  float mnC = -mn * C;
#pragma unroll
  for (int r = 0; r < 16; ++r) p0[r] = fmaf(p0[r], C, mnC);
#pragma unroll
  for (int r = 0; r < 16; ++r) p1[r] = fmaf(p1[r], C, mnC);
#pragma unroll
  for (int r = 0; r < 16; ++r) p0[r] = __builtin_amdgcn_exp2f(p0[r]);
}
__device__ __forceinline__ void finishSM(f32x16& p0, f32x16& p1, float alpha, float& l_reg, bf16x8& pa0, bf16x8& pa1, bf16x8& pa2, bf16x8& pa3) {
#pragma unroll
  for (int r = 0; r < 16; ++r) p1[r] = __builtin_amdgcn_exp2f(p1[r]);
  float ps = 0;
#pragma unroll
  for (int r = 0; r < 16; ++r) ps += p0[r];
#pragma unroll
  for (int r = 0; r < 16; ++r) ps += p1[r];
  { auto rr = __builtin_amdgcn_permlane32_swap(__float_as_uint(ps), __float_as_uint(ps), false, false);
    ps = __uint_as_float(rr[0]) + __uint_as_float(rr[1]); }
  l_reg = l_reg * alpha + ps;
#define PK4(P, BASE, OUT) do { unsigned a0 = cvtpk(P[BASE + 0], P[BASE + 1]), a1 = cvtpk(P[BASE + 2], P[BASE + 3]);   \
    unsigned b0 = cvtpk(P[BASE + 4], P[BASE + 5]), b1 = cvtpk(P[BASE + 6], P[BASE + 7]);                              \
    auto r0 = __builtin_amdgcn_permlane32_swap(a0, b0, false, false); auto r1 = __builtin_amdgcn_permlane32_swap(a1, b1, false, false); \
    u32x4 w = {r0[0], r1[0], r0[1], r1[1]}; OUT = *reinterpret_cast<bf16x8*>(&w); } while (0)
  PK4(p0, 0, pa0); PK4(p0, 8, pa1); PK4(p1, 0, pa2); PK4(p1, 8, pa3);
#undef PK4
}
__device__ __forceinline__ void qkt(f32x16& p0, f32x16& p1, const bf16_t* Ks, const bf16x8* qr, int r32, int hi) {
  p0 = f32x16{}; p1 = f32x16{};
#pragma unroll
  for (int d0 = 0; d0 < 8; ++d0) { int cb = (d0 * 16 + hi * 8) * 2;
    bf16x8 b0 = *reinterpret_cast<const bf16x8*>((const char*)Ks + KSWZ(r32, cb));
    bf16x8 b1 = *reinterpret_cast<const bf16x8*>((const char*)Ks + KSWZ(32 + r32, cb));
    p0 = __builtin_amdgcn_mfma_f32_32x32x16_bf16(b0, qr[d0], p0, 0, 0, 0);
    p1 = __builtin_amdgcn_mfma_f32_32x32x16_bf16(b1, qr[d0], p1, 0, 0, 0); }
}
__device__ __forceinline__ int v_st(int k, int c) { const int kk = (k & ~0xC) | ((k & 4) << 1) | ((k & 8) >> 1); return ((kk >> 3) * 4 + (c >> 5)) * 512 + ((kk & 7) * 32 + (c & 31)) * 2; }
__device__ __forceinline__ int v_rd_base(int lane) { return ((lane & 3) << 3) | (((lane >> 2) & 3) << 6) | (((lane >> 4) & 1) << 5) | (((lane >> 5) & 1) << 8); }
constexpr int v_rd_off(int d0, int ks, int half) { return d0 * 512 + ks * 4096 + half * 2048; }
template <int OFF> __device__ __forceinline__ s16x4 tr_read(int vb) {
  s16x4 r; asm volatile("ds_read_b64_tr_b16 %0, %1 offset:%2" : "=&v"(r) : "v"(vb), "i"(OFF) : "memory"); return r;
}
template <int D0> __device__ __forceinline__ void pv_one(f32x16& od, int vb, bf16x8 pa0, bf16x8 pa1, bf16x8 pa2, bf16x8 pa3) {
  const s16x4 l0 = tr_read<v_rd_off(D0, 0, 0)>(vb), h0 = tr_read<v_rd_off(D0, 0, 1)>(vb), l1 = tr_read<v_rd_off(D0, 1, 0)>(vb), h1 = tr_read<v_rd_off(D0, 1, 1)>(vb);
  const s16x4 l2 = tr_read<v_rd_off(D0, 2, 0)>(vb), h2 = tr_read<v_rd_off(D0, 2, 1)>(vb), l3 = tr_read<v_rd_off(D0, 3, 0)>(vb), h3 = tr_read<v_rd_off(D0, 3, 1)>(vb);
  asm volatile("s_waitcnt lgkmcnt(0)" ::: "memory"); SBAR();
#define PK(L, H) (bf16x8){L[0], L[1], L[2], L[3], H[0], H[1], H[2], H[3]}
  od = __builtin_amdgcn_mfma_f32_32x32x16_bf16(pa0, PK(l0, h0), od, 0, 0, 0);
  od = __builtin_amdgcn_mfma_f32_32x32x16_bf16(pa1, PK(l1, h1), od, 0, 0, 0);
  od = __builtin_amdgcn_mfma_f32_32x32x16_bf16(pa2, PK(l2, h2), od, 0, 0, 0);
  od = __builtin_amdgcn_mfma_f32_32x32x16_bf16(pa3, PK(l3, h3), od, 0, 0, 0);
#undef PK
}
__device__ __forceinline__ void pv_d0(f32x16* o, int vb, bf16x8 pa0, bf16x8 pa1, bf16x8 pa2, bf16x8 pa3) {
  pv_one<0>(o[0], vb, pa0, pa1, pa2, pa3); pv_one<1>(o[1], vb, pa0, pa1, pa2, pa3); pv_one<2>(o[2], vb, pa0, pa1, pa2, pa3); pv_one<3>(o[3], vb, pa0, pa1, pa2, pa3);
}

__device__ __forceinline__ void attn_dense_body(const int wv, const bf16_t* __restrict__ Qb, const bf16_t* __restrict__ Kh, const bf16_t* __restrict__ Vh,
                                                bf16_t* __restrict__ Ob, int seq, char* lds) {
  const int tidx = ltid(wv);
  const int tid = tidx, wid = wv, lane = tid & 63, r32 = lane & 31, hi = lane >> 5;
  bf16_t* V_lds = (bf16_t*)lds; bf16_t* K_lds = (bf16_t*)(lds + 2 * SHM_V);
  float* ws = (float*)(lds + 2 * SHM_V + 2 * SHM_K) + wid * 64; float* li_l = ws; float* al_l = ws + 32;
  float m_reg = -1e30f, l_reg = 0; f32x16 o[4] = {}; bf16x8 qr[8];
  const bf16_t* Qw = Qb + (long)(wid * QBLK + r32) * LDQ + hi * 8;
#pragma unroll
  for (int d0 = 0; d0 < 8; ++d0) qr[d0] = *reinterpret_cast<const bf16x8*>(Qw + d0 * 16);
  const int sr = tid >> 4, sc = (tid & 15) * 8, vst0 = v_st(sr, sc), vst1 = v_st(32 + sr, sc);
  const int vb0 = (int)(uintptr_t)V_lds + v_rd_base(lane);
  bf16x8 sA_vs0, sA_vs1, sA_ks0, sA_ks1, sB_vs0, sB_vs1, sB_ks0, sB_ks1;
#define SLOADA(k0) do { sA_vs0 = *(const bf16x8*)(&Vh[(long)((k0) + sr) * LDK + sc]); sA_vs1 = *(const bf16x8*)(&Vh[(long)((k0) + 32 + sr) * LDK + sc]); \
    sA_ks0 = *(const bf16x8*)(&Kh[(long)((k0) + sr) * LDK + sc]); sA_ks1 = *(const bf16x8*)(&Kh[(long)((k0) + 32 + sr) * LDK + sc]); } while (0)
#define SLOADB(k0) do { sB_vs0 = *(const bf16x8*)(&Vh[(long)((k0) + sr) * LDK + sc]); sB_vs1 = *(const bf16x8*)(&Vh[(long)((k0) + 32 + sr) * LDK + sc]); \
    sB_ks0 = *(const bf16x8*)(&Kh[(long)((k0) + sr) * LDK + sc]); sB_ks1 = *(const bf16x8*)(&Kh[(long)((k0) + 32 + sr) * LDK + sc]); } while (0)
#define SWRITEA(b) do { *(bf16x8*)((char*)V_lds + (b) * SHM_V + vst0) = sA_vs0; *(bf16x8*)((char*)V_lds + (b) * SHM_V + vst1) = sA_vs1; int kc = sc * 2; \
    *(bf16x8*)((char*)K_lds + (b) * SHM_K + KSWZ(sr, kc)) = sA_ks0; *(bf16x8*)((char*)K_lds + (b) * SHM_K + KSWZ(32 + sr, kc)) = sA_ks1; } while (0)
#define SWRITEB(b) do { *(bf16x8*)((char*)V_lds + (b) * SHM_V + vst0) = sB_vs0; *(bf16x8*)((char*)V_lds + (b) * SHM_V + vst1) = sB_vs1; int kc = sc * 2; \
    *(bf16x8*)((char*)K_lds + (b) * SHM_K + KSWZ(sr, kc)) = sB_ks0; *(bf16x8*)((char*)K_lds + (b) * SHM_K + KSWZ(32 + sr, kc)) = sB_ks1; } while (0)
#define SWAIT() asm volatile("s_waitcnt vmcnt(4)" ::: "memory")
#define RESC(a) do { if (__any((a) < 1.f)) { if (hi == 0) al_l[r32] = (a); asm volatile("s_waitcnt lgkmcnt(0)" ::: "memory"); \
    _Pragma("unroll") for (int d = 0; d < 4; ++d) _Pragma("unroll") for (int r = 0; r < 16; ++r) o[d][r] *= al_l[crow(r, hi)]; } } while (0)
  f32x16 pA0, pA1, pB0, pB1; float mnA, mnB, alA, alB; bf16x8 pa0, pa1, pa2, pa3; const int NT = seq / KVBLK;
  SLOADA(0); asm volatile("s_waitcnt vmcnt(0)" ::: "memory"); SWRITEA(0); __syncthreads();
  qkt(pA0, pA1, K_lds, qr, r32, hi); partialSM(pA0, pA1, m_reg, mnA, alA);
  SLOADB(KVBLK); if (2 < NT) SLOADA(2 * KVBLK);
  SWAIT(); SWRITEB(1); __syncthreads();
  for (int j = 1; j + 1 < NT; j += 2) {
    SBAR(); qkt(pB0, pB1, (bf16_t*)((char*)K_lds + SHM_K), qr, r32, hi);
    finishSM(pA0, pA1, alA, l_reg, pa0, pa1, pa2, pa3); SBAR();
    SLOADB((j + 2) * KVBLK); SBAR();
    pv_d0(o, vb0, pa0, pa1, pa2, pa3); partialSM(pB0, pB1, m_reg, mnB, alB);
    __syncthreads(); SWAIT(); SWRITEA(0);
    RESC(alB); __syncthreads();
    SBAR(); qkt(pA0, pA1, K_lds, qr, r32, hi);
    finishSM(pB0, pB1, alB, l_reg, pa0, pa1, pa2, pa3); SBAR();
    if (j + 3 < NT) SLOADA((j + 3) * KVBLK); SBAR();
    pv_d0(o, vb0 + (int)SHM_V, pa0, pa1, pa2, pa3); partialSM(pA0, pA1, m_reg, mnA, alA);
    __syncthreads(); SWAIT(); SWRITEB(1);
    RESC(alA); __syncthreads();
  }
  SBAR(); qkt(pB0, pB1, (bf16_t*)((char*)K_lds + SHM_K), qr, r32, hi);
  finishSM(pA0, pA1, alA, l_reg, pa0, pa1, pa2, pa3); SBAR();
  pv_d0(o, vb0, pa0, pa1, pa2, pa3); partialSM(pB0, pB1, m_reg, mnB, alB);
  __syncthreads(); RESC(alB);
  finishSM(pB0, pB1, alB, l_reg, pa0, pa1, pa2, pa3); SBAR();
  pv_d0(o, vb0 + (int)SHM_V, pa0, pa1, pa2, pa3);
  if (hi == 0) li_l[r32] = l_reg; asm volatile("s_waitcnt lgkmcnt(0)" ::: "memory");
  float rli[16];
#pragma unroll
  for (int r = 0; r < 16; ++r) rli[r] = __builtin_amdgcn_rcpf(li_l[crow(r, hi)]);
  bf16_t* Ow = Ob + (long)(wid * QBLK) * LDO;
#pragma unroll
  for (int r = 0; r < 16; ++r) { int orow = crow(r, hi);
#pragma unroll
    for (int d0 = 0; d0 < 4; ++d0) Ow[(long)orow * LDO + d0 * 32 + r32] = f2bf(o[d0][r] * rli[r]); }
#undef SLOADA
#undef SLOADB
#undef SWRITEA
#undef SWRITEB
#undef SWAIT
#undef RESC
}

__device__ __forceinline__ void hyena_item(const float* __restrict__ F, const float* __restrict__ VV, const bf16_t* __restrict__ X0,
                                           bf16_t* __restrict__ AO, long rowbase, int L, int c, int t0) {
  float y[16], ring[16];
#pragma unroll
  for (int i = 0; i < 16; ++i) { y[i] = 0.f; ring[i] = F[(long)(t0 + i + L - 1) * 512 + c]; }
  const float* vp = VV + rowbase * 512 + c;
  const float* fp = F + (long)(t0 + L - 2) * 512 + c;
  for (int s0 = 0; s0 < L; s0 += 16) {
#pragma unroll
    for (int j = 0; j < 16; ++j) {
      const float vs = vp[(long)(s0 + j) * 512];
      const float nf = fp[-(long)(s0 + j) * 512];
#pragma unroll
      for (int i = 0; i < 16; ++i) y[i] += ring[(i - j) & 15] * vs;
      ring[(15 - j) & 15] = nf;
    }
  }
#pragma unroll
  for (int i = 0; i < 16; ++i) {
    long row = rowbase + t0 + i;
    AO[row * 1024 + 512 + c] = f2bf(y[i] * bf2f(X0[row * 512 + c]));
  }
}

__device__ __forceinline__ void mix0_phase(const int wv, const Params& p, const int zq, const bf16_t* QA, const bf16_t* KA, const bf16_t* VA, const float* VV,
                                           const bf16_t* X0, const float* F256, const float* F2048, bf16_t* AO) {
  extern __shared__ __attribute__((aligned(16))) char shm_raw[];
#ifndef NO_ATTN
  for (int it = blockIdx.x; it < 192; it += gridDim.x) {
    long rowb, krow; int h, seqk;
    if (it < 64) { const int qb = it % 8, b = it / 32; h = (it / 8) % 4; rowb = 8192 + (long)b * 2048 + qb * 256; krow = 8192 + (long)b * 2560; seqk = 2560; }
    else { const int j = it - 64; const int b = j / 4; h = j % 4; rowb = (long)b * 256; krow = rowb; seqk = 256; }
    __syncthreads();
    attn_dense_body(wv, QA + rowb * 512 + h * 128, KA + krow * 256 + (h >> 1) * 128, VA + krow * 256 + (h >> 1) * 128, AO + rowb * 1024 + h * 128, seqk, shm_raw);
  }
#endif
#ifndef NO_HYENA
  const int lane = llane(); const int wid = wv;
  for (int it = (blockIdx.x + gridDim.x - 64) % gridDim.x; it < 768; it += gridDim.x) {
    if (it < 256) {
      const int b = it / 128, cgp = (it / 16) % 8, tg = it % 16;
      hyena_item(F2048, VV, X0, AO, 8192 + (long)b * 2048, 2048, cgp * 64 + lane, tg * 128 + wid * 16);
    } else {
      const int j = it - 256; const int b = j / 16, cgp = (j / 2) % 8, tg = j % 2;
      hyena_item(F256, VV, X0, AO, (long)b * 256, 256, cgp * 64 + lane, tg * 128 + wid * 16);
    }
  }
#endif
  __syncthreads();
}

__device__ __forceinline__ float gelu_f(float x) { return 0.5f * x * (1.f + erff(x * 0.70710678118654752f)); }
__device__ __forceinline__ void ffn_act_phase(const int wv, const bf16_t* __restrict__ P, const float* __restrict__ cw, const float* __restrict__ cb, bf16_t* __restrict__ G) {
  const int tidx = ltid(wv);
  const int tid = tidx;
  if (tid >= 352) return;
  const int c8 = tid * 8;
  float w1[3][8], w2[3][8], b1[8], b2[8];
#pragma unroll
  for (int e = 0; e < 8; ++e) {
#pragma unroll
    for (int k = 0; k < 3; ++k) { w1[k][e] = cw[k * 5632 + c8 + e]; w2[k][e] = cw[k * 5632 + 2816 + c8 + e]; }
    b1[e] = cb[c8 + e]; b2[e] = cb[2816 + c8 + e];
  }
  for (int item = blockIdx.x; item < T_TOK / 16; item += gridDim.x) {
    const int r0 = item * 16;
    const int L = r0 < TPR ? 256 : 2048;
    const int tl0 = r0 < TPR ? r0 % 256 : (r0 - TPR) % 2048;
    float am[8], a0[8], ap[8], gm[8], g0[8], gp[8];
    const u32x4 z4 = {0u, 0u, 0u, 0u};
    {
      const bf16_t* b = P + (long)r0 * 5632 + c8;
      u32x4 x = (tl0 > 0) ? *(const u32x4*)(b - 5632) : z4; unpack8(x, am);
      x = (tl0 > 0) ? *(const u32x4*)(b - 5632 + 2816) : z4; unpack8(x, gm);
      x = *(const u32x4*)(b); unpack8(x, a0);
      x = *(const u32x4*)(b + 2816); unpack8(x, g0);
    }
    for (int r = 0; r < 16; ++r) {
      const bf16_t* b = P + (long)(r0 + r) * 5632 + c8;
      const bool vn = (tl0 + r) < L - 1;
      u32x4 x = vn ? *(const u32x4*)(b + 5632) : z4; unpack8(x, ap);
      x = vn ? *(const u32x4*)(b + 5632 + 2816) : z4; unpack8(x, gp);
      float o[8];
#pragma unroll
      for (int e = 0; e < 8; ++e) {
        float h1 = w1[0][e] * am[e] + w1[1][e] * a0[e] + w1[2][e] * ap[e] + b1[e];
        float h2 = w2[0][e] * gm[e] + w2[1][e] * g0[e] + w2[2][e] * gp[e] + b2[e];
        o[e] = gelu_f(h1) * h2;
        am[e] = a0[e]; a0[e] = ap[e]; gm[e] = g0[e]; g0[e] = gp[e];
      }
      *(u32x4*)(G + (long)(r0 + r) * 2816 + c8) = pack8(o);
    }
  }
}

__device__ __forceinline__ f32x16 mma_nt(const bf16_t* A, int lda, const bf16_t* B, int ldb, int K, f32x16 acc, int r32, int hi) {
  for (int k0 = 0; k0 < K; k0 += 16) {
    bf16x8 a = *reinterpret_cast<const bf16x8*>(A + r32 * lda + k0 + 8 * hi);
    bf16x8 b = *reinterpret_cast<const bf16x8*>(B + r32 * ldb + k0 + 8 * hi);
    acc = __builtin_amdgcn_mfma_f32_32x32x16_bf16(a, b, acc, 0, 0, 0);
  }
  return acc;
}

__device__ __forceinline__ void mlstm_phase(const int wv, const Params& p, const int zq, const bf16_t* __restrict__ P1, const float* __restrict__ GT,
                                            bf16_t* __restrict__ HF, bf16_t* __restrict__ HB) {
  const int tidx = ltid(wv);
  extern __shared__ __attribute__((aligned(16))) char shm_raw[];
  bf16_t* Qs = (bf16_t*)shm_raw;
  bf16_t* Ks = Qs + 64 * 136;
  bf16_t* KwT = Ks + 64 * 136;
  bf16_t* VsT = KwT + 128 * 72;
  bf16_t* Wb = VsT + 128 * 72;
  bf16_t* Cb = Wb + 64 * 72;
  float* av = (float*)(Cb + 128 * 136);
  float* Mv = av + 64; float* bv = Mv + 64; float* sclv = bv + 64; float* wintv = sclv + 64; float* nvec = wintv + 64; float* scal = nvec + 128;
  float* cwl = scal + 8;
  const int tid = tidx, wid = wv, lane = tid & 63, r32 = lane & 31, hi = lane >> 5;
  const float* cw = p.in[zq + 35]; const float* cbias = p.in[zq + 36]; const float* bg = p.in[zq + 34];
  for (int u = blockIdx.x; u < 544; u += gridDim.x) {
    int seq, h, dir;
    if (u < 32) { seq = 32 + u / 16; h = (u / 2) % 8; dir = u % 2; } else { int j = u - 32; seq = j / 16; h = (j / 2) % 8; dir = j % 2; }
    const int L = seq < 32 ? 256 : 2048;
    const long rowbase = seq < 32 ? (long)seq * 256 : 8192 + (long)(seq - 32) * 2048;
    __syncthreads();
    f32x16 cacc[2]; float m = 0.f;
    const int vb2 = wid >> 1;
    if (seq >= 32) {
      const int b = seq - 32;
      const float* Cin = p.in[zq + 4] + (long)((b * 2 + dir) * 8 + h) * 16384;
#pragma unroll
      for (int i = 0; i < 2; ++i) { const int kb = (wid & 1) * 2 + i;
#pragma unroll
        for (int r = 0; r < 16; ++r) cacc[i][r] = Cin[(vb2 * 32 + crow(r, hi)) * 128 + kb * 32 + r32]; }
      if (tid < 128) nvec[tid] = p.in[zq + 5][((b * 2 + dir) * 8 + h) * 128 + tid];
      m = p.in[zq + 6][(b * 2 + dir) * 8 + h];
    } else {
#pragma unroll
      for (int i = 0; i < 2; ++i)
#pragma unroll
        for (int r = 0; r < 16; ++r) cacc[i][r] = 0.f;
      if (tid < 128) nvec[tid] = 0.f;
    }
#pragma unroll
    for (int i = 0; i < 2; ++i) { const int kb = (wid & 1) * 2 + i;
#pragma unroll
      for (int r = 0; r < 16; ++r) Cb[(vb2 * 32 + crow(r, hi)) * 136 + kb * 32 + r32] = f2bf(cacc[i][r]); }
    if (tid < 256) {
      const int col = (tid < 128) ? (h * 128 + tid) : (1024 + h * 128 + (tid - 128));
      cwl[tid] = cw[col]; cwl[256 + tid] = cw[2048 + col]; cwl[512 + tid] = cw[4096 + col]; cwl[768 + tid] = cbias[col];
    }
    const float bgi = bg[dir * 8 + h], bgf = bg[16 + dir * 8 + h];
    __syncthreads();
    const int nch = L / 64;
    for (int ch = 0; ch < nch; ++ch) {
      float kf[2][8];
      const int c8 = (tid & 15) * 8;
#pragma unroll
      for (int i = 0; i < 2; ++i) {
        const int r = (tid >> 4) + 32 * i;
        const int tc = ch * 64 + r;
        const int pos = dir ? (L - 1 - tc) : tc;
        const bf16_t* rowp = P1 + (rowbase + pos) * 4096;
        const u32x4 z4 = {0u, 0u, 0u, 0u};
        float um[8], u0[8], up[8], qf[8];
        { u32x4 wm = (pos > 0) ? *(const u32x4*)(rowp - 4096 + h * 128 + c8) : z4;
          u32x4 w0 = *(const u32x4*)(rowp + h * 128 + c8);
          u32x4 wp = (pos < L - 1) ? *(const u32x4*)(rowp + 4096 + h * 128 + c8) : z4;
          unpack8(wm, um); unpack8(w0, u0); unpack8(wp, up);
#pragma unroll
          for (int e = 0; e < 8; ++e) qf[e] = silu_f(cwl[c8 + e] * um[e] + cwl[256 + c8 + e] * u0[e] + cwl[512 + c8 + e] * up[e] + cwl[768 + c8 + e]);
          *(u32x4*)(Qs + r * 136 + c8) = pack8(qf); }
        { u32x4 wm = (pos > 0) ? *(const u32x4*)(rowp - 4096 + 1024 + h * 128 + c8) : z4;
          u32x4 w0 = *(const u32x4*)(rowp + 1024 + h * 128 + c8);
          u32x4 wp = (pos < L - 1) ? *(const u32x4*)(rowp + 4096 + 1024 + h * 128 + c8) : z4;
          unpack8(wm, um); unpack8(w0, u0); unpack8(wp, up);
#pragma unroll
          for (int e = 0; e < 8; ++e) kf[i][e] = 0.088388347648318440f * silu_f(cwl[128 + c8 + e] * um[e] + cwl[256 + 128 + c8 + e] * u0[e] + cwl[512 + 128 + c8 + e] * up[e] + cwl[768 + 128 + c8 + e]);
          *(u32x4*)(Ks + r * 136 + c8) = pack8(kf[i]); }
        { u32x4 wv = *(const u32x4*)(rowp + 2048 + h * 128 + c8);
          VsT[(c8 + 0) * 72 + r] = (bf16_t)(wv[0] & 0xffff); VsT[(c8 + 1) * 72 + r] = (bf16_t)(wv[0] >> 16);
          VsT[(c8 + 2) * 72 + r] = (bf16_t)(wv[1] & 0xffff); VsT[(c8 + 3) * 72 + r] = (bf16_t)(wv[1] >> 16);
          VsT[(c8 + 4) * 72 + r] = (bf16_t)(wv[2] & 0xffff); VsT[(c8 + 5) * 72 + r] = (bf16_t)(wv[2] >> 16);
          VsT[(c8 + 6) * 72 + r] = (bf16_t)(wv[3] & 0xffff); VsT[(c8 + 7) * 72 + r] = (bf16_t)(wv[3] >> 16); }
      }
      if (wid == 0) {
        const int tc = ch * 64 + lane; const int pos = dir ? (L - 1 - tc) : tc;
        const float* gr = GT + (rowbase + pos) * 32;
        const float ic = gr[dir * 8 + h] + bgi;
        const float fp = gr[16 + dir * 8 + h] + bgf;
        const float lf = fminf(fp, 0.f) - log1pf(expf(-fabsf(fp)));
        float bc = lf;
#pragma unroll
        for (int off = 1; off < 64; off <<= 1) { float t = __shfl_up(bc, off); if (lane >= off) bc += t; }
        const float a = ic - bc;
        float pm = a;
#pragma unroll
        for (int off = 1; off < 64; off <<= 1) { float t = __shfl_up(pm, off); if (lane >= off) pm = fmaxf(pm, t); }
        const float M = fmaxf(m, pm);
        av[lane] = a; Mv[lane] = M; bv[lane] = bc;
        if (lane == 63) { scal[0] = M; scal[1] = bc; }
      }
      __syncthreads();
      const float M63 = scal[0], b63 = scal[1];
      const float m_new = b63 + M63;
      const float w_state = __expf(m - M63);
#pragma unroll
      for (int i = 0; i < 2; ++i) {
        const int r = (tid >> 4) + 32 * i;
        const float wt = __expf(av[r] - M63);
#pragma unroll
        for (int e = 0; e < 8; ++e) KwT[(c8 + e) * 72 + r] = f2bf(kf[i][e] * wt);
      }
      __syncthreads();
      const int tb = wid & 1, vb = wid >> 1;
      if (wid < 4) {
        const int sb = wid >> 1;
        f32x16 s = {};
        if (sb <= tb) s = mma_nt(Qs + tb * 32 * 136, 136, Ks + sb * 32 * 136, 136, 128, s, r32, hi);
        const int sc = sb * 32 + r32; const float as = av[sc];
#pragma unroll
        for (int r = 0; r < 16; ++r) {
          const int t = tb * 32 + crow(r, hi);
          float w = (sc <= t) ? s[r] * __expf(as - Mv[t]) : 0.f;
          Wb[t * 72 + sc] = f2bf(w);
        }
      }
      f32x16 inter = {};
      inter = mma_nt(Qs + tb * 32 * 136, 136, Cb + vb * 32 * 136, 136, 128, inter, r32, hi);
      __syncthreads();
      {
        const int t = tid >> 3, part = tid & 7;
        float wsum[8]; unpack8(*(const u32x4*)(Wb + t * 72 + part * 8), wsum);
        float dw = 0.f;
#pragma unroll
        for (int e = 0; e < 8; ++e) dw += wsum[e];
        float q0[8], q1[8]; unpack8(*(const u32x4*)(Qs + t * 136 + part * 16), q0); unpack8(*(const u32x4*)(Qs + t * 136 + part * 16 + 8), q1);
        float dq = 0.f;
#pragma unroll
        for (int e = 0; e < 8; ++e) dq += q0[e] * nvec[part * 16 + e] + q1[e] * nvec[part * 16 + 8 + e];
        dw += __shfl_xor(dw, 1); dw += __shfl_xor(dw, 2); dw += __shfl_xor(dw, 4);
        dq += __shfl_xor(dq, 1); dq += __shfl_xor(dq, 2); dq += __shfl_xor(dq, 4);
        if (part == 0) {
          const float Mt = Mv[t];
          const float wint = __expf(m - Mt);
          const float den = wint * dq + dw;
          const float mt = bv[t] + Mt;
          sclv[t] = 1.f / fmaxf(fabsf(den), __expf(-mt));
          wintv[t] = wint;
        }
      }
      __syncthreads();
      {
        f32x16 num;
#pragma unroll
        for (int r = 0; r < 16; ++r) num[r] = inter[r] * wintv[tb * 32 + crow(r, hi)];
        num = mma_nt(Wb + tb * 32 * 72, 72, VsT + vb * 32 * 72, 72, 64, num, r32, hi);
        bf16_t* Hout = dir ? HB : HF;
#pragma unroll
        for (int r = 0; r < 16; ++r) {
          const int t = tb * 32 + crow(r, hi);
          const int tc = ch * 64 + t; const int pos = dir ? (L - 1 - tc) : tc;
          Hout[(rowbase + pos) * 1024 + h * 128 + vb * 32 + r32] = f2bf(num[r] * sclv[t]);
        }
      }
#pragma unroll
      for (int i = 0; i < 2; ++i) {
        const int kb = (wid & 1) * 2 + i;
#pragma unroll
        for (int r = 0; r < 16; ++r) cacc[i][r] *= w_state;
        cacc[i] = mma_nt(VsT + vb2 * 32 * 72, 72, KwT + kb * 32 * 72, 72, 64, cacc[i], r32, hi);
#pragma unroll
        for (int r = 0; r < 16; ++r) Cb[(vb2 * 32 + crow(r, hi)) * 136 + kb * 32 + r32] = f2bf(cacc[i][r]);
      }
      if (tid < 128) {
        float s = 0.f;
#pragma unroll
        for (int q = 0; q < 8; ++q) { float f[8]; unpack8(*(const u32x4*)(KwT + tid * 72 + q * 8), f);
#pragma unroll
          for (int e = 0; e < 8; ++e) s += f[e]; }
        nvec[tid] = w_state * nvec[tid] + s;
      }
      m = m_new;
      __syncthreads();
    }
    if (seq < 32) {
      float* Co = p.out + O_C + (long)((seq * 2 + dir) * 8 + h) * 16384;
#pragma unroll
      for (int i = 0; i < 2; ++i) { const int kb = (wid & 1) * 2 + i;
#pragma unroll
        for (int r = 0; r < 16; ++r) Co[(vb2 * 32 + crow(r, hi)) * 128 + kb * 32 + r32] = cacc[i][r]; }
      if (tid < 128) p.out[O_N + ((seq * 2 + dir) * 8 + h) * 128 + tid] = nvec[tid];
      if (tid == 0) p.out[O_M + (seq * 2 + dir) * 8 + h] = m;
    }
  }
  __syncthreads();
}

__device__ __forceinline__ void mlstm_post(const int wv, const Params& p, const int zq, const bf16_t* __restrict__ HF, const bf16_t* __restrict__ HB,
                                           const bf16_t* __restrict__ P1, bf16_t* __restrict__ A) {
  const int tidx = ltid(wv);
  const int wid = wv, lane = tidx & 63;
  const float* hn = p.in[zq + 37];
  for (int row = blockIdx.x * 8 + wid; row < T_TOK; row += gridDim.x * 8) {
    float hv[16], t0[8], t1[8];
    unpack8(*(const u32x4*)(HF + (long)row * 1024 + lane * 16), hv); unpack8(*(const u32x4*)(HF + (long)row * 1024 + lane * 16 + 8), hv + 8);
    unpack8(*(const u32x4*)(HB + (long)row * 1024 + lane * 16), t0); unpack8(*(const u32x4*)(HB + (long)row * 1024 + lane * 16 + 8), t1);
    float ss = 0.f;
#pragma unroll
    for (int e = 0; e < 8; ++e) { hv[e] += t0[e]; hv[8 + e] += t1[e]; }
#pragma unroll
    for (int e = 0; e < 16; ++e) ss += hv[e] * hv[e];
    ss += __shfl_xor(ss, 1); ss += __shfl_xor(ss, 2); ss += __shfl_xor(ss, 4);
    const float rs = rsqrtf(ss * (1.f / 128.f) + 1e-6f);
    float ov[16];
    unpack8(*(const u32x4*)(P1 + (long)row * 4096 + 3072 + lane * 16), ov); unpack8(*(const u32x4*)(P1 + (long)row * 4096 + 3072 + lane * 16 + 8), ov + 8);
    float y[16];
#pragma unroll
    for (int e = 0; e < 16; ++e) y[e] = hv[e] * rs * hn[lane * 16 + e] * (1.f / (1.f + __expf(-ov[e])));
    *(u32x4*)(A + (long)row * 1024 + lane * 16) = pack8(y);
    *(u32x4*)(A + (long)row * 1024 + lane * 16 + 8) = pack8(y + 8);
  }
}

__device__ __forceinline__ void gsync(const int wv, unsigned* bar, unsigned target) {
  const int tidx = ltid(wv);
  __syncthreads();
  if (tidx == 0) {
    __threadfence();
    __hip_atomic_fetch_add(bar, 1u, __ATOMIC_RELEASE, __HIP_MEMORY_SCOPE_AGENT);
    while (__hip_atomic_load(bar, __ATOMIC_ACQUIRE, __HIP_MEMORY_SCOPE_AGENT) < target) __builtin_amdgcn_s_sleep(2);
    __threadfence();
  }
  __syncthreads();
}

__global__ void __launch_bounds__(512) mega(Params p, int ph_lo, int ph_hi) {
  const int wv = __builtin_amdgcn_readfirstlane(threadIdx.x >> 6);
  if (ph_hi < 0) { cg::this_grid().sync(); }
  unsigned* bar = (unsigned*)(p.ws + WS_END);
  char* ws = p.ws;
  bf16_t* Wt_in0 = (bf16_t*)(ws + OFF_WIN0); bf16_t* Wt_out0 = (bf16_t*)(ws + OFF_WOUT0);
  bf16_t* Wt_up0 = (bf16_t*)(ws + OFF_WUP0); bf16_t* Wt_up1 = (bf16_t*)(ws + OFF_WUP1);
  bf16_t* Wt_dn0 = (bf16_t*)(ws + OFF_WDN0); bf16_t* Wt_dn1 = (bf16_t*)(ws + OFF_WDN1);
  bf16_t* Wt_in1 = (bf16_t*)(ws + OFF_WIN1); bf16_t* Wt_out1 = (bf16_t*)(ws + OFF_WOUT1);
  float* modv = (float*)(ws + OFF_MOD);
  char* Pr = ws + OFF_P; char* Gr = ws + OFF_G;
  bf16_t* Pb = (bf16_t*)Pr; float* R = (float*)Pr;
  bf16_t* QA = (bf16_t*)(Pr + P_QA); bf16_t* KA = (bf16_t*)(Pr + P_KA); bf16_t* VA = (bf16_t*)(Pr + P_VA); bf16_t* X0 = (bf16_t*)(Pr + P_X0);
  float* GT = (float*)(Pr + P_GT); bf16_t* A2 = (bf16_t*)(Pr + P_A2);
  bf16_t* A = (bf16_t*)Gr; bf16_t* Gb = (bf16_t*)Gr; float* VV = (float*)(Gr + G_VV);
  bf16_t* HF = (bf16_t*)Gr; bf16_t* HB = (bf16_t*)(Gr + G_HB);
  float* X = p.out;
  float* F256 = p.out + O_C + 512; float* F2048 = p.out + O_C + 512 * 512 + 512;
  const float* mod0 = modv; const float* mod1 = modv + 3 * 6144;
#ifdef ONLY
#define PH(i, ...) if ((i) == ONLY) { const int zq = opq(); __VA_ARGS__; gsync(wv, bar, gridDim.x); }
#else
#define PH(i, ...) if (ph_lo <= (i) && (i) < ph_hi) { const int zq = opq(); __VA_ARGS__; if ((i) + 1 < ph_hi) gsync(wv, bar, (unsigned)((i) + 1 - ph_lo) * gridDim.x); }
#endif
  PH(0, {
    conv_w(wv, p.in[zq + 19], Wt_in0, 1024, 2560, 2560);
    conv_w(wv, p.in[zq + 20], Wt_out0, 1024, 1024, 1024);
    conv_w(wv, p.in[zq + 15], Wt_up0, 1024, 5632, 5632);
    conv_w(wv, p.in[zq + 15] + (long)1024 * 5632, Wt_up1, 1024, 5632, 5632);
    conv_w(wv, p.in[zq + 18], Wt_dn0, 2816, 1024, 1024);
    conv_w(wv, p.in[zq + 18] + (long)2816 * 1024, Wt_dn1, 2816, 1024, 1024);
    conv_w(wv, p.in[zq + 33], Wt_in1, 1024, 4128, 4352);
    conv_w(wv, p.in[zq + 38], Wt_out1, 1024, 1024, 1024);
    mod_phase(wv, p, zq, modv);
    filt_phase(wv, p, zq, F256, F2048);
  })
  PH(1, (row_phase<true, false, true>(wv, p, zq, nullptr, nullptr, mod0, 0, nullptr, p.in[zq + 11], mod0, 0, A)))
  PH(2, (gemm_phase<0, 2560>(wv, A, Wt_in0, 2560, 1024, Pb, nullptr)))
  PH(3, post_inproj0(wv, p, zq, Pb, QA, KA, VA, VV, X0))
  PH(4, mix0_phase(wv, p, zq, QA, KA, VA, VV, X0, F256, F2048, A))
  PH(5, (gemm_phase<1, 1024>(wv, A, Wt_out0, 1024, 1024, R, nullptr)))
  PH(6, (row_phase<true, true, true>(wv, p, zq, R, p.in[zq + 12], mod0, 2, X, p.in[zq + 13], mod0, 3, A)))
  PH(7, (gemm_phase<0, 5632>(wv, A, Wt_up0, 5632, 1024, Pb, nullptr)))
  PH(8, ffn_act_phase(wv, Pb, p.in[zq + 16], p.in[zq + 17], Gb))
  PH(9, (gemm_phase<1, 1024>(wv, Gb, Wt_dn0, 1024, 2816, R, nullptr)))
  PH(10, (row_phase<false, true, true>(wv, p, zq, R, p.in[zq + 14], mod0, 5, X, p.in[zq + 11] + 1024, mod1, 0, A)))
  PH(11, (gemm_phase<2, 4096>(wv, A, Wt_in1, 4352, 1024, Pb, GT)))
  PH(12, {})
  PH(13, mlstm_phase(wv, p, zq, Pb, GT, HF, HB))
  PH(14, mlstm_post(wv, p, zq, HF, HB, Pb, A2))
  PH(15, (gemm_phase<1, 1024>(wv, A2, Wt_out1, 1024, 1024, R, nullptr)))
  PH(16, (row_phase<false, true, true>(wv, p, zq, R, p.in[zq + 12] + 1024, mod1, 2, X, p.in[zq + 13] + 1024, mod1, 3, A)))
  PH(17, (gemm_phase<0, 5632>(wv, A, Wt_up1, 5632, 1024, Pb, nullptr)))
  PH(18, ffn_act_phase(wv, Pb, p.in[zq + 16] + 3 * 5632, p.in[zq + 17] + 5632, Gb))
  PH(19, (gemm_phase<1, 1024>(wv, Gb, Wt_dn1, 1024, 2816, R, nullptr)))
  PH(20, (row_phase<false, true, false>(wv, p, zq, R, p.in[zq + 14] + 1024, mod1, 5, X, nullptr, mod1, 0, nullptr)))
#undef PH
}

extern "C" void kernel_launch(void* const* d_in, const int* in_sizes, int n_in, void* d_out, int out_size, void* d_ws, size_t ws_size,
                              hipStream_t stream) {
  static int grid_blocks = 0;
  if (!grid_blocks) {
    if (ws_size < WS_END + 256) fprintf(stderr, "kernel_launch: workspace too small: %zu < %zu\n", ws_size, (size_t)WS_END);
    hipFuncSetAttribute((const void*)mega, hipFuncAttributeMaxDynamicSharedMemorySize, LDS_BYTES);
    int dev = 0, cus = 0, per = 0;
    hipGetDevice(&dev);
    hipDeviceGetAttribute(&cus, hipDeviceAttributeMultiprocessorCount, dev);
    hipOccupancyMaxActiveBlocksPerMultiprocessor(&per, mega, 512, LDS_BYTES);
    if (per < 1) { fprintf(stderr, "kernel_launch: occupancy query returned %d\n", per); per = 1; }
    grid_blocks = cus;
  }
  Params p{};
  for (int i = 0; i < 39; ++i) p.in[i] = (const float*)d_in[i];
  p.out = (float*)d_out; p.ws = (char*)d_ws;
  int lo = 0, hi = NPH;
  (void)hipMemsetAsync((char*)d_ws + WS_END, 0, 256, stream);
  void* args[] = {&p, &lo, &hi};
  hipError_t e = hipLaunchCooperativeKernel((void*)mega, dim3(grid_blocks), dim3(512), args, LDS_BYTES, stream);
  if (e != hipSuccess) fprintf(stderr, "cooperative launch failed: %s (grid %d)\n", hipGetErrorString(e), grid_blocks);
}
```

```cpp
#include <hip/hip_runtime.h>
#include <hip/hip_cooperative_groups.h>
#include <cstdio>
#include <cstdint>
namespace cg = cooperative_groups;

typedef unsigned short bf16_t;
typedef short bf16x8 __attribute__((ext_vector_type(8)));
typedef short s16x4 __attribute__((ext_vector_type(4)));
typedef float f32x4 __attribute__((ext_vector_type(4)));
typedef float f32x8 __attribute__((ext_vector_type(8)));
typedef float f32x16 __attribute__((ext_vector_type(16)));
typedef unsigned u32x4 __attribute__((ext_vector_type(4)));
typedef unsigned u32x2 __attribute__((ext_vector_type(2)));

constexpr int T_TOK = 12288, TPR = 8192;
constexpr int LDS_BYTES = 131072;
constexpr int NPH = 21;

constexpr size_t OFF_WIN0 = 0, OFF_WOUT0 = 5242880, OFF_WUP0 = 7340032, OFF_WUP1 = 18874368, OFF_WDN0 = 30408704,
                 OFF_WDN1 = 36175872, OFF_WIN1 = 41943040, OFF_WOUT1 = 50855936, OFF_MOD = 52953088, OFF_P = 53100544,
                 OFF_G = 191512576, WS_END = 260718592;
constexpr size_t P_QA = 62914560, P_KA = 75497472, P_VA = 82313216, P_X0 = 89128960;
constexpr size_t P_GT = 100663296, P_A2 = 102236160;
constexpr size_t G_VV = 25165824, G_HB = 25165824;
constexpr size_t O_K = 12582912, O_V = 14680064, O_C = 16777216, O_N = 25165824, O_M = 25231360;

struct Params { const float* in[39]; float* out; char* ws; };

__device__ __forceinline__ unsigned cvtpk(float lo, float hi) {
  unsigned r; asm("v_cvt_pk_bf16_f32 %0, %1, %2" : "=v"(r) : "v"(lo), "v"(hi)); return r;
}
__device__ __forceinline__ bf16_t f2bf(float f) { return (bf16_t)(cvtpk(f, 0.f) & 0xffffu); }
__device__ __forceinline__ float bf2f(bf16_t h) { return __uint_as_float(((unsigned)h) << 16); }
__device__ __forceinline__ float bflo(unsigned w) { return __uint_as_float(w << 16); }
__device__ __forceinline__ float bfhi(unsigned w) { return __uint_as_float(w & 0xffff0000u); }
__device__ __forceinline__ float wave_sum(float v) {
#pragma unroll
  for (int o = 32; o > 0; o >>= 1) v += __shfl_xor(v, o);
  return v;
}
__device__ __forceinline__ int llane() { int l; asm volatile("v_mbcnt_lo_u32_b32 %0, -1, 0\n\tv_mbcnt_hi_u32_b32 %0, -1, %0" : "=v"(l)); return l; }
__device__ __forceinline__ int ltid(int wv) { return (wv << 6) | llane(); }
__device__ __forceinline__ int opq() { int z; asm volatile("s_mov_b32 %0, 0" : "=s"(z)); return z; }
__device__ __forceinline__ float silu_f(float x) { return x / (1.f + __expf(-x)); }
__device__ __forceinline__ int crow(int r, int hi) { return (r & 3) + 8 * (r >> 2) + 4 * hi; }
__device__ __forceinline__ void unpack8(u32x4 w, float* f) {
  f[0] = bflo(w[0]); f[1] = bfhi(w[0]); f[2] = bflo(w[1]); f[3] = bfhi(w[1]);
  f[4] = bflo(w[2]); f[5] = bfhi(w[2]); f[6] = bflo(w[3]); f[7] = bfhi(w[3]);
}
__device__ __forceinline__ u32x4 pack8(const float* f) {
  u32x4 w = {cvtpk(f[0], f[1]), cvtpk(f[2], f[3]), cvtpk(f[4], f[5]), cvtpk(f[6], f[7])}; return w;
}

__device__ __forceinline__ void conv_w(const int wv, const float* __restrict__ W, bf16_t* __restrict__ Wt, int K, int N, int NP) {
  const int tidx = ltid(wv);
  extern __shared__ __attribute__((aligned(16))) char shm_raw[];
  float* tl = (float*)shm_raw;
  const int tid = tidx;
  const int ntn = NP / 64, ntiles = (K / 64) * ntn;
  for (int tile = blockIdx.x; tile < ntiles; tile += gridDim.x) {
    const int k0 = (tile / ntn) * 64, n0 = (tile % ntn) * 64;
    __syncthreads();
#pragma unroll
    for (int i = 0; i < 2; ++i) {
      int kr = (tid >> 4) + 32 * i, nc = (tid & 15) * 4;
      float4 v = make_float4(0.f, 0.f, 0.f, 0.f);
      if (n0 + nc < N) v = *(const float4*)(W + (long)(k0 + kr) * N + n0 + nc);
      float* d = tl + kr * 65 + nc; d[0] = v.x; d[1] = v.y; d[2] = v.z; d[3] = v.w;
    }
    __syncthreads();
    {
      int n = tid >> 3, kg = (tid & 7) * 8;
      u32x4 w;
      w[0] = cvtpk(tl[(kg + 0) * 65 + n], tl[(kg + 1) * 65 + n]);
      w[1] = cvtpk(tl[(kg + 2) * 65 + n], tl[(kg + 3) * 65 + n]);
      w[2] = cvtpk(tl[(kg + 4) * 65 + n], tl[(kg + 5) * 65 + n]);
      w[3] = cvtpk(tl[(kg + 6) * 65 + n], tl[(kg + 7) * 65 + n]);
      *(u32x4*)(Wt + (long)(n0 + n) * K + k0 + kg) = w;
    }
  }
  __syncthreads();
}

__device__ __forceinline__ void mod_phase(const int wv, const Params& p, const int zq, float* modv) {
  const int tidx = ltid(wv);
  extern __shared__ __attribute__((aligned(16))) char shm_raw[];
  float* red = (float*)shm_raw;
  const int tid = tidx;
  const float* cvec = p.in[zq + 7]; const float* cctx = p.in[zq + 8]; const float* bmod = p.in[zq + 10];
  for (int item = blockIdx.x; item < 192; item += gridDim.x) {
    const int l = item / 96, cb = (item % 96) * 64;
    const float* W = p.in[zq + 9] + (long)l * 1024 * 6144;
    const int cl = tid & 15, kg = tid >> 4;
    float a0[4] = {0, 0, 0, 0}, a1[4] = {0, 0, 0, 0}, a2[4] = {0, 0, 0, 0};
#pragma unroll 4
    for (int i = 0; i < 32; ++i) {
      int k = kg + 32 * i;
      float4 w = *(const float4*)(W + (long)k * 6144 + cb + cl * 4);
      float s0 = silu_f(cctx[k]), s1 = silu_f(cvec[k]), s2 = silu_f(cvec[1024 + k]);
      a0[0] += s0 * w.x; a0[1] += s0 * w.y; a0[2] += s0 * w.z; a0[3] += s0 * w.w;
      a1[0] += s1 * w.x; a1[1] += s1 * w.y; a1[2] += s1 * w.z; a1[3] += s1 * w.w;
      a2[0] += s2 * w.x; a2[1] += s2 * w.y; a2[2] += s2 * w.z; a2[3] += s2 * w.w;
    }
    __syncthreads();
#pragma unroll
    for (int j = 0; j < 4; ++j) {
      red[kg * 192 + 0 * 64 + cl * 4 + j] = a0[j];
      red[kg * 192 + 1 * 64 + cl * 4 + j] = a1[j];
      red[kg * 192 + 2 * 64 + cl * 4 + j] = a2[j];
    }
    __syncthreads();
    if (tid < 192) {
      float s = 0.f;
#pragma unroll 8
      for (int q = 0; q < 32; ++q) s += red[q * 192 + tid];
      int g = tid / 64, col = cb + (tid % 64);
      modv[(l * 3 + g) * 6144 + col] = s + bmod[l * 6144 + col];
    }
  }
  __syncthreads();
}

__device__ __forceinline__ void filt_phase(const int wv, const Params& p, const int zq, float* F256, float* F2048) {
  const int tidx = ltid(wv);
  extern __shared__ __attribute__((aligned(16))) char shm_raw[];
  float* z = (float*)shm_raw; float* h1 = z + 32; float* h2 = h1 + 64;
  const int tid = tidx;
  const float *w1 = p.in[zq + 25], *b1 = p.in[zq + 26], *w2 = p.in[zq + 27], *b2 = p.in[zq + 28], *w3 = p.in[zq + 29], *b3 = p.in[zq + 30], *sf = p.in[zq + 31], *skip = p.in[zq + 32];
  const float DMAX = -15.350567286626973f, DMIN = -3.0701134573253946f;
  for (int item = blockIdx.x; item < 2304; item += gridDim.x) {
    const int L = item < 256 ? 256 : 2048; const int i = item < 256 ? item : item - 256;
    float* F = item < 256 ? F256 : F2048;
    const float t = (float)i / (float)(L - 1);
    __syncthreads();
    if (tid < 17) {
      float v;
      if (tid == 0) v = t;
      else if (tid <= 8) v = cosf(6.283185307179586f * t * (float)tid);
      else v = sinf(6.283185307179586f * t * (float)(tid - 8));
      z[tid] = v;
    }
    __syncthreads();
    if (tid < 64) { float s = b1[tid];
#pragma unroll 1
      for (int j = 0; j < 17; ++j) s += z[j] * w1[j * 64 + tid]; h1[tid] = sinf(sf[tid] * s); }
    __syncthreads();
    if (tid < 64) { float s = b2[tid];
#pragma unroll 8
      for (int j = 0; j < 64; ++j) s += h1[j] * w2[j * 64 + tid]; h2[tid] = sinf(sf[64 + tid] * s); }
    __syncthreads();
    {
      const int ch = tid; float sfw = b3[ch], sbw = b3[512 + ch];
#pragma unroll 8
      for (int j = 0; j < 64; ++j) { float hh = h2[j]; sfw += hh * w3[j * 1024 + ch]; sbw += hh * w3[j * 1024 + 512 + ch]; }
      float delta = fabsf(DMIN + (DMAX - DMIN) * ((float)ch / 511.f));
      float win = expf(-t * delta); sfw *= win; sbw *= win;
      if (i == 0) F[(long)(L - 1) * 512 + ch] = sfw + sbw + skip[ch];
      else { F[(long)(L - 1 + i) * 512 + ch] = sfw; F[(long)(L - 1 - i) * 512 + ch] = sbw; }
    }
  }
  __syncthreads();
}

template <bool FROM_IN, bool HAS_R, bool HAS_A>
__device__ __forceinline__ void row_phase(const int wv, const Params& p, const int zq, const float* __restrict__ R, const float* __restrict__ postg,
                                          const float* __restrict__ modg, int gate_m, float* X,
                                          const float* __restrict__ preg, const float* __restrict__ mods, int shift_m, bf16_t* __restrict__ A) {
  const int tidx = ltid(wv);
  const int wid = wv, lane = tidx & 63;
  for (int row = blockIdx.x * 8 + wid; row < T_TOK; row += gridDim.x * 8) {
    const int g = row < TPR ? 0 : 1 + (row - TPR) / 2048;
    const float* mg = modg + g * 6144;
    const float* ms = mods + g * 6144;
    const float* xin = FROM_IN ? (row < TPR ? p.in[zq + 0] + (long)row * 1024 : p.in[zq + 1] + (long)(row - TPR) * 1024) : (const float*)X + (long)row * 1024;
    float4 x[4];
#pragma unroll
    for (int j = 0; j < 4; ++j) x[j] = *(const float4*)(xin + j * 256 + lane * 4);
    if (HAS_R) {
      float4 r[4]; float ss = 0.f;
#pragma unroll
      for (int j = 0; j < 4; ++j) { r[j] = *(const float4*)(R + (long)row * 1024 + j * 256 + lane * 4); ss += r[j].x * r[j].x + r[j].y * r[j].y + r[j].z * r[j].z + r[j].w * r[j].w; }
      ss = wave_sum(ss); const float rs = rsqrtf(ss * (1.f / 1024.f) + 1e-6f);
#pragma unroll
      for (int j = 0; j < 4; ++j) {
        float4 pg = *(const float4*)(postg + j * 256 + lane * 4);
        float4 gt = *(const float4*)(mg + gate_m * 1024 + j * 256 + lane * 4);
        x[j].x += gt.x * (r[j].x * rs * pg.x); x[j].y += gt.y * (r[j].y * rs * pg.y);
        x[j].z += gt.z * (r[j].z * rs * pg.z); x[j].w += gt.w * (r[j].w * rs * pg.w);
        *(float4*)(X + (long)row * 1024 + j * 256 + lane * 4) = x[j];
      }
    }
    if (HAS_A) {
      float ss = 0.f;
#pragma unroll
      for (int j = 0; j < 4; ++j) ss += x[j].x * x[j].x + x[j].y * x[j].y + x[j].z * x[j].z + x[j].w * x[j].w;
      ss = wave_sum(ss); const float rs = rsqrtf(ss * (1.f / 1024.f) + 1e-6f);
#pragma unroll
      for (int j = 0; j < 4; ++j) {
        float4 pg = *(const float4*)(preg + j * 256 + lane * 4);
        float4 sh = *(const float4*)(ms + shift_m * 1024 + j * 256 + lane * 4);
        float4 sc = *(const float4*)(ms + (shift_m + 1) * 1024 + j * 256 + lane * 4);
        float y0 = x[j].x * rs * pg.x * (1.f + sc.x) + sh.x, y1 = x[j].y * rs * pg.y * (1.f + sc.y) + sh.y;
        float y2 = x[j].z * rs * pg.z * (1.f + sc.z) + sh.z, y3 = x[j].w * rs * pg.w * (1.f + sc.w) + sh.w;
        u32x2 w = {cvtpk(y0, y1), cvtpk(y2, y3)};
        *(u32x2*)(A + (long)row * 1024 + j * 256 + lane * 4) = w;
      }
    }
  }
}

constexpr int BM = 256, BK = 64, HALF = 128, WGM = 8, HT = HALF * BK;
__device__ __forceinline__ int lds_byte(int r, int c) {
  int st = (r >> 4) * 2 + (c >> 5), rr = r & 15, cc = c & 31, ob = rr * 64 + cc * 2;
  return st * 1024 + (ob ^ (((ob >> 9) & 1) << 5));
}
__device__ __forceinline__ void stage_rc(int b, int& R, int& C) {
  int st = b / 1024, sb = b % 1024, swz = sb ^ (((sb >> 9) & 1) << 5);
  R = (st >> 1) * 16 + swz / 64; C = (st & 1) * 32 + (swz % 64) / 2;
}

template <int MODE, int LDC>
__device__ __forceinline__ void gemm_phase(const int wv, const bf16_t* __restrict__ A, const bf16_t* __restrict__ Bt, int N, int K,
                                           void* Cout, float* GT) {
  const int tidx = ltid(wv);
  extern __shared__ __attribute__((aligned(16))) char shm_raw[];
  bf16_t* shm = (bf16_t*)shm_raw;
#define SA(b, h) (shm + ((b) * 2 + (h)) * HT)
#define SB(b, h) (shm + (4 + (b) * 2 + (h)) * HT)
#define STAGE(P, BASE, br, kt) do { const bf16_t* _gb = (BASE) + ((long)(br) * K + (long)(kt) * BK); \
    __builtin_amdgcn_global_load_lds((const unsigned*)(_gb + soff0), (unsigned*)((char*)(P) + sl0), 16, 0, 0); \
    __builtin_amdgcn_global_load_lds((const unsigned*)(_gb + soff1), (unsigned*)((char*)(P) + sl0 + 8192), 16, 0, 0); } while (0)
#define LDA(dst, b, h) _Pragma("unroll") for (int m = 0; m < 4; ++m) _Pragma("unroll") for (int k = 0; k < 2; ++k) \
    dst[m][k] = *reinterpret_cast<const bf16x8*>((char*)SA(b, h) + lds_byte(wr * 64 + m * 16 + fr, k * 32 + fq * 8))
#define LDB(dst, b, h) _Pragma("unroll") for (int n = 0; n < 2; ++n) _Pragma("unroll") for (int k = 0; k < 2; ++k) \
    dst[n][k] = *reinterpret_cast<const bf16x8*>((char*)SB(b, h) + lds_byte(wc * 32 + n * 16 + fr, k * 32 + fq * 8))
#define MMA(ai, bj, At, Bt_) do { __builtin_amdgcn_s_setprio(1); \
    _Pragma("unroll") for (int m = 0; m < 4; ++m) _Pragma("unroll") for (int n = 0; n < 2; ++n) _Pragma("unroll") for (int k = 0; k < 2; ++k) \
      acc[ai][bj][m][n] = __builtin_amdgcn_mfma_f32_16x16x32_bf16(At[m][k], Bt_[n][k], acc[ai][bj][m][n], 0, 0, 0); \
    __builtin_amdgcn_s_setprio(0); } while (0)
#define WAIT_V(n) asm volatile("s_waitcnt vmcnt(" #n ")" ::: "memory")
#define WAIT_L(n) asm volatile("s_waitcnt lgkmcnt(" #n ")" ::: "memory")
#define BAR __builtin_amdgcn_s_barrier()
#define SCHED __builtin_amdgcn_sched_barrier(0)
  const int nM = T_TOK / BM, nN = N / BM, nwg = nM * nN;
  const int wid = wv, lane = tidx & 63, wr = wid >> 2, wc = wid & 3, fr = lane & 15, fq = lane >> 4;
  const int nt = K / BK;
  unsigned soff0, soff1; const int sl0 = tidx * 16;
  { int _r, _c; stage_rc(sl0, _r, _c); soff0 = (unsigned)(_r * K + _c); stage_rc(sl0 + 8192, _r, _c); soff1 = (unsigned)(_r * K + _c); }
  for (int tile = blockIdx.x; tile < nwg; tile += gridDim.x) {
    const int nig = WGM * nN, gid = tile / nig, fm = gid * WGM, gsz = min(nM - fm, WGM);
    const int pm = fm + ((tile % nig) % gsz), pn = (tile % nig) / gsz, brow = pm * BM, bcol = pn * BM;
    f32x4 acc[2][2][4][2] = {};
    bf16x8 At[4][2], B0[2][2], B1[2][2];
    STAGE(SB(0, 0), Bt, bcol, 0); STAGE(SA(0, 0), A, brow, 0);
    STAGE(SB(0, 1), Bt, bcol + HALF, 0); STAGE(SA(0, 1), A, brow + HALF, 0);
    if (wr == 1) BAR;
    WAIT_V(4); BAR;
    STAGE(SB(1, 0), Bt, bcol, 1); STAGE(SA(1, 0), A, brow, 1); STAGE(SB(1, 1), Bt, bcol + HALF, 1);
    WAIT_V(6); BAR;
    for (int t = 0; t < nt - 2; t += 2) {
      LDB(B0, 0, 0); SCHED; LDA(At, 0, 0); STAGE(SA(1, 1), A, brow + HALF, t + 1);
      WAIT_L(8); BAR; WAIT_L(0); MMA(0, 0, At, B0); BAR; SCHED;
      LDB(B1, 0, 1); STAGE(SB(0, 0), Bt, bcol, t + 2);
      BAR; WAIT_L(0); MMA(0, 1, At, B1); BAR;
      LDA(At, 0, 1); STAGE(SA(0, 0), A, brow, t + 2);
      BAR; WAIT_L(0); MMA(1, 0, At, B0); BAR; SCHED;
      STAGE(SB(0, 1), Bt, bcol + HALF, t + 2);
      WAIT_V(6); BAR; MMA(1, 1, At, B1); BAR;
      LDB(B0, 1, 0); SCHED; LDA(At, 1, 0); STAGE(SA(0, 1), A, brow + HALF, t + 2);
      WAIT_L(8); BAR; WAIT_L(0); MMA(0, 0, At, B0); BAR; SCHED;
      LDB(B1, 1, 1); STAGE(SB(1, 0), Bt, bcol, t + 3);
      BAR; WAIT_L(0); MMA(0, 1, At, B1); BAR;
      LDA(At, 1, 1); STAGE(SA(1, 0), A, brow, t + 3);
      BAR; WAIT_L(0); MMA(1, 0, At, B0); BAR; SCHED;
      STAGE(SB(1, 1), Bt, bcol + HALF, t + 3);
      WAIT_V(6); BAR; MMA(1, 1, At, B1); BAR;
    }
    { LDB(B0, 0, 0); LDA(At, 0, 0); STAGE(SA(1, 1), A, brow + HALF, nt - 1);
      BAR; WAIT_L(0); MMA(0, 0, At, B0); BAR;
      LDB(B1, 0, 1); BAR; WAIT_L(0); MMA(0, 1, At, B1); BAR;
      LDA(At, 0, 1); WAIT_V(4); BAR; WAIT_L(0); MMA(1, 0, At, B0); MMA(1, 1, At, B1); BAR; }
    { LDB(B0, 1, 0); LDA(At, 1, 0); WAIT_V(2); BAR; WAIT_L(0); MMA(0, 0, At, B0); BAR;
      LDB(B1, 1, 1); WAIT_V(0); BAR; WAIT_L(0); MMA(0, 1, At, B1); BAR;
      LDA(At, 1, 1); BAR; WAIT_L(0); MMA(1, 0, At, B0); MMA(1, 1, At, B1); BAR; }
    if (wr == 0) BAR;
    {
      const int le = llane();
      const int fr = le & 15, fq = le >> 4;
      const long base = (long)(brow + wr * 64) * LDC + bcol + wc * 32 + (unsigned)(fq * 4 * LDC + fr);
      if (MODE == 0 || (MODE == 2 && pn < 16)) {
        bf16_t* cp = (bf16_t*)Cout + base;
#pragma unroll
        for (int ai = 0; ai < 2; ++ai)
#pragma unroll
          for (int m = 0; m < 4; ++m)
#pragma unroll
            for (int j = 0; j < 4; ++j) {
              bf16_t* rp = cp + (ai * HALF + m * 16 + j) * LDC;
#pragma unroll
              for (int bj = 0; bj < 2; ++bj)
#pragma unroll
                for (int n = 0; n < 2; ++n) rp[bj * HALF + n * 16] = f2bf(acc[ai][bj][m][n][j]);
            }
      } else if (MODE == 1) {
        float* cp = (float*)Cout + base;
#pragma unroll
        for (int ai = 0; ai < 2; ++ai)
#pragma unroll
          for (int m = 0; m < 4; ++m)
#pragma unroll
            for (int j = 0; j < 4; ++j) {
              float* rp = cp + (ai * HALF + m * 16 + j) * LDC;
#pragma unroll
              for (int bj = 0; bj < 2; ++bj)
#pragma unroll
                for (int n = 0; n < 2; ++n) rp[bj * HALF + n * 16] = acc[ai][bj][m][n][j];
            }
      } else {
        if (wc == 0) {
          float* gp = GT + (long)(brow + wr * 64) * 32 + (unsigned)(fq * 4 * 32 + fr);
#pragma unroll
          for (int ai = 0; ai < 2; ++ai)
#pragma unroll
            for (int m = 0; m < 4; ++m)
#pragma unroll
              for (int j = 0; j < 4; ++j)
#pragma unroll
                for (int n = 0; n < 2; ++n) gp[(ai * HALF + m * 16 + j) * 32 + n * 16] = acc[ai][0][m][n][j];
        }
      }
    }
    __syncthreads();
  }
#undef SA
#undef SB
#undef STAGE
#undef LDA
#undef LDB
#undef MMA
}

__device__ __forceinline__ void post_inproj0(const int wv, const Params& p, const int zq, const bf16_t* __restrict__ P0, bf16_t* __restrict__ QA, bf16_t* __restrict__ KA,
                                             bf16_t* __restrict__ VA, float* __restrict__ VV, bf16_t* __restrict__ X0) {
  const int tidx = ltid(wv);
  const int wid = wv, lane = tidx & 63;
  const float* qn = p.in[zq + 21]; const float* kn = p.in[zq + 22]; const float* cw = p.in[zq + 23]; const float* cb = p.in[zq + 24];
  float* outK = p.out + O_K; float* outV = p.out + O_V;
  for (int i = blockIdx.x * 512 + tidx; i < 2 * 512 * 256 / 4; i += gridDim.x * 512) {
    int e = i * 4; int b = e / (512 * 256), rem = e % (512 * 256);
    float4 kk = *(const float4*)(p.in[zq + 2] + e); float4 vv = *(const float4*)(p.in[zq + 3] + e);
    long d = (long)(8192 + b * 2560 + 2048) * 256 + rem;
    u32x2 wk = {cvtpk(kk.x, kk.y), cvtpk(kk.z, kk.w)}; u32x2 wv = {cvtpk(vv.x, vv.y), cvtpk(vv.z, vv.w)};
    *(u32x2*)(KA + d) = wk; *(u32x2*)(VA + d) = wv;
  }
  const int fi = lane & 31;
  const float inv = exp2f(-(float)fi * (13.287712379549449f / 32.f));
  for (int row = blockIdx.x * 8 + wid; row < T_TOK; row += gridDim.x * 8) {
    const bool samp = row >= TPR;
    const int L = samp ? 2048 : 256;
    const int tl = samp ? (row - TPR) % 2048 : row % 256;
    const long krow = samp ? (long)(8192 + ((row - TPR) / 2048) * 2560 + tl) : (long)row;
    const bf16_t* base = P0 + (long)row * 2560;
    float cs = 1.f, sn = 0.f;
    if (samp) { float pos = (lane < 32) ? (float)(tl / 64) : (float)(tl % 64); float ang = pos * inv; cs = cosf(ang); sn = sinf(ang); }
#pragma unroll
    for (int hh = 0; hh < 6; ++hh) {
      float x1 = bf2f(base[hh * 128 + lane]), x2 = bf2f(base[hh * 128 + 64 + lane]);
      float ss = wave_sum(x1 * x1 + x2 * x2);
      float rs = rsqrtf(ss * (1.f / 128.f) + 1e-6f);
      const float* gw = hh < 4 ? qn : kn;
      float y1 = x1 * rs * gw[lane], y2 = x2 * rs * gw[64 + lane];
      if (hh >= 4 && !samp) { outK[(long)row * 256 + (hh - 4) * 128 + lane] = y1; outK[(long)row * 256 + (hh - 4) * 128 + 64 + lane] = y2; }
      float o1 = y1 * cs - y2 * sn, o2 = y1 * sn + y2 * cs;
      if (hh < 4) { QA[(long)row * 512 + hh * 128 + lane] = f2bf(o1); QA[(long)row * 512 + hh * 128 + 64 + lane] = f2bf(o2); }
      else { KA[krow * 256 + (hh - 4) * 128 + lane] = f2bf(o1); KA[krow * 256 + (hh - 4) * 128 + 64 + lane] = f2bf(o2); }
    }
    {
      u32x2 w = *(const u32x2*)(base + 768 + lane * 4);
      *(u32x2*)(VA + krow * 256 + lane * 4) = w;
      if (!samp) { float4 f = make_float4(bflo(w[0]), bfhi(w[0]), bflo(w[1]), bfhi(w[1])); *(float4*)(outV + (long)row * 256 + lane * 4) = f; }
    }
    {
      const int c8 = lane * 8;
      float uc[3][8];
#pragma unroll
      for (int g = 0; g < 3; ++g) {
        const int col = g * 512 + c8;
        float um[8], u0[8], up[8];
        u32x4 z4 = {0u, 0u, 0u, 0u};
        u32x4 wm = (tl > 0) ? *(const u32x4*)(base - 2560 + 1024 + col) : z4;
        u32x4 w0 = *(const u32x4*)(base + 1024 + col);
        u32x4 wp = (tl < L - 1) ? *(const u32x4*)(base + 2560 + 1024 + col) : z4;
        unpack8(wm, um); unpack8(w0, u0); unpack8(wp, up);
#pragma unroll
        for (int e = 0; e < 8; ++e)
          uc[g][e] = cw[col + e] * um[e] + cw[1536 + col + e] * u0[e] + cw[3072 + col + e] * up[e] + cb[col + e];
      }
      float vvv[8];
#pragma unroll
      for (int e = 0; e < 8; ++e) vvv[e] = uc[2][e] * uc[1][e];
      *(float4*)(VV + (long)row * 512 + c8) = make_float4(vvv[0], vvv[1], vvv[2], vvv[3]);
      *(float4*)(VV + (long)row * 512 + c8 + 4) = make_float4(vvv[4], vvv[5], vvv[6], vvv[7]);
      *(u32x4*)(X0 + (long)row * 512 + c8) = pack8(uc[0]);
    }
  }
}

constexpr int AD = 128, ANW = 8, QBLK = 32, KVBLK = 64;
constexpr float ASCALE = 0.088388347648318440f;
constexpr float ATHR = 8.f;
constexpr int LDQ = 512, LDK = 256, LDO = 1024;
constexpr size_t SHM_V = KVBLK * AD * 2, SHM_K = KVBLK * AD * 2;
#define KSWZ(row, colB) ((row) * 256 + ((colB) ^ (((row) & 7) << 4)))
#define SBAR() __builtin_amdgcn_sched_barrier(0)

__device__ __forceinline__ void partialSM(f32x16& p0, f32x16& p1, float& m_reg, float& mn, float& alpha) {
  constexpr float C = ASCALE * 1.4426950408889634f;
  float pmax = p0[0];
#pragma unroll
  for (int r = 1; r < 16; ++r) pmax = fmaxf(pmax, p0[r]);
#pragma unroll
  for (int r = 0; r < 16; ++r) pmax = fmaxf(pmax, p1[r]);
  { auto rr = __builtin_amdgcn_permlane32_swap(__float_as_uint(pmax), __float_as_uint(pmax), false, false);
    pmax = fmaxf(__uint_as_float(rr[0]), __uint_as_float(rr[1])); }
  if (__builtin_expect(__all(pmax - m_reg <= ATHR / ASCALE), 1)) { mn = m_reg; alpha = 1.f; }
  else { mn = fmaxf(m_reg, pmax); alpha = __builtin_amdgcn_exp2f((m_reg - mn) * C); m_reg = mn; }
  float mnC = -mn * C;
#pragma unroll
  for (int r = 0; r < 16; ++r) p0[r] = fmaf(p0[r], C, mnC);
#pragma unroll
  for (int r = 0; r < 16; ++r) p1[r] = fmaf(p1[r], C, mnC);
#pragma unroll
  for (int r = 0; r < 16; ++r) p0[r] = __builtin_amdgcn_exp2f(p0[r]);
}
__device__ __forceinline__ void finishSM(f32x16& p0, f32x16& p1, float alpha, float& l_reg, bf16x8& pa0, bf16x8& pa1, bf16x8& pa2, bf16x8& pa3) {
#pragma unroll
  for (int r = 0; r < 16; ++r) p1[r] = __builtin_amdgcn_exp2f(p1[r]);
  float ps = 0;
#pragma unroll
  for (int r = 0; r < 16; ++r) ps += p0[r];
#pragma unroll
  for (int r = 0; r < 16; ++r) ps += p1[r];
  { auto rr = __builtin_amdgcn_permlane32_swap(__float_as_uint(ps), __float_as_uint(ps), false, false);
    ps = __uint_as_float(rr[0]) + __uint_as_float(rr[1]); }
  l_reg = l_reg * alpha + ps;
#define PK4(P, BASE, OUT) do { unsigned a0 = cvtpk(P[BASE + 0], P[BASE + 1]), a1 = cvtpk(P[BASE + 2], P[BASE + 3]);   \
    unsigned b0 = cvtpk(P[BASE + 4], P[BASE + 5]), b1 = cvtpk(P[BASE + 6], P[BASE + 7]);                              \
    auto r0 = __builtin_amdgcn_permlane32_swap(a0, b0, false, false); auto r1 = __builtin_amdgcn_permlane32_swap(a1, b1, false, false); \
    u32x4 w = {r0[0], r1[0], r0[1], r1[1]}; OUT = *reinterpret_cast<bf16x8*>(&w); } while (0)
  PK4(p0, 0, pa0); PK4(p0, 8, pa1); PK4(p1, 0, pa2); PK4(p1, 8, pa3);
#undef PK4
}
__device__ __forceinline__ void qkt(f32x16& p0, f32x16& p1, const bf16_t* Ks, const bf16x8* qr, int r32, int hi) {
  p0 = f32x16{}; p1 = f32x16{};
#pragma unroll
  for (int d0 = 0; d0 < 8; ++d0) { int cb = (d0 * 16 + hi * 8) * 2;
    bf16x8 b0 = *reinterpret_cast<const bf16x8*>((const char*)Ks + KSWZ(r32, cb));
    bf16x8 b1 = *reinterpret_cast<const bf16x8*>((const char*)Ks + KSWZ(32 + r32, cb));
    p0 = __builtin_amdgcn_mfma_f32_32x32x16_bf16(b0, qr[d0], p0, 0, 0, 0);
    p1 = __builtin_amdgcn_mfma_f32_32x32x16_bf16(b1, qr[d0], p1, 0, 0, 0); }
}
__device__ __forceinline__ int v_st(int k, int c) { const int kk = (k & ~0xC) | ((k & 4) << 1) | ((k & 8) >> 1); return ((kk >> 3) * 4 + (c >> 5)) * 512 + ((kk & 7) * 32 + (c & 31)) * 2; }
__device__ __forceinline__ int v_rd_base(int lane) { return ((lane & 3) << 3) | (((lane >> 2) & 3) << 6) | (((lane >> 4) & 1) << 5) | (((lane >> 5) & 1) << 8); }
constexpr int v_rd_off(int d0, int ks, int half) { return d0 * 512 + ks * 4096 + half * 2048; }
template <int OFF> __device__ __forceinline__ s16x4 tr_read(int vb) {
  s16x4 r; asm volatile("ds_read_b64_tr_b16 %0, %1 offset:%2" : "=&v"(r) : "v"(vb), "i"(OFF) : "memory"); return r;
}
template <int D0> __device__ __forceinline__ void pv_one(f32x16& od, int vb, bf16x8 pa0, bf16x8 pa1, bf16x8 pa2, bf16x8 pa3) {
  const s16x4 l0 = tr_read<v_rd_off(D0, 0, 0)>(vb), h0 = tr_read<v_rd_off(D0, 0, 1)>(vb), l1 = tr_read<v_rd_off(D0, 1, 0)>(vb), h1 = tr_read<v_rd_off(D0, 1, 1)>(vb);
  const s16x4 l2 = tr_read<v_rd_off(D0, 2, 0)>(vb), h2 = tr_read<v_rd_off(D0, 2, 1)>(vb), l3 = tr_read<v_rd_off(D0, 3, 0)>(vb), h3 = tr_read<v_rd_off(D0, 3, 1)>(vb);
  asm volatile("s_waitcnt lgkmcnt(0)" ::: "memory"); SBAR();
#define PK(L, H) (bf16x8){L[0], L[1], L[2], L[3], H[0], H[1], H[2], H[3]}
  od = __builtin_amdgcn_mfma_f32_32x32x16_bf16(pa0, PK(l0, h0), od, 0, 0, 0);
  od = __builtin_amdgcn_mfma_f32_32x32x16_bf16(pa1, PK(l1, h1), od, 0, 0, 0);
  od = __builtin_amdgcn_mfma_f32_32x32x16_bf16(pa2, PK(l2, h2), od, 0, 0, 0);
  od = __builtin_amdgcn_mfma_f32_32x32x16_bf16(pa3, PK(l3, h3), od, 0, 0, 0);
#undef PK
}
__device__ __forceinline__ void pv_d0(f32x16* o, int vb, bf16x8 pa0, bf16x8 pa1, bf16x8 pa2, bf16x8 pa3) {
  pv_one<0>(o[0], vb, pa0, pa1, pa2, pa3); pv_one<1>(o[1], vb, pa0, pa1, pa2, pa3); pv_one<2>(o[2], vb, pa0, pa1, pa2, pa3); pv_one<3>(o[3], vb, pa0, pa1, pa2, pa3);
}

__device__ __forceinline__ void attn_dense_body(const int wv, const bf16_t* __restrict__ Qb, const bf16_t* __restrict__ Kh, const bf16_t* __restrict__ Vh,
                                                bf16_t* __restrict__ Ob, int seq, char* lds) {
  const int tidx = ltid(wv);
  const int tid = tidx, wid = wv, lane = tid & 63, r32 = lane & 31, hi = lane >> 5;
  bf16_t* V_lds = (bf16_t*)lds; bf16_t* K_lds = (bf16_t*)(lds + 2 * SHM_V);
  float* ws = (float*)(lds + 2 * SHM_V + 2 * SHM_K) + wid * 64; float* li_l = ws; float* al_l = ws + 32;
  float m_reg = -1e30f, l_reg = 0; f32x16 o[4] = {}; bf16x8 qr[8];
  const bf16_t* Qw = Qb + (long)(wid * QBLK + r32) * LDQ + hi * 8;
#pragma unroll
  for (int d0 = 0; d0 < 8; ++d0) qr[d0] = *reinterpret_cast<const bf16x8*>(Qw + d0 * 16);
  const int sr = tid >> 4, sc = (tid & 15) * 8, vst0 = v_st(sr, sc), vst1 = v_st(32 + sr, sc);
  const int vb0 = (int)(uintptr_t)V_lds + v_rd_base(lane);
  bf16x8 sA_vs0, sA_vs1, sA_ks0, sA_ks1, sB_vs0, sB_vs1, sB_ks0, sB_ks1;
#define SLOADA(k0) do { sA_vs0 = *(const bf16x8*)(&Vh[(long)((k0) + sr) * LDK + sc]); sA_vs1 = *(const bf16x8*)(&Vh[(long)((k0) + 32 + sr) * LDK + sc]); \
    sA_ks0 = *(const bf16x8*)(&Kh[(long)((k0) + sr) * LDK + sc]); sA_ks1 = *(const bf16x8*)(&Kh[(long)((k0) + 32 + sr) * LDK + sc]); } while (0)
#define SLOADB(k0) do { sB_vs0 = *(const bf16x8*)(&Vh[(long)((k0) + sr) * LDK + sc]); sB_vs1 = *(const bf16x8*)(&Vh[(long)((k0) + 32 + sr) * LDK + sc]); \
    sB_ks0 = *(const bf16x8*)(&Kh[(long)((k0) + sr) * LDK + sc]); sB_ks1 = *(const bf16x8*)(&Kh[(long)((k0) + 32 + sr) * LDK + sc]); } while (0)
#define SWRITEA(b) do { *(bf16x8*)((char*)V_lds + (b) * SHM_V + vst0) = sA_vs0; *(bf16x8*)((char*)V_lds + (b) * SHM_V + vst1) = sA_vs1; int kc = sc * 2; \
    *(bf16x8*)((char*)K_lds + (b) * SHM_K + KSWZ(sr, kc)) = sA_ks0; *(bf16x8*)((char*)K_lds + (b) * SHM_K + KSWZ(32 + sr, kc)) = sA_ks1; } while (0)
#define SWRITEB(b) do { *(bf16x8*)((char*)V_lds + (b) * SHM_V + vst0) = sB_vs0; *(bf16x8*)((char*)V_lds + (b) * SHM_V + vst1) = sB_vs1; int kc = sc * 2; \
    *(bf16x8*)((char*)K_lds + (b) * SHM_K + KSWZ(sr, kc)) = sB_ks0; *(bf16x8*)((char*)K_lds + (b) * SHM_K + KSWZ(32 + sr, kc)) = sB_ks1; } while (0)
#define SWAIT() asm volatile("s_waitcnt vmcnt(4)" ::: "memory")
#define RESC(a) do { if (__any((a) < 1.f)) { if (hi == 0) al_l[r32] = (a); asm volatile("s_waitcnt lgkmcnt(0)" ::: "memory"); \
    _Pragma("unroll") for (int d = 0; d < 4; ++d) _Pragma("unroll") for (int r = 0; r < 16; ++r) o[d][r] *= al_l[crow(r, hi)]; } } while (0)
  f32x16 pA0, pA1, pB0, pB1; float mnA, mnB, alA, alB; bf16x8 pa0, pa1, pa2, pa3; const int NT = seq / KVBLK;
  SLOADA(0); asm volatile("s_waitcnt vmcnt(0)" ::: "memory"); SWRITEA(0); __syncthreads();
  qkt(pA0, pA1, K_lds, qr, r32, hi); partialSM(pA0, pA1, m_reg, mnA, alA);
  SLOADB(KVBLK); if (2 < NT) SLOADA(2 * KVBLK);
  SWAIT(); SWRITEB(1); __syncthreads();
  for (int j = 1; j + 1 < NT; j += 2) {
    SBAR(); qkt(pB0, pB1, (bf16_t*)((char*)K_lds + SHM_K), qr, r32, hi);
    finishSM(pA0, pA1, alA, l_reg, pa0, pa1, pa2, pa3); SBAR();
    SLOADB((j + 2) * KVBLK); SBAR();
    pv_d0(o, vb0, pa0, pa1, pa2, pa3); partialSM(pB0, pB1, m_reg, mnB, alB);
    __syncthreads(); SWAIT(); SWRITEA(0);
    RESC(alB); __syncthreads();
    SBAR(); qkt(pA0, pA1, K_lds, qr, r32, hi);
    finishSM(pB0, pB1, alB, l_reg, pa0, pa1, pa2, pa3); SBAR();
    if (j + 3 < NT) SLOADA((j + 3) * KVBLK); SBAR();
    pv_d0(o, vb0 + (int)SHM_V, pa0, pa1, pa2, pa3); partialSM(pA0, pA1, m_reg, mnA, alA);
    __syncthreads(); SWAIT(); SWRITEB(1);
    RESC(alA); __syncthreads();
  }
  SBAR(); qkt(pB0, pB1, (bf16_t*)((char*)K_lds + SHM_K), qr, r32, hi);
  finishSM(pA0, pA1, alA, l_reg, pa0, pa1, pa2, pa3); SBAR();
  pv_d0(o, vb0, pa0, pa1, pa2, pa3); partialSM(pB0, pB1, m_reg, mnB, alB);
  __syncthreads(); RESC(alB);
  finishSM(pB0, pB1, alB, l_reg, pa0, pa1, pa2, pa3); SBAR();
  pv_d0(o, vb0 + (int)SHM_V, pa0, pa1, pa2, pa3);
  if (hi == 0) li_l[r32] = l_reg; asm volatile("s_waitcnt lgkmcnt(0)" ::: "memory");
  float rli[16];
#pragma unroll
  for (int r = 0; r < 16; ++r) rli[r] = __builtin_amdgcn_rcpf(li_l[crow(r, hi)]);
  bf16_t* Ow = Ob + (long)(wid * QBLK) * LDO;
#pragma unroll
  for (int r = 0; r < 16; ++r) { int orow = crow(r, hi);
#pragma unroll
    for (int d0 = 0; d0 < 4; ++d0) Ow[(long)orow * LDO + d0 * 32 + r32] = f2bf(o[d0][r] * rli[r]); }
#undef SLOADA
#undef SLOADB
#undef SWRITEA
#undef SWRITEB
#undef SWAIT
#undef RESC
}

__device__ __forceinline__ void hyena_item(const float* __restrict__ F, const float* __restrict__ VV, const bf16_t* __restrict__ X0,
                                           bf16_t* __restrict__ AO, long rowbase, int L, int c, int t0) {
  float y[16], ring[16];
#pragma unroll
  for (int i = 0; i < 16; ++i) { y[i] = 0.f; ring[i] = F[(long)(t0 + i + L - 1) * 512 + c]; }
  const float* vp = VV + rowbase * 512 + c;
  const float* fp = F + (long)(t0 + L - 2) * 512 + c;
  for (int s0 = 0; s0 < L; s0 += 16) {
#pragma unroll
    for (int j = 0; j < 16; ++j) {
      const float vs = vp[(long)(s0 + j) * 512];
      const float nf = fp[-(long)(s0 + j) * 512];
#pragma unroll
      for (int i = 0; i < 16; ++i) y[i] += ring[(i - j) & 15] * vs;
      ring[(15 - j) & 15] = nf;
    }
  }
#pragma unroll
  for (int i = 0; i < 16; ++i) {
    long row = rowbase + t0 + i;
    AO[row * 1024 + 512 + c] = f2bf(y[i] * bf2f(X0[row * 512 + c]));
  }
}

__device__ __forceinline__ void mix0_phase(const int wv, const Params& p, const int zq, const bf16_t* QA, const bf16_t* KA, const bf16_t* VA, const float* VV,
                                           const bf16_t* X0, const float* F256, const float* F2048, bf16_t* AO) {
  extern __shared__ __attribute__((aligned(16))) char shm_raw[];
#ifndef NO_ATTN
  for (int it = blockIdx.x; it < 192; it += gridDim.x) {
    long rowb, krow; int h, seqk;
    if (it < 64) { const int qb = it % 8, b = it / 32; h = (it / 8) % 4; rowb = 8192 + (long)b * 2048 + qb * 256; krow = 8192 + (long)b * 2560; seqk = 2560; }
    else { const int j = it - 64; const int b = j / 4; h = j % 4; rowb = (long)b * 256; krow = rowb; seqk = 256; }
    __syncthreads();
    attn_dense_body(wv, QA + rowb * 512 + h * 128, KA + krow * 256 + (h >> 1) * 128, VA + krow * 256 + (h >> 1) * 128, AO + rowb * 1024 + h * 128, seqk, shm_raw);
  }
#endif
#ifndef NO_HYENA
  const int lane = llane(); const int wid = wv;
  for (int it = (blockIdx.x + gridDim.x - 64) % gridDim.x; it < 768; it += gridDim.x) {
    if (it < 256) {
      const int b = it / 128, cgp = (it / 16) % 8, tg = it % 16;
      hyena_item(F2048, VV, X0, AO, 8192 + (long)b * 2048, 2048, cgp * 64 + lane, tg * 128 + wid * 16);
    } else {
      const int j = it - 256; const int b = j / 16, cgp = (j / 2) % 8, tg = j % 2;
      hyena_item(F256, VV, X0, AO, (long)b * 256, 256, cgp * 64 + lane, tg * 128 + wid * 16);
    }
  }
#endif
  __syncthreads();
}

__device__ __forceinline__ float gelu_f(float x) { return 0.5f * x * (1.f + erff(x * 0.70710678118654752f)); }
__device__ __forceinline__ void ffn_act_phase(const int wv, const bf16_t* __restrict__ P, const float* __restrict__ cw, const float* __restrict__ cb, bf16_t* __restrict__ G) {
  const int tidx = ltid(wv);
  const int tid = tidx;
  if (tid >= 352) return;
  const int c8 = tid * 8;
  float w1[3][8], w2[3][8], b1[8], b2[8];
#pragma unroll
  for (int e = 0; e < 8; ++e) {
#pragma unroll
    for (int k = 0; k < 3; ++k) { w1[k][e] = cw[k * 5632 + c8 + e]; w2[k][e] = cw[k * 5632 + 2816 + c8 + e]; }
    b1[e] = cb[c8 + e]; b2[e] = cb[2816 + c8 + e];
  }
  for (int item = blockIdx.x; item < T_TOK / 16; item += gridDim.x) {
    const int r0 = item * 16;
    const int L = r0 < TPR ? 256 : 2048;
    const int tl0 = r0 < TPR ? r0 % 256 : (r0 - TPR) % 2048;
    float am[8], a0[8], ap[8], gm[8], g0[8], gp[8];
    const u32x4 z4 = {0u, 0u, 0u, 0u};
    {
      const bf16_t* b = P + (long)r0 * 5632 + c8;
      u32x4 x = (tl0 > 0) ? *(const u32x4*)(b - 5632) : z4; unpack8(x, am);
      x = (tl0 > 0) ? *(const u32x4*)(b - 5632 + 2816) : z4; unpack8(x, gm);
      x = *(const u32x4*)(b); unpack8(x, a0);
      x = *(const u32x4*)(b + 2816); unpack8(x, g0);
    }
    for (int r = 0; r < 16; ++r) {
      const bf16_t* b = P + (long)(r0 + r) * 5632 + c8;
      const bool vn = (tl0 + r) < L - 1;
      u32x4 x = vn ? *(const u32x4*)(b + 5632) : z4; unpack8(x, ap);
      x = vn ? *(const u32x4*)(b + 5632 + 2816) : z4; unpack8(x, gp);
      float o[8];
#pragma unroll
      for (int e = 0; e < 8; ++e) {
        float h1 = w1[0][e] * am[e] + w1[1][e] * a0[e] + w1[2][e] * ap[e] + b1[e];
        float h2 = w2[0][e] * gm[e] + w2[1][e] * g0[e] + w2[2][e] * gp[e] + b2[e];
        o[e] = gelu_f(h1) * h2;
        am[e] = a0[e]; a0[e] = ap[e]; gm[e] = g0[e]; g0[e] = gp[e];
      }
      *(u32x4*)(G + (long)(r0 + r) * 2816 + c8) = pack8(o);
    }
  }
}

__device__ __forceinline__ f32x16 mma_nt(const bf16_t* A, int lda, const bf16_t* B, int ldb, int K, f32x16 acc, int r32, int hi) {
  for (int k0 = 0; k0 < K; k0 += 16) {
    bf16x8 a = *reinterpret_cast<const bf16x8*>(A + r32 * lda + k0 + 8 * hi);
    bf16x8 b = *reinterpret_cast<const bf16x8*>(B + r32 * ldb + k0 + 8 * hi);
    acc = __builtin_amdgcn_mfma_f32_32x32x16_bf16(a, b, acc, 0, 0, 0);
  }
  return acc;
}

__device__ __forceinline__ void mlstm_phase(const int wv, const Params& p, const int zq, const bf16_t* __restrict__ P1, const float* __restrict__ GT,
                                            bf16_t* __restrict__ HF, bf16_t* __restrict__ HB) {
  const int tidx = ltid(wv);
  extern __shared__ __attribute__((aligned(16))) char shm_raw[];
  bf16_t* Qs = (bf16_t*)shm_raw;
  bf16_t* Ks = Qs + 64 * 136;
  bf16_t* KwT = Ks + 64 * 136;
  bf16_t* VsT = KwT + 128 * 72;
  bf16_t* Wb = VsT + 128 * 72;
  bf16_t* Cb = Wb + 64 * 72;
  float* av = (float*)(Cb + 128 * 136);
  float* Mv = av + 64; float* bv = Mv + 64; float* sclv = bv + 64; float* wintv = sclv + 64; float* nvec = wintv + 64; float* scal = nvec + 128;
  float* cwl = scal + 8;
  const int tid = tidx, wid = wv, lane = tid & 63, r32 = lane & 31, hi = lane >> 5;
  const float* cw = p.in[zq + 35]; const float* cbias = p.in[zq + 36]; const float* bg = p.in[zq + 34];
  for (int u = blockIdx.x; u < 544; u += gridDim.x) {
    int seq, h, dir;
    if (u < 32) { seq = 32 + u / 16; h = (u / 2) % 8; dir = u % 2; } else { int j = u - 32; seq = j / 16; h = (j / 2) % 8; dir = j % 2; }
    const int L = seq < 32 ? 256 : 2048;
    const long rowbase = seq < 32 ? (long)seq * 256 : 8192 + (long)(seq - 32) * 2048;
    __syncthreads();
    f32x16 cacc[2]; float m = 0.f;
    const int vb2 = wid >> 1;
    if (seq >= 32) {
      const int b = seq - 32;
      const float* Cin = p.in[zq + 4] + (long)((b * 2 + dir) * 8 + h) * 16384;
#pragma unroll
      for (int i = 0; i < 2; ++i) { const int kb = (wid & 1) * 2 + i;
#pragma unroll
        for (int r = 0; r < 16; ++r) cacc[i][r] = Cin[(vb2 * 32 + crow(r, hi)) * 128 + kb * 32 + r32]; }
      if (tid < 128) nvec[tid] = p.in[zq + 5][((b * 2 + dir) * 8 + h) * 128 + tid];
      m = p.in[zq + 6][(b * 2 + dir) * 8 + h];
    } else {
#pragma unroll
      for (int i = 0; i < 2; ++i)
#pragma unroll
        for (int r = 0; r < 16; ++r) cacc[i][r] = 0.f;
      if (tid < 128) nvec[tid] = 0.f;
    }
#pragma unroll
    for (int i = 0; i < 2; ++i) { const int kb = (wid & 1) * 2 + i;
#pragma unroll
      for (int r = 0; r < 16; ++r) Cb[(vb2 * 32 + crow(r, hi)) * 136 + kb * 32 + r32] = f2bf(cacc[i][r]); }
    if (tid < 256) {
      const int col = (tid < 128) ? (h * 128 + tid) : (1024 + h * 128 + (tid - 128));
      cwl[tid] = cw[col]; cwl[256 + tid] = cw[2048 + col]; cwl[512 + tid] = cw[4096 + col]; cwl[768 + tid] = cbias[col];
    }
    const float bgi = bg[dir * 8 + h], bgf = bg[16 + dir * 8 + h];
    __syncthreads();
    const int nch = L / 64;
    for (int ch = 0; ch < nch; ++ch) {
      float kf[2][8];
      const int c8 = (tid & 15) * 8;
#pragma unroll
      for (int i = 0; i < 2; ++i) {
        const int r = (tid >> 4) + 32 * i;
        const int tc = ch * 64 + r;
        const int pos = dir ? (L - 1 - tc) : tc;
        const bf16_t* rowp = P1 + (rowbase + pos) * 4096;
        const u32x4 z4 = {0u, 0u, 0u, 0u};
        float um[8], u0[8], up[8], qf[8];
        { u32x4 wm = (pos > 0) ? *(const u32x4*)(rowp - 4096 + h * 128 + c8) : z4;
          u32x4 w0 = *(const u32x4*)(rowp + h * 128 + c8);
          u32x4 wp = (pos < L - 1) ? *(const u32x4*)(rowp + 4096 + h * 128 + c8) : z4;
          unpack8(wm, um); unpack8(w0, u0); unpack8(wp, up);
#pragma unroll
          for (int e = 0; e < 8; ++e) qf[e] = silu_f(cwl[c8 + e] * um[e] + cwl[256 + c8 + e] * u0[e] + cwl[512 + c8 + e] * up[e] + cwl[768 + c8 + e]);
          *(u32x4*)(Qs + r * 136 + c8) = pack8(qf); }
        { u32x4 wm = (pos > 0) ? *(const u32x4*)(rowp - 4096 + 1024 + h * 128 + c8) : z4;
          u32x4 w0 = *(const u32x4*)(rowp + 1024 + h * 128 + c8);
          u32x4 wp = (pos < L - 1) ? *(const u32x4*)(rowp + 4096 + 1024 + h * 128 + c8) : z4;
          unpack8(wm, um); unpack8(w0, u0); unpack8(wp, up);
#pragma unroll
          for (int e = 0; e < 8; ++e) kf[i][e] = 0.088388347648318440f * silu_f(cwl[128 + c8 + e] * um[e] + cwl[256 + 128 + c8 + e] * u0[e] + cwl[512 + 128 + c8 + e] * up[e] + cwl[768 + 128 + c8 + e]);
          *(u32x4*)(Ks + r * 136 + c8) = pack8(kf[i]); }
        { u32x4 wv = *(const u32x4*)(rowp + 2048 + h * 128 + c8);
          VsT[(c8 + 0) * 72 + r] = (bf16_t)(wv[0] & 0xffff); VsT[(c8 + 1) * 72 + r] = (bf16_t)(wv[0] >> 16);
          VsT[(c8 + 2) * 72 + r] = (bf16_t)(wv[1] & 0xffff); VsT[(c8 + 3) * 72 + r] = (bf16_t)(wv[1] >> 16);
          VsT[(c8 + 4) * 72 + r] = (bf16_t)(wv[2] & 0xffff); VsT[(c8 + 5) * 72 + r] = (bf16_t)(wv[2] >> 16);
          VsT[(c8 + 6) * 72 + r] = (bf16_t)(wv[3] & 0xffff); VsT[(c8 + 7) * 72 + r] = (bf16_t)(wv[3] >> 16); }
      }
      if (wid == 0) {
        const int tc = ch * 64 + lane; const int pos = dir ? (L - 1 - tc) : tc;
        const float* gr = GT + (rowbase + pos) * 32;
        const float ic = gr[dir * 8 + h] + bgi;
        const float fp = gr[16 + dir * 8 + h] + bgf;
        const float lf = fminf(fp, 0.f) - log1pf(expf(-fabsf(fp)));
        float bc = lf;
#pragma unroll
        for (int off = 1; off < 64; off <<= 1) { float t = __shfl_up(bc, off); if (lane >= off) bc += t; }
        const float a = ic - bc;
        float pm = a;
#pragma unroll
        for (int off = 1; off < 64; off <<= 1) { float t = __shfl_up(pm, off); if (lane >= off) pm = fmaxf(pm, t); }
        const float M = fmaxf(m, pm);
        av[lane] = a; Mv[lane] = M; bv[lane] = bc;
        if (lane == 63) { scal[0] = M; scal[1] = bc; }
      }
      __syncthreads();
      const float M63 = scal[0], b63 = scal[1];
      const float m_new = b63 + M63;
      const float w_state = __expf(m - M63);
#pragma unroll
      for (int i = 0; i < 2; ++i) {
        const int r = (tid >> 4) + 32 * i;
        const float wt = __expf(av[r] - M63);
#pragma unroll
        for (int e = 0; e < 8; ++e) KwT[(c8 + e) * 72 + r] = f2bf(kf[i][e] * wt);
      }
      __syncthreads();
      const int tb = wid & 1, vb = wid >> 1;
      if (wid < 4) {
        const int sb = wid >> 1;
        f32x16 s = {};
        if (sb <= tb) s = mma_nt(Qs + tb * 32 * 136, 136, Ks + sb * 32 * 136, 136, 128, s, r32, hi);
        const int sc = sb * 32 + r32; const float as = av[sc];
#pragma unroll
        for (int r = 0; r < 16; ++r) {
          const int t = tb * 32 + crow(r, hi);
          float w = (sc <= t) ? s[r] * __expf(as - Mv[t]) : 0.f;
          Wb[t * 72 + sc] = f2bf(w);
        }
      }
      f32x16 inter = {};
      inter = mma_nt(Qs + tb * 32 * 136, 136, Cb + vb * 32 * 136, 136, 128, inter, r32, hi);
      __syncthreads();
      {
        const int t = tid >> 3, part = tid & 7;
        float wsum[8]; unpack8(*(const u32x4*)(Wb + t * 72 + part * 8), wsum);
        float dw = 0.f;
#pragma unroll
        for (int e = 0; e < 8; ++e) dw += wsum[e];
        float q0[8], q1[8]; unpack8(*(const u32x4*)(Qs + t * 136 + part * 16), q0); unpack8(*(const u32x4*)(Qs + t * 136 + part * 16 + 8), q1);
        float dq = 0.f;
#pragma unroll
        for (int e = 0; e < 8; ++e) dq += q0[e] * nvec[part * 16 + e] + q1[e] * nvec[part * 16 + 8 + e];
        dw += __shfl_xor(dw, 1); dw += __shfl_xor(dw, 2); dw += __shfl_xor(dw, 4);
        dq += __shfl_xor(dq, 1); dq += __shfl_xor(dq, 2); dq += __shfl_xor(dq, 4);
        if (part == 0) {
          const float Mt = Mv[t];
          const float wint = __expf(m - Mt);
          const float den = wint * dq + dw;
          const float mt = bv[t] + Mt;
          sclv[t] = 1.f / fmaxf(fabsf(den), __expf(-mt));
          wintv[t] = wint;
        }
      }
      __syncthreads();
      {
        f32x16 num;
#pragma unroll
        for (int r = 0; r < 16; ++r) num[r] = inter[r] * wintv[tb * 32 + crow(r, hi)];
        num = mma_nt(Wb + tb * 32 * 72, 72, VsT + vb * 32 * 72, 72, 64, num, r32, hi);
        bf16_t* Hout = dir ? HB : HF;
#pragma unroll
        for (int r = 0; r < 16; ++r) {
          const int t = tb * 32 + crow(r, hi);
          const int tc = ch * 64 + t; const int pos = dir ? (L - 1 - tc) : tc;
          Hout[(rowbase + pos) * 1024 + h * 128 + vb * 32 + r32] = f2bf(num[r] * sclv[t]);
        }
      }
#pragma unroll
      for (int i = 0; i < 2; ++i) {
        const int kb = (wid & 1) * 2 + i;
#pragma unroll
        for (int r = 0; r < 16; ++r) cacc[i][r] *= w_state;
        cacc[i] = mma_nt(VsT + vb2 * 32 * 72, 72, KwT + kb * 32 * 72, 72, 64, cacc[i], r32, hi);
#pragma unroll
        for (int r = 0; r < 16; ++r) Cb[(vb2 * 32 + crow(r, hi)) * 136 + kb * 32 + r32] = f2bf(cacc[i][r]);
      }
      if (tid < 128) {
        float s = 0.f;
#pragma unroll
        for (int q = 0; q < 8; ++q) { float f[8]; unpack8(*(const u32x4*)(KwT + tid * 72 + q * 8), f);
#pragma unroll
          for (int e = 0; e < 8; ++e) s += f[e]; }
        nvec[tid] = w_state * nvec[tid] + s;
      }
      m = m_new;
      __syncthreads();
    }
    if (seq < 32) {
      float* Co = p.out + O_C + (long)((seq * 2 + dir) * 8 + h) * 16384;
#pragma unroll
      for (int i = 0; i < 2; ++i) { const int kb = (wid & 1) * 2 + i;
#pragma unroll
        for (int r = 0; r < 16; ++r) Co[(vb2 * 32 + crow(r, hi)) * 128 + kb * 32 + r32] = cacc[i][r]; }
      if (tid < 128) p.out[O_N + ((seq * 2 + dir) * 8 + h) * 128 + tid] = nvec[tid];
      if (tid == 0) p.out[O_M + (seq * 2 + dir) * 8 + h] = m;
    }
  }
  __syncthreads();
}

__device__ __forceinline__ void mlstm_post(const int wv, const Params& p, const int zq, const bf16_t* __restrict__ HF, const bf16_t* __restrict__ HB,
                                           const bf16_t* __restrict__ P1, bf16_t* __restrict__ A) {
  const int tidx = ltid(wv);
  const int wid = wv, lane = tidx & 63;
  const float* hn = p.in[zq + 37];
  for (int row = blockIdx.x * 8 + wid; row < T_TOK; row += gridDim.x * 8) {
    float hv[16], t0[8], t1[8];
    unpack8(*(const u32x4*)(HF + (long)row * 1024 + lane * 16), hv); unpack8(*(const u32x4*)(HF + (long)row * 1024 + lane * 16 + 8), hv + 8);
    unpack8(*(const u32x4*)(HB + (long)row * 1024 + lane * 16), t0); unpack8(*(const u32x4*)(HB + (long)row * 1024 + lane * 16 + 8), t1);
    float ss = 0.f;
#pragma unroll
    for (int e = 0; e < 8; ++e) { hv[e] += t0[e]; hv[8 + e] += t1[e]; }
#pragma unroll
    for (int e = 0; e < 16; ++e) ss += hv[e] * hv[e];
    ss += __shfl_xor(ss, 1); ss += __shfl_xor(ss, 2); ss += __shfl_xor(ss, 4);
    const float rs = rsqrtf(ss * (1.f / 128.f) + 1e-6f);
    float ov[16];
    unpack8(*(const u32x4*)(P1 + (long)row * 4096 + 3072 + lane * 16), ov); unpack8(*(const u32x4*)(P1 + (long)row * 4096 + 3072 + lane * 16 + 8), ov + 8);
    float y[16];
#pragma unroll
    for (int e = 0; e < 16; ++e) y[e] = hv[e] * rs * hn[lane * 16 + e] * (1.f / (1.f + __expf(-ov[e])));
    *(u32x4*)(A + (long)row * 1024 + lane * 16) = pack8(y);
    *(u32x4*)(A + (long)row * 1024 + lane * 16 + 8) = pack8(y + 8);
  }
}

__device__ __forceinline__ void gsync(const int wv, unsigned* bar, unsigned target) {
  const int tidx = ltid(wv);
  __syncthreads();
  if (tidx == 0) {
    __threadfence();
    __hip_atomic_fetch_add(bar, 1u, __ATOMIC_RELEASE, __HIP_MEMORY_SCOPE_AGENT);
    while (__hip_atomic_load(bar, __ATOMIC_RELAXED, __HIP_MEMORY_SCOPE_AGENT) < target) __builtin_amdgcn_s_sleep(4);
    __threadfence();
  }
  __syncthreads();
}

__global__ void __launch_bounds__(512) mega(Params p, int ph_lo, int ph_hi) {
  const int wv = __builtin_amdgcn_readfirstlane(threadIdx.x >> 6);
  if (ph_hi < 0) { cg::this_grid().sync(); }
  unsigned* bar = (unsigned*)(p.ws + WS_END);
  char* ws = p.ws;
  bf16_t* Wt_in0 = (bf16_t*)(ws + OFF_WIN0); bf16_t* Wt_out0 = (bf16_t*)(ws + OFF_WOUT0);
  bf16_t* Wt_up0 = (bf16_t*)(ws + OFF_WUP0); bf16_t* Wt_up1 = (bf16_t*)(ws + OFF_WUP1);
  bf16_t* Wt_dn0 = (bf16_t*)(ws + OFF_WDN0); bf16_t* Wt_dn1 = (bf16_t*)(ws + OFF_WDN1);
  bf16_t* Wt_in1 = (bf16_t*)(ws + OFF_WIN1); bf16_t* Wt_out1 = (bf16_t*)(ws + OFF_WOUT1);
  float* modv = (float*)(ws + OFF_MOD);
  char* Pr = ws + OFF_P; char* Gr = ws + OFF_G;
  bf16_t* Pb = (bf16_t*)Pr; float* R = (float*)Pr;
  bf16_t* QA = (bf16_t*)(Pr + P_QA); bf16_t* KA = (bf16_t*)(Pr + P_KA); bf16_t* VA = (bf16_t*)(Pr + P_VA); bf16_t* X0 = (bf16_t*)(Pr + P_X0);
  float* GT = (float*)(Pr + P_GT); bf16_t* A2 = (bf16_t*)(Pr + P_A2);
  bf16_t* A = (bf16_t*)Gr; bf16_t* Gb = (bf16_t*)Gr; float* VV = (float*)(Gr + G_VV);
  bf16_t* HF = (bf16_t*)Gr; bf16_t* HB = (bf16_t*)(Gr + G_HB);
  float* X = p.out;
  float* F256 = p.out + O_C + 512; float* F2048 = p.out + O_C + 512 * 512 + 512;
  const float* mod0 = modv; const float* mod1 = modv + 3 * 6144;
#ifdef ONLY
#define PH(i, ...) if ((i) == ONLY) { const int zq = opq(); __VA_ARGS__; gsync(wv, bar, gridDim.x); }
#else
#ifndef REP
#define REP -1
#endif
#define PH(i, ...) if (ph_lo <= (i) && (i) < ph_hi) { const int zq = opq(); __VA_ARGS__; \
    if ((i) == REP) { gsync(wv, bar, (unsigned)((i) + 1) * gridDim.x); __VA_ARGS__; gsync(wv, bar, (unsigned)((i) + 2) * gridDim.x); __VA_ARGS__; } \
    if ((i) + 1 < ph_hi) gsync(wv, bar, (unsigned)((i) + 1 - ph_lo + ((i) >= REP && REP >= 0 ? 2 : 0)) * gridDim.x); }
#endif
  PH(0, {
    conv_w(wv, p.in[zq + 19], Wt_in0, 1024, 2560, 2560);
    conv_w(wv, p.in[zq + 20], Wt_out0, 1024, 1024, 1024);
    conv_w(wv, p.in[zq + 15], Wt_up0, 1024, 5632, 5632);
    conv_w(wv, p.in[zq + 15] + (long)1024 * 5632, Wt_up1, 1024, 5632, 5632);
    conv_w(wv, p.in[zq + 18], Wt_dn0, 2816, 1024, 1024);
    conv_w(wv, p.in[zq + 18] + (long)2816 * 1024, Wt_dn1, 2816, 1024, 1024);
    conv_w(wv, p.in[zq + 33], Wt_in1, 1024, 4128, 4352);
    conv_w(wv, p.in[zq + 38], Wt_out1, 1024, 1024, 1024);
    mod_phase(wv, p, zq, modv);
    filt_phase(wv, p, zq, F256, F2048);
  })
  PH(1, (row_phase<true, false, true>(wv, p, zq, nullptr, nullptr, mod0, 0, nullptr, p.in[zq + 11], mod0, 0, A)))
  PH(2, (gemm_phase<0, 2560>(wv, A, Wt_in0, 2560, 1024, Pb, nullptr)))
  PH(3, post_inproj0(wv, p, zq, Pb, QA, KA, VA, VV, X0))
  PH(4, mix0_phase(wv, p, zq, QA, KA, VA, VV, X0, F256, F2048, A))
  PH(5, (gemm_phase<1, 1024>(wv, A, Wt_out0, 1024, 1024, R, nullptr)))
  PH(6, (row_phase<true, true, true>(wv, p, zq, R, p.in[zq + 12], mod0, 2, X, p.in[zq + 13], mod0, 3, A)))
  PH(7, (gemm_phase<0, 5632>(wv, A, Wt_up0, 5632, 1024, Pb, nullptr)))
  PH(8, ffn_act_phase(wv, Pb, p.in[zq + 16], p.in[zq + 17], Gb))
  PH(9, (gemm_phase<1, 1024>(wv, Gb, Wt_dn0, 1024, 2816, R, nullptr)))
  PH(10, (row_phase<false, true, true>(wv, p, zq, R, p.in[zq + 14], mod0, 5, X, p.in[zq + 11] + 1024, mod1, 0, A)))
  PH(11, (gemm_phase<2, 4096>(wv, A, Wt_in1, 4352, 1024, Pb, GT)))
  PH(12, {})
  PH(13, mlstm_phase(wv, p, zq, Pb, GT, HF, HB))
  PH(14, mlstm_post(wv, p, zq, HF, HB, Pb, A2))
  PH(15, (gemm_phase<1, 1024>(wv, A2, Wt_out1, 1024, 1024, R, nullptr)))
  PH(16, (row_phase<false, true, true>(wv, p, zq, R, p.in[zq + 12] + 1024, mod1, 2, X, p.in[zq + 13] + 1024, mod1, 3, A)))
  PH(17, (gemm_phase<0, 5632>(wv, A, Wt_up1, 5632, 1024, Pb, nullptr)))
  PH(18, ffn_act_phase(wv, Pb, p.in[zq + 16] + 3 * 5632, p.in[zq + 17] + 5632, Gb))
  PH(19, (gemm_phase<1, 1024>(wv, Gb, Wt_dn1, 1024, 2816, R, nullptr)))
  PH(20, (row_phase<false, true, false>(wv, p, zq, R, p.in[zq + 14] + 1024, mod1, 5, X, nullptr, mod1, 0, nullptr)))
#undef PH
}

extern "C" void kernel_launch(void* const* d_in, const int* in_sizes, int n_in, void* d_out, int out_size, void* d_ws, size_t ws_size,
                              hipStream_t stream) {
  static int grid_blocks = 0;
  if (!grid_blocks) {
    if (ws_size < WS_END + 256) fprintf(stderr, "kernel_launch: workspace too small: %zu < %zu\n", ws_size, (size_t)WS_END);
    hipFuncSetAttribute((const void*)mega, hipFuncAttributeMaxDynamicSharedMemorySize, LDS_BYTES);
    int dev = 0, cus = 0, per = 0;
    hipGetDevice(&dev);
    hipDeviceGetAttribute(&cus, hipDeviceAttributeMultiprocessorCount, dev);
    hipOccupancyMaxActiveBlocksPerMultiprocessor(&per, mega, 512, LDS_BYTES);
    if (per < 1) { fprintf(stderr, "kernel_launch: occupancy query returned %d\n", per); per = 1; }
    grid_blocks = cus;
  }
  Params p{};
  for (int i = 0; i < 39; ++i) p.in[i] = (const float*)d_in[i];
  p.out = (float*)d_out; p.ws = (char*)d_ws;
  int lo = 0, hi = NPH;
  (void)hipMemsetAsync((char*)d_ws + WS_END, 0, 256, stream);
  void* args[] = {&p, &lo, &hi};
  hipError_t e = hipLaunchCooperativeKernel((void*)mega, dim3(grid_blocks), dim3(512), args, LDS_BYTES, stream);
  if (e != hipSuccess) fprintf(stderr, "cooperative launch failed: %s (grid %d)\n", hipGetErrorString(e), grid_blocks);
}
```

```cpp
#include <hip/hip_runtime.h>
#include <hip/hip_cooperative_groups.h>
#include <cstdio>
#include <cstdint>
namespace cg = cooperative_groups;

typedef unsigned short bf16_t;
typedef short bf16x8 __attribute__((ext_vector_type(8)));
typedef short s16x4 __attribute__((ext_vector_type(4)));
typedef float f32x4 __attribute__((ext_vector_type(4)));
typedef float f32x8 __attribute__((ext_vector_type(8)));
typedef float f32x16 __attribute__((ext_vector_type(16)));
typedef unsigned u32x4 __attribute__((ext_vector_type(4)));
typedef unsigned u32x2 __attribute__((ext_vector_type(2)));

constexpr int T_TOK = 12288, TPR = 8192;
constexpr int LDS_BYTES = 131072;
constexpr int NPH = 21;

constexpr size_t OFF_WIN0 = 0, OFF_WOUT0 = 5242880, OFF_WUP0 = 7340032, OFF_WUP1 = 18874368, OFF_WDN0 = 30408704,
                 OFF_WDN1 = 36175872, OFF_WIN1 = 41943040, OFF_WOUT1 = 50855936, OFF_MOD = 52953088, OFF_P = 53100544,
                 OFF_G = 191512576, WS_END = 260718592;
constexpr size_t P_QA = 62914560, P_KA = 75497472, P_VA = 82313216, P_X0 = 89128960;
constexpr size_t P_GT = 100663296, P_A2 = 102236160;
constexpr size_t G_VV = 25165824, G_HB = 25165824;
constexpr size_t O_K = 12582912, O_V = 14680064, O_C = 16777216, O_N = 25165824, O_M = 25231360;

struct Params { const float* in[39]; float* out; char* ws; };

typedef __bf16 nbf16x2 __attribute__((ext_vector_type(2)));
typedef float nf32x2 __attribute__((ext_vector_type(2)));
__device__ __forceinline__ unsigned cvtpk(float lo, float hi) {
  nf32x2 v = {lo, hi};
  nbf16x2 b = __builtin_convertvector(v, nbf16x2);
  return __builtin_bit_cast(unsigned, b);
}
__device__ __forceinline__ bf16_t f2bf(float f) { return (bf16_t)(cvtpk(f, 0.f) & 0xffffu); }
__device__ __forceinline__ float bf2f(bf16_t h) { return __uint_as_float(((unsigned)h) << 16); }
__device__ __forceinline__ float bflo(unsigned w) { return __uint_as_float(w << 16); }
__device__ __forceinline__ float bfhi(unsigned w) { return __uint_as_float(w & 0xffff0000u); }
__device__ __forceinline__ float wave_sum(float v) {
#pragma unroll
  for (int o = 32; o > 0; o >>= 1) v += __shfl_xor(v, o);
  return v;
}
__device__ __forceinline__ int llane() { int l; asm volatile("v_mbcnt_lo_u32_b32 %0, -1, 0\n\tv_mbcnt_hi_u32_b32 %0, -1, %0" : "=v"(l)); return l; }
__device__ __forceinline__ int ltid(int wv) { return (wv << 6) | llane(); }
__device__ __forceinline__ int opq() { int z; asm volatile("s_mov_b32 %0, 0" : "=s"(z)); return z; }
__device__ __forceinline__ float silu_f(float x) { return x / (1.f + __expf(-x)); }
__device__ __forceinline__ int crow(int r, int hi) { return (r & 3) + 8 * (r >> 2) + 4 * hi; }
__device__ __forceinline__ void unpack8(u32x4 w, float* f) {
  f[0] = bflo(w[0]); f[1] = bfhi(w[0]); f[2] = bflo(w[1]); f[3] = bfhi(w[1]);
  f[4] = bflo(w[2]); f[5] = bfhi(w[2]); f[6] = bflo(w[3]); f[7] = bfhi(w[3]);
}
__device__ __forceinline__ u32x4 pack8(const float* f) {
  u32x4 w = {cvtpk(f[0], f[1]), cvtpk(f[2], f[3]), cvtpk(f[4], f[5]), cvtpk(f[6], f[7])}; return w;
}

__device__ __forceinline__ void conv_w(const int wv, const float* __restrict__ W, bf16_t* __restrict__ Wt, int K, int N, int NP) {
  const int tidx = ltid(wv);
  extern __shared__ __attribute__((aligned(16))) char shm_raw[];
  float* tl = (float*)shm_raw;
  const int tid = tidx;
  const int ntn = NP / 64, ntiles = (K / 64) * ntn;
  for (int tile = blockIdx.x; tile < ntiles; tile += gridDim.x) {
    const int k0 = (tile / ntn) * 64, n0 = (tile % ntn) * 64;
    __syncthreads();
#pragma unroll
    for (int i = 0; i < 2; ++i) {
      int kr = (tid >> 4) + 32 * i, nc = (tid & 15) * 4;
      float4 v = make_float4(0.f, 0.f, 0.f, 0.f);
      if (n0 + nc < N) v = *(const float4*)(W + (long)(k0 + kr) * N + n0 + nc);
      float* d = tl + kr * 65 + nc; d[0] = v.x; d[1] = v.y; d[2] = v.z; d[3] = v.w;
    }
    __syncthreads();
    {
      int n = tid >> 3, kg = (tid & 7) * 8;
      u32x4 w;
      w[0] = cvtpk(tl[(kg + 0) * 65 + n], tl[(kg + 1) * 65 + n]);
      w[1] = cvtpk(tl[(kg + 2) * 65 + n], tl[(kg + 3) * 65 + n]);
      w[2] = cvtpk(tl[(kg + 4) * 65 + n], tl[(kg + 5) * 65 + n]);
      w[3] = cvtpk(tl[(kg + 6) * 65 + n], tl[(kg + 7) * 65 + n]);
      *(u32x4*)(Wt + (long)(n0 + n) * K + k0 + kg) = w;
    }
  }
  __syncthreads();
}

__device__ __forceinline__ void mod_phase(const int wv, const Params& p, const int zq, float* modv) {
  const int tidx = ltid(wv);
  extern __shared__ __attribute__((aligned(16))) char shm_raw[];
  float* red = (float*)shm_raw;
  const int tid = tidx;
  const float* cvec = p.in[zq + 7]; const float* cctx = p.in[zq + 8]; const float* bmod = p.in[zq + 10];
  for (int item = blockIdx.x; item < 192; item += gridDim.x) {
    const int l = item / 96, cb = (item % 96) * 64;
    const float* W = p.in[zq + 9] + (long)l * 1024 * 6144;
    const int cl = tid & 15, kg = tid >> 4;
    float a0[4] = {0, 0, 0, 0}, a1[4] = {0, 0, 0, 0}, a2[4] = {0, 0, 0, 0};
#pragma unroll 4
    for (int i = 0; i < 32; ++i) {
      int k = kg + 32 * i;
      float4 w = *(const float4*)(W + (long)k * 6144 + cb + cl * 4);
      float s0 = silu_f(cctx[k]), s1 = silu_f(cvec[k]), s2 = silu_f(cvec[1024 + k]);
      a0[0] += s0 * w.x; a0[1] += s0 * w.y; a0[2] += s0 * w.z; a0[3] += s0 * w.w;
      a1[0] += s1 * w.x; a1[1] += s1 * w.y; a1[2] += s1 * w.z; a1[3] += s1 * w.w;
      a2[0] += s2 * w.x; a2[1] += s2 * w.y; a2[2] += s2 * w.z; a2[3] += s2 * w.w;
    }
    __syncthreads();
#pragma unroll
    for (int j = 0; j < 4; ++j) {
      red[kg * 192 + 0 * 64 + cl * 4 + j] = a0[j];
      red[kg * 192 + 1 * 64 + cl * 4 + j] = a1[j];
      red[kg * 192 + 2 * 64 + cl * 4 + j] = a2[j];
    }
    __syncthreads();
    if (tid < 192) {
      float s = 0.f;
#pragma unroll 8
      for (int q = 0; q < 32; ++q) s += red[q * 192 + tid];
      int g = tid / 64, col = cb + (tid % 64);
      modv[(l * 3 + g) * 6144 + col] = s + bmod[l * 6144 + col];
    }
  }
  __syncthreads();
}

__device__ __forceinline__ void filt_phase(const int wv, const Params& p, const int zq, float* F256, float* F2048) {
  const int tidx = ltid(wv);
  extern __shared__ __attribute__((aligned(16))) char shm_raw[];
  float* z = (float*)shm_raw; float* h1 = z + 32; float* h2 = h1 + 64;
  const int tid = tidx;
  const float *w1 = p.in[zq + 25], *b1 = p.in[zq + 26], *w2 = p.in[zq + 27], *b2 = p.in[zq + 28], *w3 = p.in[zq + 29], *b3 = p.in[zq + 30], *sf = p.in[zq + 31], *skip = p.in[zq + 32];
  const float DMAX = -15.350567286626973f, DMIN = -3.0701134573253946f;
  for (int item = blockIdx.x; item < 2304; item += gridDim.x) {
    const int L = item < 256 ? 256 : 2048; const int i = item < 256 ? item : item - 256;
    float* F = item < 256 ? F256 : F2048;
    const float t = (float)i / (float)(L - 1);
    __syncthreads();
    if (tid < 17) {
      float v;
      if (tid == 0) v = t;
      else if (tid <= 8) v = cosf(6.283185307179586f * t * (float)tid);
      else v = sinf(6.283185307179586f * t * (float)(tid - 8));
      z[tid] = v;
    }
    __syncthreads();
    if (tid < 64) { float s = b1[tid];
#pragma unroll 1
      for (int j = 0; j < 17; ++j) s += z[j] * w1[j * 64 + tid]; h1[tid] = sinf(sf[tid] * s); }
    __syncthreads();
    if (tid < 64) { float s = b2[tid];
#pragma unroll 8
      for (int j = 0; j < 64; ++j) s += h1[j] * w2[j * 64 + tid]; h2[tid] = sinf(sf[64 + tid] * s); }
    __syncthreads();
    {
      const int ch = tid; float sfw = b3[ch], sbw = b3[512 + ch];
#pragma unroll 8
      for (int j = 0; j < 64; ++j) { float hh = h2[j]; sfw += hh * w3[j * 1024 + ch]; sbw += hh * w3[j * 1024 + 512 + ch]; }
      float delta = fabsf(DMIN + (DMAX - DMIN) * ((float)ch / 511.f));
      float win = expf(-t * delta); sfw *= win; sbw *= win;
      if (i == 0) F[(long)(L - 1) * 512 + ch] = sfw + sbw + skip[ch];
      else { F[(long)(L - 1 + i) * 512 + ch] = sfw; F[(long)(L - 1 - i) * 512 + ch] = sbw; }
    }
  }
  __syncthreads();
}

template <bool FROM_IN, bool HAS_R, bool HAS_A>
__device__ __forceinline__ void row_phase(const int wv, const Params& p, const int zq, const float* __restrict__ R, const float* __restrict__ postg,
                                          const float* __restrict__ modg, int gate_m, float* X,
                                          const float* __restrict__ preg, const float* __restrict__ mods, int shift_m, bf16_t* __restrict__ A) {
  const int tidx = ltid(wv);
  const int wid = wv, lane = tidx & 63;
  for (int row = blockIdx.x * 8 + wid; row < T_TOK; row += gridDim.x * 8) {
    const int g = row < TPR ? 0 : 1 + (row - TPR) / 2048;
    const float* mg = modg + g * 6144;
    const float* ms = mods + g * 6144;
    const float* xin = FROM_IN ? (row < TPR ? p.in[zq + 0] + (long)row * 1024 : p.in[zq + 1] + (long)(row - TPR) * 1024) : (const float*)X + (long)row * 1024;
    float4 x[4];
#pragma unroll
    for (int j = 0; j < 4; ++j) x[j] = *(const float4*)(xin + j * 256 + lane * 4);
    if (HAS_R) {
      float4 r[4]; float ss = 0.f;
#pragma unroll
      for (int j = 0; j < 4; ++j) { r[j] = *(const float4*)(R + (long)row * 1024 + j * 256 + lane * 4); ss += r[j].x * r[j].x + r[j].y * r[j].y + r[j].z * r[j].z + r[j].w * r[j].w; }
      ss = wave_sum(ss); const float rs = rsqrtf(ss * (1.f / 1024.f) + 1e-6f);
#pragma unroll
      for (int j = 0; j < 4; ++j) {
        float4 pg = *(const float4*)(postg + j * 256 + lane * 4);
        float4 gt = *(const float4*)(mg + gate_m * 1024 + j * 256 + lane * 4);
        x[j].x += gt.x * (r[j].x * rs * pg.x); x[j].y += gt.y * (r[j].y * rs * pg.y);
        x[j].z += gt.z * (r[j].z * rs * pg.z); x[j].w += gt.w * (r[j].w * rs * pg.w);
        *(float4*)(X + (long)row * 1024 + j * 256 + lane * 4) = x[j];
      }
    }
    if (HAS_A) {
      float ss = 0.f;
#pragma unroll
      for (int j = 0; j < 4; ++j) ss += x[j].x * x[j].x + x[j].y * x[j].y + x[j].z * x[j].z + x[j].w * x[j].w;
      ss = wave_sum(ss); const float rs = rsqrtf(ss * (1.f / 1024.f) + 1e-6f);
#pragma unroll
      for (int j = 0; j < 4; ++j) {
        float4 pg = *(const float4*)(preg + j * 256 + lane * 4);
        float4 sh = *(const float4*)(ms + shift_m * 1024 + j * 256 + lane * 4);
        float4 sc = *(const float4*)(ms + (shift_m + 1) * 1024 + j * 256 + lane * 4);
        float y0 = x[j].x * rs * pg.x * (1.f + sc.x) + sh.x, y1 = x[j].y * rs * pg.y * (1.f + sc.y) + sh.y;
        float y2 = x[j].z * rs * pg.z * (1.f + sc.z) + sh.z, y3 = x[j].w * rs * pg.w * (1.f + sc.w) + sh.w;
        u32x2 w = {cvtpk(y0, y1), cvtpk(y2, y3)};
        *(u32x2*)(A + (long)row * 1024 + j * 256 + lane * 4) = w;
      }
    }
  }
}

constexpr int BM = 256, BK = 64, HALF = 128, WGM = 8, HT = HALF * BK;
__device__ __forceinline__ int lds_byte(int r, int c) {
  int st = (r >> 4) * 2 + (c >> 5), rr = r & 15, cc = c & 31, ob = rr * 64 + cc * 2;
  return st * 1024 + (ob ^ (((ob >> 9) & 1) << 5));
}
__device__ __forceinline__ void stage_rc(int b, int& R, int& C) {
  int st = b / 1024, sb = b % 1024, swz = sb ^ (((sb >> 9) & 1) << 5);
  R = (st >> 1) * 16 + swz / 64; C = (st & 1) * 32 + (swz % 64) / 2;
}

template <int MODE, int LDC>
__device__ __forceinline__ void gemm_phase(const int wv, const bf16_t* __restrict__ A, const bf16_t* __restrict__ Bt, int N, int K,
                                           void* Cout, float* GT) {
  const int tidx = ltid(wv);
  extern __shared__ __attribute__((aligned(16))) char shm_raw[];
  bf16_t* shm = (bf16_t*)shm_raw;
#define SA(b, h) (shm + ((b) * 2 + (h)) * HT)
#define SB(b, h) (shm + (4 + (b) * 2 + (h)) * HT)
#define STAGE(P, BASE, br, kt) do { const bf16_t* _gb = (BASE) + ((long)(br) * K + (long)(kt) * BK); \
    __builtin_amdgcn_global_load_lds((const unsigned*)(_gb + soff0), (unsigned*)((char*)(P) + sl0), 16, 0, 0); \
    __builtin_amdgcn_global_load_lds((const unsigned*)(_gb + soff1), (unsigned*)((char*)(P) + sl0 + 8192), 16, 0, 0); } while (0)
#define LDA(dst, b, h) _Pragma("unroll") for (int m = 0; m < 4; ++m) _Pragma("unroll") for (int k = 0; k < 2; ++k) \
    dst[m][k] = *reinterpret_cast<const bf16x8*>((char*)SA(b, h) + lds_byte(wr * 64 + m * 16 + fr, k * 32 + fq * 8))
#define LDB(dst, b, h) _Pragma("unroll") for (int n = 0; n < 2; ++n) _Pragma("unroll") for (int k = 0; k < 2; ++k) \
    dst[n][k] = *reinterpret_cast<const bf16x8*>((char*)SB(b, h) + lds_byte(wc * 32 + n * 16 + fr, k * 32 + fq * 8))
#define MMA(ai, bj, At, Bt_) do { __builtin_amdgcn_s_setprio(1); \
    _Pragma("unroll") for (int m = 0; m < 4; ++m) _Pragma("unroll") for (int n = 0; n < 2; ++n) _Pragma("unroll") for (int k = 0; k < 2; ++k) \
      acc[ai][bj][m][n] = __builtin_amdgcn_mfma_f32_16x16x32_bf16(At[m][k], Bt_[n][k], acc[ai][bj][m][n], 0, 0, 0); \
    __builtin_amdgcn_s_setprio(0); } while (0)
#define WAIT_V(n) asm volatile("s_waitcnt vmcnt(" #n ")" ::: "memory")
#define WAIT_L(n) asm volatile("s_waitcnt lgkmcnt(" #n ")" ::: "memory")
#define BAR __builtin_amdgcn_s_barrier()
#define SCHED __builtin_amdgcn_sched_barrier(0)
  const int nM = T_TOK / BM, nN = N / BM, nwg = nM * nN;
  const int wid = wv, lane = tidx & 63, wr = wid >> 2, wc = wid & 3, fr = lane & 15, fq = lane >> 4;
  const int nt = K / BK;
  unsigned soff0, soff1; const int sl0 = tidx * 16;
  { int _r, _c; stage_rc(sl0, _r, _c); soff0 = (unsigned)(_r * K + _c); stage_rc(sl0 + 8192, _r, _c); soff1 = (unsigned)(_r * K + _c); }
  for (int tile = blockIdx.x; tile < nwg; tile += gridDim.x) {
    int wgt = tile;
    { const int q = nwg / 8, r = nwg % 8, xcd = wgt % 8, off = wgt / 8;
      wgt = (xcd < r ? xcd * (q + 1) : r * (q + 1) + (xcd - r) * q) + off; }
    const int nig = WGM * nN, gid = wgt / nig, fm = gid * WGM, gsz = min(nM - fm, WGM);
    const int pm = fm + ((wgt % nig) % gsz), pn = (wgt % nig) / gsz, brow = pm * BM, bcol = pn * BM;
    f32x4 acc[2][2][4][2] = {};
    bf16x8 At[4][2], B0[2][2], B1[2][2];
    STAGE(SB(0, 0), Bt, bcol, 0); STAGE(SA(0, 0), A, brow, 0);
    STAGE(SB(0, 1), Bt, bcol + HALF, 0); STAGE(SA(0, 1), A, brow + HALF, 0);
    if (wr == 1) BAR;
    WAIT_V(4); BAR;
    STAGE(SB(1, 0), Bt, bcol, 1); STAGE(SA(1, 0), A, brow, 1); STAGE(SB(1, 1), Bt, bcol + HALF, 1);
    WAIT_V(6); BAR;
    for (int t = 0; t < nt - 2; t += 2) {
      LDB(B0, 0, 0); SCHED; LDA(At, 0, 0); STAGE(SA(1, 1), A, brow + HALF, t + 1);
      WAIT_L(8); BAR; WAIT_L(0); MMA(0, 0, At, B0); BAR; SCHED;
      LDB(B1, 0, 1); STAGE(SB(0, 0), Bt, bcol, t + 2);
      BAR; WAIT_L(0); MMA(0, 1, At, B1); BAR;
      LDA(At, 0, 1); STAGE(SA(0, 0), A, brow, t + 2);
      BAR; WAIT_L(0); MMA(1, 0, At, B0); BAR; SCHED;
      STAGE(SB(0, 1), Bt, bcol + HALF, t + 2);
      WAIT_V(6); BAR; MMA(1, 1, At, B1); BAR;
      LDB(B0, 1, 0); SCHED; LDA(At, 1, 0); STAGE(SA(0, 1), A, brow + HALF, t + 2);
      WAIT_L(8); BAR; WAIT_L(0); MMA(0, 0, At, B0); BAR; SCHED;
      LDB(B1, 1, 1); STAGE(SB(1, 0), Bt, bcol, t + 3);
      BAR; WAIT_L(0); MMA(0, 1, At, B1); BAR;
      LDA(At, 1, 1); STAGE(SA(1, 0), A, brow, t + 3);
      BAR; WAIT_L(0); MMA(1, 0, At, B0); BAR; SCHED;
      STAGE(SB(1, 1), Bt, bcol + HALF, t + 3);
      WAIT_V(6); BAR; MMA(1, 1, At, B1); BAR;
    }
    { LDB(B0, 0, 0); LDA(At, 0, 0); STAGE(SA(1, 1), A, brow + HALF, nt - 1);
      BAR; WAIT_L(0); MMA(0, 0, At, B0); BAR;
      LDB(B1, 0, 1); BAR; WAIT_L(0); MMA(0, 1, At, B1); BAR;
      LDA(At, 0, 1); WAIT_V(4); BAR; WAIT_L(0); MMA(1, 0, At, B0); MMA(1, 1, At, B1); BAR; }
    { LDB(B0, 1, 0); LDA(At, 1, 0); WAIT_V(2); BAR; WAIT_L(0); MMA(0, 0, At, B0); BAR;
      LDB(B1, 1, 1); WAIT_V(0); BAR; WAIT_L(0); MMA(0, 1, At, B1); BAR;
      LDA(At, 1, 1); BAR; WAIT_L(0); MMA(1, 0, At, B0); MMA(1, 1, At, B1); BAR; }
    if (wr == 0) BAR;
    {
      const int le = llane();
      const int fr = le & 15, fq = le >> 4;
      const long base = (long)(brow + wr * 64) * LDC + bcol + wc * 32 + (unsigned)(fq * 4 * LDC + fr);
      if (MODE == 0 || (MODE == 2 && pn < 16)) {
        bf16_t* cp = (bf16_t*)Cout + base;
#pragma unroll
        for (int ai = 0; ai < 2; ++ai)
#pragma unroll
          for (int m = 0; m < 4; ++m)
#pragma unroll
            for (int j = 0; j < 4; ++j) {
              bf16_t* rp = cp + (ai * HALF + m * 16 + j) * LDC;
#pragma unroll
              for (int bj = 0; bj < 2; ++bj)
#pragma unroll
                for (int n = 0; n < 2; ++n) rp[bj * HALF + n * 16] = f2bf(acc[ai][bj][m][n][j]);
            }
      } else if (MODE == 1) {
        float* cp = (float*)Cout + base;
#pragma unroll
        for (int ai = 0; ai < 2; ++ai)
#pragma unroll
          for (int m = 0; m < 4; ++m)
#pragma unroll
            for (int j = 0; j < 4; ++j) {
              float* rp = cp + (ai * HALF + m * 16 + j) * LDC;
#pragma unroll
              for (int bj = 0; bj < 2; ++bj)
#pragma unroll
                for (int n = 0; n < 2; ++n) rp[bj * HALF + n * 16] = acc[ai][bj][m][n][j];
            }
      } else {
        if (wc == 0) {
          float* gp = GT + (long)(brow + wr * 64) * 32 + (unsigned)(fq * 4 * 32 + fr);
#pragma unroll
          for (int ai = 0; ai < 2; ++ai)
#pragma unroll
            for (int m = 0; m < 4; ++m)
#pragma unroll
              for (int j = 0; j < 4; ++j)
#pragma unroll
                for (int n = 0; n < 2; ++n) gp[(ai * HALF + m * 16 + j) * 32 + n * 16] = acc[ai][0][m][n][j];
        }
      }
    }
    __syncthreads();
  }
#undef SA
#undef SB
#undef STAGE
#undef LDA
#undef LDB
#undef MMA
}

__device__ __forceinline__ void post_inproj0(const int wv, const Params& p, const int zq, const bf16_t* __restrict__ P0, bf16_t* __restrict__ QA, bf16_t* __restrict__ KA,
                                             bf16_t* __restrict__ VA, float* __restrict__ VV, bf16_t* __restrict__ X0) {
  const int tidx = ltid(wv);
  const int wid = wv, lane = tidx & 63;
  const float* qn = p.in[zq + 21]; const float* kn = p.in[zq + 22]; const float* cw = p.in[zq + 23]; const float* cb = p.in[zq + 24];
  float* outK = p.out + O_K; float* outV = p.out + O_V;
  for (int i = blockIdx.x * 512 + tidx; i < 2 * 512 * 256 / 4; i += gridDim.x * 512) {
    int e = i * 4; int b = e / (512 * 256), rem = e % (512 * 256);
    float4 kk = *(const float4*)(p.in[zq + 2] + e); float4 vv = *(const float4*)(p.in[zq + 3] + e);
    long d = (long)(8192 + b * 2560 + 2048) * 256 + rem;
    u32x2 wk = {cvtpk(kk.x, kk.y), cvtpk(kk.z, kk.w)}; u32x2 wv = {cvtpk(vv.x, vv.y), cvtpk(vv.z, vv.w)};
    *(u32x2*)(KA + d) = wk; *(u32x2*)(VA + d) = wv;
  }
  const int fi = lane & 31;
  const float inv = exp2f(-(float)fi * (13.287712379549449f / 32.f));
  for (int row = blockIdx.x * 8 + wid; row < T_TOK; row += gridDim.x * 8) {
    const bool samp = row >= TPR;
    const int L = samp ? 2048 : 256;
    const int tl = samp ? (row - TPR) % 2048 : row % 256;
    const long krow = samp ? (long)(8192 + ((row - TPR) / 2048) * 2560 + tl) : (long)row;
    const bf16_t* base = P0 + (long)row * 2560;
    float cs = 1.f, sn = 0.f;
    if (samp) { float pos = (lane < 32) ? (float)(tl / 64) : (float)(tl % 64); float ang = pos * inv; cs = cosf(ang); sn = sinf(ang); }
#pragma unroll
    for (int hh = 0; hh < 6; ++hh) {
      float x1 = bf2f(base[hh * 128 + lane]), x2 = bf2f(base[hh * 128 + 64 + lane]);
      float ss = wave_sum(x1 * x1 + x2 * x2);
      float rs = rsqrtf(ss * (1.f / 128.f) + 1e-6f);
      const float* gw = hh < 4 ? qn : kn;
      float y1 = x1 * rs * gw[lane], y2 = x2 * rs * gw[64 + lane];
      if (hh >= 4 && !samp) { outK[(long)row * 256 + (hh - 4) * 128 + lane] = y1; outK[(long)row * 256 + (hh - 4) * 128 + 64 + lane] = y2; }
      float o1 = y1 * cs - y2 * sn, o2 = y1 * sn + y2 * cs;
      if (hh < 4) { QA[(long)row * 512 + hh * 128 + lane] = f2bf(o1); QA[(long)row * 512 + hh * 128 + 64 + lane] = f2bf(o2); }
      else { KA[krow * 256 + (hh - 4) * 128 + lane] = f2bf(o1); KA[krow * 256 + (hh - 4) * 128 + 64 + lane] = f2bf(o2); }
    }
    {
      u32x2 w = *(const u32x2*)(base + 768 + lane * 4);
      *(u32x2*)(VA + krow * 256 + lane * 4) = w;
      if (!samp) { float4 f = make_float4(bflo(w[0]), bfhi(w[0]), bflo(w[1]), bfhi(w[1])); *(float4*)(outV + (long)row * 256 + lane * 4) = f; }
    }
    {
      const int c8 = lane * 8;
      float uc[3][8];
#pragma unroll
      for (int g = 0; g < 3; ++g) {
        const int col = g * 512 + c8;
        float um[8], u0[8], up[8];
        u32x4 z4 = {0u, 0u, 0u, 0u};
        u32x4 wm = (tl > 0) ? *(const u32x4*)(base - 2560 + 1024 + col) : z4;
        u32x4 w0 = *(const u32x4*)(base + 1024 + col);
        u32x4 wp = (tl < L - 1) ? *(const u32x4*)(base + 2560 + 1024 + col) : z4;
        unpack8(wm, um); unpack8(w0, u0); unpack8(wp, up);
#pragma unroll
        for (int e = 0; e < 8; ++e)
          uc[g][e] = cw[col + e] * um[e] + cw[1536 + col + e] * u0[e] + cw[3072 + col + e] * up[e] + cb[col + e];
      }
      float vvv[8];
#pragma unroll
      for (int e = 0; e < 8; ++e) vvv[e] = uc[2][e] * uc[1][e];
      *(float4*)(VV + (long)row * 512 + c8) = make_float4(vvv[0], vvv[1], vvv[2], vvv[3]);
      *(float4*)(VV + (long)row * 512 + c8 + 4) = make_float4(vvv[4], vvv[5], vvv[6], vvv[7]);
      *(u32x4*)(X0 + (long)row * 512 + c8) = pack8(uc[0]);
    }
  }
}

constexpr int AD = 128, ANW = 8, QBLK = 32, KVBLK = 64;
constexpr float ASCALE = 0.088388347648318440f;
constexpr float ATHR = 8.f;
constexpr int LDQ = 512, LDK = 256, LDO = 1024;
constexpr size_t SHM_V = KVBLK * AD * 2, SHM_K = KVBLK * AD * 2;
#define KSWZ(row, colB) ((row) * 256 + ((colB) ^ (((row) & 7) << 4)))
#define SBAR() __builtin_amdgcn_sched_barrier(0)

__device__ __forceinline__ void partialSM(f32x16& p0, f32x16& p1, float& m_reg, float& mn, float& alpha) {
  constexpr float C = ASCALE * 1.4426950408889634f;
  float pmax = p0[0];
#pragma unroll
  for (int r = 1; r < 16; ++r) pmax = fmaxf(pmax, p0[r]);
#pragma unroll
  for (int r = 0; r < 16; ++r) pmax = fmaxf(pmax, p1[r]);
  { auto rr = __builtin_amdgcn_permlane32_swap(__float_as_uint(pmax), __float_as_uint(pmax), false, false);
    pmax = fmaxf(__uint_as_float(rr[0]), __uint_as_float(rr[1])); }
  if (__builtin_expect(__all(pmax - m_reg <= ATHR / ASCALE), 1)) { mn = m_reg; alpha = 1.f; }
  else { mn = fmaxf(m_reg, pmax); alpha = __builtin_amdgcn_exp2f((m_reg - mn) * C); m_reg = mn; }
  float mnC = -mn * C;
#pragma unroll
  for (int r = 0; r < 16; ++r) p0[r] = fmaf(p0[r], C, mnC);
#pragma unroll
  for (int r = 0; r < 16; ++r) p1[r] = fmaf(p1[r], C, mnC);
#pragma unroll
  for (int r = 0; r < 16; ++r) p0[r] = __builtin_amdgcn_exp2f(p0[r]);
}
__device__ __forceinline__ void finishSM(f32x16& p0, f32x16& p1, float alpha, float& l_reg, bf16x8& pa0, bf16x8& pa1, bf16x8& pa2, bf16x8& pa3) {
#pragma unroll
  for (int r = 0; r < 16; ++r) p1[r] = __builtin_amdgcn_exp2f(p1[r]);
  float ps = 0;
#pragma unroll
  for (int r = 0; r < 16; ++r) ps += p0[r];
#pragma unroll
  for (int r = 0; r < 16; ++r) ps += p1[r];
  { auto rr = __builtin_amdgcn_permlane32_swap(__float_as_uint(ps), __float_as_uint(ps), false, false);
    ps = __uint_as_float(rr[0]) + __uint_as_float(rr[1]); }
  l_reg = l_reg * alpha + ps;
#define PK4(P, BASE, OUT) do { unsigned a0 = cvtpk(P[BASE + 0], P[BASE + 1]), a1 = cvtpk(P[BASE + 2], P[BASE + 3]);   \
    unsigned b0 = cvtpk(P[BASE + 4], P[BASE + 5]), b1 = cvtpk(P[BASE + 6], P[BASE + 7]);                              \
    auto r0 = __builtin_amdgcn_permlane32_swap(a0, b0, false, false); auto r1 = __builtin_amdgcn_permlane32_swap(a1, b1, false, false); \
    u32x4 w = {r0[0], r1[0], r0[1], r1[1]}; OUT = *reinterpret_cast<bf16x8*>(&w); } while (0)
  PK4(p0, 0, pa0); PK4(p0, 8, pa1); PK4(p1, 0, pa2); PK4(p1, 8, pa3);
#undef PK4
}
__device__ __forceinline__ void qkt(f32x16& p0, f32x16& p1, const bf16_t* Ks, const bf16x8* qr, int r32, int hi) {
  p0 = f32x16{}; p1 = f32x16{};
#pragma unroll
  for (int d0 = 0; d0 < 8; ++d0) { int cb = (d0 * 16 + hi * 8) * 2;
    bf16x8 b0 = *reinterpret_cast<const bf16x8*>((const char*)Ks + KSWZ(r32, cb));
    bf16x8 b1 = *reinterpret_cast<const bf16x8*>((const char*)Ks + KSWZ(32 + r32, cb));
    p0 = __builtin_amdgcn_mfma_f32_32x32x16_bf16(b0, qr[d0], p0, 0, 0, 0);
    p1 = __builtin_amdgcn_mfma_f32_32x32x16_bf16(b1, qr[d0], p1, 0, 0, 0); }
}
__device__ __forceinline__ int v_st(int k, int c) { const int kk = (k & ~0xC) | ((k & 4) << 1) | ((k & 8) >> 1); return ((kk >> 3) * 4 + (c >> 5)) * 512 + ((kk & 7) * 32 + (c & 31)) * 2; }
__device__ __forceinline__ int v_rd_base(int lane) { return ((lane & 3) << 3) | (((lane >> 2) & 3) << 6) | (((lane >> 4) & 1) << 5) | (((lane >> 5) & 1) << 8); }
constexpr int v_rd_off(int d0, int ks, int half) { return d0 * 512 + ks * 4096 + half * 2048; }
template <int OFF> __device__ __forceinline__ s16x4 tr_read(int vb) {
  s16x4 r; asm volatile("ds_read_b64_tr_b16 %0, %1 offset:%2" : "=&v"(r) : "v"(vb), "i"(OFF) : "memory"); return r;
}
template <int D0> __device__ __forceinline__ void pv_one(f32x16& od, int vb, bf16x8 pa0, bf16x8 pa1, bf16x8 pa2, bf16x8 pa3) {
  const s16x4 l0 = tr_read<v_rd_off(D0, 0, 0)>(vb), h0 = tr_read<v_rd_off(D0, 0, 1)>(vb), l1 = tr_read<v_rd_off(D0, 1, 0)>(vb), h1 = tr_read<v_rd_off(D0, 1, 1)>(vb);
  const s16x4 l2 = tr_read<v_rd_off(D0, 2, 0)>(vb), h2 = tr_read<v_rd_off(D0, 2, 1)>(vb), l3 = tr_read<v_rd_off(D0, 3, 0)>(vb), h3 = tr_read<v_rd_off(D0, 3, 1)>(vb);
  asm volatile("s_waitcnt lgkmcnt(0)" ::: "memory"); SBAR();
#define PK(L, H) (bf16x8){L[0], L[1], L[2], L[3], H[0], H[1], H[2], H[3]}
  od = __builtin_amdgcn_mfma_f32_32x32x16_bf16(pa0, PK(l0, h0), od, 0, 0, 0);
  od = __builtin_amdgcn_mfma_f32_32x32x16_bf16(pa1, PK(l1, h1), od, 0, 0, 0);
  od = __builtin_amdgcn_mfma_f32_32x32x16_bf16(pa2, PK(l2, h2), od, 0, 0, 0);
  od = __builtin_amdgcn_mfma_f32_32x32x16_bf16(pa3, PK(l3, h3), od, 0, 0, 0);
#undef PK
}
__device__ __forceinline__ void pv_d0(f32x16* o, int vb, bf16x8 pa0, bf16x8 pa1, bf16x8 pa2, bf16x8 pa3) {
  pv_one<0>(o[0], vb, pa0, pa1, pa2, pa3); pv_one<1>(o[1], vb, pa0, pa1, pa2, pa3); pv_one<2>(o[2], vb, pa0, pa1, pa2, pa3); pv_one<3>(o[3], vb, pa0, pa1, pa2, pa3);
}

__device__ __forceinline__ void attn_dense_body(const int wv, const bf16_t* __restrict__ Qb, const bf16_t* __restrict__ Kh, const bf16_t* __restrict__ Vh,
                                                bf16_t* __restrict__ Ob, int seq, char* lds) {
  const int tidx = ltid(wv);
  const int tid = tidx, wid = wv, lane = tid & 63, r32 = lane & 31, hi = lane >> 5;
  bf16_t* V_lds = (bf16_t*)lds; bf16_t* K_lds = (bf16_t*)(lds + 2 * SHM_V);
  float* ws = (float*)(lds + 2 * SHM_V + 2 * SHM_K) + wid * 64; float* li_l = ws; float* al_l = ws + 32;
  float m_reg = -1e30f, l_reg = 0; f32x16 o[4] = {}; bf16x8 qr[8];
  const bf16_t* Qw = Qb + (long)(wid * QBLK + r32) * LDQ + hi * 8;
#pragma unroll
  for (int d0 = 0; d0 < 8; ++d0) qr[d0] = *reinterpret_cast<const bf16x8*>(Qw + d0 * 16);
  const int sr = tid >> 4, sc = (tid & 15) * 8, vst0 = v_st(sr, sc), vst1 = v_st(32 + sr, sc);
  const int vb0 = (int)(uintptr_t)V_lds + v_rd_base(lane);
  bf16x8 sA_vs0, sA_vs1, sA_ks0, sA_ks1, sB_vs0, sB_vs1, sB_ks0, sB_ks1;
#define SLOADA(k0) do { sA_vs0 = *(const bf16x8*)(&Vh[(long)((k0) + sr) * LDK + sc]); sA_vs1 = *(const bf16x8*)(&Vh[(long)((k0) + 32 + sr) * LDK + sc]); \
    sA_ks0 = *(const bf16x8*)(&Kh[(long)((k0) + sr) * LDK + sc]); sA_ks1 = *(const bf16x8*)(&Kh[(long)((k0) + 32 + sr) * LDK + sc]); } while (0)
#define SLOADB(k0) do { sB_vs0 = *(const bf16x8*)(&Vh[(long)((k0) + sr) * LDK + sc]); sB_vs1 = *(const bf16x8*)(&Vh[(long)((k0) + 32 + sr) * LDK + sc]); \
    sB_ks0 = *(const bf16x8*)(&Kh[(long)((k0) + sr) * LDK + sc]); sB_ks1 = *(const bf16x8*)(&Kh[(long)((k0) + 32 + sr) * LDK + sc]); } while (0)
#define SWRITEA(b) do { *(bf16x8*)((char*)V_lds + (b) * SHM_V + vst0) = sA_vs0; *(bf16x8*)((char*)V_lds + (b) * SHM_V + vst1) = sA_vs1; int kc = sc * 2; \
    *(bf16x8*)((char*)K_lds + (b) * SHM_K + KSWZ(sr, kc)) = sA_ks0; *(bf16x8*)((char*)K_lds + (b) * SHM_K + KSWZ(32 + sr, kc)) = sA_ks1; } while (0)
#define SWRITEB(b) do { *(bf16x8*)((char*)V_lds + (b) * SHM_V + vst0) = sB_vs0; *(bf16x8*)((char*)V_lds + (b) * SHM_V + vst1) = sB_vs1; int kc = sc * 2; \
    *(bf16x8*)((char*)K_lds + (b) * SHM_K + KSWZ(sr, kc)) = sB_ks0; *(bf16x8*)((char*)K_lds + (b) * SHM_K + KSWZ(32 + sr, kc)) = sB_ks1; } while (0)
#define SWAIT() asm volatile("s_waitcnt vmcnt(4)" ::: "memory")
#define RESC(a) do { if (__any((a) < 1.f)) { if (hi == 0) al_l[r32] = (a); asm volatile("s_waitcnt lgkmcnt(0)" ::: "memory"); \
    _Pragma("unroll") for (int d = 0; d < 4; ++d) _Pragma("unroll") for (int r = 0; r < 16; ++r) o[d][r] *= al_l[crow(r, hi)]; } } while (0)
  f32x16 pA0, pA1, pB0, pB1; float mnA, mnB, alA, alB; bf16x8 pa0, pa1, pa2, pa3; const int NT = seq / KVBLK;
  SLOADA(0); asm volatile("s_waitcnt vmcnt(0)" ::: "memory"); SWRITEA(0); __syncthreads();
  qkt(pA0, pA1, K_lds, qr, r32, hi); partialSM(pA0, pA1, m_reg, mnA, alA);
  SLOADB(KVBLK); if (2 < NT) SLOADA(2 * KVBLK);
  SWAIT(); SWRITEB(1); __syncthreads();
  for (int j = 1; j + 1 < NT; j += 2) {
    SBAR(); qkt(pB0, pB1, (bf16_t*)((char*)K_lds + SHM_K), qr, r32, hi);
    finishSM(pA0, pA1, alA, l_reg, pa0, pa1, pa2, pa3); SBAR();
    SLOADB((j + 2) * KVBLK); SBAR();
    pv_d0(o, vb0, pa0, pa1, pa2, pa3); partialSM(pB0, pB1, m_reg, mnB, alB);
    __syncthreads(); SWAIT(); SWRITEA(0);
    RESC(alB); __syncthreads();
    SBAR(); qkt(pA0, pA1, K_lds, qr, r32, hi);
    finishSM(pB0, pB1, alB, l_reg, pa0, pa1, pa2, pa3); SBAR();
    if (j + 3 < NT) SLOADA((j + 3) * KVBLK); SBAR();
    pv_d0(o, vb0 + (int)SHM_V, pa0, pa1, pa2, pa3); partialSM(pA0, pA1, m_reg, mnA, alA);
    __syncthreads(); SWAIT(); SWRITEB(1);
    RESC(alA); __syncthreads();
  }
  SBAR(); qkt(pB0, pB1, (bf16_t*)((char*)K_lds + SHM_K), qr, r32, hi);
  finishSM(pA0, pA1, alA, l_reg, pa0, pa1, pa2, pa3); SBAR();
  pv_d0(o, vb0, pa0, pa1, pa2, pa3); partialSM(pB0, pB1, m_reg, mnB, alB);
  __syncthreads(); RESC(alB);
  finishSM(pB0, pB1, alB, l_reg, pa0, pa1, pa2, pa3); SBAR();
  pv_d0(o, vb0 + (int)SHM_V, pa0, pa1, pa2, pa3);
  if (hi == 0) li_l[r32] = l_reg; asm volatile("s_waitcnt lgkmcnt(0)" ::: "memory");
  float rli[16];
#pragma unroll
  for (int r = 0; r < 16; ++r) rli[r] = __builtin_amdgcn_rcpf(li_l[crow(r, hi)]);
  bf16_t* Ow = Ob + (long)(wid * QBLK) * LDO;
#pragma unroll
  for (int r = 0; r < 16; ++r) { int orow = crow(r, hi);
#pragma unroll
    for (int d0 = 0; d0 < 4; ++d0) Ow[(long)orow * LDO + d0 * 32 + r32] = f2bf(o[d0][r] * rli[r]); }
#undef SLOADA
#undef SLOADB
#undef SWRITEA
#undef SWRITEB
#undef SWAIT
#undef RESC
}

__device__ __forceinline__ void hyena_item(const float* __restrict__ F, const float* __restrict__ VV, const bf16_t* __restrict__ X0,
                                           bf16_t* __restrict__ AO, long rowbase, int L, int c, int t0) {
  float y[16], ring[16];
#pragma unroll
  for (int i = 0; i < 16; ++i) { y[i] = 0.f; ring[i] = F[(long)(t0 + i + L - 1) * 512 + c]; }
  const float* vp = VV + rowbase * 512 + c;
  const float* fp = F + (long)(t0 + L - 2) * 512 + c;
  for (int s0 = 0; s0 < L; s0 += 16) {
#pragma unroll
    for (int j = 0; j < 16; ++j) {
      const float vs = vp[(long)(s0 + j) * 512];
      const float nf = fp[-(long)(s0 + j) * 512];
#pragma unroll
      for (int i = 0; i < 16; ++i) y[i] += ring[(i - j) & 15] * vs;
      ring[(15 - j) & 15] = nf;
    }
  }
#pragma unroll
  for (int i = 0; i < 16; ++i) {
    long row = rowbase + t0 + i;
    AO[row * 1024 + 512 + c] = f2bf(y[i] * bf2f(X0[row * 512 + c]));
  }
}

__device__ __forceinline__ void mix0_phase(const int wv, const Params& p, const int zq, const bf16_t* QA, const bf16_t* KA, const bf16_t* VA, const float* VV,
                                           const bf16_t* X0, const float* F256, const float* F2048, bf16_t* AO) {
  extern __shared__ __attribute__((aligned(16))) char shm_raw[];
#ifndef NO_ATTN
  for (int it = blockIdx.x; it < 192; it += gridDim.x) {
    long rowb, krow; int h, seqk;
    if (it < 64) { const int qb = it % 8, b = it / 32; h = (it / 8) % 4; rowb = 8192 + (long)b * 2048 + qb * 256; krow = 8192 + (long)b * 2560; seqk = 2560; }
    else { const int j = it - 64; const int b = j / 4; h = j % 4; rowb = (long)b * 256; krow = rowb; seqk = 256; }
    __syncthreads();
    attn_dense_body(wv, QA + rowb * 512 + h * 128, KA + krow * 256 + (h >> 1) * 128, VA + krow * 256 + (h >> 1) * 128, AO + rowb * 1024 + h * 128, seqk, shm_raw);
  }
#endif
#ifndef NO_HYENA
  const int lane = llane(); const int wid = wv;
  for (int it = (blockIdx.x + gridDim.x - 64) % gridDim.x; it < 768; it += gridDim.x) {
    if (it < 256) {
      const int b = it / 128, cgp = (it / 16) % 8, tg = it % 16;
      hyena_item(F2048, VV, X0, AO, 8192 + (long)b * 2048, 2048, cgp * 64 + lane, tg * 128 + wid * 16);
    } else {
      const int j = it - 256; const int b = j / 16, cgp = (j / 2) % 8, tg = j % 2;
      hyena_item(F256, VV, X0, AO, (long)b * 256, 256, cgp * 64 + lane, tg * 128 + wid * 16);
    }
  }
#endif
  __syncthreads();
}

__device__ __forceinline__ float gelu_f(float x) { return 0.5f * x * (1.f + erff(x * 0.70710678118654752f)); }
__device__ __forceinline__ void ffn_act_phase(const int wv, const bf16_t* __restrict__ P, const float* __restrict__ cw, const float* __restrict__ cb, bf16_t* __restrict__ G) {
  const int tidx = ltid(wv);
  const int tid = tidx;
  if (tid >= 352) return;
  const int c8 = tid * 8;
  float w1[3][8], w2[3][8], b1[8], b2[8];
#pragma unroll
  for (int e = 0; e < 8; ++e) {
#pragma unroll
    for (int k = 0; k < 3; ++k) { w1[k][e] = cw[k * 5632 + c8 + e]; w2[k][e] = cw[k * 5632 + 2816 + c8 + e]; }
    b1[e] = cb[c8 + e]; b2[e] = cb[2816 + c8 + e];
  }
  for (int item = blockIdx.x; item < T_TOK / 16; item += gridDim.x) {
    const int r0 = item * 16;
    const int L = r0 < TPR ? 256 : 2048;
    const int tl0 = r0 < TPR ? r0 % 256 : (r0 - TPR) % 2048;
    float am[8], a0[8], ap[8], gm[8], g0[8], gp[8];
    const u32x4 z4 = {0u, 0u, 0u, 0u};
    {
      const bf16_t* b = P + (long)r0 * 5632 + c8;
      u32x4 x = (tl0 > 0) ? *(const u32x4*)(b - 5632) : z4; unpack8(x, am);
      x = (tl0 > 0) ? *(const u32x4*)(b - 5632 + 2816) : z4; unpack8(x, gm);
      x = *(const u32x4*)(b); unpack8(x, a0);
      x = *(const u32x4*)(b + 2816); unpack8(x, g0);
    }
    for (int r = 0; r < 16; ++r) {
      const bf16_t* b = P + (long)(r0 + r) * 5632 + c8;
      const bool vn = (tl0 + r) < L - 1;
      u32x4 x = vn ? *(const u32x4*)(b + 5632) : z4; unpack8(x, ap);
      x = vn ? *(const u32x4*)(b + 5632 + 2816) : z4; unpack8(x, gp);
      float o[8];
#pragma unroll
      for (int e = 0; e < 8; ++e) {
        float h1 = w1[0][e] * am[e] + w1[1][e] * a0[e] + w1[2][e] * ap[e] + b1[e];
        float h2 = w2[0][e] * gm[e] + w2[1][e] * g0[e] + w2[2][e] * gp[e] + b2[e];
        o[e] = gelu_f(h1) * h2;
        am[e] = a0[e]; a0[e] = ap[e]; gm[e] = g0[e]; g0[e] = gp[e];
      }
      *(u32x4*)(G + (long)(r0 + r) * 2816 + c8) = pack8(o);
    }
  }
}

__device__ __forceinline__ f32x16 mma_nt(const bf16_t* A, int lda, const bf16_t* B, int ldb, int K, f32x16 acc, int r32, int hi) {
  for (int k0 = 0; k0 < K; k0 += 16) {
    bf16x8 a = *reinterpret_cast<const bf16x8*>(A + r32 * lda + k0 + 8 * hi);
    bf16x8 b = *reinterpret_cast<const bf16x8*>(B + r32 * ldb + k0 + 8 * hi);
    acc = __builtin_amdgcn_mfma_f32_32x32x16_bf16(a, b, acc, 0, 0, 0);
  }
  return acc;
}

__device__ __forceinline__ void mlstm_phase(const int wv, const Params& p, const int zq, const bf16_t* __restrict__ P1, const float* __restrict__ GT,
                                            bf16_t* __restrict__ HF, bf16_t* __restrict__ HB) {
  const int tidx = ltid(wv);
  extern __shared__ __attribute__((aligned(16))) char shm_raw[];
  bf16_t* Qs = (bf16_t*)shm_raw;
  bf16_t* Ks = Qs + 64 * 136;
  bf16_t* KwT = Ks + 64 * 136;
  bf16_t* VsT = KwT + 128 * 72;
  bf16_t* Wb = VsT + 128 * 72;
  bf16_t* Cb = Wb + 64 * 72;
  float* av = (float*)(Cb + 128 * 136);
  float* Mv = av + 64; float* bv = Mv + 64; float* sclv = bv + 64; float* wintv = sclv + 64; float* nvec = wintv + 64; float* scal = nvec + 128;
  float* cwl = scal + 8;
  const int tid = tidx, wid = wv, lane = tid & 63, r32 = lane & 31, hi = lane >> 5;
  const float* cw = p.in[zq + 35]; const float* cbias = p.in[zq + 36]; const float* bg = p.in[zq + 34];
  for (int u = blockIdx.x; u < 544; u += gridDim.x) {
    int seq, h, dir;
    if (u < 32) { seq = 32 + u / 16; h = (u / 2) % 8; dir = u % 2; } else { int j = u - 32; seq = j / 16; h = (j / 2) % 8; dir = j % 2; }
    const int L = seq < 32 ? 256 : 2048;
    const long rowbase = seq < 32 ? (long)seq * 256 : 8192 + (long)(seq - 32) * 2048;
    __syncthreads();
    f32x16 cacc[2]; float m = 0.f;
    const int vb2 = wid >> 1;
    if (seq >= 32) {
      const int b = seq - 32;
      const float* Cin = p.in[zq + 4] + (long)((b * 2 + dir) * 8 + h) * 16384;
#pragma unroll
      for (int i = 0; i < 2; ++i) { const int kb = (wid & 1) * 2 + i;
#pragma unroll
        for (int r = 0; r < 16; ++r) cacc[i][r] = Cin[(vb2 * 32 + crow(r, hi)) * 128 + kb * 32 + r32]; }
      if (tid < 128) nvec[tid] = p.in[zq + 5][((b * 2 + dir) * 8 + h) * 128 + tid];
      m = p.in[zq + 6][(b * 2 + dir) * 8 + h];
    } else {
#pragma unroll
      for (int i = 0; i < 2; ++i)
#pragma unroll
        for (int r = 0; r < 16; ++r) cacc[i][r] = 0.f;
      if (tid < 128) nvec[tid] = 0.f;
    }
#pragma unroll
    for (int i = 0; i < 2; ++i) { const int kb = (wid & 1) * 2 + i;
#pragma unroll
      for (int r = 0; r < 16; ++r) Cb[(vb2 * 32 + crow(r, hi)) * 136 + kb * 32 + r32] = f2bf(cacc[i][r]); }
    if (tid < 256) {
      const int col = (tid < 128) ? (h * 128 + tid) : (1024 + h * 128 + (tid - 128));
      cwl[tid] = cw[col]; cwl[256 + tid] = cw[2048 + col]; cwl[512 + tid] = cw[4096 + col]; cwl[768 + tid] = cbias[col];
    }
    const float bgi = bg[dir * 8 + h], bgf = bg[16 + dir * 8 + h];
    __syncthreads();
    const int nch = L / 64;
    for (int ch = 0; ch < nch; ++ch) {
      float kf[2][8];
      const int c8 = (tid & 15) * 8;
#pragma unroll
      for (int i = 0; i < 2; ++i) {
        const int r = (tid >> 4) + 32 * i;
        const int tc = ch * 64 + r;
        const int pos = dir ? (L - 1 - tc) : tc;
        const bf16_t* rowp = P1 + (rowbase + pos) * 4096;
        const u32x4 z4 = {0u, 0u, 0u, 0u};
        float um[8], u0[8], up[8], qf[8];
        { u32x4 wm = (pos > 0) ? *(const u32x4*)(rowp - 4096 + h * 128 + c8) : z4;
          u32x4 w0 = *(const u32x4*)(rowp + h * 128 + c8);
          u32x4 wp = (pos < L - 1) ? *(const u32x4*)(rowp + 4096 + h * 128 + c8) : z4;
          unpack8(wm, um); unpack8(w0, u0); unpack8(wp, up);
#pragma unroll
          for (int e = 0; e < 8; ++e) qf[e] = silu_f(cwl[c8 + e] * um[e] + cwl[256 + c8 + e] * u0[e] + cwl[512 + c8 + e] * up[e] + cwl[768 + c8 + e]);
          *(u32x4*)(Qs + r * 136 + c8) = pack8(qf); }
        { u32x4 wm = (pos > 0) ? *(const u32x4*)(rowp - 4096 + 1024 + h * 128 + c8) : z4;
          u32x4 w0 = *(const u32x4*)(rowp + 1024 + h * 128 + c8);
          u32x4 wp = (pos < L - 1) ? *(const u32x4*)(rowp + 4096 + 1024 + h * 128 + c8) : z4;
          unpack8(wm, um); unpack8(w0, u0); unpack8(wp, up);
#pragma unroll
          for (int e = 0; e < 8; ++e) kf[i][e] = 0.088388347648318440f * silu_f(cwl[128 + c8 + e] * um[e] + cwl[256 + 128 + c8 + e] * u0[e] + cwl[512 + 128 + c8 + e] * up[e] + cwl[768 + 128 + c8 + e]);
          *(u32x4*)(Ks + r * 136 + c8) = pack8(kf[i]); }
        { u32x4 wv = *(const u32x4*)(rowp + 2048 + h * 128 + c8);
          VsT[(c8 + 0) * 72 + r] = (bf16_t)(wv[0] & 0xffff); VsT[(c8 + 1) * 72 + r] = (bf16_t)(wv[0] >> 16);
          VsT[(c8 + 2) * 72 + r] = (bf16_t)(wv[1] & 0xffff); VsT[(c8 + 3) * 72 + r] = (bf16_t)(wv[1] >> 16);
          VsT[(c8 + 4) * 72 + r] = (bf16_t)(wv[2] & 0xffff); VsT[(c8 + 5) * 72 + r] = (bf16_t)(wv[2] >> 16);
          VsT[(c8 + 6) * 72 + r] = (bf16_t)(wv[3] & 0xffff); VsT[(c8 + 7) * 72 + r] = (bf16_t)(wv[3] >> 16); }
      }
      if (wid == 0) {
        const int tc = ch * 64 + lane; const int pos = dir ? (L - 1 - tc) : tc;
        const float* gr = GT + (rowbase + pos) * 32;
        const float ic = gr[dir * 8 + h] + bgi;
        const float fp = gr[16 + dir * 8 + h] + bgf;
        const float lf = fminf(fp, 0.f) - log1pf(expf(-fabsf(fp)));
        float bc = lf;
#pragma unroll
        for (int off = 1; off < 64; off <<= 1) { float t = __shfl_up(bc, off); if (lane >= off) bc += t; }
        const float a = ic - bc;
        float pm = a;
#pragma unroll
        for (int off = 1; off < 64; off <<= 1) { float t = __shfl_up(pm, off); if (lane >= off) pm = fmaxf(pm, t); }
        const float M = fmaxf(m, pm);
        av[lane] = a; Mv[lane] = M; bv[lane] = bc;
        if (lane == 63) { scal[0] = M; scal[1] = bc; }
      }
      __syncthreads();
      const float M63 = scal[0], b63 = scal[1];
      const float m_new = b63 + M63;
      const float w_state = __expf(m - M63);
#pragma unroll
      for (int i = 0; i < 2; ++i) {
        const int r = (tid >> 4) + 32 * i;
        const float wt = __expf(av[r] - M63);
#pragma unroll
        for (int e = 0; e < 8; ++e) KwT[(c8 + e) * 72 + r] = f2bf(kf[i][e] * wt);
      }
      __syncthreads();
      const int tb = wid & 1, vb = wid >> 1;
      if (wid < 4) {
        const int sb = wid >> 1;
        f32x16 s = {};
        if (sb <= tb) s = mma_nt(Qs + tb * 32 * 136, 136, Ks + sb * 32 * 136, 136, 128, s, r32, hi);
        const int sc = sb * 32 + r32; const float as = av[sc];
#pragma unroll
        for (int r = 0; r < 16; ++r) {
          const int t = tb * 32 + crow(r, hi);
          float w = (sc <= t) ? s[r] * __expf(as - Mv[t]) : 0.f;
          Wb[t * 72 + sc] = f2bf(w);
        }
      }
      f32x16 inter = {};
      inter = mma_nt(Qs + tb * 32 * 136, 136, Cb + vb * 32 * 136, 136, 128, inter, r32, hi);
      __syncthreads();
      {
        const int t = tid >> 3, part = tid & 7;
        float wsum[8]; unpack8(*(const u32x4*)(Wb + t * 72 + part * 8), wsum);
        float dw = 0.f;
#pragma unroll
        for (int e = 0; e < 8; ++e) dw += wsum[e];
        float q0[8], q1[8]; unpack8(*(const u32x4*)(Qs + t * 136 + part * 16), q0); unpack8(*(const u32x4*)(Qs + t * 136 + part * 16 + 8), q1);
        float dq = 0.f;
#pragma unroll
        for (int e = 0; e < 8; ++e) dq += q0[e] * nvec[part * 16 + e] + q1[e] * nvec[part * 16 + 8 + e];
        dw += __shfl_xor(dw, 1); dw += __shfl_xor(dw, 2); dw += __shfl_xor(dw, 4);
        dq += __shfl_xor(dq, 1); dq += __shfl_xor(dq, 2); dq += __shfl_xor(dq, 4);
        if (part == 0) {
          const float Mt = Mv[t];
          const float wint = __expf(m - Mt);
          const float den = wint * dq + dw;
          const float mt = bv[t] + Mt;
          sclv[t] = 1.f / fmaxf(fabsf(den), __expf(-mt));
          wintv[t] = wint;
        }
      }
      __syncthreads();
      {
        f32x16 num;
#pragma unroll
        for (int r = 0; r < 16; ++r) num[r] = inter[r] * wintv[tb * 32 + crow(r, hi)];
        num = mma_nt(Wb + tb * 32 * 72, 72, VsT + vb * 32 * 72, 72, 64, num, r32, hi);
        bf16_t* Hout = dir ? HB : HF;
#pragma unroll
        for (int r = 0; r < 16; ++r) {
          const int t = tb * 32 + crow(r, hi);
          const int tc = ch * 64 + t; const int pos = dir ? (L - 1 - tc) : tc;
          Hout[(rowbase + pos) * 1024 + h * 128 + vb * 32 + r32] = f2bf(num[r] * sclv[t]);
        }
      }
#pragma unroll
      for (int i = 0; i < 2; ++i) {
        const int kb = (wid & 1) * 2 + i;
#pragma unroll
        for (int r = 0; r < 16; ++r) cacc[i][r] *= w_state;
        cacc[i] = mma_nt(VsT + vb2 * 32 * 72, 72, KwT + kb * 32 * 72, 72, 64, cacc[i], r32, hi);
#pragma unroll
        for (int r = 0; r < 16; ++r) Cb[(vb2 * 32 + crow(r, hi)) * 136 + kb * 32 + r32] = f2bf(cacc[i][r]);
      }
      if (tid < 128) {
        float s = 0.f;
#pragma unroll
        for (int q = 0; q < 8; ++q) { float f[8]; unpack8(*(const u32x4*)(KwT + tid * 72 + q * 8), f);
#pragma unroll
          for (int e = 0; e < 8; ++e) s += f[e]; }
        nvec[tid] = w_state * nvec[tid] + s;
      }
      m = m_new;
      __syncthreads();
    }
    if (seq < 32) {
      float* Co = p.out + O_C + (long)((seq * 2 + dir) * 8 + h) * 16384;
#pragma unroll
      for (int i = 0; i < 2; ++i) { const int kb = (wid & 1) * 2 + i;
#pragma unroll
        for (int r = 0; r < 16; ++r) Co[(vb2 * 32 + crow(r, hi)) * 128 + kb * 32 + r32] = cacc[i][r]; }
      if (tid < 128) p.out[O_N + ((seq * 2 + dir) * 8 + h) * 128 + tid] = nvec[tid];
      if (tid == 0) p.out[O_M + (seq * 2 + dir) * 8 + h] = m;
    }
  }
  __syncthreads();
}

__device__ __forceinline__ void mlstm_post(const int wv, const Params& p, const int zq, const bf16_t* __restrict__ HF, const bf16_t* __restrict__ HB,
                                           const bf16_t* __restrict__ P1, bf16_t* __restrict__ A) {
  const int tidx = ltid(wv);
  const int wid = wv, lane = tidx & 63;
  const float* hn = p.in[zq + 37];
  for (int row = blockIdx.x * 8 + wid; row < T_TOK; row += gridDim.x * 8) {
    float hv[16], t0[8], t1[8];
    unpack8(*(const u32x4*)(HF + (long)row * 1024 + lane * 16), hv); unpack8(*(const u32x4*)(HF + (long)row * 1024 + lane * 16 + 8), hv + 8);
    unpack8(*(const u32x4*)(HB + (long)row * 1024 + lane * 16), t0); unpack8(*(const u32x4*)(HB + (long)row * 1024 + lane * 16 + 8), t1);
    float ss = 0.f;
#pragma unroll
    for (int e = 0; e < 8; ++e) { hv[e] += t0[e]; hv[8 + e] += t1[e]; }
#pragma unroll
    for (int e = 0; e < 16; ++e) ss += hv[e] * hv[e];
    ss += __shfl_xor(ss, 1); ss += __shfl_xor(ss, 2); ss += __shfl_xor(ss, 4);
    const float rs = rsqrtf(ss * (1.f / 128.f) + 1e-6f);
    float ov[16];
    unpack8(*(const u32x4*)(P1 + (long)row * 4096 + 3072 + lane * 16), ov); unpack8(*(const u32x4*)(P1 + (long)row * 4096 + 3072 + lane * 16 + 8), ov + 8);
    float y[16];
#pragma unroll
    for (int e = 0; e < 16; ++e) y[e] = hv[e] * rs * hn[lane * 16 + e] * (1.f / (1.f + __expf(-ov[e])));
    *(u32x4*)(A + (long)row * 1024 + lane * 16) = pack8(y);
    *(u32x4*)(A + (long)row * 1024 + lane * 16 + 8) = pack8(y + 8);
  }
}

__device__ __forceinline__ void gsync(const int wv, unsigned* bar, const unsigned k) {
  const int tidx = ltid(wv);
  asm volatile("s_waitcnt vmcnt(0)" ::: "memory");
  __syncthreads();
  if (tidx == 0) {
    __builtin_amdgcn_fence(__ATOMIC_RELEASE, "agent");
    asm volatile("s_waitcnt vmcnt(0)" ::: "memory");
    const unsigned g = blockIdx.x & 7u;
    const unsigned ng = (gridDim.x + 7u - g) >> 3;
    const unsigned ngroups = gridDim.x < 8u ? gridDim.x : 8u;
    const unsigned old = __hip_atomic_fetch_add(bar + g * 32, 1u, __ATOMIC_RELAXED, __HIP_MEMORY_SCOPE_AGENT);
    if (old + 1u == k * ng) {
      const unsigned o2 = __hip_atomic_fetch_add(bar + 256, 1u, __ATOMIC_RELAXED, __HIP_MEMORY_SCOPE_AGENT);
      if (o2 + 1u == k * ngroups) {
#pragma unroll
        for (int q = 0; q < 8; ++q) __hip_atomic_store(bar + 512 + q * 32, k, __ATOMIC_RELAXED, __HIP_MEMORY_SCOPE_AGENT);
      }
    }
    while (__hip_atomic_load(bar + 512 + g * 32, __ATOMIC_RELAXED, __HIP_MEMORY_SCOPE_AGENT) < k) __builtin_amdgcn_s_sleep(4);
    __builtin_amdgcn_fence(__ATOMIC_ACQUIRE, "agent");
    asm volatile("s_waitcnt vmcnt(0)" ::: "memory");
  }
  __syncthreads();
}

__global__ void __launch_bounds__(512) mega(Params p, int ph_lo, int ph_hi) {
  const int wv = __builtin_amdgcn_readfirstlane(threadIdx.x >> 6);
  if (ph_hi < 0) { cg::this_grid().sync(); }
  unsigned* bar = (unsigned*)(p.ws + WS_END);
  char* ws = p.ws;
  bf16_t* Wt_in0 = (bf16_t*)(ws + OFF_WIN0); bf16_t* Wt_out0 = (bf16_t*)(ws + OFF_WOUT0);
  bf16_t* Wt_up0 = (bf16_t*)(ws + OFF_WUP0); bf16_t* Wt_up1 = (bf16_t*)(ws + OFF_WUP1);
  bf16_t* Wt_dn0 = (bf16_t*)(ws + OFF_WDN0); bf16_t* Wt_dn1 = (bf16_t*)(ws + OFF_WDN1);
  bf16_t* Wt_in1 = (bf16_t*)(ws + OFF_WIN1); bf16_t* Wt_out1 = (bf16_t*)(ws + OFF_WOUT1);
  float* modv = (float*)(ws + OFF_MOD);
  char* Pr = ws + OFF_P; char* Gr = ws + OFF_G;
  bf16_t* Pb = (bf16_t*)Pr; float* R = (float*)Pr;
  bf16_t* QA = (bf16_t*)(Pr + P_QA); bf16_t* KA = (bf16_t*)(Pr + P_KA); bf16_t* VA = (bf16_t*)(Pr + P_VA); bf16_t* X0 = (bf16_t*)(Pr + P_X0);
  float* GT = (float*)(Pr + P_GT); bf16_t* A2 = (bf16_t*)(Pr + P_A2);
  bf16_t* A = (bf16_t*)Gr; bf16_t* Gb = (bf16_t*)Gr; float* VV = (float*)(Gr + G_VV);
  bf16_t* HF = (bf16_t*)Gr; bf16_t* HB = (bf16_t*)(Gr + G_HB);
  float* X = p.out;
  float* F256 = p.out + O_C + 512; float* F2048 = p.out + O_C + 512 * 512 + 512;
  const float* mod0 = modv; const float* mod1 = modv + 3 * 6144;
  unsigned bk = 0;
#define PH(i, ...) if (ph_lo <= (i) && (i) < ph_hi) { const int zq = opq(); __VA_ARGS__; if ((i) + 1 < ph_hi) gsync(wv, bar, ++bk); }
  PH(0, {
    conv_w(wv, p.in[zq + 19], Wt_in0, 1024, 2560, 2560);
    conv_w(wv, p.in[zq + 20], Wt_out0, 1024, 1024, 1024);
    conv_w(wv, p.in[zq + 15], Wt_up0, 1024, 5632, 5632);
    conv_w(wv, p.in[zq + 15] + (long)1024 * 5632, Wt_up1, 1024, 5632, 5632);
    conv_w(wv, p.in[zq + 18], Wt_dn0, 2816, 1024, 1024);
    conv_w(wv, p.in[zq + 18] + (long)2816 * 1024, Wt_dn1, 2816, 1024, 1024);
    conv_w(wv, p.in[zq + 33], Wt_in1, 1024, 4128, 4352);
    conv_w(wv, p.in[zq + 38], Wt_out1, 1024, 1024, 1024);
    mod_phase(wv, p, zq, modv);
    filt_phase(wv, p, zq, F256, F2048);
  })
  PH(1, (row_phase<true, false, true>(wv, p, zq, nullptr, nullptr, mod0, 0, nullptr, p.in[zq + 11], mod0, 0, A)))
  PH(2, (gemm_phase<0, 2560>(wv, A, Wt_in0, 2560, 1024, Pb, nullptr)))
  PH(3, post_inproj0(wv, p, zq, Pb, QA, KA, VA, VV, X0))
  PH(4, mix0_phase(wv, p, zq, QA, KA, VA, VV, X0, F256, F2048, A))
  PH(5, (gemm_phase<1, 1024>(wv, A, Wt_out0, 1024, 1024, R, nullptr)))
  PH(6, (row_phase<true, true, true>(wv, p, zq, R, p.in[zq + 12], mod0, 2, X, p.in[zq + 13], mod0, 3, A)))
  PH(7, (gemm_phase<0, 5632>(wv, A, Wt_up0, 5632, 1024, Pb, nullptr)))
  PH(8, ffn_act_phase(wv, Pb, p.in[zq + 16], p.in[zq + 17], Gb))
  PH(9, (gemm_phase<1, 1024>(wv, Gb, Wt_dn0, 1024, 2816, R, nullptr)))
  PH(10, (row_phase<false, true, true>(wv, p, zq, R, p.in[zq + 14], mod0, 5, X, p.in[zq + 11] + 1024, mod1, 0, A)))
  PH(11, (gemm_phase<2, 4096>(wv, A, Wt_in1, 4352, 1024, Pb, GT)))
  PH(13, mlstm_phase(wv, p, zq, Pb, GT, HF, HB))
  PH(14, mlstm_post(wv, p, zq, HF, HB, Pb, A2))
  PH(15, (gemm_phase<1, 1024>(wv, A2, Wt_out1, 1024, 1024, R, nullptr)))
  PH(16, (row_phase<false, true, true>(wv, p, zq, R, p.in[zq + 12] + 1024, mod1, 2, X, p.in[zq + 13] + 1024, mod1, 3, A)))
  PH(17, (gemm_phase<0, 5632>(wv, A, Wt_up1, 5632, 1024, Pb, nullptr)))
  PH(18, ffn_act_phase(wv, Pb, p.in[zq + 16] + 3 * 5632, p.in[zq + 17] + 5632, Gb))
  PH(19, (gemm_phase<1, 1024>(wv, Gb, Wt_dn1, 1024, 2816, R, nullptr)))
  PH(20, (row_phase<false, true, false>(wv, p, zq, R, p.in[zq + 14] + 1024, mod1, 5, X, nullptr, mod1, 0, nullptr)))
#undef PH
}

extern "C" void kernel_launch(void* const* d_in, const int* in_sizes, int n_in, void* d_out, int out_size, void* d_ws, size_t ws_size,
                              hipStream_t stream) {
  static int grid_blocks = 0;
  if (!grid_blocks) {
    if (ws_size < WS_END + 4096) fprintf(stderr, "kernel_launch: workspace too small: %zu < %zu\n", ws_size, (size_t)WS_END);
    hipFuncSetAttribute((const void*)mega, hipFuncAttributeMaxDynamicSharedMemorySize, LDS_BYTES);
    int dev = 0, cus = 0, per = 0;
    hipGetDevice(&dev);
    hipDeviceGetAttribute(&cus, hipDeviceAttributeMultiprocessorCount, dev);
    hipOccupancyMaxActiveBlocksPerMultiprocessor(&per, mega, 512, LDS_BYTES);
    if (per < 1) { fprintf(stderr, "kernel_launch: occupancy query returned %d\n", per); per = 1; }
    grid_blocks = cus;
  }
  Params p{};
  for (int i = 0; i < 39; ++i) p.in[i] = (const float*)d_in[i];
  p.out = (float*)d_out; p.ws = (char*)d_ws;
  int lo = 0, hi = NPH;
  (void)hipMemsetAsync((char*)d_ws + WS_END, 0, 4096, stream);
  void* args[] = {&p, &lo, &hi};
  hipError_t e = hipLaunchCooperativeKernel((void*)mega, dim3(grid_blocks), dim3(512), args, LDS_BYTES, stream);
  if (e != hipSuccess) fprintf(stderr, "cooperative launch failed: %s (grid %d)\n", hipGetErrorString(e), grid_blocks);
}
```

```cpp
#include <hip/hip_runtime.h>
#include <hip/hip_cooperative_groups.h>
#include <cstdio>
#include <cstdint>
namespace cg = cooperative_groups;

typedef unsigned short bf16_t;
typedef short bf16x8 __attribute__((ext_vector_type(8)));
typedef short s16x4 __attribute__((ext_vector_type(4)));
typedef float f32x4 __attribute__((ext_vector_type(4)));
typedef float f32x8 __attribute__((ext_vector_type(8)));
typedef float f32x16 __attribute__((ext_vector_type(16)));
typedef unsigned u32x4 __attribute__((ext_vector_type(4)));
typedef unsigned u32x2 __attribute__((ext_vector_type(2)));

constexpr int T_TOK = 12288, TPR = 8192;
constexpr int LDS_BYTES = 131072;
constexpr int NPH = 21;

constexpr size_t OFF_WIN0 = 0, OFF_WOUT0 = 5242880, OFF_WUP0 = 7340032, OFF_WUP1 = 18874368, OFF_WDN0 = 30408704,
                 OFF_WDN1 = 36175872, OFF_WIN1 = 41943040, OFF_WOUT1 = 50855936, OFF_MOD = 52953088, OFF_P = 53100544,
                 OFF_G = 191512576, WS_END = 260718592;
constexpr size_t P_QA = 62914560, P_KA = 75497472, P_VA = 82313216, P_X0 = 89128960;
constexpr size_t P_GT = 100663296, P_A2 = 102236160;
constexpr size_t G_VV = 25165824, G_HB = 25165824;
constexpr size_t O_K = 12582912, O_V = 14680064, O_C = 16777216, O_N = 25165824, O_M = 25231360;

struct Params { const float* in[39]; float* out; char* ws; };

typedef __bf16 nbf16x2 __attribute__((ext_vector_type(2)));
typedef float nf32x2 __attribute__((ext_vector_type(2)));
__device__ __forceinline__ unsigned cvtpk(float lo, float hi) {
  nf32x2 v = {lo, hi};
  nbf16x2 b = __builtin_convertvector(v, nbf16x2);
  return __builtin_bit_cast(unsigned, b);
}
__device__ __forceinline__ bf16_t f2bf(float f) { return (bf16_t)(cvtpk(f, 0.f) & 0xffffu); }
__device__ __forceinline__ float bf2f(bf16_t h) { return __uint_as_float(((unsigned)h) << 16); }
__device__ __forceinline__ float bflo(unsigned w) { return __uint_as_float(w << 16); }
__device__ __forceinline__ float bfhi(unsigned w) { return __uint_as_float(w & 0xffff0000u); }
__device__ __forceinline__ float wave_sum(float v) {
#pragma unroll
  for (int o = 32; o > 0; o >>= 1) v += __shfl_xor(v, o);
  return v;
}
__device__ __forceinline__ int llane() { int l; asm volatile("v_mbcnt_lo_u32_b32 %0, -1, 0\n\tv_mbcnt_hi_u32_b32 %0, -1, %0" : "=v"(l)); return l; }
__device__ __forceinline__ int ltid(int wv) { return (wv << 6) | llane(); }
__device__ __forceinline__ int opq() { int z; asm volatile("s_mov_b32 %0, 0" : "=s"(z)); return z; }
__device__ __forceinline__ float silu_f(float x) { return x / (1.f + __expf(-x)); }
__device__ __forceinline__ int crow(int r, int hi) { return (r & 3) + 8 * (r >> 2) + 4 * hi; }
__device__ __forceinline__ void unpack8(u32x4 w, float* f) {
  f[0] = bflo(w[0]); f[1] = bfhi(w[0]); f[2] = bflo(w[1]); f[3] = bfhi(w[1]);
  f[4] = bflo(w[2]); f[5] = bfhi(w[2]); f[6] = bflo(w[3]); f[7] = bfhi(w[3]);
}
__device__ __forceinline__ u32x4 pack8(const float* f) {
  u32x4 w = {cvtpk(f[0], f[1]), cvtpk(f[2], f[3]), cvtpk(f[4], f[5]), cvtpk(f[6], f[7])}; return w;
}

__device__ __forceinline__ void conv_w(const int wv, const float* __restrict__ W, bf16_t* __restrict__ Wt, int K, int N, int NP) {
  const int tidx = ltid(wv);
  extern __shared__ __attribute__((aligned(16))) char shm_raw[];
  float* tl = (float*)shm_raw;
  const int tid = tidx;
  const int ntn = NP / 64, ntiles = (K / 64) * ntn;
  for (int tile = blockIdx.x; tile < ntiles; tile += gridDim.x) {
    const int k0 = (tile / ntn) * 64, n0 = (tile % ntn) * 64;
    __syncthreads();
#pragma unroll
    for (int i = 0; i < 2; ++i) {
      int kr = (tid >> 4) + 32 * i, nc = (tid & 15) * 4;
      float4 v = make_float4(0.f, 0.f, 0.f, 0.f);
      if (n0 + nc < N) v = *(const float4*)(W + (long)(k0 + kr) * N + n0 + nc);
      float* d = tl + kr * 65 + nc; d[0] = v.x; d[1] = v.y; d[2] = v.z; d[3] = v.w;
    }
    __syncthreads();
    {
      int n = tid >> 3, kg = (tid & 7) * 8;
      u32x4 w;
      w[0] = cvtpk(tl[(kg + 0) * 65 + n], tl[(kg + 1) * 65 + n]);
      w[1] = cvtpk(tl[(kg + 2) * 65 + n], tl[(kg + 3) * 65 + n]);
      w[2] = cvtpk(tl[(kg + 4) * 65 + n], tl[(kg + 5) * 65 + n]);
      w[3] = cvtpk(tl[(kg + 6) * 65 + n], tl[(kg + 7) * 65 + n]);
      *(u32x4*)(Wt + (long)(n0 + n) * K + k0 + kg) = w;
    }
  }
  __syncthreads();
}

__device__ __forceinline__ void mod_phase(const int wv, const Params& p, const int zq, float* modv) {
  const int tidx = ltid(wv);
  extern __shared__ __attribute__((aligned(16))) char shm_raw[];
  float* red = (float*)shm_raw;
  const int tid = tidx;
  const float* cvec = p.in[zq + 7]; const float* cctx = p.in[zq + 8]; const float* bmod = p.in[zq + 10];
  for (int item = blockIdx.x; item < 192; item += gridDim.x) {
    const int l = item / 96, cb = (item % 96) * 64;
    const float* W = p.in[zq + 9] + (long)l * 1024 * 6144;
    const int cl = tid & 15, kg = tid >> 4;
    float a0[4] = {0, 0, 0, 0}, a1[4] = {0, 0, 0, 0}, a2[4] = {0, 0, 0, 0};
#pragma unroll 4
    for (int i = 0; i < 32; ++i) {
      int k = kg + 32 * i;
      float4 w = *(const float4*)(W + (long)k * 6144 + cb + cl * 4);
      float s0 = silu_f(cctx[k]), s1 = silu_f(cvec[k]), s2 = silu_f(cvec[1024 + k]);
      a0[0] += s0 * w.x; a0[1] += s0 * w.y; a0[2] += s0 * w.z; a0[3] += s0 * w.w;
      a1[0] += s1 * w.x; a1[1] += s1 * w.y; a1[2] += s1 * w.z; a1[3] += s1 * w.w;
      a2[0] += s2 * w.x; a2[1] += s2 * w.y; a2[2] += s2 * w.z; a2[3] += s2 * w.w;
    }
    __syncthreads();
#pragma unroll
    for (int j = 0; j < 4; ++j) {
      red[kg * 192 + 0 * 64 + cl * 4 + j] = a0[j];
      red[kg * 192 + 1 * 64 + cl * 4 + j] = a1[j];
      red[kg * 192 + 2 * 64 + cl * 4 + j] = a2[j];
    }
    __syncthreads();
    if (tid < 192) {
      float s = 0.f;
#pragma unroll 8
      for (int q = 0; q < 32; ++q) s += red[q * 192 + tid];
      int g = tid / 64, col = cb + (tid % 64);
      modv[(l * 3 + g) * 6144 + col] = s + bmod[l * 6144 + col];
    }
  }
  __syncthreads();
}

__device__ __forceinline__ void filt_phase(const int wv, const Params& p, const int zq, float* F256, float* F2048) {
  const int tidx = ltid(wv);
  extern __shared__ __attribute__((aligned(16))) char shm_raw[];
  float* z = (float*)shm_raw; float* h1 = z + 32; float* h2 = h1 + 64;
  const int tid = tidx;
  const float *w1 = p.in[zq + 25], *b1 = p.in[zq + 26], *w2 = p.in[zq + 27], *b2 = p.in[zq + 28], *w3 = p.in[zq + 29], *b3 = p.in[zq + 30], *sf = p.in[zq + 31], *skip = p.in[zq + 32];
  const float DMAX = -15.350567286626973f, DMIN = -3.0701134573253946f;
  for (int item = blockIdx.x; item < 2304; item += gridDim.x) {
    const int L = item < 256 ? 256 : 2048; const int i = item < 256 ? item : item - 256;
    float* F = item < 256 ? F256 : F2048;
    const float t = (float)i / (float)(L - 1);
    __syncthreads();
    if (tid < 17) {
      float v;
      if (tid == 0) v = t;
      else if (tid <= 8) v = cosf(6.283185307179586f * t * (float)tid);
      else v = sinf(6.283185307179586f * t * (float)(tid - 8));
      z[tid] = v;
    }
    __syncthreads();
    if (tid < 64) { float s = b1[tid];
#pragma unroll 1
      for (int j = 0; j < 17; ++j) s += z[j] * w1[j * 64 + tid]; h1[tid] = sinf(sf[tid] * s); }
    __syncthreads();
    if (tid < 64) { float s = b2[tid];
#pragma unroll 8
      for (int j = 0; j < 64; ++j) s += h1[j] * w2[j * 64 + tid]; h2[tid] = sinf(sf[64 + tid] * s); }
    __syncthreads();
    {
      const int ch = tid; float sfw = b3[ch], sbw = b3[512 + ch];
#pragma unroll 8
      for (int j = 0; j < 64; ++j) { float hh = h2[j]; sfw += hh * w3[j * 1024 + ch]; sbw += hh * w3[j * 1024 + 512 + ch]; }
      float delta = fabsf(DMIN + (DMAX - DMIN) * ((float)ch / 511.f));
      float win = expf(-t * delta); sfw *= win; sbw *= win;
      if (i == 0) F[(long)(L - 1) * 512 + ch] = sfw + sbw + skip[ch];
      else { F[(long)(L - 1 + i) * 512 + ch] = sfw; F[(long)(L - 1 - i) * 512 + ch] = sbw; }
    }
  }
  __syncthreads();
}

template <bool FROM_IN, bool HAS_R, bool HAS_A>
__device__ __forceinline__ void row_phase(const int wv, const Params& p, const int zq, const float* __restrict__ R, const float* __restrict__ postg,
                                          const float* __restrict__ modg, int gate_m, float* X,
                                          const float* __restrict__ preg, const float* __restrict__ mods, int shift_m, bf16_t* __restrict__ A) {
  const int tidx = ltid(wv);
  const int wid = wv, lane = tidx & 63;
  for (int row = blockIdx.x * 8 + wid; row < T_TOK; row += gridDim.x * 8) {
    const int g = row < TPR ? 0 : 1 + (row - TPR) / 2048;
    const float* mg = modg + g * 6144;
    const float* ms = mods + g * 6144;
    const float* xin = FROM_IN ? (row < TPR ? p.in[zq + 0] + (long)row * 1024 : p.in[zq + 1] + (long)(row - TPR) * 1024) : (const float*)X + (long)row * 1024;
    float4 x[4];
#pragma unroll
    for (int j = 0; j < 4; ++j) x[j] = *(const float4*)(xin + j * 256 + lane * 4);
    if (HAS_R) {
      float4 r[4]; float ss = 0.f;
#pragma unroll
      for (int j = 0; j < 4; ++j) { r[j] = *(const float4*)(R + (long)row * 1024 + j * 256 + lane * 4); ss += r[j].x * r[j].x + r[j].y * r[j].y + r[j].z * r[j].z + r[j].w * r[j].w; }
      ss = wave_sum(ss); const float rs = rsqrtf(ss * (1.f / 1024.f) + 1e-6f);
#pragma unroll
      for (int j = 0; j < 4; ++j) {
        float4 pg = *(const float4*)(postg + j * 256 + lane * 4);
        float4 gt = *(const float4*)(mg + gate_m * 1024 + j * 256 + lane * 4);
        x[j].x += gt.x * (r[j].x * rs * pg.x); x[j].y += gt.y * (r[j].y * rs * pg.y);
        x[j].z += gt.z * (r[j].z * rs * pg.z); x[j].w += gt.w * (r[j].w * rs * pg.w);
        *(float4*)(X + (long)row * 1024 + j * 256 + lane * 4) = x[j];
      }
    }
    if (HAS_A) {
      float ss = 0.f;
#pragma unroll
      for (int j = 0; j < 4; ++j) ss += x[j].x * x[j].x + x[j].y * x[j].y + x[j].z * x[j].z + x[j].w * x[j].w;
      ss = wave_sum(ss); const float rs = rsqrtf(ss * (1.f / 1024.f) + 1e-6f);
#pragma unroll
      for (int j = 0; j < 4; ++j) {
        float4 pg = *(const float4*)(preg + j * 256 + lane * 4);
        float4 sh = *(const float4*)(ms + shift_m * 1024 + j * 256 + lane * 4);
        float4 sc = *(const float4*)(ms + (shift_m + 1) * 1024 + j * 256 + lane * 4);
        float y0 = x[j].x * rs * pg.x * (1.f + sc.x) + sh.x, y1 = x[j].y * rs * pg.y * (1.f + sc.y) + sh.y;
        float y2 = x[j].z * rs * pg.z * (1.f + sc.z) + sh.z, y3 = x[j].w * rs * pg.w * (1.f + sc.w) + sh.w;
        u32x2 w = {cvtpk(y0, y1), cvtpk(y2, y3)};
        *(u32x2*)(A + (long)row * 1024 + j * 256 + lane * 4) = w;
      }
    }
  }
}

constexpr int BM = 256, BK = 64, HALF = 128, WGM = 8, HT = HALF * BK;
__device__ __forceinline__ int lds_byte(int r, int c) {
  int st = (r >> 4) * 2 + (c >> 5), rr = r & 15, cc = c & 31, ob = rr * 64 + cc * 2;
  return st * 1024 + (ob ^ (((ob >> 9) & 1) << 5));
}
__device__ __forceinline__ void stage_rc(int b, int& R, int& C) {
  int st = b / 1024, sb = b % 1024, swz = sb ^ (((sb >> 9) & 1) << 5);
  R = (st >> 1) * 16 + swz / 64; C = (st & 1) * 32 + (swz % 64) / 2;
}

template <int MODE, int LDC>
__device__ __forceinline__ void gemm_phase(const int wv, const bf16_t* __restrict__ A, const bf16_t* __restrict__ Bt, int N, int K,
                                           void* Cout, float* GT) {
  const int tidx = ltid(wv);
  extern __shared__ __attribute__((aligned(16))) char shm_raw[];
  bf16_t* shm = (bf16_t*)shm_raw;
#define SA(b, h) (shm + ((b) * 2 + (h)) * HT)
#define SB(b, h) (shm + (4 + (b) * 2 + (h)) * HT)
#define STAGE(P, BASE, br, kt) do { const bf16_t* _gb = (BASE) + ((long)(br) * K + (long)(kt) * BK); \
    __builtin_amdgcn_global_load_lds((const unsigned*)(_gb + soff0), (unsigned*)((char*)(P) + sl0), 16, 0, 0); \
    __builtin_amdgcn_global_load_lds((const unsigned*)(_gb + soff1), (unsigned*)((char*)(P) + sl0 + 8192), 16, 0, 0); } while (0)
#define LDA(dst, b, h) _Pragma("unroll") for (int m = 0; m < 4; ++m) _Pragma("unroll") for (int k = 0; k < 2; ++k) \
    dst[m][k] = *reinterpret_cast<const bf16x8*>((char*)SA(b, h) + lds_byte(wr * 64 + m * 16 + fr, k * 32 + fq * 8))
#define LDB(dst, b, h) _Pragma("unroll") for (int n = 0; n < 2; ++n) _Pragma("unroll") for (int k = 0; k < 2; ++k) \
    dst[n][k] = *reinterpret_cast<const bf16x8*>((char*)SB(b, h) + lds_byte(wc * 32 + n * 16 + fr, k * 32 + fq * 8))
#define MMA(ai, bj, At, Bt_) do { __builtin_amdgcn_s_setprio(1); \
    _Pragma("unroll") for (int m = 0; m < 4; ++m) _Pragma("unroll") for (int n = 0; n < 2; ++n) _Pragma("unroll") for (int k = 0; k < 2; ++k) \
      acc[ai][bj][m][n] = __builtin_amdgcn_mfma_f32_16x16x32_bf16(At[m][k], Bt_[n][k], acc[ai][bj][m][n], 0, 0, 0); \
    __builtin_amdgcn_s_setprio(0); } while (0)
#define WAIT_V(n) asm volatile("s_waitcnt vmcnt(" #n ")" ::: "memory")
#define WAIT_L(n) asm volatile("s_waitcnt lgkmcnt(" #n ")" ::: "memory")
#define BAR __builtin_amdgcn_s_barrier()
#define SCHED __builtin_amdgcn_sched_barrier(0)
  const int nM = T_TOK / BM, nN = N / BM, nwg = nM * nN;
  const int wid = wv, lane = tidx & 63, wr = wid >> 2, wc = wid & 3, fr = lane & 15, fq = lane >> 4;
  const int nt = K / BK;
  unsigned soff0, soff1; const int sl0 = tidx * 16;
  { int _r, _c; stage_rc(sl0, _r, _c); soff0 = (unsigned)(_r * K + _c); stage_rc(sl0 + 8192, _r, _c); soff1 = (unsigned)(_r * K + _c); }
  for (int tile = blockIdx.x; tile < nwg; tile += gridDim.x) {
    int wgt = tile;
    { const int q = nwg / 8, r = nwg % 8, xcd = wgt % 8, off = wgt / 8;
      wgt = (xcd < r ? xcd * (q + 1) : r * (q + 1) + (xcd - r) * q) + off; }
    const int nig = WGM * nN, gid = wgt / nig, fm = gid * WGM, gsz = min(nM - fm, WGM);
    const int pm = fm + ((wgt % nig) % gsz), pn = (wgt % nig) / gsz, brow = pm * BM, bcol = pn * BM;
    f32x4 acc[2][2][4][2] = {};
    bf16x8 At[4][2], B0[2][2], B1[2][2];
    STAGE(SB(0, 0), Bt, bcol, 0); STAGE(SA(0, 0), A, brow, 0);
    STAGE(SB(0, 1), Bt, bcol + HALF, 0); STAGE(SA(0, 1), A, brow + HALF, 0);
    if (wr == 1) BAR;
    WAIT_V(4); BAR;
    STAGE(SB(1, 0), Bt, bcol, 1); STAGE(SA(1, 0), A, brow, 1); STAGE(SB(1, 1), Bt, bcol + HALF, 1);
    WAIT_V(6); BAR;
    for (int t = 0; t < nt - 2; t += 2) {
      LDB(B0, 0, 0); SCHED; LDA(At, 0, 0); STAGE(SA(1, 1), A, brow + HALF, t + 1);
      WAIT_L(8); BAR; WAIT_L(0); MMA(0, 0, At, B0); BAR; SCHED;
      LDB(B1, 0, 1); STAGE(SB(0, 0), Bt, bcol, t + 2);
      BAR; WAIT_L(0); MMA(0, 1, At, B1); BAR;
      LDA(At, 0, 1); STAGE(SA(0, 0), A, brow, t + 2);
      BAR; WAIT_L(0); MMA(1, 0, At, B0); BAR; SCHED;
      STAGE(SB(0, 1), Bt, bcol + HALF, t + 2);
      WAIT_V(6); BAR; MMA(1, 1, At, B1); BAR;
      LDB(B0, 1, 0); SCHED; LDA(At, 1, 0); STAGE(SA(0, 1), A, brow + HALF, t + 2);
      WAIT_L(8); BAR; WAIT_L(0); MMA(0, 0, At, B0); BAR; SCHED;
      LDB(B1, 1, 1); STAGE(SB(1, 0), Bt, bcol, t + 3);
      BAR; WAIT_L(0); MMA(0, 1, At, B1); BAR;
      LDA(At, 1, 1); STAGE(SA(1, 0), A, brow, t + 3);
      BAR; WAIT_L(0); MMA(1, 0, At, B0); BAR; SCHED;
      STAGE(SB(1, 1), Bt, bcol + HALF, t + 3);
      WAIT_V(6); BAR; MMA(1, 1, At, B1); BAR;
    }
    { LDB(B0, 0, 0); LDA(At, 0, 0); STAGE(SA(1, 1), A, brow + HALF, nt - 1);
      BAR; WAIT_L(0); MMA(0, 0, At, B0); BAR;
      LDB(B1, 0, 1); BAR; WAIT_L(0); MMA(0, 1, At, B1); BAR;
      LDA(At, 0, 1); WAIT_V(4); BAR; WAIT_L(0); MMA(1, 0, At, B0); MMA(1, 1, At, B1); BAR; }
    { LDB(B0, 1, 0); LDA(At, 1, 0); WAIT_V(2); BAR; WAIT_L(0); MMA(0, 0, At, B0); BAR;
      LDB(B1, 1, 1); WAIT_V(0); BAR; WAIT_L(0); MMA(0, 1, At, B1); BAR;
      LDA(At, 1, 1); BAR; WAIT_L(0); MMA(1, 0, At, B0); MMA(1, 1, At, B1); BAR; }
    if (wr == 0) BAR;
    {
      const int le = llane();
      const int fr = le & 15, fq = le >> 4;
      const long base = (long)(brow + wr * 64) * LDC + bcol + wc * 32 + (unsigned)(fq * 4 * LDC + fr);
      if (MODE == 0 || (MODE == 2 && pn < 16)) {
        bf16_t* cp = (bf16_t*)Cout + base;
#pragma unroll
        for (int ai = 0; ai < 2; ++ai)
#pragma unroll
          for (int m = 0; m < 4; ++m)
#pragma unroll
            for (int j = 0; j < 4; ++j) {
              bf16_t* rp = cp + (ai * HALF + m * 16 + j) * LDC;
#pragma unroll
              for (int bj = 0; bj < 2; ++bj)
#pragma unroll
                for (int n = 0; n < 2; ++n) rp[bj * HALF + n * 16] = f2bf(acc[ai][bj][m][n][j]);
            }
      } else if (MODE == 1) {
        float* cp = (float*)Cout + base;
#pragma unroll
        for (int ai = 0; ai < 2; ++ai)
#pragma unroll
          for (int m = 0; m < 4; ++m)
#pragma unroll
            for (int j = 0; j < 4; ++j) {
              float* rp = cp + (ai * HALF + m * 16 + j) * LDC;
#pragma unroll
              for (int bj = 0; bj < 2; ++bj)
#pragma unroll
                for (int n = 0; n < 2; ++n) rp[bj * HALF + n * 16] = acc[ai][bj][m][n][j];
            }
      } else {
        if (wc == 0) {
          float* gp = GT + (long)(brow + wr * 64) * 32 + (unsigned)(fq * 4 * 32 + fr);
#pragma unroll
          for (int ai = 0; ai < 2; ++ai)
#pragma unroll
            for (int m = 0; m < 4; ++m)
#pragma unroll
              for (int j = 0; j < 4; ++j)
#pragma unroll
                for (int n = 0; n < 2; ++n) gp[(ai * HALF + m * 16 + j) * 32 + n * 16] = acc[ai][0][m][n][j];
        }
      }
    }
    __syncthreads();
  }
#undef SA
#undef SB
#undef STAGE
#undef LDA
#undef LDB
#undef MMA
}

__device__ __forceinline__ void post_inproj0(const int wv, const Params& p, const int zq, const bf16_t* __restrict__ P0, bf16_t* __restrict__ QA, bf16_t* __restrict__ KA,
                                             bf16_t* __restrict__ VA, float* __restrict__ VV, bf16_t* __restrict__ X0) {
  const int tidx = ltid(wv);
  const int wid = wv, lane = tidx & 63;
  const float* qn = p.in[zq + 21]; const float* kn = p.in[zq + 22]; const float* cw = p.in[zq + 23]; const float* cb = p.in[zq + 24];
  float* outK = p.out + O_K; float* outV = p.out + O_V;
  for (int i = blockIdx.x * 512 + tidx; i < 2 * 512 * 256 / 4; i += gridDim.x * 512) {
    int e = i * 4; int b = e / (512 * 256), rem = e % (512 * 256);
    float4 kk = *(const float4*)(p.in[zq + 2] + e); float4 vv = *(const float4*)(p.in[zq + 3] + e);
    long d = (long)(8192 + b * 2560 + 2048) * 256 + rem;
    u32x2 wk = {cvtpk(kk.x, kk.y), cvtpk(kk.z, kk.w)}; u32x2 wv = {cvtpk(vv.x, vv.y), cvtpk(vv.z, vv.w)};
    *(u32x2*)(KA + d) = wk; *(u32x2*)(VA + d) = wv;
  }
  const int fi = lane & 31;
  const float inv = exp2f(-(float)fi * (13.287712379549449f / 32.f));
  for (int row = blockIdx.x * 8 + wid; row < T_TOK; row += gridDim.x * 8) {
    const bool samp = row >= TPR;
    const int L = samp ? 2048 : 256;
    const int tl = samp ? (row - TPR) % 2048 : row % 256;
    const long krow = samp ? (long)(8192 + ((row - TPR) / 2048) * 2560 + tl) : (long)row;
    const bf16_t* base = P0 + (long)row * 2560;
    float cs = 1.f, sn = 0.f;
    if (samp) { float pos = (lane < 32) ? (float)(tl / 64) : (float)(tl % 64); float ang = pos * inv; cs = cosf(ang); sn = sinf(ang); }
#pragma unroll
    for (int hh = 0; hh < 6; ++hh) {
      float x1 = bf2f(base[hh * 128 + lane]), x2 = bf2f(base[hh * 128 + 64 + lane]);
      float ss = wave_sum(x1 * x1 + x2 * x2);
      float rs = rsqrtf(ss * (1.f / 128.f) + 1e-6f);
      const float* gw = hh < 4 ? qn : kn;
      float y1 = x1 * rs * gw[lane], y2 = x2 * rs * gw[64 + lane];
      if (hh >= 4 && !samp) { outK[(long)row * 256 + (hh - 4) * 128 + lane] = y1; outK[(long)row * 256 + (hh - 4) * 128 + 64 + lane] = y2; }
      float o1 = y1 * cs - y2 * sn, o2 = y1 * sn + y2 * cs;
      if (hh < 4) { QA[(long)row * 512 + hh * 128 + lane] = f2bf(o1); QA[(long)row * 512 + hh * 128 + 64 + lane] = f2bf(o2); }
      else { KA[krow * 256 + (hh - 4) * 128 + lane] = f2bf(o1); KA[krow * 256 + (hh - 4) * 128 + 64 + lane] = f2bf(o2); }
    }
    {
      u32x2 w = *(const u32x2*)(base + 768 + lane * 4);
      *(u32x2*)(VA + krow * 256 + lane * 4) = w;
      if (!samp) { float4 f = make_float4(bflo(w[0]), bfhi(w[0]), bflo(w[1]), bfhi(w[1])); *(float4*)(outV + (long)row * 256 + lane * 4) = f; }
    }
    {
      const int c8 = lane * 8;
      float uc[3][8];
#pragma unroll
      for (int g = 0; g < 3; ++g) {
        const int col = g * 512 + c8;
        float um[8], u0[8], up[8];
        u32x4 z4 = {0u, 0u, 0u, 0u};
        u32x4 wm = (tl > 0) ? *(const u32x4*)(base - 2560 + 1024 + col) : z4;
        u32x4 w0 = *(const u32x4*)(base + 1024 + col);
        u32x4 wp = (tl < L - 1) ? *(const u32x4*)(base + 2560 + 1024 + col) : z4;
        unpack8(wm, um); unpack8(w0, u0); unpack8(wp, up);
#pragma unroll
        for (int e = 0; e < 8; ++e)
          uc[g][e] = cw[col + e] * um[e] + cw[1536 + col + e] * u0[e] + cw[3072 + col + e] * up[e] + cb[col + e];
      }
      float vvv[8];
#pragma unroll
      for (int e = 0; e < 8; ++e) vvv[e] = uc[2][e] * uc[1][e];
      *(float4*)(VV + (long)row * 512 + c8) = make_float4(vvv[0], vvv[1], vvv[2], vvv[3]);
      *(float4*)(VV + (long)row * 512 + c8 + 4) = make_float4(vvv[4], vvv[5], vvv[6], vvv[7]);
      *(u32x4*)(X0 + (long)row * 512 + c8) = pack8(uc[0]);
    }
  }
}

constexpr int AD = 128, ANW = 8, QBLK = 32, KVBLK = 64;
constexpr float ASCALE = 0.088388347648318440f;
constexpr float ATHR = 8.f;
constexpr int LDQ = 512, LDK = 256, LDO = 1024;
constexpr size_t SHM_V = KVBLK * AD * 2, SHM_K = KVBLK * AD * 2;
#define KSWZ(row, colB) ((row) * 256 + ((colB) ^ (((row) & 7) << 4)))
#define SBAR() __builtin_amdgcn_sched_barrier(0)

__device__ __forceinline__ void partialSM(f32x16& p0, f32x16& p1, float& m_reg, float& mn, float& alpha) {
  constexpr float C = ASCALE * 1.4426950408889634f;
  float pmax = p0[0];
#pragma unroll
  for (int r = 1; r < 16; ++r) pmax = fmaxf(pmax, p0[r]);
#pragma unroll
  for (int r = 0; r < 16; ++r) pmax = fmaxf(pmax, p1[r]);
  { auto rr = __builtin_amdgcn_permlane32_swap(__float_as_uint(pmax), __float_as_uint(pmax), false, false);
    pmax = fmaxf(__uint_as_float(rr[0]), __uint_as_float(rr[1])); }
  if (__builtin_expect(__all(pmax - m_reg <= ATHR / ASCALE), 1)) { mn = m_reg; alpha = 1.f; }
  else { mn = fmaxf(m_reg, pmax); alpha = __builtin_amdgcn_exp2f((m_reg - mn) * C); m_reg = mn; }
  float mnC = -mn * C;
#pragma unroll
  for (int r = 0; r < 16; ++r) p0[r] = fmaf(p0[r], C, mnC);
#pragma unroll
  for (int r = 0; r < 16; ++r) p1[r] = fmaf(p1[r], C, mnC);
#pragma unroll
  for (int r = 0; r < 16; ++r) p0[r] = __builtin_amdgcn_exp2f(p0[r]);
}
__device__ __forceinline__ void finishSM(f32x16& p0, f32x16& p1, float alpha, float& l_reg, bf16x8& pa0, bf16x8& pa1, bf16x8& pa2, bf16x8& pa3) {
#pragma unroll
  for (int r = 0; r < 16; ++r) p1[r] = __builtin_amdgcn_exp2f(p1[r]);
  float ps = 0;
#pragma unroll
  for (int r = 0; r < 16; ++r) ps += p0[r];
#pragma unroll
  for (int r = 0; r < 16; ++r) ps += p1[r];
  { auto rr = __builtin_amdgcn_permlane32_swap(__float_as_uint(ps), __float_as_uint(ps), false, false);
    ps = __uint_as_float(rr[0]) + __uint_as_float(rr[1]); }
  l_reg = l_reg * alpha + ps;
#define PK4(P, BASE, OUT) do { unsigned a0 = cvtpk(P[BASE + 0], P[BASE + 1]), a1 = cvtpk(P[BASE + 2], P[BASE + 3]);   \
    unsigned b0 = cvtpk(P[BASE + 4], P[BASE + 5]), b1 = cvtpk(P[BASE + 6], P[BASE + 7]);                              \
    auto r0 = __builtin_amdgcn_permlane32_swap(a0, b0, false, false); auto r1 = __builtin_amdgcn_permlane32_swap(a1, b1, false, false); \
    u32x4 w = {r0[0], r1[0], r0[1], r1[1]}; OUT = *reinterpret_cast<bf16x8*>(&w); } while (0)
  PK4(p0, 0, pa0); PK4(p0, 8, pa1); PK4(p1, 0, pa2); PK4(p1, 8, pa3);
#undef PK4
}
__device__ __forceinline__ void qkt(f32x16& p0, f32x16& p1, const bf16_t* Ks, const bf16x8* qr, int r32, int hi) {
  p0 = f32x16{}; p1 = f32x16{};
#pragma unroll
  for (int d0 = 0; d0 < 8; ++d0) { int cb = (d0 * 16 + hi * 8) * 2;
    bf16x8 b0 = *reinterpret_cast<const bf16x8*>((const char*)Ks + KSWZ(r32, cb));
    bf16x8 b1 = *reinterpret_cast<const bf16x8*>((const char*)Ks + KSWZ(32 + r32, cb));
    p0 = __builtin_amdgcn_mfma_f32_32x32x16_bf16(b0, qr[d0], p0, 0, 0, 0);
    p1 = __builtin_amdgcn_mfma_f32_32x32x16_bf16(b1, qr[d0], p1, 0, 0, 0); }
}
__device__ __forceinline__ int v_st(int k, int c) { const int kk = (k & ~0xC) | ((k & 4) << 1) | ((k & 8) >> 1); return ((kk >> 3) * 4 + (c >> 5)) * 512 + ((kk & 7) * 32 + (c & 31)) * 2; }
__device__ __forceinline__ int v_rd_base(int lane) { return ((lane & 3) << 3) | (((lane >> 2) & 3) << 6) | (((lane >> 4) & 1) << 5) | (((lane >> 5) & 1) << 8); }
constexpr int v_rd_off(int d0, int ks, int half) { return d0 * 512 + ks * 4096 + half * 2048; }
template <int OFF> __device__ __forceinline__ s16x4 tr_read(int vb) {
  s16x4 r; asm volatile("ds_read_b64_tr_b16 %0, %1 offset:%2" : "=&v"(r) : "v"(vb), "i"(OFF) : "memory"); return r;
}
template <int D0> __device__ __forceinline__ void pv_one(f32x16& od, int vb, bf16x8 pa0, bf16x8 pa1, bf16x8 pa2, bf16x8 pa3) {
  const s16x4 l0 = tr_read<v_rd_off(D0, 0, 0)>(vb), h0 = tr_read<v_rd_off(D0, 0, 1)>(vb), l1 = tr_read<v_rd_off(D0, 1, 0)>(vb), h1 = tr_read<v_rd_off(D0, 1, 1)>(vb);
  const s16x4 l2 = tr_read<v_rd_off(D0, 2, 0)>(vb), h2 = tr_read<v_rd_off(D0, 2, 1)>(vb), l3 = tr_read<v_rd_off(D0, 3, 0)>(vb), h3 = tr_read<v_rd_off(D0, 3, 1)>(vb);
  asm volatile("s_waitcnt lgkmcnt(0)" ::: "memory"); SBAR();
#define PK(L, H) (bf16x8){L[0], L[1], L[2], L[3], H[0], H[1], H[2], H[3]}
  od = __builtin_amdgcn_mfma_f32_32x32x16_bf16(pa0, PK(l0, h0), od, 0, 0, 0);
  od = __builtin_amdgcn_mfma_f32_32x32x16_bf16(pa1, PK(l1, h1), od, 0, 0, 0);
  od = __builtin_amdgcn_mfma_f32_32x32x16_bf16(pa2, PK(l2, h2), od, 0, 0, 0);
  od = __builtin_amdgcn_mfma_f32_32x32x16_bf16(pa3, PK(l3, h3), od, 0, 0, 0);
#undef PK
}
__device__ __forceinline__ void pv_d0(f32x16* o, int vb, bf16x8 pa0, bf16x8 pa1, bf16x8 pa2, bf16x8 pa3) {
  pv_one<0>(o[0], vb, pa0, pa1, pa2, pa3); pv_one<1>(o[1], vb, pa0, pa1, pa2, pa3); pv_one<2>(o[2], vb, pa0, pa1, pa2, pa3); pv_one<3>(o[3], vb, pa0, pa1, pa2, pa3);
}

__device__ __forceinline__ void attn_dense_body(const int wv, const bf16_t* __restrict__ Qb, const bf16_t* __restrict__ Kh, const bf16_t* __restrict__ Vh,
                                                bf16_t* __restrict__ Ob, int seq, char* lds) {
  const int tidx = ltid(wv);
  const int tid = tidx, wid = wv, lane = tid & 63, r32 = lane & 31, hi = lane >> 5;
  bf16_t* V_lds = (bf16_t*)lds; bf16_t* K_lds = (bf16_t*)(lds + 2 * SHM_V);
  float* ws = (float*)(lds + 2 * SHM_V + 2 * SHM_K) + wid * 64; float* li_l = ws; float* al_l = ws + 32;
  float m_reg = -1e30f, l_reg = 0; f32x16 o[4] = {}; bf16x8 qr[8];
  const bf16_t* Qw = Qb + (long)(wid * QBLK + r32) * LDQ + hi * 8;
#pragma unroll
  for (int d0 = 0; d0 < 8; ++d0) qr[d0] = *reinterpret_cast<const bf16x8*>(Qw + d0 * 16);
  const int sr = tid >> 4, sc = (tid & 15) * 8, vst0 = v_st(sr, sc), vst1 = v_st(32 + sr, sc);
  const int vb0 = (int)(uintptr_t)V_lds + v_rd_base(lane);
  bf16x8 sA_vs0, sA_vs1, sA_ks0, sA_ks1, sB_vs0, sB_vs1, sB_ks0, sB_ks1;
#define SLOADA(k0) do { sA_vs0 = *(const bf16x8*)(&Vh[(long)((k0) + sr) * LDK + sc]); sA_vs1 = *(const bf16x8*)(&Vh[(long)((k0) + 32 + sr) * LDK + sc]); \
    sA_ks0 = *(const bf16x8*)(&Kh[(long)((k0) + sr) * LDK + sc]); sA_ks1 = *(const bf16x8*)(&Kh[(long)((k0) + 32 + sr) * LDK + sc]); } while (0)
#define SLOADB(k0) do { sB_vs0 = *(const bf16x8*)(&Vh[(long)((k0) + sr) * LDK + sc]); sB_vs1 = *(const bf16x8*)(&Vh[(long)((k0) + 32 + sr) * LDK + sc]); \
    sB_ks0 = *(const bf16x8*)(&Kh[(long)((k0) + sr) * LDK + sc]); sB_ks1 = *(const bf16x8*)(&Kh[(long)((k0) + 32 + sr) * LDK + sc]); } while (0)
#define SWRITEA(b) do { *(bf16x8*)((char*)V_lds + (b) * SHM_V + vst0) = sA_vs0; *(bf16x8*)((char*)V_lds + (b) * SHM_V + vst1) = sA_vs1; int kc = sc * 2; \
    *(bf16x8*)((char*)K_lds + (b) * SHM_K + KSWZ(sr, kc)) = sA_ks0; *(bf16x8*)((char*)K_lds + (b) * SHM_K + KSWZ(32 + sr, kc)) = sA_ks1; } while (0)
#define SWRITEB(b) do { *(bf16x8*)((char*)V_lds + (b) * SHM_V + vst0) = sB_vs0; *(bf16x8*)((char*)V_lds + (b) * SHM_V + vst1) = sB_vs1; int kc = sc * 2; \
    *(bf16x8*)((char*)K_lds + (b) * SHM_K + KSWZ(sr, kc)) = sB_ks0; *(bf16x8*)((char*)K_lds + (b) * SHM_K + KSWZ(32 + sr, kc)) = sB_ks1; } while (0)
#define SWAIT() asm volatile("s_waitcnt vmcnt(4)" ::: "memory")
#define RESC(a) do { if (__any((a) < 1.f)) { if (hi == 0) al_l[r32] = (a); asm volatile("s_waitcnt lgkmcnt(0)" ::: "memory"); \
    _Pragma("unroll") for (int d = 0; d < 4; ++d) _Pragma("unroll") for (int r = 0; r < 16; ++r) o[d][r] *= al_l[crow(r, hi)]; } } while (0)
  f32x16 pA0, pA1, pB0, pB1; float mnA, mnB, alA, alB; bf16x8 pa0, pa1, pa2, pa3; const int NT = seq / KVBLK;
  SLOADA(0); asm volatile("s_waitcnt vmcnt(0)" ::: "memory"); SWRITEA(0); __syncthreads();
  qkt(pA0, pA1, K_lds, qr, r32, hi); partialSM(pA0, pA1, m_reg, mnA, alA);
  SLOADB(KVBLK); if (2 < NT) SLOADA(2 * KVBLK);
  SWAIT(); SWRITEB(1); __syncthreads();
  for (int j = 1; j + 1 < NT; j += 2) {
    SBAR(); qkt(pB0, pB1, (bf16_t*)((char*)K_lds + SHM_K), qr, r32, hi);
    finishSM(pA0, pA1, alA, l_reg, pa0, pa1, pa2, pa3); SBAR();
    SLOADB((j + 2) * KVBLK); SBAR();
    pv_d0(o, vb0, pa0, pa1, pa2, pa3); partialSM(pB0, pB1, m_reg, mnB, alB);
    __syncthreads(); SWAIT(); SWRITEA(0);
    RESC(alB); __syncthreads();
    SBAR(); qkt(pA0, pA1, K_lds, qr, r32, hi);
    finishSM(pB0, pB1, alB, l_reg, pa0, pa1, pa2, pa3); SBAR();
    if (j + 3 < NT) SLOADA((j + 3) * KVBLK); SBAR();
    pv_d0(o, vb0 + (int)SHM_V, pa0, pa1, pa2, pa3); partialSM(pA0, pA1, m_reg, mnA, alA);
    __syncthreads(); SWAIT(); SWRITEB(1);
    RESC(alA); __syncthreads();
  }
  SBAR(); qkt(pB0, pB1, (bf16_t*)((char*)K_lds + SHM_K), qr, r32, hi);
  finishSM(pA0, pA1, alA, l_reg, pa0, pa1, pa2, pa3); SBAR();
  pv_d0(o, vb0, pa0, pa1, pa2, pa3); partialSM(pB0, pB1, m_reg, mnB, alB);
  __syncthreads(); RESC(alB);
  finishSM(pB0, pB1, alB, l_reg, pa0, pa1, pa2, pa3); SBAR();
  pv_d0(o, vb0 + (int)SHM_V, pa0, pa1, pa2, pa3);
  if (hi == 0) li_l[r32] = l_reg; asm volatile("s_waitcnt lgkmcnt(0)" ::: "memory");
  float rli[16];
#pragma unroll
  for (int r = 0; r < 16; ++r) rli[r] = __builtin_amdgcn_rcpf(li_l[crow(r, hi)]);
  bf16_t* Ow = Ob + (long)(wid * QBLK) * LDO;
#pragma unroll
  for (int r = 0; r < 16; ++r) { int orow = crow(r, hi);
#pragma unroll
    for (int d0 = 0; d0 < 4; ++d0) Ow[(long)orow * LDO + d0 * 32 + r32] = f2bf(o[d0][r] * rli[r]); }
#undef SLOADA
#undef SLOADB
#undef SWRITEA
#undef SWRITEB
#undef SWAIT
#undef RESC
}

__device__ __forceinline__ void hyena_item(const float* __restrict__ F, const float* __restrict__ VV, const bf16_t* __restrict__ X0,
                                           bf16_t* __restrict__ AO, long rowbase, int L, int c, int t0) {
  float y[16], ring[16];
#pragma unroll
  for (int i = 0; i < 16; ++i) { y[i] = 0.f; ring[i] = F[(long)(t0 + i + L - 1) * 512 + c]; }
  const float* vp = VV + rowbase * 512 + c;
  const float* fp = F + (long)(t0 + L - 2) * 512 + c;
  for (int s0 = 0; s0 < L; s0 += 16) {
#pragma unroll
    for (int j = 0; j < 16; ++j) {
      const float vs = vp[(long)(s0 + j) * 512];
      const float nf = fp[-(long)(s0 + j) * 512];
#pragma unroll
      for (int i = 0; i < 16; ++i) y[i] += ring[(i - j) & 15] * vs;
      ring[(15 - j) & 15] = nf;
    }
  }
#pragma unroll
  for (int i = 0; i < 16; ++i) {
    long row = rowbase + t0 + i;
    AO[row * 1024 + 512 + c] = f2bf(y[i] * bf2f(X0[row * 512 + c]));
  }
}

__device__ __forceinline__ void mix0_phase(const int wv, const Params& p, const int zq, const bf16_t* QA, const bf16_t* KA, const bf16_t* VA, const float* VV,
                                           const bf16_t* X0, const float* F256, const float* F2048, bf16_t* AO) {
  extern __shared__ __attribute__((aligned(16))) char shm_raw[];
#ifndef NO_ATTN
  for (int it = blockIdx.x; it < 192; it += gridDim.x) {
    long rowb, krow; int h, seqk;
    if (it < 64) { const int qb = it % 8, b = it / 32; h = (it / 8) % 4; rowb = 8192 + (long)b * 2048 + qb * 256; krow = 8192 + (long)b * 2560; seqk = 2560; }
    else { const int j = it - 64; const int b = j / 4; h = j % 4; rowb = (long)b * 256; krow = rowb; seqk = 256; }
    __syncthreads();
    attn_dense_body(wv, QA + rowb * 512 + h * 128, KA + krow * 256 + (h >> 1) * 128, VA + krow * 256 + (h >> 1) * 128, AO + rowb * 1024 + h * 128, seqk, shm_raw);
  }
#endif
#ifndef NO_HYENA
  const int lane = llane(); const int wid = wv;
  {
    const int G = gridDim.x;
    for (int it = (blockIdx.x + G - 64) % G; it < 256; it += G) {
      const int b = it / 128, cgp = (it / 16) % 8, tg = it % 16;
      hyena_item(F2048, VV, X0, AO, 8192 + (long)b * 2048, 2048, cgp * 64 + lane, tg * 128 + wid * 16);
    }
    const int nl = G > 64 ? G - 64 : G, l0 = G > 64 ? (int)blockIdx.x - 64 : (int)blockIdx.x;
    if (l0 >= 0)
      for (int j = l0; j < 512; j += nl) {
        const int b = j / 16, cgp = (j / 2) % 8, tg = j % 2;
        hyena_item(F256, VV, X0, AO, (long)b * 256, 256, cgp * 64 + lane, tg * 128 + wid * 16);
      }
  }
#endif
  __syncthreads();
}

__device__ __forceinline__ float erf_as(float x) {
  const float ax = fabsf(x);
  const float t = __builtin_amdgcn_rcpf(fmaf(0.3275911f, ax, 1.f));
  float p = fmaf(1.061405429f, t, -1.453152027f);
  p = fmaf(p, t, 1.421413741f); p = fmaf(p, t, -0.284496736f); p = fmaf(p, t, 0.254829592f);
  const float r = 1.f - p * t * __expf(-ax * ax);
  return copysignf(r, x);
}
__device__ __forceinline__ float gelu_f(float x) { return 0.5f * x * (1.f + erf_as(x * 0.70710678118654752f)); }
__device__ __forceinline__ void ffn_act_phase(const int wv, const bf16_t* __restrict__ P, const float* __restrict__ cw, const float* __restrict__ cb, bf16_t* __restrict__ G) {
  const int tidx = ltid(wv);
  const int tid = tidx;
  if (tid >= 352) return;
  const int c8 = tid * 8;
  float w1[3][8], w2[3][8], b1[8], b2[8];
#pragma unroll
  for (int e = 0; e < 8; ++e) {
#pragma unroll
    for (int k = 0; k < 3; ++k) { w1[k][e] = cw[k * 5632 + c8 + e]; w2[k][e] = cw[k * 5632 + 2816 + c8 + e]; }
    b1[e] = cb[c8 + e]; b2[e] = cb[2816 + c8 + e];
  }
  for (int item = blockIdx.x; item < T_TOK / 16; item += gridDim.x) {
    const int r0 = item * 16;
    const int L = r0 < TPR ? 256 : 2048;
    const int tl0 = r0 < TPR ? r0 % 256 : (r0 - TPR) % 2048;
    float am[8], a0[8], ap[8], gm[8], g0[8], gp[8];
    const u32x4 z4 = {0u, 0u, 0u, 0u};
    {
      const bf16_t* b = P + (long)r0 * 5632 + c8;
      u32x4 x = (tl0 > 0) ? *(const u32x4*)(b - 5632) : z4; unpack8(x, am);
      x = (tl0 > 0) ? *(const u32x4*)(b - 5632 + 2816) : z4; unpack8(x, gm);
      x = *(const u32x4*)(b); unpack8(x, a0);
      x = *(const u32x4*)(b + 2816); unpack8(x, g0);
    }
    for (int r = 0; r < 16; ++r) {
      const bf16_t* b = P + (long)(r0 + r) * 5632 + c8;
      const bool vn = (tl0 + r) < L - 1;
      u32x4 x = vn ? *(const u32x4*)(b + 5632) : z4; unpack8(x, ap);
      x = vn ? *(const u32x4*)(b + 5632 + 2816) : z4; unpack8(x, gp);
      float o[8];
#pragma unroll
      for (int e = 0; e < 8; ++e) {
        float h1 = w1[0][e] * am[e] + w1[1][e] * a0[e] + w1[2][e] * ap[e] + b1[e];
        float h2 = w2[0][e] * gm[e] + w2[1][e] * g0[e] + w2[2][e] * gp[e] + b2[e];
        o[e] = gelu_f(h1) * h2;
        am[e] = a0[e]; a0[e] = ap[e]; gm[e] = g0[e]; g0[e] = gp[e];
      }
      *(u32x4*)(G + (long)(r0 + r) * 2816 + c8) = pack8(o);
    }
  }
}

template <int K>
__device__ __forceinline__ f32x16 mma_nt(const bf16_t* A, int lda, const bf16_t* B, int ldb, f32x16 acc, int r32, int hi) {
  bf16x8 a[K / 16], b[K / 16];
#pragma unroll
  for (int k0 = 0; k0 < K / 16; ++k0) {
    a[k0] = *reinterpret_cast<const bf16x8*>(A + r32 * lda + k0 * 16 + 8 * hi);
    b[k0] = *reinterpret_cast<const bf16x8*>(B + r32 * ldb + k0 * 16 + 8 * hi);
  }
#pragma unroll
  for (int k0 = 0; k0 < K / 16; ++k0) acc = __builtin_amdgcn_mfma_f32_32x32x16_bf16(a[k0], b[k0], acc, 0, 0, 0);
  return acc;
}

__device__ __forceinline__ void mlstm_phase(const int wv, const Params& p, const int zq, const bf16_t* __restrict__ P1, const float* __restrict__ GT,
                                            bf16_t* __restrict__ HF, bf16_t* __restrict__ HB) {
  const int tidx = ltid(wv);
  extern __shared__ __attribute__((aligned(16))) char shm_raw[];
  bf16_t* Qs = (bf16_t*)shm_raw;
  bf16_t* Ks = Qs + 64 * 136;
  bf16_t* KwT = Ks + 64 * 136;
  bf16_t* VsT = KwT + 128 * 72;
  bf16_t* Wb = VsT + 128 * 72;
  bf16_t* Cb = Wb + 64 * 72;
  float* av = (float*)(Cb + 128 * 136);
  float* Mv = av + 64; float* bv = Mv + 64; float* sclv = bv + 64; float* wintv = sclv + 64; float* nvec = wintv + 64; float* scal = nvec + 128;
  float* cwl = scal + 8;
  const int tid = tidx, wid = wv, lane = tid & 63, r32 = lane & 31, hi = lane >> 5;
  const float* cw = p.in[zq + 35]; const float* cbias = p.in[zq + 36]; const float* bg = p.in[zq + 34];
  for (int u = blockIdx.x; u < 544; u += gridDim.x) {
    int seq, h, dir;
    if (u < 32) { seq = 32 + u / 16; h = (u / 2) % 8; dir = u % 2; } else { int j = u - 32; seq = j / 16; h = (j / 2) % 8; dir = j % 2; }
    const int L = seq < 32 ? 256 : 2048;
    const long rowbase = seq < 32 ? (long)seq * 256 : 8192 + (long)(seq - 32) * 2048;
    __syncthreads();
    f32x16 cacc[2]; float m = 0.f;
    const int vb2 = wid >> 1;
    if (seq >= 32) {
      const int b = seq - 32;
      const float* Cin = p.in[zq + 4] + (long)((b * 2 + dir) * 8 + h) * 16384;
#pragma unroll
      for (int i = 0; i < 2; ++i) { const int kb = (wid & 1) * 2 + i;
#pragma unroll
        for (int r = 0; r < 16; ++r) cacc[i][r] = Cin[(vb2 * 32 + crow(r, hi)) * 128 + kb * 32 + r32]; }
      if (tid < 128) nvec[tid] = p.in[zq + 5][((b * 2 + dir) * 8 + h) * 128 + tid];
      m = p.in[zq + 6][(b * 2 + dir) * 8 + h];
    } else {
#pragma unroll
      for (int i = 0; i < 2; ++i)
#pragma unroll
        for (int r = 0; r < 16; ++r) cacc[i][r] = 0.f;
      if (tid < 128) nvec[tid] = 0.f;
    }
#pragma unroll
    for (int i = 0; i < 2; ++i) { const int kb = (wid & 1) * 2 + i;
#pragma unroll
      for (int r = 0; r < 16; ++r) Cb[(vb2 * 32 + crow(r, hi)) * 136 + kb * 32 + r32] = f2bf(cacc[i][r]); }
    if (tid < 256) {
      const int col = (tid < 128) ? (h * 128 + tid) : (1024 + h * 128 + (tid - 128));
      cwl[tid] = cw[col]; cwl[256 + tid] = cw[2048 + col]; cwl[512 + tid] = cw[4096 + col]; cwl[768 + tid] = cbias[col];
    }
    const float bgi = bg[dir * 8 + h], bgf = bg[16 + dir * 8 + h];
    __syncthreads();
    const int nch = L / 64;
    for (int ch = 0; ch < nch; ++ch) {
      float kf[16];
      {
        const int r = lane, c16 = wv * 16;
        const int tcr = ch * 64 + r;
        const int posr = dir ? (L - 1 - tcr) : tcr;
        const bf16_t* rowp = P1 + (rowbase + posr) * 4096 + h * 128 + c16;
        const u32x4 z4 = {0u, 0u, 0u, 0u};
        const bool hm = posr > 0, hp = posr < L - 1;
#pragma unroll
        for (int hf = 0; hf < 2; ++hf) {
          float um[8], u0[8], up[8], qf[8];
          { u32x4 wm = hm ? *(const u32x4*)(rowp - 4096 + hf * 8) : z4;
            u32x4 w0 = *(const u32x4*)(rowp + hf * 8);
            u32x4 wp = hp ? *(const u32x4*)(rowp + 4096 + hf * 8) : z4;
            unpack8(wm, um); unpack8(w0, u0); unpack8(wp, up);
#pragma unroll
            for (int e = 0; e < 8; ++e) { const int c = c16 + hf * 8 + e;
              qf[e] = silu_f(cwl[c] * um[e] + cwl[256 + c] * u0[e] + cwl[512 + c] * up[e] + cwl[768 + c]); }
            *(u32x4*)(Qs + r * 136 + c16 + hf * 8) = pack8(qf); }
          { u32x4 wm = hm ? *(const u32x4*)(rowp - 4096 + 1024 + hf * 8) : z4;
            u32x4 w0 = *(const u32x4*)(rowp + 1024 + hf * 8);
            u32x4 wp = hp ? *(const u32x4*)(rowp + 4096 + 1024 + hf * 8) : z4;
            unpack8(wm, um); unpack8(w0, u0); unpack8(wp, up);
#pragma unroll
            for (int e = 0; e < 8; ++e) { const int c = 128 + c16 + hf * 8 + e;
              qf[e] = 0.088388347648318440f * silu_f(cwl[c] * um[e] + cwl[256 + c] * u0[e] + cwl[512 + c] * up[e] + cwl[768 + c]);
              kf[hf * 8 + e] = qf[e]; }
            *(u32x4*)(Ks + r * 136 + c16 + hf * 8) = pack8(qf); }
          { u32x4 wv4 = *(const u32x4*)(rowp + 2048 + hf * 8);
            bf16_t* vd = VsT + (c16 + hf * 8) * 72 + r;
            vd[0 * 72] = (bf16_t)(wv4[0] & 0xffff); vd[1 * 72] = (bf16_t)(wv4[0] >> 16);
            vd[2 * 72] = (bf16_t)(wv4[1] & 0xffff); vd[3 * 72] = (bf16_t)(wv4[1] >> 16);
            vd[4 * 72] = (bf16_t)(wv4[2] & 0xffff); vd[5 * 72] = (bf16_t)(wv4[2] >> 16);
            vd[6 * 72] = (bf16_t)(wv4[3] & 0xffff); vd[7 * 72] = (bf16_t)(wv4[3] >> 16); }
        }
      }
      if (wid == 0) {
        const int tc = ch * 64 + lane; const int pos = dir ? (L - 1 - tc) : tc;
        const float* gr = GT + (rowbase + pos) * 32;
        const float ic = gr[dir * 8 + h] + bgi;
        const float fp = gr[16 + dir * 8 + h] + bgf;
        const float lf = fminf(fp, 0.f) - log1pf(expf(-fabsf(fp)));
        float bc = lf;
#pragma unroll
        for (int off = 1; off < 64; off <<= 1) { float t = __shfl_up(bc, off); if (lane >= off) bc += t; }
        const float a = ic - bc;
        float pm = a;
#pragma unroll
        for (int off = 1; off < 64; off <<= 1) { float t = __shfl_up(pm, off); if (lane >= off) pm = fmaxf(pm, t); }
        const float M = fmaxf(m, pm);
        av[lane] = a; Mv[lane] = M; bv[lane] = bc;
        if (lane == 63) { scal[0] = M; scal[1] = bc; }
      }
      __syncthreads();
      const float M63 = scal[0], b63 = scal[1];
      const float m_new = b63 + M63;
      const float w_state = __expf(m - M63);
      {
        const float wt = __expf(av[lane] - M63);
        bf16_t* kd = KwT + (wv * 16) * 72 + lane;
#pragma unroll
        for (int e = 0; e < 16; ++e) kd[e * 72] = f2bf(kf[e] * wt);
      }
      __syncthreads();
      const int tb = wid & 1, vb = wid >> 1;
      if (wid < 4) {
        const int sb = wid >> 1;
        f32x16 s = {};
        if (sb <= tb) s = mma_nt<128>(Qs + tb * 32 * 136, 136, Ks + sb * 32 * 136, 136, s, r32, hi);
        const int sc = sb * 32 + r32; const float as = av[sc];
#pragma unroll
        for (int r = 0; r < 16; ++r) {
          const int t = tb * 32 + crow(r, hi);
          float w = (sc <= t) ? s[r] * __expf(as - Mv[t]) : 0.f;
          Wb[t * 72 + sc] = f2bf(w);
        }
      }
      f32x16 inter = {};
      inter = mma_nt<128>(Qs + tb * 32 * 136, 136, Cb + vb * 32 * 136, 136, inter, r32, hi);
      __syncthreads();
      {
        const int t = tid >> 3, part = tid & 7;
        float wsum[8]; unpack8(*(const u32x4*)(Wb + t * 72 + part * 8), wsum);
        float dw = 0.f;
#pragma unroll
        for (int e = 0; e < 8; ++e) dw += wsum[e];
        float q0[8], q1[8]; unpack8(*(const u32x4*)(Qs + t * 136 + part * 16), q0); unpack8(*(const u32x4*)(Qs + t * 136 + part * 16 + 8), q1);
        float dq = 0.f;
#pragma unroll
        for (int e = 0; e < 8; ++e) dq += q0[e] * nvec[part * 16 + e] + q1[e] * nvec[part * 16 + 8 + e];
        dw += __shfl_xor(dw, 1); dw += __shfl_xor(dw, 2); dw += __shfl_xor(dw, 4);
        dq += __shfl_xor(dq, 1); dq += __shfl_xor(dq, 2); dq += __shfl_xor(dq, 4);
        if (part == 0) {
          const float Mt = Mv[t];
          const float wint = __expf(m - Mt);
          const float den = wint * dq + dw;
          const float mt = bv[t] + Mt;
          sclv[t] = 1.f / fmaxf(fabsf(den), __expf(-mt));
          wintv[t] = wint;
        }
      }
      __syncthreads();
      {
        f32x16 num;
#pragma unroll
        for (int r = 0; r < 16; ++r) num[r] = inter[r] * wintv[tb * 32 + crow(r, hi)];
        num = mma_nt<64>(Wb + tb * 32 * 72, 72, VsT + vb * 32 * 72, 72, num, r32, hi);
        bf16_t* Hout = dir ? HB : HF;
#pragma unroll
        for (int r = 0; r < 16; ++r) {
          const int t = tb * 32 + crow(r, hi);
          const int tc = ch * 64 + t; const int pos = dir ? (L - 1 - tc) : tc;
          Hout[(rowbase + pos) * 1024 + h * 128 + vb * 32 + r32] = f2bf(num[r] * sclv[t]);
        }
      }
#pragma unroll
      for (int i = 0; i < 2; ++i) {
        const int kb = (wid & 1) * 2 + i;
#pragma unroll
        for (int r = 0; r < 16; ++r) cacc[i][r] *= w_state;
        cacc[i] = mma_nt<64>(VsT + vb2 * 32 * 72, 72, KwT + kb * 32 * 72, 72, cacc[i], r32, hi);
#pragma unroll
        for (int r = 0; r < 16; ++r) Cb[(vb2 * 32 + crow(r, hi)) * 136 + kb * 32 + r32] = f2bf(cacc[i][r]);
      }
      if (tid < 128) {
        float s = 0.f;
#pragma unroll
        for (int q = 0; q < 8; ++q) { float f[8]; unpack8(*(const u32x4*)(KwT + tid * 72 + q * 8), f);
#pragma unroll
          for (int e = 0; e < 8; ++e) s += f[e]; }
        nvec[tid] = w_state * nvec[tid] + s;
      }
      m = m_new;
      __syncthreads();
    }
    if (seq < 32) {
      float* Co = p.out + O_C + (long)((seq * 2 + dir) * 8 + h) * 16384;
#pragma unroll
      for (int i = 0; i < 2; ++i) { const int kb = (wid & 1) * 2 + i;
#pragma unroll
        for (int r = 0; r < 16; ++r) Co[(vb2 * 32 + crow(r, hi)) * 128 + kb * 32 + r32] = cacc[i][r]; }
      if (tid < 128) p.out[O_N + ((seq * 2 + dir) * 8 + h) * 128 + tid] = nvec[tid];
      if (tid == 0) p.out[O_M + (seq * 2 + dir) * 8 + h] = m;
    }
  }
  __syncthreads();
}

__device__ __forceinline__ void mlstm_post(const int wv, const Params& p, const int zq, const bf16_t* __restrict__ HF, const bf16_t* __restrict__ HB,
                                           const bf16_t* __restrict__ P1, bf16_t* __restrict__ A) {
  const int tidx = ltid(wv);
  const int wid = wv, lane = tidx & 63;
  const float* hn = p.in[zq + 37];
  for (int row = blockIdx.x * 8 + wid; row < T_TOK; row += gridDim.x * 8) {
    float hv[16], t0[8], t1[8];
    unpack8(*(const u32x4*)(HF + (long)row * 1024 + lane * 16), hv); unpack8(*(const u32x4*)(HF + (long)row * 1024 + lane * 16 + 8), hv + 8);
    unpack8(*(const u32x4*)(HB + (long)row * 1024 + lane * 16), t0); unpack8(*(const u32x4*)(HB + (long)row * 1024 + lane * 16 + 8), t1);
    float ss = 0.f;
#pragma unroll
    for (int e = 0; e < 8; ++e) { hv[e] += t0[e]; hv[8 + e] += t1[e]; }
#pragma unroll
    for (int e = 0; e < 16; ++e) ss += hv[e] * hv[e];
    ss += __shfl_xor(ss, 1); ss += __shfl_xor(ss, 2); ss += __shfl_xor(ss, 4);
    const float rs = rsqrtf(ss * (1.f / 128.f) + 1e-6f);
    float ov[16];
    unpack8(*(const u32x4*)(P1 + (long)row * 4096 + 3072 + lane * 16), ov); unpack8(*(const u32x4*)(P1 + (long)row * 4096 + 3072 + lane * 16 + 8), ov + 8);
    float y[16];
#pragma unroll
    for (int e = 0; e < 16; ++e) y[e] = hv[e] * rs * hn[lane * 16 + e] * (1.f / (1.f + __expf(-ov[e])));
    *(u32x4*)(A + (long)row * 1024 + lane * 16) = pack8(y);
    *(u32x4*)(A + (long)row * 1024 + lane * 16 + 8) = pack8(y + 8);
  }
}

__device__ __forceinline__ void gsync(const int wv, unsigned* bar, const unsigned k) {
  const int tidx = ltid(wv);
  asm volatile("s_waitcnt vmcnt(0)" ::: "memory");
  __syncthreads();
  if (tidx == 0) {
    __builtin_amdgcn_fence(__ATOMIC_RELEASE, "agent");
    asm volatile("s_waitcnt vmcnt(0)" ::: "memory");
    const unsigned g = blockIdx.x & 7u;
    const unsigned ng = (gridDim.x + 7u - g) >> 3;
    const unsigned ngroups = gridDim.x < 8u ? gridDim.x : 8u;
    const unsigned old = __hip_atomic_fetch_add(bar + g * 32, 1u, __ATOMIC_RELAXED, __HIP_MEMORY_SCOPE_AGENT);
    if (old + 1u == k * ng) {
      const unsigned o2 = __hip_atomic_fetch_add(bar + 256, 1u, __ATOMIC_RELAXED, __HIP_MEMORY_SCOPE_AGENT);
      if (o2 + 1u == k * ngroups) {
#pragma unroll
        for (int q = 0; q < 8; ++q) __hip_atomic_store(bar + 512 + q * 32, k, __ATOMIC_RELAXED, __HIP_MEMORY_SCOPE_AGENT);
      }
    }
    while (__hip_atomic_load(bar + 512 + g * 32, __ATOMIC_RELAXED, __HIP_MEMORY_SCOPE_AGENT) < k) __builtin_amdgcn_s_sleep(4);
    __builtin_amdgcn_fence(__ATOMIC_ACQUIRE, "agent");
    asm volatile("s_waitcnt vmcnt(0)" ::: "memory");
  }
  __syncthreads();
}

__global__ void __launch_bounds__(512) mega(Params p, int ph_lo, int ph_hi) {
  const int wv = __builtin_amdgcn_readfirstlane(threadIdx.x >> 6);
  if (ph_hi < 0) { cg::this_grid().sync(); }
  unsigned* bar = (unsigned*)(p.ws + WS_END);
  char* ws = p.ws;
  bf16_t* Wt_in0 = (bf16_t*)(ws + OFF_WIN0); bf16_t* Wt_out0 = (bf16_t*)(ws + OFF_WOUT0);
  bf16_t* Wt_up0 = (bf16_t*)(ws + OFF_WUP0); bf16_t* Wt_up1 = (bf16_t*)(ws + OFF_WUP1);
  bf16_t* Wt_dn0 = (bf16_t*)(ws + OFF_WDN0); bf16_t* Wt_dn1 = (bf16_t*)(ws + OFF_WDN1);
  bf16_t* Wt_in1 = (bf16_t*)(ws + OFF_WIN1); bf16_t* Wt_out1 = (bf16_t*)(ws + OFF_WOUT1);
  float* modv = (float*)(ws + OFF_MOD);
  char* Pr = ws + OFF_P; char* Gr = ws + OFF_G;
  bf16_t* Pb = (bf16_t*)Pr; float* R = (float*)Pr;
  bf16_t* QA = (bf16_t*)(Pr + P_QA); bf16_t* KA = (bf16_t*)(Pr + P_KA); bf16_t* VA = (bf16_t*)(Pr + P_VA); bf16_t* X0 = (bf16_t*)(Pr + P_X0);
  float* GT = (float*)(Pr + P_GT); bf16_t* A2 = (bf16_t*)(Pr + P_A2);
  bf16_t* A = (bf16_t*)Gr; bf16_t* Gb = (bf16_t*)Gr; float* VV = (float*)(Gr + G_VV);
  bf16_t* HF = (bf16_t*)Gr; bf16_t* HB = (bf16_t*)(Gr + G_HB);
  float* X = p.out;
  float* F256 = p.out + O_C + 512; float* F2048 = p.out + O_C + 512 * 512 + 512;
  const float* mod0 = modv; const float* mod1 = modv + 3 * 6144;
  unsigned bk = 0;
#define PH(i, ...) if (ph_lo <= (i) && (i) < ph_hi) { const int zq = opq(); __VA_ARGS__; if ((i) + 1 < ph_hi) gsync(wv, bar, ++bk); }
  PH(0, {
    conv_w(wv, p.in[zq + 19], Wt_in0, 1024, 2560, 2560);
    conv_w(wv, p.in[zq + 20], Wt_out0, 1024, 1024, 1024);
    conv_w(wv, p.in[zq + 15], Wt_up0, 1024, 5632, 5632);
    conv_w(wv, p.in[zq + 15] + (long)1024 * 5632, Wt_up1, 1024, 5632, 5632);
    conv_w(wv, p.in[zq + 18], Wt_dn0, 2816, 1024, 1024);
    conv_w(wv, p.in[zq + 18] + (long)2816 * 1024, Wt_dn1, 2816, 1024, 1024);
    conv_w(wv, p.in[zq + 33], Wt_in1, 1024, 4128, 4352);
    conv_w(wv, p.in[zq + 38], Wt_out1, 1024, 1024, 1024);
    mod_phase(wv, p, zq, modv);
    filt_phase(wv, p, zq, F256, F2048);
  })
  PH(1, (row_phase<true, false, true>(wv, p, zq, nullptr, nullptr, mod0, 0, nullptr, p.in[zq + 11], mod0, 0, A)))
  PH(2, (gemm_phase<0, 2560>(wv, A, Wt_in0, 2560, 1024, Pb, nullptr)))
  PH(3, post_inproj0(wv, p, zq, Pb, QA, KA, VA, VV, X0))
  PH(4, mix0_phase(wv, p, zq, QA, KA, VA, VV, X0, F256, F2048, A))
  PH(5, (gemm_phase<1, 1024>(wv, A, Wt_out0, 1024, 1024, R, nullptr)))
  PH(6, (row_phase<true, true, true>(wv, p, zq, R, p.in[zq + 12], mod0, 2, X, p.in[zq + 13], mod0, 3, A)))
  PH(7, (gemm_phase<0, 5632>(wv, A, Wt_up0, 5632, 1024, Pb, nullptr)))
  PH(8, ffn_act_phase(wv, Pb, p.in[zq + 16], p.in[zq + 17], Gb))
  PH(9, (gemm_phase<1, 1024>(wv, Gb, Wt_dn0, 1024, 2816, R, nullptr)))
  PH(10, (row_phase<false, true, true>(wv, p, zq, R, p.in[zq + 14], mod0, 5, X, p.in[zq + 11] + 1024, mod1, 0, A)))
  PH(11, (gemm_phase<2, 4096>(wv, A, Wt_in1, 4352, 1024, Pb, GT)))
  PH(13, mlstm_phase(wv, p, zq, Pb, GT, HF, HB))
  PH(14, mlstm_post(wv, p, zq, HF, HB, Pb, A2))
  PH(15, (gemm_phase<1, 1024>(wv, A2, Wt_out1, 1024, 1024, R, nullptr)))
  PH(16, (row_phase<false, true, true>(wv, p, zq, R, p.in[zq + 12] + 1024, mod1, 2, X, p.in[zq + 13] + 1024, mod1, 3, A)))
  PH(17, (gemm_phase<0, 5632>(wv, A, Wt_up1, 5632, 1024, Pb, nullptr)))
  PH(18, ffn_act_phase(wv, Pb, p.in[zq + 16] + 3 * 5632, p.in[zq + 17] + 5632, Gb))
  PH(19, (gemm_phase<1, 1024>(wv, Gb, Wt_dn1, 1024, 2816, R, nullptr)))
  PH(20, (row_phase<false, true, false>(wv, p, zq, R, p.in[zq + 14] + 1024, mod1, 5, X, nullptr, mod1, 0, nullptr)))
#undef PH
}

extern "C" void kernel_launch(void* const* d_in, const int* in_sizes, int n_in, void* d_out, int out_size, void* d_ws, size_t ws_size,
                              hipStream_t stream) {
  static int grid_blocks = 0;
  if (!grid_blocks) {
    if (ws_size < WS_END + 4096) fprintf(stderr, "kernel_launch: workspace too small: %zu < %zu\n", ws_size, (size_t)WS_END);
    hipFuncSetAttribute((const void*)mega, hipFuncAttributeMaxDynamicSharedMemorySize, LDS_BYTES);
    int dev = 0, cus = 0, per = 0;
    hipGetDevice(&dev);
    hipDeviceGetAttribute(&cus, hipDeviceAttributeMultiprocessorCount, dev);
    hipOccupancyMaxActiveBlocksPerMultiprocessor(&per, mega, 512, LDS_BYTES);
    if (per < 1) { fprintf(stderr, "kernel_launch: occupancy query returned %d\n", per); per = 1; }
    grid_blocks = cus;
  }
  Params p{};
  for (int i = 0; i < 39; ++i) p.in[i] = (const float*)d_in[i];
  p.out = (float*)d_out; p.ws = (char*)d_ws;
  int lo = 0, hi = NPH;
  (void)hipMemsetAsync((char*)d_ws + WS_END, 0, 4096, stream);
  void* args[] = {&p, &lo, &hi};
  hipError_t e = hipLaunchCooperativeKernel((void*)mega, dim3(grid_blocks), dim3(512), args, LDS_BYTES, stream);
  if (e != hipSuccess) fprintf(stderr, "cooperative launch failed: %s (grid %d)\n", hipGetErrorString(e), grid_blocks);
}
```

```cpp
#include <hip/hip_runtime.h>
#include <hip/hip_cooperative_groups.h>
#include <cstdio>
#include <cstdint>
namespace cg = cooperative_groups;

typedef unsigned short bf16_t;
typedef short bf16x8 __attribute__((ext_vector_type(8)));
typedef short s16x4 __attribute__((ext_vector_type(4)));
typedef float f32x4 __attribute__((ext_vector_type(4)));
typedef float f32x8 __attribute__((ext_vector_type(8)));
typedef float f32x16 __attribute__((ext_vector_type(16)));
typedef unsigned u32x4 __attribute__((ext_vector_type(4)));
typedef unsigned u32x2 __attribute__((ext_vector_type(2)));

constexpr int T_TOK = 12288, TPR = 8192;
constexpr int LDS_BYTES = 131072;
constexpr int NPH = 21;

constexpr size_t OFF_WIN0 = 0, OFF_WOUT0 = 5242880, OFF_WUP0 = 7340032, OFF_WUP1 = 18874368, OFF_WDN0 = 30408704,
                 OFF_WDN1 = 36175872, OFF_WIN1 = 41943040, OFF_WOUT1 = 50855936, OFF_MOD = 52953088, OFF_P = 53100544,
                 OFF_G = 191512576, WS_END = 260718592;
constexpr size_t P_QA = 62914560, P_KA = 75497472, P_VA = 82313216, P_X0 = 89128960;
constexpr size_t P_GT = 100663296, P_A2 = 102236160;
constexpr size_t G_VV = 25165824, G_HB = 25165824;
constexpr size_t O_K = 12582912, O_V = 14680064, O_C = 16777216, O_N = 25165824, O_M = 25231360;

struct Params { const float* in[39]; float* out; char* ws; };

typedef __bf16 nbf16x2 __attribute__((ext_vector_type(2)));
typedef float nf32x2 __attribute__((ext_vector_type(2)));
__device__ __forceinline__ unsigned cvtpk(float lo, float hi) {
  nf32x2 v = {lo, hi};
  nbf16x2 b = __builtin_convertvector(v, nbf16x2);
  return __builtin_bit_cast(unsigned, b);
}
__device__ __forceinline__ bf16_t f2bf(float f) { return (bf16_t)(cvtpk(f, 0.f) & 0xffffu); }
__device__ __forceinline__ float bf2f(bf16_t h) { return __uint_as_float(((unsigned)h) << 16); }
__device__ __forceinline__ float bflo(unsigned w) { return __uint_as_float(w << 16); }
__device__ __forceinline__ float bfhi(unsigned w) { return __uint_as_float(w & 0xffff0000u); }
__device__ __forceinline__ float wave_sum(float v) {
#pragma unroll
  for (int o = 32; o > 0; o >>= 1) v += __shfl_xor(v, o);
  return v;
}
__device__ __forceinline__ int llane() { int l; asm volatile("v_mbcnt_lo_u32_b32 %0, -1, 0\n\tv_mbcnt_hi_u32_b32 %0, -1, %0" : "=v"(l)); return l; }
__device__ __forceinline__ int ltid(int wv) { return (wv << 6) | llane(); }
__device__ __forceinline__ int opq() { int z; asm volatile("s_mov_b32 %0, 0" : "=s"(z)); return z; }
__device__ __forceinline__ float silu_f(float x) { return x * __builtin_amdgcn_rcpf(1.f + __expf(-x)); }
__device__ __forceinline__ int crow(int r, int hi) { return (r & 3) + 8 * (r >> 2) + 4 * hi; }
__device__ __forceinline__ void unpack8(u32x4 w, float* f) {
  f[0] = bflo(w[0]); f[1] = bfhi(w[0]); f[2] = bflo(w[1]); f[3] = bfhi(w[1]);
  f[4] = bflo(w[2]); f[5] = bfhi(w[2]); f[6] = bflo(w[3]); f[7] = bfhi(w[3]);
}
__device__ __forceinline__ u32x4 pack8(const float* f) {
  u32x4 w = {cvtpk(f[0], f[1]), cvtpk(f[2], f[3]), cvtpk(f[4], f[5]), cvtpk(f[6], f[7])}; return w;
}

__device__ __forceinline__ void conv_w(const int wv, const float* __restrict__ W, bf16_t* __restrict__ Wt, int K, int N, int NP) {
  const int tidx = ltid(wv);
  extern __shared__ __attribute__((aligned(16))) char shm_raw[];
  float* tl = (float*)shm_raw;
  const int tid = tidx;
  const int ntn = NP / 64, ntiles = (K / 64) * ntn;
  for (int tile = blockIdx.x; tile < ntiles; tile += gridDim.x) {
    const int k0 = (tile / ntn) * 64, n0 = (tile % ntn) * 64;
    __syncthreads();
#pragma unroll
    for (int i = 0; i < 2; ++i) {
      int kr = (tid >> 4) + 32 * i, nc = (tid & 15) * 4;
      float4 v = make_float4(0.f, 0.f, 0.f, 0.f);
      if (n0 + nc < N) v = *(const float4*)(W + (long)(k0 + kr) * N + n0 + nc);
      float* d = tl + kr * 65 + nc; d[0] = v.x; d[1] = v.y; d[2] = v.z; d[3] = v.w;
    }
    __syncthreads();
    {
      int n = tid >> 3, kg = (tid & 7) * 8;
      u32x4 w;
      w[0] = cvtpk(tl[(kg + 0) * 65 + n], tl[(kg + 1) * 65 + n]);
      w[1] = cvtpk(tl[(kg + 2) * 65 + n], tl[(kg + 3) * 65 + n]);
      w[2] = cvtpk(tl[(kg + 4) * 65 + n], tl[(kg + 5) * 65 + n]);
      w[3] = cvtpk(tl[(kg + 6) * 65 + n], tl[(kg + 7) * 65 + n]);
      *(u32x4*)(Wt + (long)(n0 + n) * K + k0 + kg) = w;
    }
  }
  __syncthreads();
}

__device__ __forceinline__ void mod_phase(const int wv, const Params& p, const int zq, float* modv) {
  const int tidx = ltid(wv);
  extern __shared__ __attribute__((aligned(16))) char shm_raw[];
  float* red = (float*)shm_raw;
  const int tid = tidx;
  const float* cvec = p.in[zq + 7]; const float* cctx = p.in[zq + 8]; const float* bmod = p.in[zq + 10];
  for (int item = blockIdx.x; item < 192; item += gridDim.x) {
    const int l = item / 96, cb = (item % 96) * 64;
    const float* W = p.in[zq + 9] + (long)l * 1024 * 6144;
    const int cl = tid & 15, kg = tid >> 4;
    float a0[4] = {0, 0, 0, 0}, a1[4] = {0, 0, 0, 0}, a2[4] = {0, 0, 0, 0};
#pragma unroll 4
    for (int i = 0; i < 32; ++i) {
      int k = kg + 32 * i;
      float4 w = *(const float4*)(W + (long)k * 6144 + cb + cl * 4);
      float s0 = silu_f(cctx[k]), s1 = silu_f(cvec[k]), s2 = silu_f(cvec[1024 + k]);
      a0[0] += s0 * w.x; a0[1] += s0 * w.y; a0[2] += s0 * w.z; a0[3] += s0 * w.w;
      a1[0] += s1 * w.x; a1[1] += s1 * w.y; a1[2] += s1 * w.z; a1[3] += s1 * w.w;
      a2[0] += s2 * w.x; a2[1] += s2 * w.y; a2[2] += s2 * w.z; a2[3] += s2 * w.w;
    }
    __syncthreads();
#pragma unroll
    for (int j = 0; j < 4; ++j) {
      red[kg * 192 + 0 * 64 + cl * 4 + j] = a0[j];
      red[kg * 192 + 1 * 64 + cl * 4 + j] = a1[j];
      red[kg * 192 + 2 * 64 + cl * 4 + j] = a2[j];
    }
    __syncthreads();
    if (tid < 192) {
      float s = 0.f;
#pragma unroll 8
      for (int q = 0; q < 32; ++q) s += red[q * 192 + tid];
      int g = tid / 64, col = cb + (tid % 64);
      modv[(l * 3 + g) * 6144 + col] = s + bmod[l * 6144 + col];
    }
  }
  __syncthreads();
}

__device__ __forceinline__ void filt_phase(const int wv, const Params& p, const int zq, float* F256, float* F2048) {
  const int tidx = ltid(wv);
  extern __shared__ __attribute__((aligned(16))) char shm_raw[];
  float* z = (float*)shm_raw; float* h1 = z + 32; float* h2 = h1 + 64;
  const int tid = tidx;
  const float *w1 = p.in[zq + 25], *b1 = p.in[zq + 26], *w2 = p.in[zq + 27], *b2 = p.in[zq + 28], *w3 = p.in[zq + 29], *b3 = p.in[zq + 30], *sf = p.in[zq + 31], *skip = p.in[zq + 32];
  const float DMAX = -15.350567286626973f, DMIN = -3.0701134573253946f;
  for (int item = blockIdx.x; item < 2304; item += gridDim.x) {
    const int L = item < 256 ? 256 : 2048; const int i = item < 256 ? item : item - 256;
    float* F = item < 256 ? F256 : F2048;
    const float t = (float)i / (float)(L - 1);
    __syncthreads();
    if (tid < 17) {
      float v;
      if (tid == 0) v = t;
      else if (tid <= 8) v = cosf(6.283185307179586f * t * (float)tid);
      else v = sinf(6.283185307179586f * t * (float)(tid - 8));
      z[tid] = v;
    }
    __syncthreads();
    if (tid < 64) { float s = b1[tid];
#pragma unroll 1
      for (int j = 0; j < 17; ++j) s += z[j] * w1[j * 64 + tid]; h1[tid] = sinf(sf[tid] * s); }
    __syncthreads();
    if (tid < 64) { float s = b2[tid];
#pragma unroll 8
      for (int j = 0; j < 64; ++j) s += h1[j] * w2[j * 64 + tid]; h2[tid] = sinf(sf[64 + tid] * s); }
    __syncthreads();
    {
      const int ch = tid; float sfw = b3[ch], sbw = b3[512 + ch];
#pragma unroll 8
      for (int j = 0; j < 64; ++j) { float hh = h2[j]; sfw += hh * w3[j * 1024 + ch]; sbw += hh * w3[j * 1024 + 512 + ch]; }
      float delta = fabsf(DMIN + (DMAX - DMIN) * ((float)ch / 511.f));
      float win = expf(-t * delta); sfw *= win; sbw *= win;
      if (i == 0) F[(long)(L - 1) * 512 + ch] = sfw + sbw + skip[ch];
      else { F[(long)(L - 1 + i) * 512 + ch] = sfw; F[(long)(L - 1 - i) * 512 + ch] = sbw; }
    }
  }
  __syncthreads();
}

template <bool FROM_IN, bool HAS_R, bool HAS_A>
__device__ __forceinline__ void row_phase(const int wv, const Params& p, const int zq, const float* __restrict__ R, const float* __restrict__ postg,
                                          const float* __restrict__ modg, int gate_m, float* X,
                                          const float* __restrict__ preg, const float* __restrict__ mods, int shift_m, bf16_t* __restrict__ A) {
  const int tidx = ltid(wv);
  const int wid = wv, lane = tidx & 63;
  for (int row = blockIdx.x * 8 + wid; row < T_TOK; row += gridDim.x * 8) {
    const int g = row < TPR ? 0 : 1 + (row - TPR) / 2048;
    const float* mg = modg + g * 6144;
    const float* ms = mods + g * 6144;
    const float* xin = FROM_IN ? (row < TPR ? p.in[zq + 0] + (long)row * 1024 : p.in[zq + 1] + (long)(row - TPR) * 1024) : (const float*)X + (long)row * 1024;
    float4 x[4];
#pragma unroll
    for (int j = 0; j < 4; ++j) x[j] = *(const float4*)(xin + j * 256 + lane * 4);
    if (HAS_R) {
      float4 r[4]; float ss = 0.f;
#pragma unroll
      for (int j = 0; j < 4; ++j) { r[j] = *(const float4*)(R + (long)row * 1024 + j * 256 + lane * 4); ss += r[j].x * r[j].x + r[j].y * r[j].y + r[j].z * r[j].z + r[j].w * r[j].w; }
      ss = wave_sum(ss); const float rs = rsqrtf(ss * (1.f / 1024.f) + 1e-6f);
#pragma unroll
      for (int j = 0; j < 4; ++j) {
        float4 pg = *(const float4*)(postg + j * 256 + lane * 4);
        float4 gt = *(const float4*)(mg + gate_m * 1024 + j * 256 + lane * 4);
        x[j].x += gt.x * (r[j].x * rs * pg.x); x[j].y += gt.y * (r[j].y * rs * pg.y);
        x[j].z += gt.z * (r[j].z * rs * pg.z); x[j].w += gt.w * (r[j].w * rs * pg.w);
        *(float4*)(X + (long)row * 1024 + j * 256 + lane * 4) = x[j];
      }
    }
    if (HAS_A) {
      float ss = 0.f;
#pragma unroll
      for (int j = 0; j < 4; ++j) ss += x[j].x * x[j].x + x[j].y * x[j].y + x[j].z * x[j].z + x[j].w * x[j].w;
      ss = wave_sum(ss); const float rs = rsqrtf(ss * (1.f / 1024.f) + 1e-6f);
#pragma unroll
      for (int j = 0; j < 4; ++j) {
        float4 pg = *(const float4*)(preg + j * 256 + lane * 4);
        float4 sh = *(const float4*)(ms + shift_m * 1024 + j * 256 + lane * 4);
        float4 sc = *(const float4*)(ms + (shift_m + 1) * 1024 + j * 256 + lane * 4);
        float y0 = x[j].x * rs * pg.x * (1.f + sc.x) + sh.x, y1 = x[j].y * rs * pg.y * (1.f + sc.y) + sh.y;
        float y2 = x[j].z * rs * pg.z * (1.f + sc.z) + sh.z, y3 = x[j].w * rs * pg.w * (1.f + sc.w) + sh.w;
        u32x2 w = {cvtpk(y0, y1), cvtpk(y2, y3)};
        *(u32x2*)(A + (long)row * 1024 + j * 256 + lane * 4) = w;
      }
    }
  }
}

constexpr int BM = 256, BK = 64, HALF = 128, WGM = 8, HT = HALF * BK;
__device__ __forceinline__ int lds_byte(int r, int c) {
  int st = (r >> 4) * 2 + (c >> 5), rr = r & 15, cc = c & 31, ob = rr * 64 + cc * 2;
  return st * 1024 + (ob ^ (((ob >> 9) & 1) << 5));
}
__device__ __forceinline__ void stage_rc(int b, int& R, int& C) {
  int st = b / 1024, sb = b % 1024, swz = sb ^ (((sb >> 9) & 1) << 5);
  R = (st >> 1) * 16 + swz / 64; C = (st & 1) * 32 + (swz % 64) / 2;
}

template <int MODE, int LDC>
__device__ __forceinline__ void gemm_phase(const int wv, const bf16_t* __restrict__ A, const bf16_t* __restrict__ Bt, int N, int K,
                                           void* Cout, float* GT) {
  const int tidx = ltid(wv);
  extern __shared__ __attribute__((aligned(16))) char shm_raw[];
  bf16_t* shm = (bf16_t*)shm_raw;
#define SA(b, h) (shm + ((b) * 2 + (h)) * HT)
#define SB(b, h) (shm + (4 + (b) * 2 + (h)) * HT)
#define STAGE(P, BASE, br, kt) do { const bf16_t* _gb = (BASE) + ((long)(br) * K + (long)(kt) * BK); \
    __builtin_amdgcn_global_load_lds((const unsigned*)(_gb + soff0), (unsigned*)((char*)(P) + sl0), 16, 0, 0); \
    __builtin_amdgcn_global_load_lds((const unsigned*)(_gb + soff1), (unsigned*)((char*)(P) + sl0 + 8192), 16, 0, 0); } while (0)
#define LDA(dst, b, h) _Pragma("unroll") for (int m = 0; m < 4; ++m) _Pragma("unroll") for (int k = 0; k < 2; ++k) \
    dst[m][k] = *reinterpret_cast<const bf16x8*>((char*)SA(b, h) + lds_byte(wr * 64 + m * 16 + fr, k * 32 + fq * 8))
#define LDB(dst, b, h) _Pragma("unroll") for (int n = 0; n < 2; ++n) _Pragma("unroll") for (int k = 0; k < 2; ++k) \
    dst[n][k] = *reinterpret_cast<const bf16x8*>((char*)SB(b, h) + lds_byte(wc * 32 + n * 16 + fr, k * 32 + fq * 8))
#define MMA(ai, bj, At, Bt_) do { __builtin_amdgcn_s_setprio(1); \
    _Pragma("unroll") for (int m = 0; m < 4; ++m) _Pragma("unroll") for (int n = 0; n < 2; ++n) _Pragma("unroll") for (int k = 0; k < 2; ++k) \
      acc[ai][bj][m][n] = __builtin_amdgcn_mfma_f32_16x16x32_bf16(At[m][k], Bt_[n][k], acc[ai][bj][m][n], 0, 0, 0); \
    __builtin_amdgcn_s_setprio(0); } while (0)
#define WAIT_V(n) asm volatile("s_waitcnt vmcnt(" #n ")" ::: "memory")
#define WAIT_L(n) asm volatile("s_waitcnt lgkmcnt(" #n ")" ::: "memory")
#define BAR __builtin_amdgcn_s_barrier()
#define SCHED __builtin_amdgcn_sched_barrier(0)
  const int nM = T_TOK / BM, nN = N / BM, nwg = nM * nN;
  const int wid = wv, lane = tidx & 63, wr = wid >> 2, wc = wid & 3, fr = lane & 15, fq = lane >> 4;
  const int nt = K / BK;
  unsigned soff0, soff1; const int sl0 = tidx * 16;
  { int _r, _c; stage_rc(sl0, _r, _c); soff0 = (unsigned)(_r * K + _c); stage_rc(sl0 + 8192, _r, _c); soff1 = (unsigned)(_r * K + _c); }
  for (int tile = blockIdx.x; tile < nwg; tile += gridDim.x) {
    int wgt = tile;
    { const int q = nwg / 8, r = nwg % 8, xcd = wgt % 8, off = wgt / 8;
      wgt = (xcd < r ? xcd * (q + 1) : r * (q + 1) + (xcd - r) * q) + off; }
    const int nig = WGM * nN, gid = wgt / nig, fm = gid * WGM, gsz = min(nM - fm, WGM);
    const int pm = fm + ((wgt % nig) % gsz), pn = (wgt % nig) / gsz, brow = pm * BM, bcol = pn * BM;
    f32x4 acc[2][2][4][2] = {};
    bf16x8 At[4][2], B0[2][2], B1[2][2];
    STAGE(SB(0, 0), Bt, bcol, 0); STAGE(SA(0, 0), A, brow, 0);
    STAGE(SB(0, 1), Bt, bcol + HALF, 0); STAGE(SA(0, 1), A, brow + HALF, 0);
    if (wr == 1) BAR;
    WAIT_V(4); BAR;
    STAGE(SB(1, 0), Bt, bcol, 1); STAGE(SA(1, 0), A, brow, 1); STAGE(SB(1, 1), Bt, bcol + HALF, 1);
    WAIT_V(6); BAR;
    for (int t = 0; t < nt - 2; t += 2) {
      LDB(B0, 0, 0); SCHED; LDA(At, 0, 0); STAGE(SA(1, 1), A, brow + HALF, t + 1);
      WAIT_L(8); BAR; WAIT_L(0); MMA(0, 0, At, B0); BAR; SCHED;
      LDB(B1, 0, 1); STAGE(SB(0, 0), Bt, bcol, t + 2);
      BAR; WAIT_L(0); MMA(0, 1, At, B1); BAR;
      LDA(At, 0, 1); STAGE(SA(0, 0), A, brow, t + 2);
      BAR; WAIT_L(0); MMA(1, 0, At, B0); BAR; SCHED;
      STAGE(SB(0, 1), Bt, bcol + HALF, t + 2);
      WAIT_V(6); BAR; MMA(1, 1, At, B1); BAR;
      LDB(B0, 1, 0); SCHED; LDA(At, 1, 0); STAGE(SA(0, 1), A, brow + HALF, t + 2);
      WAIT_L(8); BAR; WAIT_L(0); MMA(0, 0, At, B0); BAR; SCHED;
      LDB(B1, 1, 1); STAGE(SB(1, 0), Bt, bcol, t + 3);
      BAR; WAIT_L(0); MMA(0, 1, At, B1); BAR;
      LDA(At, 1, 1); STAGE(SA(1, 0), A, brow, t + 3);
      BAR; WAIT_L(0); MMA(1, 0, At, B0); BAR; SCHED;
      STAGE(SB(1, 1), Bt, bcol + HALF, t + 3);
      WAIT_V(6); BAR; MMA(1, 1, At, B1); BAR;
    }
    { LDB(B0, 0, 0); LDA(At, 0, 0); STAGE(SA(1, 1), A, brow + HALF, nt - 1);
      BAR; WAIT_L(0); MMA(0, 0, At, B0); BAR;
      LDB(B1, 0, 1); BAR; WAIT_L(0); MMA(0, 1, At, B1); BAR;
      LDA(At, 0, 1); WAIT_V(4); BAR; WAIT_L(0); MMA(1, 0, At, B0); MMA(1, 1, At, B1); BAR; }
    { LDB(B0, 1, 0); LDA(At, 1, 0); WAIT_V(2); BAR; WAIT_L(0); MMA(0, 0, At, B0); BAR;
      LDB(B1, 1, 1); WAIT_V(0); BAR; WAIT_L(0); MMA(0, 1, At, B1); BAR;
      LDA(At, 1, 1); BAR; WAIT_L(0); MMA(1, 0, At, B0); MMA(1, 1, At, B1); BAR; }
    if (wr == 0) BAR;
    {
      const int le = llane();
      const int fr = le & 15, fq = le >> 4;
      const long base = (long)(brow + wr * 64) * LDC + bcol + wc * 32 + (unsigned)(fq * 4 * LDC + fr);
      if (MODE == 0 || (MODE == 2 && pn < 16)) {
        bf16_t* cp = (bf16_t*)Cout + base;
#pragma unroll
        for (int ai = 0; ai < 2; ++ai)
#pragma unroll
          for (int m = 0; m < 4; ++m)
#pragma unroll
            for (int j = 0; j < 4; ++j) {
              bf16_t* rp = cp + (ai * HALF + m * 16 + j) * LDC;
#pragma unroll
              for (int bj = 0; bj < 2; ++bj)
#pragma unroll
                for (int n = 0; n < 2; ++n) rp[bj * HALF + n * 16] = f2bf(acc[ai][bj][m][n][j]);
            }
      } else if (MODE == 1) {
        float* cp = (float*)Cout + base;
#pragma unroll
        for (int ai = 0; ai < 2; ++ai)
#pragma unroll
          for (int m = 0; m < 4; ++m)
#pragma unroll
            for (int j = 0; j < 4; ++j) {
              float* rp = cp + (ai * HALF + m * 16 + j) * LDC;
#pragma unroll
              for (int bj = 0; bj < 2; ++bj)
#pragma unroll
                for (int n = 0; n < 2; ++n) rp[bj * HALF + n * 16] = acc[ai][bj][m][n][j];
            }
      } else {
        if (wc == 0) {
          float* gp = GT + (long)(brow + wr * 64) * 32 + (unsigned)(fq * 4 * 32 + fr);
#pragma unroll
          for (int ai = 0; ai < 2; ++ai)
#pragma unroll
            for (int m = 0; m < 4; ++m)
#pragma unroll
              for (int j = 0; j < 4; ++j)
#pragma unroll
                for (int n = 0; n < 2; ++n) gp[(ai * HALF + m * 16 + j) * 32 + n * 16] = acc[ai][0][m][n][j];
        }
      }
    }
    __syncthreads();
  }
#undef SA
#undef SB
#undef STAGE
#undef LDA
#undef LDB
#undef MMA
}

__device__ __forceinline__ void post_inproj0(const int wv, const Params& p, const int zq, const bf16_t* __restrict__ P0, bf16_t* __restrict__ QA, bf16_t* __restrict__ KA,
                                             bf16_t* __restrict__ VA, float* __restrict__ VV, bf16_t* __restrict__ X0) {
  const int tidx = ltid(wv);
  const int wid = wv, lane = tidx & 63;
  const float* qn = p.in[zq + 21]; const float* kn = p.in[zq + 22]; const float* cw = p.in[zq + 23]; const float* cb = p.in[zq + 24];
  float* outK = p.out + O_K; float* outV = p.out + O_V;
  for (int i = blockIdx.x * 512 + tidx; i < 2 * 512 * 256 / 4; i += gridDim.x * 512) {
    int e = i * 4; int b = e / (512 * 256), rem = e % (512 * 256);
    float4 kk = *(const float4*)(p.in[zq + 2] + e); float4 vv = *(const float4*)(p.in[zq + 3] + e);
    long d = (long)(8192 + b * 2560 + 2048) * 256 + rem;
    u32x2 wk = {cvtpk(kk.x, kk.y), cvtpk(kk.z, kk.w)}; u32x2 wv = {cvtpk(vv.x, vv.y), cvtpk(vv.z, vv.w)};
    *(u32x2*)(KA + d) = wk; *(u32x2*)(VA + d) = wv;
  }
  const int fi = lane & 31;
  const float inv = exp2f(-(float)fi * (13.287712379549449f / 32.f));
  for (int row = blockIdx.x * 8 + wid; row < T_TOK; row += gridDim.x * 8) {
    const bool samp = row >= TPR;
    const int L = samp ? 2048 : 256;
    const int tl = samp ? (row - TPR) % 2048 : row % 256;
    const long krow = samp ? (long)(8192 + ((row - TPR) / 2048) * 2560 + tl) : (long)row;
    const bf16_t* base = P0 + (long)row * 2560;
    float cs = 1.f, sn = 0.f;
    if (samp) { float pos = (lane < 32) ? (float)(tl / 64) : (float)(tl % 64); float ang = pos * inv; cs = cosf(ang); sn = sinf(ang); }
#pragma unroll
    for (int hh = 0; hh < 6; ++hh) {
      float x1 = bf2f(base[hh * 128 + lane]), x2 = bf2f(base[hh * 128 + 64 + lane]);
      float ss = wave_sum(x1 * x1 + x2 * x2);
      float rs = rsqrtf(ss * (1.f / 128.f) + 1e-6f);
      const float* gw = hh < 4 ? qn : kn;
      float y1 = x1 * rs * gw[lane], y2 = x2 * rs * gw[64 + lane];
      if (hh >= 4 && !samp) { outK[(long)row * 256 + (hh - 4) * 128 + lane] = y1; outK[(long)row * 256 + (hh - 4) * 128 + 64 + lane] = y2; }
      float o1 = y1 * cs - y2 * sn, o2 = y1 * sn + y2 * cs;
      if (hh < 4) { QA[(long)row * 512 + hh * 128 + lane] = f2bf(o1); QA[(long)row * 512 + hh * 128 + 64 + lane] = f2bf(o2); }
      else { KA[krow * 256 + (hh - 4) * 128 + lane] = f2bf(o1); KA[krow * 256 + (hh - 4) * 128 + 64 + lane] = f2bf(o2); }
    }
    {
      u32x2 w = *(const u32x2*)(base + 768 + lane * 4);
      *(u32x2*)(VA + krow * 256 + lane * 4) = w;
      if (!samp) { float4 f = make_float4(bflo(w[0]), bfhi(w[0]), bflo(w[1]), bfhi(w[1])); *(float4*)(outV + (long)row * 256 + lane * 4) = f; }
    }
    {
      const int c8 = lane * 8;
      float uc[3][8];
#pragma unroll
      for (int g = 0; g < 3; ++g) {
        const int col = g * 512 + c8;
        float um[8], u0[8], up[8];
        u32x4 z4 = {0u, 0u, 0u, 0u};
        u32x4 wm = (tl > 0) ? *(const u32x4*)(base - 2560 + 1024 + col) : z4;
        u32x4 w0 = *(const u32x4*)(base + 1024 + col);
        u32x4 wp = (tl < L - 1) ? *(const u32x4*)(base + 2560 + 1024 + col) : z4;
        unpack8(wm, um); unpack8(w0, u0); unpack8(wp, up);
#pragma unroll
        for (int e = 0; e < 8; ++e)
          uc[g][e] = cw[col + e] * um[e] + cw[1536 + col + e] * u0[e] + cw[3072 + col + e] * up[e] + cb[col + e];
      }
      float vvv[8];
#pragma unroll
      for (int e = 0; e < 8; ++e) vvv[e] = uc[2][e] * uc[1][e];
      *(float4*)(VV + (long)row * 512 + c8) = make_float4(vvv[0], vvv[1], vvv[2], vvv[3]);
      *(float4*)(VV + (long)row * 512 + c8 + 4) = make_float4(vvv[4], vvv[5], vvv[6], vvv[7]);
      *(u32x4*)(X0 + (long)row * 512 + c8) = pack8(uc[0]);
    }
  }
}

constexpr int AD = 128, ANW = 8, QBLK = 32, KVBLK = 64;
constexpr float ASCALE = 0.088388347648318440f;
constexpr float ATHR = 8.f;
constexpr int LDQ = 512, LDK = 256, LDO = 1024;
constexpr size_t SHM_V = KVBLK * AD * 2, SHM_K = KVBLK * AD * 2;
#define KSWZ(row, colB) ((row) * 256 + ((colB) ^ (((row) & 7) << 4)))
#define SBAR() __builtin_amdgcn_sched_barrier(0)

__device__ __forceinline__ void partialSM(f32x16& p0, f32x16& p1, float& m_reg, float& mn, float& alpha) {
  constexpr float C = ASCALE * 1.4426950408889634f;
  float pmax = p0[0];
#pragma unroll
  for (int r = 1; r < 16; ++r) pmax = fmaxf(pmax, p0[r]);
#pragma unroll
  for (int r = 0; r < 16; ++r) pmax = fmaxf(pmax, p1[r]);
  { auto rr = __builtin_amdgcn_permlane32_swap(__float_as_uint(pmax), __float_as_uint(pmax), false, false);
    pmax = fmaxf(__uint_as_float(rr[0]), __uint_as_float(rr[1])); }
  if (__builtin_expect(__all(pmax - m_reg <= ATHR / ASCALE), 1)) { mn = m_reg; alpha = 1.f; }
  else { mn = fmaxf(m_reg, pmax); alpha = __builtin_amdgcn_exp2f((m_reg - mn) * C); m_reg = mn; }
  float mnC = -mn * C;
#pragma unroll
  for (int r = 0; r < 16; ++r) p0[r] = fmaf(p0[r], C, mnC);
#pragma unroll
  for (int r = 0; r < 16; ++r) p1[r] = fmaf(p1[r], C, mnC);
#pragma unroll
  for (int r = 0; r < 16; ++r) p0[r] = __builtin_amdgcn_exp2f(p0[r]);
}
__device__ __forceinline__ void finishSM(f32x16& p0, f32x16& p1, float alpha, float& l_reg, bf16x8& pa0, bf16x8& pa1, bf16x8& pa2, bf16x8& pa3) {
#pragma unroll
  for (int r = 0; r < 16; ++r) p1[r] = __builtin_amdgcn_exp2f(p1[r]);
  float ps = 0;
#pragma unroll
  for (int r = 0; r < 16; ++r) ps += p0[r];
#pragma unroll
  for (int r = 0; r < 16; ++r) ps += p1[r];
  { auto rr = __builtin_amdgcn_permlane32_swap(__float_as_uint(ps), __float_as_uint(ps), false, false);
    ps = __uint_as_float(rr[0]) + __uint_as_float(rr[1]); }
  l_reg = l_reg * alpha + ps;
#define PK4(P, BASE, OUT) do { unsigned a0 = cvtpk(P[BASE + 0], P[BASE + 1]), a1 = cvtpk(P[BASE + 2], P[BASE + 3]);   \
    unsigned b0 = cvtpk(P[BASE + 4], P[BASE + 5]), b1 = cvtpk(P[BASE + 6], P[BASE + 7]);                              \
    auto r0 = __builtin_amdgcn_permlane32_swap(a0, b0, false, false); auto r1 = __builtin_amdgcn_permlane32_swap(a1, b1, false, false); \
    u32x4 w = {r0[0], r1[0], r0[1], r1[1]}; OUT = *reinterpret_cast<bf16x8*>(&w); } while (0)
  PK4(p0, 0, pa0); PK4(p0, 8, pa1); PK4(p1, 0, pa2); PK4(p1, 8, pa3);
#undef PK4
}
__device__ __forceinline__ void qkt(f32x16& p0, f32x16& p1, const bf16_t* Ks, const bf16x8* qr, int r32, int hi) {
  p0 = f32x16{}; p1 = f32x16{};
#pragma unroll
  for (int d0 = 0; d0 < 8; ++d0) { int cb = (d0 * 16 + hi * 8) * 2;
    bf16x8 b0 = *reinterpret_cast<const bf16x8*>((const char*)Ks + KSWZ(r32, cb));
    bf16x8 b1 = *reinterpret_cast<const bf16x8*>((const char*)Ks + KSWZ(32 + r32, cb));
    p0 = __builtin_amdgcn_mfma_f32_32x32x16_bf16(b0, qr[d0], p0, 0, 0, 0);
    p1 = __builtin_amdgcn_mfma_f32_32x32x16_bf16(b1, qr[d0], p1, 0, 0, 0); }
}
__device__ __forceinline__ int v_st(int k, int c) { const int kk = (k & ~0xC) | ((k & 4) << 1) | ((k & 8) >> 1); return ((kk >> 3) * 4 + (c >> 5)) * 512 + ((kk & 7) * 32 + (c & 31)) * 2; }
__device__ __forceinline__ int v_rd_base(int lane) { return ((lane & 3) << 3) | (((lane >> 2) & 3) << 6) | (((lane >> 4) & 1) << 5) | (((lane >> 5) & 1) << 8); }
constexpr int v_rd_off(int d0, int ks, int half) { return d0 * 512 + ks * 4096 + half * 2048; }
template <int OFF> __device__ __forceinline__ s16x4 tr_read(int vb) {
  s16x4 r; asm volatile("ds_read_b64_tr_b16 %0, %1 offset:%2" : "=&v"(r) : "v"(vb), "i"(OFF) : "memory"); return r;
}
template <int D0> __device__ __forceinline__ void pv_one(f32x16& od, int vb, bf16x8 pa0, bf16x8 pa1, bf16x8 pa2, bf16x8 pa3) {
  const s16x4 l0 = tr_read<v_rd_off(D0, 0, 0)>(vb), h0 = tr_read<v_rd_off(D0, 0, 1)>(vb), l1 = tr_read<v_rd_off(D0, 1, 0)>(vb), h1 = tr_read<v_rd_off(D0, 1, 1)>(vb);
  const s16x4 l2 = tr_read<v_rd_off(D0, 2, 0)>(vb), h2 = tr_read<v_rd_off(D0, 2, 1)>(vb), l3 = tr_read<v_rd_off(D0, 3, 0)>(vb), h3 = tr_read<v_rd_off(D0, 3, 1)>(vb);
  asm volatile("s_waitcnt lgkmcnt(0)" ::: "memory"); SBAR();
#define PK(L, H) (bf16x8){L[0], L[1], L[2], L[3], H[0], H[1], H[2], H[3]}
  od = __builtin_amdgcn_mfma_f32_32x32x16_bf16(pa0, PK(l0, h0), od, 0, 0, 0);
  od = __builtin_amdgcn_mfma_f32_32x32x16_bf16(pa1, PK(l1, h1), od, 0, 0, 0);
  od = __builtin_amdgcn_mfma_f32_32x32x16_bf16(pa2, PK(l2, h2), od, 0, 0, 0);
  od = __builtin_amdgcn_mfma_f32_32x32x16_bf16(pa3, PK(l3, h3), od, 0, 0, 0);
#undef PK
}
__device__ __forceinline__ void pv_d0(f32x16* o, int vb, bf16x8 pa0, bf16x8 pa1, bf16x8 pa2, bf16x8 pa3) {
  pv_one<0>(o[0], vb, pa0, pa1, pa2, pa3); pv_one<1>(o[1], vb, pa0, pa1, pa2, pa3); pv_one<2>(o[2], vb, pa0, pa1, pa2, pa3); pv_one<3>(o[3], vb, pa0, pa1, pa2, pa3);
}

__device__ __forceinline__ void attn_dense_body(const int wv, const bf16_t* __restrict__ Qb, const bf16_t* __restrict__ Kh, const bf16_t* __restrict__ Vh,
                                                bf16_t* __restrict__ Ob, int seq, char* lds) {
  const int tidx = ltid(wv);
  const int tid = tidx, wid = wv, lane = tid & 63, r32 = lane & 31, hi = lane >> 5;
  bf16_t* V_lds = (bf16_t*)lds; bf16_t* K_lds = (bf16_t*)(lds + 2 * SHM_V);
  float* ws = (float*)(lds + 2 * SHM_V + 2 * SHM_K) + wid * 64; float* li_l = ws; float* al_l = ws + 32;
  float m_reg = -1e30f, l_reg = 0; f32x16 o[4] = {}; bf16x8 qr[8];
  const bf16_t* Qw = Qb + (long)(wid * QBLK + r32) * LDQ + hi * 8;
#pragma unroll
  for (int d0 = 0; d0 < 8; ++d0) qr[d0] = *reinterpret_cast<const bf16x8*>(Qw + d0 * 16);
  const int sr = tid >> 4, sc = (tid & 15) * 8, vst0 = v_st(sr, sc), vst1 = v_st(32 + sr, sc);
  const int vb0 = (int)(uintptr_t)V_lds + v_rd_base(lane);
  bf16x8 sA_vs0, sA_vs1, sA_ks0, sA_ks1, sB_vs0, sB_vs1, sB_ks0, sB_ks1;
#define SLOADA(k0) do { sA_vs0 = *(const bf16x8*)(&Vh[(long)((k0) + sr) * LDK + sc]); sA_vs1 = *(const bf16x8*)(&Vh[(long)((k0) + 32 + sr) * LDK + sc]); \
    sA_ks0 = *(const bf16x8*)(&Kh[(long)((k0) + sr) * LDK + sc]); sA_ks1 = *(const bf16x8*)(&Kh[(long)((k0) + 32 + sr) * LDK + sc]); } while (0)
#define SLOADB(k0) do { sB_vs0 = *(const bf16x8*)(&Vh[(long)((k0) + sr) * LDK + sc]); sB_vs1 = *(const bf16x8*)(&Vh[(long)((k0) + 32 + sr) * LDK + sc]); \
    sB_ks0 = *(const bf16x8*)(&Kh[(long)((k0) + sr) * LDK + sc]); sB_ks1 = *(const bf16x8*)(&Kh[(long)((k0) + 32 + sr) * LDK + sc]); } while (0)
#define SWRITEA(b) do { *(bf16x8*)((char*)V_lds + (b) * SHM_V + vst0) = sA_vs0; *(bf16x8*)((char*)V_lds + (b) * SHM_V + vst1) = sA_vs1; int kc = sc * 2; \
    *(bf16x8*)((char*)K_lds + (b) * SHM_K + KSWZ(sr, kc)) = sA_ks0; *(bf16x8*)((char*)K_lds + (b) * SHM_K + KSWZ(32 + sr, kc)) = sA_ks1; } while (0)
#define SWRITEB(b) do { *(bf16x8*)((char*)V_lds + (b) * SHM_V + vst0) = sB_vs0; *(bf16x8*)((char*)V_lds + (b) * SHM_V + vst1) = sB_vs1; int kc = sc * 2; \
    *(bf16x8*)((char*)K_lds + (b) * SHM_K + KSWZ(sr, kc)) = sB_ks0; *(bf16x8*)((char*)K_lds + (b) * SHM_K + KSWZ(32 + sr, kc)) = sB_ks1; } while (0)
#define SWAIT() asm volatile("s_waitcnt vmcnt(4)" ::: "memory")
#define RESC(a) do { if (__any((a) < 1.f)) { if (hi == 0) al_l[r32] = (a); asm volatile("s_waitcnt lgkmcnt(0)" ::: "memory"); \
    _Pragma("unroll") for (int d = 0; d < 4; ++d) _Pragma("unroll") for (int r = 0; r < 16; ++r) o[d][r] *= al_l[crow(r, hi)]; } } while (0)
  f32x16 pA0, pA1, pB0, pB1; float mnA, mnB, alA, alB; bf16x8 pa0, pa1, pa2, pa3; const int NT = seq / KVBLK;
  SLOADA(0); asm volatile("s_waitcnt vmcnt(0)" ::: "memory"); SWRITEA(0); __syncthreads();
  qkt(pA0, pA1, K_lds, qr, r32, hi); partialSM(pA0, pA1, m_reg, mnA, alA);
  SLOADB(KVBLK); if (2 < NT) SLOADA(2 * KVBLK);
  SWAIT(); SWRITEB(1); __syncthreads();
  for (int j = 1; j + 1 < NT; j += 2) {
    SBAR(); qkt(pB0, pB1, (bf16_t*)((char*)K_lds + SHM_K), qr, r32, hi);
    finishSM(pA0, pA1, alA, l_reg, pa0, pa1, pa2, pa3); SBAR();
    SLOADB((j + 2) * KVBLK); SBAR();
    pv_d0(o, vb0, pa0, pa1, pa2, pa3); partialSM(pB0, pB1, m_reg, mnB, alB);
    __syncthreads(); SWAIT(); SWRITEA(0);
    RESC(alB); __syncthreads();
    SBAR(); qkt(pA0, pA1, K_lds, qr, r32, hi);
    finishSM(pB0, pB1, alB, l_reg, pa0, pa1, pa2, pa3); SBAR();
    if (j + 3 < NT) SLOADA((j + 3) * KVBLK); SBAR();
    pv_d0(o, vb0 + (int)SHM_V, pa0, pa1, pa2, pa3); partialSM(pA0, pA1, m_reg, mnA, alA);
    __syncthreads(); SWAIT(); SWRITEB(1);
    RESC(alA); __syncthreads();
  }
  SBAR(); qkt(pB0, pB1, (bf16_t*)((char*)K_lds + SHM_K), qr, r32, hi);
  finishSM(pA0, pA1, alA, l_reg, pa0, pa1, pa2, pa3); SBAR();
  pv_d0(o, vb0, pa0, pa1, pa2, pa3); partialSM(pB0, pB1, m_reg, mnB, alB);
  __syncthreads(); RESC(alB);
  finishSM(pB0, pB1, alB, l_reg, pa0, pa1, pa2, pa3); SBAR();
  pv_d0(o, vb0 + (int)SHM_V, pa0, pa1, pa2, pa3);
  if (hi == 0) li_l[r32] = l_reg; asm volatile("s_waitcnt lgkmcnt(0)" ::: "memory");
  float rli[16];
#pragma unroll
  for (int r = 0; r < 16; ++r) rli[r] = __builtin_amdgcn_rcpf(li_l[crow(r, hi)]);
  bf16_t* Ow = Ob + (long)(wid * QBLK) * LDO;
#pragma unroll
  for (int r = 0; r < 16; ++r) { int orow = crow(r, hi);
#pragma unroll
    for (int d0 = 0; d0 < 4; ++d0) Ow[(long)orow * LDO + d0 * 32 + r32] = f2bf(o[d0][r] * rli[r]); }
#undef SLOADA
#undef SLOADB
#undef SWRITEA
#undef SWRITEB
#undef SWAIT
#undef RESC
}

__device__ __forceinline__ void hyena_item(const float* __restrict__ F, const float* __restrict__ VV, const bf16_t* __restrict__ X0,
                                           bf16_t* __restrict__ AO, long rowbase, int L, int c, int t0) {
  float y[16], ring[16];
#pragma unroll
  for (int i = 0; i < 16; ++i) { y[i] = 0.f; ring[i] = F[(long)(t0 + i + L - 1) * 512 + c]; }
  const float* vp = VV + rowbase * 512 + c;
  const float* fp = F + (long)(t0 + L - 2) * 512 + c;
  for (int s0 = 0; s0 < L; s0 += 16) {
#pragma unroll
    for (int j = 0; j < 16; ++j) {
      const float vs = vp[(long)(s0 + j) * 512];
      const float nf = fp[-(long)(s0 + j) * 512];
#pragma unroll
      for (int i = 0; i < 16; ++i) y[i] += ring[(i - j) & 15] * vs;
      ring[(15 - j) & 15] = nf;
    }
  }
#pragma unroll
  for (int i = 0; i < 16; ++i) {
    long row = rowbase + t0 + i;
    AO[row * 1024 + 512 + c] = f2bf(y[i] * bf2f(X0[row * 512 + c]));
  }
}

__device__ __forceinline__ void mix0_phase(const int wv, const Params& p, const int zq, const bf16_t* QA, const bf16_t* KA, const bf16_t* VA, const float* VV,
                                           const bf16_t* X0, const float* F256, const float* F2048, bf16_t* AO) {
  extern __shared__ __attribute__((aligned(16))) char shm_raw[];
#ifndef NO_ATTN
  for (int it = blockIdx.x; it < 192; it += gridDim.x) {
    long rowb, krow; int h, seqk;
    if (it < 64) { const int qb = it % 8, b = it / 32; h = (it / 8) % 4; rowb = 8192 + (long)b * 2048 + qb * 256; krow = 8192 + (long)b * 2560; seqk = 2560; }
    else { const int j = it - 64; const int b = j / 4; h = j % 4; rowb = (long)b * 256; krow = rowb; seqk = 256; }
    __syncthreads();
    attn_dense_body(wv, QA + rowb * 512 + h * 128, KA + krow * 256 + (h >> 1) * 128, VA + krow * 256 + (h >> 1) * 128, AO + rowb * 1024 + h * 128, seqk, shm_raw);
  }
#endif
#ifndef NO_HYENA
  const int lane = llane(); const int wid = wv;
  {
    const int G = gridDim.x;
    for (int it = (blockIdx.x + G - 64) % G; it < 256; it += G) {
      const int b = it / 128, cgp = (it / 16) % 8, tg = it % 16;
      hyena_item(F2048, VV, X0, AO, 8192 + (long)b * 2048, 2048, cgp * 64 + lane, tg * 128 + wid * 16);
    }
    const int nl = G > 64 ? G - 64 : G, l0 = G > 64 ? (int)blockIdx.x - 64 : (int)blockIdx.x;
    if (l0 >= 0)
      for (int j = l0; j < 512; j += nl) {
        const int b = j / 16, cgp = (j / 2) % 8, tg = j % 2;
        hyena_item(F256, VV, X0, AO, (long)b * 256, 256, cgp * 64 + lane, tg * 128 + wid * 16);
      }
  }
#endif
  __syncthreads();
}

__device__ __forceinline__ float erf_as(float x) {
  const float ax = fabsf(x);
  const float t = __builtin_amdgcn_rcpf(fmaf(0.3275911f, ax, 1.f));
  float p = fmaf(1.061405429f, t, -1.453152027f);
  p = fmaf(p, t, 1.421413741f); p = fmaf(p, t, -0.284496736f); p = fmaf(p, t, 0.254829592f);
  const float r = 1.f - p * t * __expf(-ax * ax);
  return copysignf(r, x);
}
__device__ __forceinline__ float gelu_f(float x) { return 0.5f * x * (1.f + erf_as(x * 0.70710678118654752f)); }
__device__ __forceinline__ void ffn_act_phase(const int wv, const bf16_t* __restrict__ P, const float* __restrict__ cw, const float* __restrict__ cb, bf16_t* __restrict__ G) {
  const int tidx = ltid(wv);
  const int tid = tidx;
  if (tid >= 352) return;
  const int c8 = tid * 8;
  float w1[3][8], w2[3][8], b1[8], b2[8];
#pragma unroll
  for (int e = 0; e < 8; ++e) {
#pragma unroll
    for (int k = 0; k < 3; ++k) { w1[k][e] = cw[k * 5632 + c8 + e]; w2[k][e] = cw[k * 5632 + 2816 + c8 + e]; }
    b1[e] = cb[c8 + e]; b2[e] = cb[2816 + c8 + e];
  }
  for (int item = blockIdx.x; item < T_TOK / 16; item += gridDim.x) {
    const int r0 = item * 16;
    const int L = r0 < TPR ? 256 : 2048;
    const int tl0 = r0 < TPR ? r0 % 256 : (r0 - TPR) % 2048;
    float am[8], a0[8], ap[8], gm[8], g0[8], gp[8];
    const u32x4 z4 = {0u, 0u, 0u, 0u};
    {
      const bf16_t* b = P + (long)r0 * 5632 + c8;
      u32x4 x = (tl0 > 0) ? *(const u32x4*)(b - 5632) : z4; unpack8(x, am);
      x = (tl0 > 0) ? *(const u32x4*)(b - 5632 + 2816) : z4; unpack8(x, gm);
      x = *(const u32x4*)(b); unpack8(x, a0);
      x = *(const u32x4*)(b + 2816); unpack8(x, g0);
    }
    for (int r = 0; r < 16; ++r) {
      const bf16_t* b = P + (long)(r0 + r) * 5632 + c8;
      const bool vn = (tl0 + r) < L - 1;
      u32x4 x = vn ? *(const u32x4*)(b + 5632) : z4; unpack8(x, ap);
      x = vn ? *(const u32x4*)(b + 5632 + 2816) : z4; unpack8(x, gp);
      float o[8];
#pragma unroll
      for (int e = 0; e < 8; ++e) {
        float h1 = w1[0][e] * am[e] + w1[1][e] * a0[e] + w1[2][e] * ap[e] + b1[e];
        float h2 = w2[0][e] * gm[e] + w2[1][e] * g0[e] + w2[2][e] * gp[e] + b2[e];
        o[e] = gelu_f(h1) * h2;
        am[e] = a0[e]; a0[e] = ap[e]; gm[e] = g0[e]; g0[e] = gp[e];
      }
      *(u32x4*)(G + (long)(r0 + r) * 2816 + c8) = pack8(o);
    }
  }
}

template <int K>
__device__ __forceinline__ f32x16 mma_nt(const bf16_t* A, int lda, const bf16_t* B, int ldb, f32x16 acc, int r32, int hi) {
  bf16x8 a[K / 16], b[K / 16];
#pragma unroll
  for (int k0 = 0; k0 < K / 16; ++k0) {
    a[k0] = *reinterpret_cast<const bf16x8*>(A + r32 * lda + k0 * 16 + 8 * hi);
    b[k0] = *reinterpret_cast<const bf16x8*>(B + r32 * ldb + k0 * 16 + 8 * hi);
  }
#pragma unroll
  for (int k0 = 0; k0 < K / 16; ++k0) acc = __builtin_amdgcn_mfma_f32_32x32x16_bf16(a[k0], b[k0], acc, 0, 0, 0);
  return acc;
}

__device__ __forceinline__ void mlstm_phase(const int wv, const Params& p, const int zq, const bf16_t* __restrict__ P1, const float* __restrict__ GT,
                                            bf16_t* __restrict__ HF, bf16_t* __restrict__ HB) {
  const int tidx = ltid(wv);
  extern __shared__ __attribute__((aligned(16))) char shm_raw[];
  bf16_t* Qs = (bf16_t*)shm_raw;
  bf16_t* Ks = Qs + 64 * 136;
  bf16_t* KwT = Ks + 64 * 136;
  bf16_t* VsT = KwT + 128 * 72;
  bf16_t* Wb = VsT + 128 * 72;
  bf16_t* Cb = Wb + 64 * 72;
  float* gbuf = (float*)(Cb + 128 * 136);
  float* sclv = gbuf + 400; float* wintv = sclv + 64; float* nvec = wintv + 64;
  float* cwl = nvec + 128;
  const int tid = tidx, wid = wv, lane = tid & 63, r32 = lane & 31, hi = lane >> 5;
  const float* cw = p.in[zq + 35]; const float* cbias = p.in[zq + 36]; const float* bg = p.in[zq + 34];
  for (int u = blockIdx.x; u < 544; u += gridDim.x) {
    int seq, h, dir;
    if (u < 32) { seq = 32 + u / 16; h = (u / 2) % 8; dir = u % 2; } else { int j = u - 32; seq = j / 16; h = (j / 2) % 8; dir = j % 2; }
    const int L = seq < 32 ? 256 : 2048;
    const long rowbase = seq < 32 ? (long)seq * 256 : 8192 + (long)(seq - 32) * 2048;
    __syncthreads();
    f32x16 cacc[2]; float m = 0.f;
    const int vb2 = wid >> 1;
    if (seq >= 32) {
      const int b = seq - 32;
      const float* Cin = p.in[zq + 4] + (long)((b * 2 + dir) * 8 + h) * 16384;
#pragma unroll
      for (int i = 0; i < 2; ++i) { const int kb = (wid & 1) * 2 + i;
#pragma unroll
        for (int r = 0; r < 16; ++r) cacc[i][r] = Cin[(vb2 * 32 + crow(r, hi)) * 128 + kb * 32 + r32]; }
      if (tid < 128) nvec[tid] = p.in[zq + 5][((b * 2 + dir) * 8 + h) * 128 + tid];
      m = p.in[zq + 6][(b * 2 + dir) * 8 + h];
    } else {
#pragma unroll
      for (int i = 0; i < 2; ++i)
#pragma unroll
        for (int r = 0; r < 16; ++r) cacc[i][r] = 0.f;
      if (tid < 128) nvec[tid] = 0.f;
    }
#pragma unroll
    for (int i = 0; i < 2; ++i) { const int kb = (wid & 1) * 2 + i;
#pragma unroll
      for (int r = 0; r < 16; ++r) Cb[(vb2 * 32 + crow(r, hi)) * 136 + kb * 32 + r32] = f2bf(cacc[i][r]); }
    if (tid < 256) {
      const int col = (tid < 128) ? (h * 128 + tid) : (1024 + h * 128 + (tid - 128));
      cwl[tid] = cw[col]; cwl[256 + tid] = cw[2048 + col]; cwl[512 + tid] = cw[4096 + col]; cwl[768 + tid] = cbias[col];
    }
    const float bgi = bg[dir * 8 + h], bgf = bg[16 + dir * 8 + h];
    __syncthreads();
    const int nch = L / 64;
    u32x4 rq[2][3], rk[2][3], rv[2]; float g_i = 0.f, g_f = 0.f;
#define ML_LOADRAW(chn) do { \
      const int tcr_ = (chn) * 64 + lane; const int posr_ = dir ? (L - 1 - tcr_) : tcr_; \
      const bf16_t* rp_ = P1 + (rowbase + posr_) * 4096 + h * 128 + wv * 16; \
      const bool hm_ = posr_ > 0, hp_ = posr_ < L - 1; const u32x4 z4_ = {0u, 0u, 0u, 0u}; \
      _Pragma("unroll") for (int hf = 0; hf < 2; ++hf) { \
        rq[hf][0] = hm_ ? *(const u32x4*)(rp_ - 4096 + hf * 8) : z4_; rq[hf][1] = *(const u32x4*)(rp_ + hf * 8); \
        rq[hf][2] = hp_ ? *(const u32x4*)(rp_ + 4096 + hf * 8) : z4_; \
        rk[hf][0] = hm_ ? *(const u32x4*)(rp_ - 4096 + 1024 + hf * 8) : z4_; rk[hf][1] = *(const u32x4*)(rp_ + 1024 + hf * 8); \
        rk[hf][2] = hp_ ? *(const u32x4*)(rp_ + 4096 + 1024 + hf * 8) : z4_; \
        rv[hf] = *(const u32x4*)(rp_ + 2048 + hf * 8); } \
      if (wid == 7) { const float* gr_ = GT + (rowbase + posr_) * 32; g_i = gr_[dir * 8 + h]; g_f = gr_[16 + dir * 8 + h]; } \
    } while (0)
#define ML_GATES(setp, mval) do { float* av_ = gbuf + (setp) * 200; float* Mv_ = av_ + 64; float* bv_ = Mv_ + 64; float* scal_ = bv_ + 64; \
      const float ic_ = g_i + bgi; const float fp_ = g_f + bgf; \
      const float lf_ = fminf(fp_, 0.f) - __logf(1.f + __expf(-fabsf(fp_))); \
      float bc_ = lf_; \
      _Pragma("unroll") for (int off = 1; off < 64; off <<= 1) { float t_ = __shfl_up(bc_, off); if (lane >= off) bc_ += t_; } \
      const float a_ = ic_ - bc_; float pm_ = a_; \
      _Pragma("unroll") for (int off = 1; off < 64; off <<= 1) { float t_ = __shfl_up(pm_, off); if (lane >= off) pm_ = fmaxf(pm_, t_); } \
      const float M_ = fmaxf((mval), pm_); \
      av_[lane] = a_; Mv_[lane] = M_; bv_[lane] = bc_; if (lane == 63) { scal_[0] = M_; scal_[1] = bc_; } } while (0)
    ML_LOADRAW(0);
    if (wid == 7) ML_GATES(0, m);
    for (int ch = 0; ch < nch; ++ch) {
      float* av = gbuf + (ch & 1) * 200; float* Mv = av + 64; float* bv = Mv + 64; float* scal = bv + 64;
      float kf[16];
      {
        const int r = lane, c16 = wv * 16;
#pragma unroll
        for (int hf = 0; hf < 2; ++hf) {
          float um[8], u0[8], up[8], qf[8];
          { unpack8(rq[hf][0], um); unpack8(rq[hf][1], u0); unpack8(rq[hf][2], up);
#pragma unroll
            for (int e = 0; e < 8; ++e) { const int c = c16 + hf * 8 + e;
              qf[e] = silu_f(cwl[c] * um[e] + cwl[256 + c] * u0[e] + cwl[512 + c] * up[e] + cwl[768 + c]); }
            *(u32x4*)(Qs + r * 136 + c16 + hf * 8) = pack8(qf); }
          { unpack8(rk[hf][0], um); unpack8(rk[hf][1], u0); unpack8(rk[hf][2], up);
#pragma unroll
            for (int e = 0; e < 8; ++e) { const int c = 128 + c16 + hf * 8 + e;
              qf[e] = 0.088388347648318440f * silu_f(cwl[c] * um[e] + cwl[256 + c] * u0[e] + cwl[512 + c] * up[e] + cwl[768 + c]);
              kf[hf * 8 + e] = qf[e]; }
            *(u32x4*)(Ks + r * 136 + c16 + hf * 8) = pack8(qf); }
          { const u32x4 wv4 = rv[hf];
            bf16_t* vd = VsT + (c16 + hf * 8) * 72 + r;
            vd[0 * 72] = (bf16_t)(wv4[0] & 0xffff); vd[1 * 72] = (bf16_t)(wv4[0] >> 16);
            vd[2 * 72] = (bf16_t)(wv4[1] & 0xffff); vd[3 * 72] = (bf16_t)(wv4[1] >> 16);
            vd[4 * 72] = (bf16_t)(wv4[2] & 0xffff); vd[5 * 72] = (bf16_t)(wv4[2] >> 16);
            vd[6 * 72] = (bf16_t)(wv4[3] & 0xffff); vd[7 * 72] = (bf16_t)(wv4[3] >> 16); }
        }
      }
      if (ch + 1 < nch) ML_LOADRAW(ch + 1);
      __syncthreads();
      const float M63 = scal[0], b63 = scal[1];
      const float m_new = b63 + M63;
      const float w_state = __expf(m - M63);
      {
        const float wt = __expf(av[lane] - M63);
        bf16_t* kd = KwT + (wv * 16) * 72 + lane;
#pragma unroll
        for (int e = 0; e < 16; ++e) kd[e * 72] = f2bf(kf[e] * wt);
      }
      __syncthreads();
      if (wid == 7 && ch + 1 < nch) ML_GATES((ch + 1) & 1, m_new);
      const int tb = wid & 1, vb = wid >> 1;
      if (wid < 4) {
        const int sb = wid >> 1;
        f32x16 s = {};
        if (sb <= tb) { s = mma_nt<64>(Qs + tb * 32 * 136, 136, Ks + sb * 32 * 136, 136, s, r32, hi); s = mma_nt<64>(Qs + tb * 32 * 136 + 64, 136, Ks + sb * 32 * 136 + 64, 136, s, r32, hi); }
        const int sc = sb * 32 + r32; const float as = av[sc];
#pragma unroll
        for (int r = 0; r < 16; ++r) {
          const int t = tb * 32 + crow(r, hi);
          float w = (sc <= t) ? s[r] * __expf(as - Mv[t]) : 0.f;
          Wb[t * 72 + sc] = f2bf(w);
        }
      }
      f32x16 inter = {};
      inter = mma_nt<64>(Qs + tb * 32 * 136, 136, Cb + vb * 32 * 136, 136, inter, r32, hi); inter = mma_nt<64>(Qs + tb * 32 * 136 + 64, 136, Cb + vb * 32 * 136 + 64, 136, inter, r32, hi);
      __syncthreads();
      {
        const int t = tid >> 3, part = tid & 7;
        float wsum[8]; unpack8(*(const u32x4*)(Wb + t * 72 + part * 8), wsum);
        float dw = 0.f;
#pragma unroll
        for (int e = 0; e < 8; ++e) dw += wsum[e];
        float q0[8], q1[8]; unpack8(*(const u32x4*)(Qs + t * 136 + part * 16), q0); unpack8(*(const u32x4*)(Qs + t * 136 + part * 16 + 8), q1);
        float dq = 0.f;
#pragma unroll
        for (int e = 0; e < 8; ++e) dq += q0[e] * nvec[part * 16 + e] + q1[e] * nvec[part * 16 + 8 + e];
        dw += __shfl_xor(dw, 1); dw += __shfl_xor(dw, 2); dw += __shfl_xor(dw, 4);
        dq += __shfl_xor(dq, 1); dq += __shfl_xor(dq, 2); dq += __shfl_xor(dq, 4);
        if (part == 0) {
          const float Mt = Mv[t];
          const float wint = __expf(m - Mt);
          const float den = wint * dq + dw;
          const float mt = bv[t] + Mt;
          sclv[t] = 1.f / fmaxf(fabsf(den), __expf(-mt));
          wintv[t] = wint;
        }
      }
      __syncthreads();
      {
        f32x16 num;
#pragma unroll
        for (int r = 0; r < 16; ++r) num[r] = inter[r] * wintv[tb * 32 + crow(r, hi)];
        num = mma_nt<64>(Wb + tb * 32 * 72, 72, VsT + vb * 32 * 72, 72, num, r32, hi);
        bf16_t* Hout = dir ? HB : HF;
#pragma unroll
        for (int r = 0; r < 16; ++r) {
          const int t = tb * 32 + crow(r, hi);
          const int tc = ch * 64 + t; const int pos = dir ? (L - 1 - tc) : tc;
          Hout[(rowbase + pos) * 1024 + h * 128 + vb * 32 + r32] = f2bf(num[r] * sclv[t]);
        }
      }
#pragma unroll
      for (int i = 0; i < 2; ++i) {
        const int kb = (wid & 1) * 2 + i;
#pragma unroll
        for (int r = 0; r < 16; ++r) cacc[i][r] *= w_state;
        cacc[i] = mma_nt<64>(VsT + vb2 * 32 * 72, 72, KwT + kb * 32 * 72, 72, cacc[i], r32, hi);
#pragma unroll
        for (int r = 0; r < 16; ++r) Cb[(vb2 * 32 + crow(r, hi)) * 136 + kb * 32 + r32] = f2bf(cacc[i][r]);
      }
      if (tid < 128) {
        float s = 0.f;
#pragma unroll
        for (int q = 0; q < 8; ++q) { float f[8]; unpack8(*(const u32x4*)(KwT + tid * 72 + q * 8), f);
#pragma unroll
          for (int e = 0; e < 8; ++e) s += f[e]; }
        nvec[tid] = w_state * nvec[tid] + s;
      }
      m = m_new;
      __syncthreads();
    }
    if (seq < 32) {
      float* Co = p.out + O_C + (long)((seq * 2 + dir) * 8 + h) * 16384;
#pragma unroll
      for (int i = 0; i < 2; ++i) { const int kb = (wid & 1) * 2 + i;
#pragma unroll
        for (int r = 0; r < 16; ++r) Co[(vb2 * 32 + crow(r, hi)) * 128 + kb * 32 + r32] = cacc[i][r]; }
      if (tid < 128) p.out[O_N + ((seq * 2 + dir) * 8 + h) * 128 + tid] = nvec[tid];
      if (tid == 0) p.out[O_M + (seq * 2 + dir) * 8 + h] = m;
    }
  }
  __syncthreads();
}

#undef ML_LOADRAW
#undef ML_GATES
__device__ __forceinline__ void mlstm_post(const int wv, const Params& p, const int zq, const bf16_t* __restrict__ HF, const bf16_t* __restrict__ HB,
                                           const bf16_t* __restrict__ P1, bf16_t* __restrict__ A) {
  const int tidx = ltid(wv);
  const int wid = wv, lane = tidx & 63;
  const float* hn = p.in[zq + 37];
  for (int row = blockIdx.x * 8 + wid; row < T_TOK; row += gridDim.x * 8) {
    float hv[16], t0[8], t1[8];
    unpack8(*(const u32x4*)(HF + (long)row * 1024 + lane * 16), hv); unpack8(*(const u32x4*)(HF + (long)row * 1024 + lane * 16 + 8), hv + 8);
    unpack8(*(const u32x4*)(HB + (long)row * 1024 + lane * 16), t0); unpack8(*(const u32x4*)(HB + (long)row * 1024 + lane * 16 + 8), t1);
    float ss = 0.f;
#pragma unroll
    for (int e = 0; e < 8; ++e) { hv[e] += t0[e]; hv[8 + e] += t1[e]; }
#pragma unroll
    for (int e = 0; e < 16; ++e) ss += hv[e] * hv[e];
    ss += __shfl_xor(ss, 1); ss += __shfl_xor(ss, 2); ss += __shfl_xor(ss, 4);
    const float rs = rsqrtf(ss * (1.f / 128.f) + 1e-6f);
    float ov[16];
    unpack8(*(const u32x4*)(P1 + (long)row * 4096 + 3072 + lane * 16), ov); unpack8(*(const u32x4*)(P1 + (long)row * 4096 + 3072 + lane * 16 + 8), ov + 8);
    float y[16];
#pragma unroll
    for (int e = 0; e < 16; ++e) y[e] = hv[e] * rs * hn[lane * 16 + e] * (1.f / (1.f + __expf(-ov[e])));
    *(u32x4*)(A + (long)row * 1024 + lane * 16) = pack8(y);
    *(u32x4*)(A + (long)row * 1024 + lane * 16 + 8) = pack8(y + 8);
  }
}

__device__ __forceinline__ void gsync(const int wv, unsigned* bar, const unsigned k) {
  const int tidx = ltid(wv);
  asm volatile("s_waitcnt vmcnt(0)" ::: "memory");
  __syncthreads();
  if (tidx == 0) {
    __builtin_amdgcn_fence(__ATOMIC_RELEASE, "agent");
    asm volatile("s_waitcnt vmcnt(0)" ::: "memory");
    const unsigned g = blockIdx.x & 7u;
    const unsigned ng = (gridDim.x + 7u - g) >> 3;
    const unsigned ngroups = gridDim.x < 8u ? gridDim.x : 8u;
    const unsigned old = __hip_atomic_fetch_add(bar + g * 32, 1u, __ATOMIC_RELAXED, __HIP_MEMORY_SCOPE_AGENT);
    if (old + 1u == k * ng) {
      const unsigned o2 = __hip_atomic_fetch_add(bar + 256, 1u, __ATOMIC_RELAXED, __HIP_MEMORY_SCOPE_AGENT);
      if (o2 + 1u == k * ngroups) {
#pragma unroll
        for (int q = 0; q < 8; ++q) __hip_atomic_store(bar + 512 + q * 32, k, __ATOMIC_RELAXED, __HIP_MEMORY_SCOPE_AGENT);
      }
    }
    while (__hip_atomic_load(bar + 512 + g * 32, __ATOMIC_RELAXED, __HIP_MEMORY_SCOPE_AGENT) < k) __builtin_amdgcn_s_sleep(4);
    __builtin_amdgcn_fence(__ATOMIC_ACQUIRE, "agent");
    asm volatile("s_waitcnt vmcnt(0)" ::: "memory");
  }
  __syncthreads();
}

__global__ void __launch_bounds__(512) mega(Params p, int ph_lo, int ph_hi) {
  const int wv = __builtin_amdgcn_readfirstlane(threadIdx.x >> 6);
  if (ph_hi < 0) { cg::this_grid().sync(); }
  unsigned* bar = (unsigned*)(p.ws + WS_END);
  char* ws = p.ws;
  bf16_t* Wt_in0 = (bf16_t*)(ws + OFF_WIN0); bf16_t* Wt_out0 = (bf16_t*)(ws + OFF_WOUT0);
  bf16_t* Wt_up0 = (bf16_t*)(ws + OFF_WUP0); bf16_t* Wt_up1 = (bf16_t*)(ws + OFF_WUP1);
  bf16_t* Wt_dn0 = (bf16_t*)(ws + OFF_WDN0); bf16_t* Wt_dn1 = (bf16_t*)(ws + OFF_WDN1);
  bf16_t* Wt_in1 = (bf16_t*)(ws + OFF_WIN1); bf16_t* Wt_out1 = (bf16_t*)(ws + OFF_WOUT1);
  float* modv = (float*)(ws + OFF_MOD);
  char* Pr = ws + OFF_P; char* Gr = ws + OFF_G;
  bf16_t* Pb = (bf16_t*)Pr; float* R = (float*)Pr;
  bf16_t* QA = (bf16_t*)(Pr + P_QA); bf16_t* KA = (bf16_t*)(Pr + P_KA); bf16_t* VA = (bf16_t*)(Pr + P_VA); bf16_t* X0 = (bf16_t*)(Pr + P_X0);
  float* GT = (float*)(Pr + P_GT); bf16_t* A2 = (bf16_t*)(Pr + P_A2);
  bf16_t* A = (bf16_t*)Gr; bf16_t* Gb = (bf16_t*)Gr; float* VV = (float*)(Gr + G_VV);
  bf16_t* HF = (bf16_t*)Gr; bf16_t* HB = (bf16_t*)(Gr + G_HB);
  float* X = p.out;
  float* F256 = p.out + O_C + 512; float* F2048 = p.out + O_C + 512 * 512 + 512;
  const float* mod0 = modv; const float* mod1 = modv + 3 * 6144;
  unsigned bk = 0;
#define PH(i, ...) if (ph_lo <= (i) && (i) < ph_hi) { const int zq = opq(); __VA_ARGS__; if ((i) + 1 < ph_hi) gsync(wv, bar, ++bk); }
  PH(0, {
    conv_w(wv, p.in[zq + 19], Wt_in0, 1024, 2560, 2560);
    conv_w(wv, p.in[zq + 20], Wt_out0, 1024, 1024, 1024);
    conv_w(wv, p.in[zq + 15], Wt_up0, 1024, 5632, 5632);
    conv_w(wv, p.in[zq + 15] + (long)1024 * 5632, Wt_up1, 1024, 5632, 5632);
    conv_w(wv, p.in[zq + 18], Wt_dn0, 2816, 1024, 1024);
    conv_w(wv, p.in[zq + 18] + (long)2816 * 1024, Wt_dn1, 2816, 1024, 1024);
    conv_w(wv, p.in[zq + 33], Wt_in1, 1024, 4128, 4352);
    conv_w(wv, p.in[zq + 38], Wt_out1, 1024, 1024, 1024);
    mod_phase(wv, p, zq, modv);
    filt_phase(wv, p, zq, F256, F2048);
  })
  PH(1, (row_phase<true, false, true>(wv, p, zq, nullptr, nullptr, mod0, 0, nullptr, p.in[zq + 11], mod0, 0, A)))
  PH(2, (gemm_phase<0, 2560>(wv, A, Wt_in0, 2560, 1024, Pb, nullptr)))
  PH(3, post_inproj0(wv, p, zq, Pb, QA, KA, VA, VV, X0))
  PH(4, mix0_phase(wv, p, zq, QA, KA, VA, VV, X0, F256, F2048, A))
  PH(5, (gemm_phase<1, 1024>(wv, A, Wt_out0, 1024, 1024, R, nullptr)))
  PH(6, (row_phase<true, true, true>(wv, p, zq, R, p.in[zq + 12], mod0, 2, X, p.in[zq + 13], mod0, 3, A)))
  PH(7, (gemm_phase<0, 5632>(wv, A, Wt_up0, 5632, 1024, Pb, nullptr)))
  PH(8, ffn_act_phase(wv, Pb, p.in[zq + 16], p.in[zq + 17], Gb))
  PH(9, (gemm_phase<1, 1024>(wv, Gb, Wt_dn0, 1024, 2816, R, nullptr)))
  PH(10, (row_phase<false, true, true>(wv, p, zq, R, p.in[zq + 14], mod0, 5, X, p.in[zq + 11] + 1024, mod1, 0, A)))
  PH(11, (gemm_phase<2, 4096>(wv, A, Wt_in1, 4352, 1024, Pb, GT)))
  PH(13, mlstm_phase(wv, p, zq, Pb, GT, HF, HB))
  PH(14, mlstm_post(wv, p, zq, HF, HB, Pb, A2))
  PH(15, (gemm_phase<1, 1024>(wv, A2, Wt_out1, 1024, 1024, R, nullptr)))
  PH(16, (row_phase<false, true, true>(wv, p, zq, R, p.in[zq + 12] + 1024, mod1, 2, X, p.in[zq + 13] + 1024, mod1, 3, A)))
  PH(17, (gemm_phase<0, 5632>(wv, A, Wt_up1, 5632, 1024, Pb, nullptr)))
  PH(18, ffn_act_phase(wv, Pb, p.in[zq + 16] + 3 * 5632, p.in[zq + 17] + 5632, Gb))
  PH(19, (gemm_phase<1, 1024>(wv, Gb, Wt_dn1, 1024, 2816, R, nullptr)))
  PH(20, (row_phase<false, true, false>(wv, p, zq, R, p.in[zq + 14] + 1024, mod1, 5, X, nullptr, mod1, 0, nullptr)))
#undef PH
}

extern "C" void kernel_launch(void* const* d_in, const int* in_sizes, int n_in, void* d_out, int out_size, void* d_ws, size_t ws_size,
                              hipStream_t stream) {
  static int grid_blocks = 0;
  if (!grid_blocks) {
    if (ws_size < WS_END + 4096) fprintf(stderr, "kernel_launch: workspace too small: %zu < %zu\n", ws_size, (size_t)WS_END);
    hipFuncSetAttribute((const void*)mega, hipFuncAttributeMaxDynamicSharedMemorySize, LDS_BYTES);
    int dev = 0, cus = 0, per = 0;
    hipGetDevice(&dev);
    hipDeviceGetAttribute(&cus, hipDeviceAttributeMultiprocessorCount, dev);
    hipOccupancyMaxActiveBlocksPerMultiprocessor(&per, mega, 512, LDS_BYTES);
    if (per < 1) { fprintf(stderr, "kernel_launch: occupancy query returned %d\n", per); per = 1; }
    grid_blocks = cus;
  }
  Params p{};
  for (int i = 0; i < 39; ++i) p.in[i] = (const float*)d_in[i];
  p.out = (float*)d_out; p.ws = (char*)d_ws;
  int lo = 0, hi = NPH;
  (void)hipMemsetAsync((char*)d_ws + WS_END, 0, 4096, stream);
  void* args[] = {&p, &lo, &hi};
  hipError_t e = hipLaunchCooperativeKernel((void*)mega, dim3(grid_blocks), dim3(512), args, LDS_BYTES, stream);
  if (e != hipSuccess) fprintf(stderr, "cooperative launch failed: %s (grid %d)\n", hipGetErrorString(e), grid_blocks);
}
```

```cpp
#include <hip/hip_runtime.h>
#include <hip/hip_cooperative_groups.h>
#include <cstdio>
#include <cstdint>
namespace cg = cooperative_groups;

typedef unsigned short bf16_t;
typedef short bf16x8 __attribute__((ext_vector_type(8)));
typedef short s16x4 __attribute__((ext_vector_type(4)));
typedef float f32x4 __attribute__((ext_vector_type(4)));
typedef float f32x8 __attribute__((ext_vector_type(8)));
typedef float f32x16 __attribute__((ext_vector_type(16)));
typedef unsigned u32x4 __attribute__((ext_vector_type(4)));
typedef unsigned u32x2 __attribute__((ext_vector_type(2)));

constexpr int T_TOK = 12288, TPR = 8192;
constexpr int LDS_BYTES = 131072;
constexpr int NPH = 21;

constexpr size_t OFF_WIN0 = 0, OFF_WOUT0 = 5242880, OFF_WUP0 = 7340032, OFF_WUP1 = 18874368, OFF_WDN0 = 30408704,
                 OFF_WDN1 = 36175872, OFF_WIN1 = 41943040, OFF_WOUT1 = 50855936, OFF_MOD = 52953088, OFF_P = 53100544,
                 OFF_G = 191512576, WS_END = 260718592;
constexpr size_t P_QA = 62914560, P_KA = 75497472, P_VA = 82313216, P_X0 = 89128960;
constexpr size_t P_GT = 100663296, P_A2 = 102236160;
constexpr size_t G_VV = 25165824, G_HB = 25165824;
constexpr size_t O_K = 12582912, O_V = 14680064, O_C = 16777216, O_N = 25165824, O_M = 25231360;

struct Params { const float* in[39]; float* out; char* ws; };

typedef __bf16 nbf16x2 __attribute__((ext_vector_type(2)));
typedef float nf32x2 __attribute__((ext_vector_type(2)));
__device__ __forceinline__ unsigned cvtpk(float lo, float hi) {
  nf32x2 v = {lo, hi};
  nbf16x2 b = __builtin_convertvector(v, nbf16x2);
  return __builtin_bit_cast(unsigned, b);
}
__device__ __forceinline__ bf16_t f2bf(float f) { return (bf16_t)(cvtpk(f, 0.f) & 0xffffu); }
__device__ __forceinline__ float bf2f(bf16_t h) { return __uint_as_float(((unsigned)h) << 16); }
__device__ __forceinline__ float bflo(unsigned w) { return __uint_as_float(w << 16); }
__device__ __forceinline__ float bfhi(unsigned w) { return __uint_as_float(w & 0xffff0000u); }
__device__ __forceinline__ float wave_sum(float v) {
#pragma unroll
  for (int o = 32; o > 0; o >>= 1) v += __shfl_xor(v, o);
  return v;
}
__device__ __forceinline__ int llane() { int l; asm volatile("v_mbcnt_lo_u32_b32 %0, -1, 0\n\tv_mbcnt_hi_u32_b32 %0, -1, %0" : "=v"(l)); return l; }
__device__ __forceinline__ int ltid(int wv) { return (wv << 6) | llane(); }
__device__ __forceinline__ int opq() { int z; asm volatile("s_mov_b32 %0, 0" : "=s"(z)); return z; }
__device__ __forceinline__ float silu_f(float x) { return x * __builtin_amdgcn_rcpf(1.f + __expf(-x)); }
__device__ __forceinline__ int crow(int r, int hi) { return (r & 3) + 8 * (r >> 2) + 4 * hi; }
__device__ __forceinline__ void unpack8(u32x4 w, float* f) {
  f[0] = bflo(w[0]); f[1] = bfhi(w[0]); f[2] = bflo(w[1]); f[3] = bfhi(w[1]);
  f[4] = bflo(w[2]); f[5] = bfhi(w[2]); f[6] = bflo(w[3]); f[7] = bfhi(w[3]);
}
__device__ __forceinline__ u32x4 pack8(const float* f) {
  u32x4 w = {cvtpk(f[0], f[1]), cvtpk(f[2], f[3]), cvtpk(f[4], f[5]), cvtpk(f[6], f[7])}; return w;
}

__device__ __forceinline__ void conv_w(const int wv, const float* __restrict__ W, bf16_t* __restrict__ Wt, int K, int N, int NP) {
  const int tidx = ltid(wv);
  extern __shared__ __attribute__((aligned(16))) char shm_raw[];
  float* tl = (float*)shm_raw;
  const int tid = tidx;
  const int ntn = NP / 64, ntiles = (K / 64) * ntn;
  for (int tile = blockIdx.x; tile < ntiles; tile += gridDim.x) {
    const int k0 = (tile / ntn) * 64, n0 = (tile % ntn) * 64;
    __syncthreads();
#pragma unroll
    for (int i = 0; i < 2; ++i) {
      int kr = (tid >> 4) + 32 * i, nc = (tid & 15) * 4;
      float4 v = make_float4(0.f, 0.f, 0.f, 0.f);
      if (n0 + nc < N) v = *(const float4*)(W + (long)(k0 + kr) * N + n0 + nc);
      float* d = tl + kr * 65 + nc; d[0] = v.x; d[1] = v.y; d[2] = v.z; d[3] = v.w;
    }
    __syncthreads();
    {
      int n = tid >> 3, kg = (tid & 7) * 8;
      u32x4 w;
      w[0] = cvtpk(tl[(kg + 0) * 65 + n], tl[(kg + 1) * 65 + n]);
      w[1] = cvtpk(tl[(kg + 2) * 65 + n], tl[(kg + 3) * 65 + n]);
      w[2] = cvtpk(tl[(kg + 4) * 65 + n], tl[(kg + 5) * 65 + n]);
      w[3] = cvtpk(tl[(kg + 6) * 65 + n], tl[(kg + 7) * 65 + n]);
      *(u32x4*)(Wt + (long)(n0 + n) * K + k0 + kg) = w;
    }
  }
  __syncthreads();
}

__device__ __forceinline__ void mod_phase(const int wv, const Params& p, const int zq, float* modv) {
  const int tidx = ltid(wv);
  extern __shared__ __attribute__((aligned(16))) char shm_raw[];
  float* red = (float*)shm_raw;
  const int tid = tidx;
  const float* cvec = p.in[zq + 7]; const float* cctx = p.in[zq + 8]; const float* bmod = p.in[zq + 10];
  for (int item = blockIdx.x; item < 192; item += gridDim.x) {
    const int l = item / 96, cb = (item % 96) * 64;
    const float* W = p.in[zq + 9] + (long)l * 1024 * 6144;
    const int cl = tid & 15, kg = tid >> 4;
    float a0[4] = {0, 0, 0, 0}, a1[4] = {0, 0, 0, 0}, a2[4] = {0, 0, 0, 0};
#pragma unroll 8
    for (int i = 0; i < 32; ++i) {
      int k = kg + 32 * i;
      float4 w = *(const float4*)(W + (long)k * 6144 + cb + cl * 4);
      float s0 = silu_f(cctx[k]), s1 = silu_f(cvec[k]), s2 = silu_f(cvec[1024 + k]);
      a0[0] += s0 * w.x; a0[1] += s0 * w.y; a0[2] += s0 * w.z; a0[3] += s0 * w.w;
      a1[0] += s1 * w.x; a1[1] += s1 * w.y; a1[2] += s1 * w.z; a1[3] += s1 * w.w;
      a2[0] += s2 * w.x; a2[1] += s2 * w.y; a2[2] += s2 * w.z; a2[3] += s2 * w.w;
    }
    __syncthreads();
#pragma unroll
    for (int j = 0; j < 4; ++j) {
      red[kg * 192 + 0 * 64 + cl * 4 + j] = a0[j];
      red[kg * 192 + 1 * 64 + cl * 4 + j] = a1[j];
      red[kg * 192 + 2 * 64 + cl * 4 + j] = a2[j];
    }
    __syncthreads();
    if (tid < 192) {
      float s = 0.f;
#pragma unroll 8
      for (int q = 0; q < 32; ++q) s += red[q * 192 + tid];
      int g = tid / 64, col = cb + (tid % 64);
      modv[(l * 3 + g) * 6144 + col] = s + bmod[l * 6144 + col];
    }
  }
  __syncthreads();
}

__device__ __forceinline__ void filt_phase(const int wv, const Params& p, const int zq, float* F256, float* F2048) {
  const int tidx = ltid(wv);
  extern __shared__ __attribute__((aligned(16))) char shm_raw[];
  float* z = (float*)shm_raw;
  float* h1 = z + 256;
  float* h2 = h1 + 512;
  const int tid = tidx;
  const float *w1 = p.in[zq + 25], *b1 = p.in[zq + 26], *w2 = p.in[zq + 27], *b2 = p.in[zq + 28], *w3 = p.in[zq + 29], *b3 = p.in[zq + 30], *sf = p.in[zq + 31], *skip = p.in[zq + 32];
  const float DMAX = -15.350567286626973f, DMIN = -3.0701134573253946f;
  for (int item = blockIdx.x; item < 288; item += gridDim.x) {
    const int L = item < 32 ? 256 : 2048; const int i0 = item < 32 ? item * 8 : (item - 32) * 8;
    float* F = item < 32 ? F256 : F2048;
    __syncthreads();
    if (tid < 136) {
      const int q = tid / 17, f = tid % 17;
      const float t = (float)(i0 + q) / (float)(L - 1);
      float v;
      if (f == 0) v = t;
      else if (f <= 8) v = cosf(6.283185307179586f * t * (float)f);
      else v = sinf(6.283185307179586f * t * (float)(f - 8));
      z[q * 32 + f] = v;
    }
    __syncthreads();
    { const int q = tid >> 6, u = tid & 63; float a = b1[u];
#pragma unroll 1
      for (int jj = 0; jj < 17; ++jj) a += z[q * 32 + jj] * w1[jj * 64 + u];
      h1[q * 64 + u] = sinf(sf[u] * a); }
    __syncthreads();
    { const int q = tid >> 6, u = tid & 63; float a = b2[u];
#pragma unroll 8
      for (int jj = 0; jj < 64; ++jj) a += h1[q * 64 + jj] * w2[jj * 64 + u];
      h2[q * 64 + u] = sinf(sf[64 + u] * a); }
    __syncthreads();
    {
      const int ch = tid;
      float af[8], ab[8];
#pragma unroll
      for (int q = 0; q < 8; ++q) { af[q] = b3[ch]; ab[q] = b3[512 + ch]; }
#pragma unroll 4
      for (int jj = 0; jj < 64; ++jj) {
        const float wa = w3[jj * 1024 + ch], wb = w3[jj * 1024 + 512 + ch];
#pragma unroll
        for (int q = 0; q < 8; ++q) { const float hh = h2[q * 64 + jj]; af[q] += hh * wa; ab[q] += hh * wb; }
      }
      const float delta = fabsf(DMIN + (DMAX - DMIN) * ((float)ch / 511.f));
#pragma unroll
      for (int q = 0; q < 8; ++q) {
        const int i = i0 + q;
        const float t = (float)i / (float)(L - 1);
        const float win = expf(-t * delta);
        const float sfw = af[q] * win, sbw = ab[q] * win;
        if (i == 0) F[(long)(L - 1) * 512 + ch] = sfw + sbw + skip[ch];
        else { F[(long)(L - 1 + i) * 512 + ch] = sfw; F[(long)(L - 1 - i) * 512 + ch] = sbw; }
      }
    }
  }
  __syncthreads();
}

template <bool FROM_IN, bool HAS_R, bool HAS_A>
__device__ __forceinline__ void row_phase(const int wv, const Params& p, const int zq, const float* __restrict__ R, const float* __restrict__ postg,
                                          const float* __restrict__ modg, int gate_m, float* X,
                                          const float* __restrict__ preg, const float* __restrict__ mods, int shift_m, bf16_t* __restrict__ A) {
  const int tidx = ltid(wv);
  const int wid = wv, lane = tidx & 63;
  for (int row = blockIdx.x * 8 + wid; row < T_TOK; row += gridDim.x * 8) {
    const int g = row < TPR ? 0 : 1 + (row - TPR) / 2048;
    const float* mg = modg + g * 6144;
    const float* ms = mods + g * 6144;
    const float* xin = FROM_IN ? (row < TPR ? p.in[zq + 0] + (long)row * 1024 : p.in[zq + 1] + (long)(row - TPR) * 1024) : (const float*)X + (long)row * 1024;
    float4 x[4];
#pragma unroll
    for (int j = 0; j < 4; ++j) x[j] = *(const float4*)(xin + j * 256 + lane * 4);
    if (HAS_R) {
      float4 r[4]; float ss = 0.f;
#pragma unroll
      for (int j = 0; j < 4; ++j) { r[j] = *(const float4*)(R + (long)row * 1024 + j * 256 + lane * 4); ss += r[j].x * r[j].x + r[j].y * r[j].y + r[j].z * r[j].z + r[j].w * r[j].w; }
      ss = wave_sum(ss); const float rs = rsqrtf(ss * (1.f / 1024.f) + 1e-6f);
#pragma unroll
      for (int j = 0; j < 4; ++j) {
        float4 pg = *(const float4*)(postg + j * 256 + lane * 4);
        float4 gt = *(const float4*)(mg + gate_m * 1024 + j * 256 + lane * 4);
        x[j].x += gt.x * (r[j].x * rs * pg.x); x[j].y += gt.y * (r[j].y * rs * pg.y);
        x[j].z += gt.z * (r[j].z * rs * pg.z); x[j].w += gt.w * (r[j].w * rs * pg.w);
        *(float4*)(X + (long)row * 1024 + j * 256 + lane * 4) = x[j];
      }
    }
    if (HAS_A) {
      float ss = 0.f;
#pragma unroll
      for (int j = 0; j < 4; ++j) ss += x[j].x * x[j].x + x[j].y * x[j].y + x[j].z * x[j].z + x[j].w * x[j].w;
      ss = wave_sum(ss); const float rs = rsqrtf(ss * (1.f / 1024.f) + 1e-6f);
#pragma unroll
      for (int j = 0; j < 4; ++j) {
        float4 pg = *(const float4*)(preg + j * 256 + lane * 4);
        float4 sh = *(const float4*)(ms + shift_m * 1024 + j * 256 + lane * 4);
        float4 sc = *(const float4*)(ms + (shift_m + 1) * 1024 + j * 256 + lane * 4);
        float y0 = x[j].x * rs * pg.x * (1.f + sc.x) + sh.x, y1 = x[j].y * rs * pg.y * (1.f + sc.y) + sh.y;
        float y2 = x[j].z * rs * pg.z * (1.f + sc.z) + sh.z, y3 = x[j].w * rs * pg.w * (1.f + sc.w) + sh.w;
        u32x2 w = {cvtpk(y0, y1), cvtpk(y2, y3)};
        *(u32x2*)(A + (long)row * 1024 + j * 256 + lane * 4) = w;
      }
    }
  }
}

constexpr int BM = 256, BK = 64, HALF = 128, WGM = 8, HT = HALF * BK;
__device__ __forceinline__ int lds_byte(int r, int c) {
  int st = (r >> 4) * 2 + (c >> 5), rr = r & 15, cc = c & 31, ob = rr * 64 + cc * 2;
  return st * 1024 + (ob ^ (((ob >> 9) & 1) << 5));
}
__device__ __forceinline__ void stage_rc(int b, int& R, int& C) {
  int st = b / 1024, sb = b % 1024, swz = sb ^ (((sb >> 9) & 1) << 5);
  R = (st >> 1) * 16 + swz / 64; C = (st & 1) * 32 + (swz % 64) / 2;
}

template <int MODE, int LDC>
__device__ __forceinline__ void gemm_phase(const int wv, const bf16_t* __restrict__ A, const bf16_t* __restrict__ Bt, int N, int K,
                                           void* Cout, float* GT) {
  const int tidx = ltid(wv);
  extern __shared__ __attribute__((aligned(16))) char shm_raw[];
  bf16_t* shm = (bf16_t*)shm_raw;
#define SA(b, h) (shm + ((b) * 2 + (h)) * HT)
#define SB(b, h) (shm + (4 + (b) * 2 + (h)) * HT)
#define STAGE(P, BASE, br, kt) do { const bf16_t* _gb = (BASE) + ((long)(br) * K + (long)(kt) * BK); \
    __builtin_amdgcn_global_load_lds((const unsigned*)(_gb + soff0), (unsigned*)((char*)(P) + sl0), 16, 0, 0); \
    __builtin_amdgcn_global_load_lds((const unsigned*)(_gb + soff1), (unsigned*)((char*)(P) + sl0 + 8192), 16, 0, 0); } while (0)
#define LDA(dst, b, h) _Pragma("unroll") for (int m = 0; m < 4; ++m) _Pragma("unroll") for (int k = 0; k < 2; ++k) \
    dst[m][k] = *reinterpret_cast<const bf16x8*>((char*)SA(b, h) + lds_byte(wr * 64 + m * 16 + fr, k * 32 + fq * 8))
#define LDB(dst, b, h) _Pragma("unroll") for (int n = 0; n < 2; ++n) _Pragma("unroll") for (int k = 0; k < 2; ++k) \
    dst[n][k] = *reinterpret_cast<const bf16x8*>((char*)SB(b, h) + lds_byte(wc * 32 + n * 16 + fr, k * 32 + fq * 8))
#define MMA(ai, bj, At, Bt_) do { __builtin_amdgcn_s_setprio(1); \
    _Pragma("unroll") for (int m = 0; m < 4; ++m) _Pragma("unroll") for (int n = 0; n < 2; ++n) _Pragma("unroll") for (int k = 0; k < 2; ++k) \
      acc[ai][bj][m][n] = __builtin_amdgcn_mfma_f32_16x16x32_bf16(At[m][k], Bt_[n][k], acc[ai][bj][m][n], 0, 0, 0); \
    __builtin_amdgcn_s_setprio(0); } while (0)
#define WAIT_V(n) asm volatile("s_waitcnt vmcnt(" #n ")" ::: "memory")
#define WAIT_L(n) asm volatile("s_waitcnt lgkmcnt(" #n ")" ::: "memory")
#define BAR __builtin_amdgcn_s_barrier()
#define SCHED __builtin_amdgcn_sched_barrier(0)
  const int nM = T_TOK / BM, nN = N / BM, nwg = nM * nN;
  const int wid = wv, lane = tidx & 63, wr = wid >> 2, wc = wid & 3, fr = lane & 15, fq = lane >> 4;
  const int nt = K / BK;
  unsigned soff0, soff1; const int sl0 = tidx * 16;
  { int _r, _c; stage_rc(sl0, _r, _c); soff0 = (unsigned)(_r * K + _c); stage_rc(sl0 + 8192, _r, _c); soff1 = (unsigned)(_r * K + _c); }
  for (int tile = blockIdx.x; tile < nwg; tile += gridDim.x) {
    int wgt = tile;
    { const int q = nwg / 8, r = nwg % 8, xcd = wgt % 8, off = wgt / 8;
      wgt = (xcd < r ? xcd * (q + 1) : r * (q + 1) + (xcd - r) * q) + off; }
    const int nig = WGM * nN, gid = wgt / nig, fm = gid * WGM, gsz = min(nM - fm, WGM);
    const int pm = fm + ((wgt % nig) % gsz), pn = (wgt % nig) / gsz, brow = pm * BM, bcol = pn * BM;
    f32x4 acc[2][2][4][2] = {};
    bf16x8 At[4][2], B0[2][2], B1[2][2];
    STAGE(SB(0, 0), Bt, bcol, 0); STAGE(SA(0, 0), A, brow, 0);
    STAGE(SB(0, 1), Bt, bcol + HALF, 0); STAGE(SA(0, 1), A, brow + HALF, 0);
    if (wr == 1) BAR;
    WAIT_V(4); BAR;
    STAGE(SB(1, 0), Bt, bcol, 1); STAGE(SA(1, 0), A, brow, 1); STAGE(SB(1, 1), Bt, bcol + HALF, 1);
    WAIT_V(6); BAR;
    for (int t = 0; t < nt - 2; t += 2) {
      LDB(B0, 0, 0); SCHED; LDA(At, 0, 0); STAGE(SA(1, 1), A, brow + HALF, t + 1);
      WAIT_L(8); BAR; WAIT_L(0); MMA(0, 0, At, B0); BAR; SCHED;
      LDB(B1, 0, 1); STAGE(SB(0, 0), Bt, bcol, t + 2);
      BAR; WAIT_L(0); MMA(0, 1, At, B1); BAR;
      LDA(At, 0, 1); STAGE(SA(0, 0), A, brow, t + 2);
      BAR; WAIT_L(0); MMA(1, 0, At, B0); BAR; SCHED;
      STAGE(SB(0, 1), Bt, bcol + HALF, t + 2);
      WAIT_V(6); BAR; MMA(1, 1, At, B1); BAR;
      LDB(B0, 1, 0); SCHED; LDA(At, 1, 0); STAGE(SA(0, 1), A, brow + HALF, t + 2);
      WAIT_L(8); BAR; WAIT_L(0); MMA(0, 0, At, B0); BAR; SCHED;
      LDB(B1, 1, 1); STAGE(SB(1, 0), Bt, bcol, t + 3);
      BAR; WAIT_L(0); MMA(0, 1, At, B1); BAR;
      LDA(At, 1, 1); STAGE(SA(1, 0), A, brow, t + 3);
      BAR; WAIT_L(0); MMA(1, 0, At, B0); BAR; SCHED;
      STAGE(SB(1, 1), Bt, bcol + HALF, t + 3);
      WAIT_V(6); BAR; MMA(1, 1, At, B1); BAR;
    }
    { LDB(B0, 0, 0); LDA(At, 0, 0); STAGE(SA(1, 1), A, brow + HALF, nt - 1);
      BAR; WAIT_L(0); MMA(0, 0, At, B0); BAR;
      LDB(B1, 0, 1); BAR; WAIT_L(0); MMA(0, 1, At, B1); BAR;
      LDA(At, 0, 1); WAIT_V(4); BAR; WAIT_L(0); MMA(1, 0, At, B0); MMA(1, 1, At, B1); BAR; }
    { LDB(B0, 1, 0); LDA(At, 1, 0); WAIT_V(2); BAR; WAIT_L(0); MMA(0, 0, At, B0); BAR;
      LDB(B1, 1, 1); WAIT_V(0); BAR; WAIT_L(0); MMA(0, 1, At, B1); BAR;
      LDA(At, 1, 1); BAR; WAIT_L(0); MMA(1, 0, At, B0); MMA(1, 1, At, B1); BAR; }
    if (wr == 0) BAR;
    {
      const int le = llane();
      const int fr = le & 15, fq = le >> 4;
      const long base = (long)(brow + wr * 64) * LDC + bcol + wc * 32 + (unsigned)(fq * 4 * LDC + fr);
      if (MODE == 0 || (MODE == 2 && pn < 16)) {
        bf16_t* cp = (bf16_t*)Cout + base;
#pragma unroll
        for (int ai = 0; ai < 2; ++ai)
#pragma unroll
          for (int m = 0; m < 4; ++m)
#pragma unroll
            for (int j = 0; j < 4; ++j) {
              bf16_t* rp = cp + (ai * HALF + m * 16 + j) * LDC;
#pragma unroll
              for (int bj = 0; bj < 2; ++bj)
#pragma unroll
                for (int n = 0; n < 2; ++n) rp[bj * HALF + n * 16] = f2bf(acc[ai][bj][m][n][j]);
            }
      } else if (MODE == 1) {
        float* cp = (float*)Cout + base;
#pragma unroll
        for (int ai = 0; ai < 2; ++ai)
#pragma unroll
          for (int m = 0; m < 4; ++m)
#pragma unroll
            for (int j = 0; j < 4; ++j) {
              float* rp = cp + (ai * HALF + m * 16 + j) * LDC;
#pragma unroll
              for (int bj = 0; bj < 2; ++bj)
#pragma unroll
                for (int n = 0; n < 2; ++n) rp[bj * HALF + n * 16] = acc[ai][bj][m][n][j];
            }
      } else {
        if (wc == 0) {
          float* gp = GT + (long)(brow + wr * 64) * 32 + (unsigned)(fq * 4 * 32 + fr);
#pragma unroll
          for (int ai = 0; ai < 2; ++ai)
#pragma unroll
            for (int m = 0; m < 4; ++m)
#pragma unroll
              for (int j = 0; j < 4; ++j)
#pragma unroll
                for (int n = 0; n < 2; ++n) gp[(ai * HALF + m * 16 + j) * 32 + n * 16] = acc[ai][0][m][n][j];
        }
      }
    }
    __syncthreads();
  }
#undef SA
#undef SB
#undef STAGE
#undef LDA
#undef LDB
#undef MMA
}

__device__ __forceinline__ void post_inproj0(const int wv, const Params& p, const int zq, const bf16_t* __restrict__ P0, bf16_t* __restrict__ QA, bf16_t* __restrict__ KA,
                                             bf16_t* __restrict__ VA, float* __restrict__ VV, bf16_t* __restrict__ X0) {
  const int tidx = ltid(wv);
  const int wid = wv, lane = tidx & 63;
  const float* qn = p.in[zq + 21]; const float* kn = p.in[zq + 22]; const float* cw = p.in[zq + 23]; const float* cb = p.in[zq + 24];
  float* outK = p.out + O_K; float* outV = p.out + O_V;
  for (int i = blockIdx.x * 512 + tidx; i < 2 * 512 * 256 / 4; i += gridDim.x * 512) {
    int e = i * 4; int b = e / (512 * 256), rem = e % (512 * 256);
    float4 kk = *(const float4*)(p.in[zq + 2] + e); float4 vv = *(const float4*)(p.in[zq + 3] + e);
    long d = (long)(8192 + b * 2560 + 2048) * 256 + rem;
    u32x2 wk = {cvtpk(kk.x, kk.y), cvtpk(kk.z, kk.w)}; u32x2 wv = {cvtpk(vv.x, vv.y), cvtpk(vv.z, vv.w)};
    *(u32x2*)(KA + d) = wk; *(u32x2*)(VA + d) = wv;
  }
  const int fi = lane & 31;
  const float inv = exp2f(-(float)fi * (13.287712379549449f / 32.f));
  for (int row = blockIdx.x * 8 + wid; row < T_TOK; row += gridDim.x * 8) {
    const bool samp = row >= TPR;
    const int L = samp ? 2048 : 256;
    const int tl = samp ? (row - TPR) % 2048 : row % 256;
    const long krow = samp ? (long)(8192 + ((row - TPR) / 2048) * 2560 + tl) : (long)row;
    const bf16_t* base = P0 + (long)row * 2560;
    float cs = 1.f, sn = 0.f;
    if (samp) { float pos = (lane < 32) ? (float)(tl / 64) : (float)(tl % 64); float ang = pos * inv; cs = cosf(ang); sn = sinf(ang); }
#pragma unroll
    for (int hh = 0; hh < 6; ++hh) {
      float x1 = bf2f(base[hh * 128 + lane]), x2 = bf2f(base[hh * 128 + 64 + lane]);
      float ss = wave_sum(x1 * x1 + x2 * x2);
      float rs = rsqrtf(ss * (1.f / 128.f) + 1e-6f);
      const float* gw = hh < 4 ? qn : kn;
      float y1 = x1 * rs * gw[lane], y2 = x2 * rs * gw[64 + lane];
      if (hh >= 4 && !samp) { outK[(long)row * 256 + (hh - 4) * 128 + lane] = y1; outK[(long)row * 256 + (hh - 4) * 128 + 64 + lane] = y2; }
      float o1 = y1 * cs - y2 * sn, o2 = y1 * sn + y2 * cs;
      if (hh < 4) { QA[(long)row * 512 + hh * 128 + lane] = f2bf(o1); QA[(long)row * 512 + hh * 128 + 64 + lane] = f2bf(o2); }
      else { KA[krow * 256 + (hh - 4) * 128 + lane] = f2bf(o1); KA[krow * 256 + (hh - 4) * 128 + 64 + lane] = f2bf(o2); }
    }
    {
      u32x2 w = *(const u32x2*)(base + 768 + lane * 4);
      *(u32x2*)(VA + krow * 256 + lane * 4) = w;
      if (!samp) { float4 f = make_float4(bflo(w[0]), bfhi(w[0]), bflo(w[1]), bfhi(w[1])); *(float4*)(outV + (long)row * 256 + lane * 4) = f; }
    }
    {
      const int c8 = lane * 8;
      float uc[3][8];
#pragma unroll
      for (int g = 0; g < 3; ++g) {
        const int col = g * 512 + c8;
        float um[8], u0[8], up[8];
        u32x4 z4 = {0u, 0u, 0u, 0u};
        u32x4 wm = (tl > 0) ? *(const u32x4*)(base - 2560 + 1024 + col) : z4;
        u32x4 w0 = *(const u32x4*)(base + 1024 + col);
        u32x4 wp = (tl < L - 1) ? *(const u32x4*)(base + 2560 + 1024 + col) : z4;
        unpack8(wm, um); unpack8(w0, u0); unpack8(wp, up);
#pragma unroll
        for (int e = 0; e < 8; ++e)
          uc[g][e] = cw[col + e] * um[e] + cw[1536 + col + e] * u0[e] + cw[3072 + col + e] * up[e] + cb[col + e];
      }
      float vvv[8];
#pragma unroll
      for (int e = 0; e < 8; ++e) vvv[e] = uc[2][e] * uc[1][e];
      *(float4*)(VV + (long)row * 512 + c8) = make_float4(vvv[0], vvv[1], vvv[2], vvv[3]);
      *(float4*)(VV + (long)row * 512 + c8 + 4) = make_float4(vvv[4], vvv[5], vvv[6], vvv[7]);
      *(u32x4*)(X0 + (long)row * 512 + c8) = pack8(uc[0]);
    }
  }
}

constexpr int AD = 128, ANW = 8, QBLK = 32, KVBLK = 64;
constexpr float ASCALE = 0.088388347648318440f;
constexpr float ATHR = 8.f;
constexpr int LDQ = 512, LDK = 256, LDO = 1024;
constexpr size_t SHM_V = KVBLK * AD * 2, SHM_K = KVBLK * AD * 2;
#define KSWZ(row, colB) ((row) * 256 + ((colB) ^ (((row) & 7) << 4)))
#define SBAR() __builtin_amdgcn_sched_barrier(0)

__device__ __forceinline__ void partialSM(f32x16& p0, f32x16& p1, float& m_reg, float& mn, float& alpha) {
  constexpr float C = ASCALE * 1.4426950408889634f;
  float pmax = p0[0];
#pragma unroll
  for (int r = 1; r < 16; ++r) pmax = fmaxf(pmax, p0[r]);
#pragma unroll
  for (int r = 0; r < 16; ++r) pmax = fmaxf(pmax, p1[r]);
  { auto rr = __builtin_amdgcn_permlane32_swap(__float_as_uint(pmax), __float_as_uint(pmax), false, false);
    pmax = fmaxf(__uint_as_float(rr[0]), __uint_as_float(rr[1])); }
  if (__builtin_expect(__all(pmax - m_reg <= ATHR / ASCALE), 1)) { mn = m_reg; alpha = 1.f; }
  else { mn = fmaxf(m_reg, pmax); alpha = __builtin_amdgcn_exp2f((m_reg - mn) * C); m_reg = mn; }
  float mnC = -mn * C;
#pragma unroll
  for (int r = 0; r < 16; ++r) p0[r] = fmaf(p0[r], C, mnC);
#pragma unroll
  for (int r = 0; r < 16; ++r) p1[r] = fmaf(p1[r], C, mnC);
#pragma unroll
  for (int r = 0; r < 16; ++r) p0[r] = __builtin_amdgcn_exp2f(p0[r]);
}
__device__ __forceinline__ void finishSM(f32x16& p0, f32x16& p1, float alpha, float& l_reg, bf16x8& pa0, bf16x8& pa1, bf16x8& pa2, bf16x8& pa3) {
#pragma unroll
  for (int r = 0; r < 16; ++r) p1[r] = __builtin_amdgcn_exp2f(p1[r]);
  float ps = 0;
#pragma unroll
  for (int r = 0; r < 16; ++r) ps += p0[r];
#pragma unroll
  for (int r = 0; r < 16; ++r) ps += p1[r];
  { auto rr = __builtin_amdgcn_permlane32_swap(__float_as_uint(ps), __float_as_uint(ps), false, false);
    ps = __uint_as_float(rr[0]) + __uint_as_float(rr[1]); }
  l_reg = l_reg * alpha + ps;
#define PK4(P, BASE, OUT) do { unsigned a0 = cvtpk(P[BASE + 0], P[BASE + 1]), a1 = cvtpk(P[BASE + 2], P[BASE + 3]);   \
    unsigned b0 = cvtpk(P[BASE + 4], P[BASE + 5]), b1 = cvtpk(P[BASE + 6], P[BASE + 7]);                              \
    auto r0 = __builtin_amdgcn_permlane32_swap(a0, b0, false, false); auto r1 = __builtin_amdgcn_permlane32_swap(a1, b1, false, false); \
    u32x4 w = {r0[0], r1[0], r0[1], r1[1]}; OUT = *reinterpret_cast<bf16x8*>(&w); } while (0)
  PK4(p0, 0, pa0); PK4(p0, 8, pa1); PK4(p1, 0, pa2); PK4(p1, 8, pa3);
#undef PK4
}
__device__ __forceinline__ void qkt(f32x16& p0, f32x16& p1, const bf16_t* Ks, const bf16x8* qr, int r32, int hi) {
  p0 = f32x16{}; p1 = f32x16{};
#pragma unroll
  for (int d0 = 0; d0 < 8; ++d0) { int cb = (d0 * 16 + hi * 8) * 2;
    bf16x8 b0 = *reinterpret_cast<const bf16x8*>((const char*)Ks + KSWZ(r32, cb));
    bf16x8 b1 = *reinterpret_cast<const bf16x8*>((const char*)Ks + KSWZ(32 + r32, cb));
    p0 = __builtin_amdgcn_mfma_f32_32x32x16_bf16(b0, qr[d0], p0, 0, 0, 0);
    p1 = __builtin_amdgcn_mfma_f32_32x32x16_bf16(b1, qr[d0], p1, 0, 0, 0); }
}
__device__ __forceinline__ int v_st(int k, int c) { const int kk = (k & ~0xC) | ((k & 4) << 1) | ((k & 8) >> 1); return ((kk >> 3) * 4 + (c >> 5)) * 512 + ((kk & 7) * 32 + (c & 31)) * 2; }
__device__ __forceinline__ int v_rd_base(int lane) { return ((lane & 3) << 3) | (((lane >> 2) & 3) << 6) | (((lane >> 4) & 1) << 5) | (((lane >> 5) & 1) << 8); }
constexpr int v_rd_off(int d0, int ks, int half) { return d0 * 512 + ks * 4096 + half * 2048; }
template <int OFF> __device__ __forceinline__ s16x4 tr_read(int vb) {
  s16x4 r; asm volatile("ds_read_b64_tr_b16 %0, %1 offset:%2" : "=&v"(r) : "v"(vb), "i"(OFF) : "memory"); return r;
}
template <int D0> __device__ __forceinline__ void pv_one(f32x16& od, int vb, bf16x8 pa0, bf16x8 pa1, bf16x8 pa2, bf16x8 pa3) {
  const s16x4 l0 = tr_read<v_rd_off(D0, 0, 0)>(vb), h0 = tr_read<v_rd_off(D0, 0, 1)>(vb), l1 = tr_read<v_rd_off(D0, 1, 0)>(vb), h1 = tr_read<v_rd_off(D0, 1, 1)>(vb);
  const s16x4 l2 = tr_read<v_rd_off(D0, 2, 0)>(vb), h2 = tr_read<v_rd_off(D0, 2, 1)>(vb), l3 = tr_read<v_rd_off(D0, 3, 0)>(vb), h3 = tr_read<v_rd_off(D0, 3, 1)>(vb);
  asm volatile("s_waitcnt lgkmcnt(0)" ::: "memory"); SBAR();
#define PK(L, H) (bf16x8){L[0], L[1], L[2], L[3], H[0], H[1], H[2], H[3]}
  od = __builtin_amdgcn_mfma_f32_32x32x16_bf16(pa0, PK(l0, h0), od, 0, 0, 0);
  od = __builtin_amdgcn_mfma_f32_32x32x16_bf16(pa1, PK(l1, h1), od, 0, 0, 0);
  od = __builtin_amdgcn_mfma_f32_32x32x16_bf16(pa2, PK(l2, h2), od, 0, 0, 0);
  od = __builtin_amdgcn_mfma_f32_32x32x16_bf16(pa3, PK(l3, h3), od, 0, 0, 0);
#undef PK
}
__device__ __forceinline__ void pv_d0(f32x16* o, int vb, bf16x8 pa0, bf16x8 pa1, bf16x8 pa2, bf16x8 pa3) {
  pv_one<0>(o[0], vb, pa0, pa1, pa2, pa3); pv_one<1>(o[1], vb, pa0, pa1, pa2, pa3); pv_one<2>(o[2], vb, pa0, pa1, pa2, pa3); pv_one<3>(o[3], vb, pa0, pa1, pa2, pa3);
}

__device__ __forceinline__ void attn_dense_body(const int wv, const bf16_t* __restrict__ Qb, const bf16_t* __restrict__ Kh, const bf16_t* __restrict__ Vh,
                                                bf16_t* __restrict__ Ob, int seq, char* lds) {
  const int tidx = ltid(wv);
  const int tid = tidx, wid = wv, lane = tid & 63, r32 = lane & 31, hi = lane >> 5;
  bf16_t* V_lds = (bf16_t*)lds; bf16_t* K_lds = (bf16_t*)(lds + 2 * SHM_V);
  float* ws = (float*)(lds + 2 * SHM_V + 2 * SHM_K) + wid * 64; float* li_l = ws; float* al_l = ws + 32;
  float m_reg = -1e30f, l_reg = 0; f32x16 o[4] = {}; bf16x8 qr[8];
  const bf16_t* Qw = Qb + (long)(wid * QBLK + r32) * LDQ + hi * 8;
#pragma unroll
  for (int d0 = 0; d0 < 8; ++d0) qr[d0] = *reinterpret_cast<const bf16x8*>(Qw + d0 * 16);
  const int sr = tid >> 4, sc = (tid & 15) * 8, vst0 = v_st(sr, sc), vst1 = v_st(32 + sr, sc);
  const int vb0 = (int)(uintptr_t)V_lds + v_rd_base(lane);
  bf16x8 sA_vs0, sA_vs1, sA_ks0, sA_ks1, sB_vs0, sB_vs1, sB_ks0, sB_ks1;
#define SLOADA(k0) do { sA_vs0 = *(const bf16x8*)(&Vh[(long)((k0) + sr) * LDK + sc]); sA_vs1 = *(const bf16x8*)(&Vh[(long)((k0) + 32 + sr) * LDK + sc]); \
    sA_ks0 = *(const bf16x8*)(&Kh[(long)((k0) + sr) * LDK + sc]); sA_ks1 = *(const bf16x8*)(&Kh[(long)((k0) + 32 + sr) * LDK + sc]); } while (0)
#define SLOADB(k0) do { sB_vs0 = *(const bf16x8*)(&Vh[(long)((k0) + sr) * LDK + sc]); sB_vs1 = *(const bf16x8*)(&Vh[(long)((k0) + 32 + sr) * LDK + sc]); \
    sB_ks0 = *(const bf16x8*)(&Kh[(long)((k0) + sr) * LDK + sc]); sB_ks1 = *(const bf16x8*)(&Kh[(long)((k0) + 32 + sr) * LDK + sc]); } while (0)
#define SWRITEA(b) do { *(bf16x8*)((char*)V_lds + (b) * SHM_V + vst0) = sA_vs0; *(bf16x8*)((char*)V_lds + (b) * SHM_V + vst1) = sA_vs1; int kc = sc * 2; \
    *(bf16x8*)((char*)K_lds + (b) * SHM_K + KSWZ(sr, kc)) = sA_ks0; *(bf16x8*)((char*)K_lds + (b) * SHM_K + KSWZ(32 + sr, kc)) = sA_ks1; } while (0)
#define SWRITEB(b) do { *(bf16x8*)((char*)V_lds + (b) * SHM_V + vst0) = sB_vs0; *(bf16x8*)((char*)V_lds + (b) * SHM_V + vst1) = sB_vs1; int kc = sc * 2; \
    *(bf16x8*)((char*)K_lds + (b) * SHM_K + KSWZ(sr, kc)) = sB_ks0; *(bf16x8*)((char*)K_lds + (b) * SHM_K + KSWZ(32 + sr, kc)) = sB_ks1; } while (0)
#define SWAIT() asm volatile("s_waitcnt vmcnt(4)" ::: "memory")
#define RESC(a) do { if (__any((a) < 1.f)) { if (hi == 0) al_l[r32] = (a); asm volatile("s_waitcnt lgkmcnt(0)" ::: "memory"); \
    _Pragma("unroll") for (int d = 0; d < 4; ++d) _Pragma("unroll") for (int r = 0; r < 16; ++r) o[d][r] *= al_l[crow(r, hi)]; } } while (0)
  f32x16 pA0, pA1, pB0, pB1; float mnA, mnB, alA, alB; bf16x8 pa0, pa1, pa2, pa3; const int NT = seq / KVBLK;
  SLOADA(0); asm volatile("s_waitcnt vmcnt(0)" ::: "memory"); SWRITEA(0); __syncthreads();
  qkt(pA0, pA1, K_lds, qr, r32, hi); partialSM(pA0, pA1, m_reg, mnA, alA);
  SLOADB(KVBLK); if (2 < NT) SLOADA(2 * KVBLK);
  SWAIT(); SWRITEB(1); __syncthreads();
  for (int j = 1; j + 1 < NT; j += 2) {
    SBAR(); qkt(pB0, pB1, (bf16_t*)((char*)K_lds + SHM_K), qr, r32, hi);
    finishSM(pA0, pA1, alA, l_reg, pa0, pa1, pa2, pa3); SBAR();
    SLOADB((j + 2) * KVBLK); SBAR();
    pv_d0(o, vb0, pa0, pa1, pa2, pa3); partialSM(pB0, pB1, m_reg, mnB, alB);
    __syncthreads(); SWAIT(); SWRITEA(0);
    RESC(alB); __syncthreads();
    SBAR(); qkt(pA0, pA1, K_lds, qr, r32, hi);
    finishSM(pB0, pB1, alB, l_reg, pa0, pa1, pa2, pa3); SBAR();
    if (j + 3 < NT) SLOADA((j + 3) * KVBLK); SBAR();
    pv_d0(o, vb0 + (int)SHM_V, pa0, pa1, pa2, pa3); partialSM(pA0, pA1, m_reg, mnA, alA);
    __syncthreads(); SWAIT(); SWRITEB(1);
    RESC(alA); __syncthreads();
  }
  SBAR(); qkt(pB0, pB1, (bf16_t*)((char*)K_lds + SHM_K), qr, r32, hi);
  finishSM(pA0, pA1, alA, l_reg, pa0, pa1, pa2, pa3); SBAR();
  pv_d0(o, vb0, pa0, pa1, pa2, pa3); partialSM(pB0, pB1, m_reg, mnB, alB);
  __syncthreads(); RESC(alB);
  finishSM(pB0, pB1, alB, l_reg, pa0, pa1, pa2, pa3); SBAR();
  pv_d0(o, vb0 + (int)SHM_V, pa0, pa1, pa2, pa3);
  if (hi == 0) li_l[r32] = l_reg; asm volatile("s_waitcnt lgkmcnt(0)" ::: "memory");
  float rli[16];
#pragma unroll
  for (int r = 0; r < 16; ++r) rli[r] = __builtin_amdgcn_rcpf(li_l[crow(r, hi)]);
  bf16_t* Ow = Ob + (long)(wid * QBLK) * LDO;
#pragma unroll
  for (int r = 0; r < 16; ++r) { int orow = crow(r, hi);
#pragma unroll
    for (int d0 = 0; d0 < 4; ++d0) Ow[(long)orow * LDO + d0 * 32 + r32] = f2bf(o[d0][r] * rli[r]); }
#undef SLOADA
#undef SLOADB
#undef SWRITEA
#undef SWRITEB
#undef SWAIT
#undef RESC
}

__device__ __forceinline__ void hyena_item(const float* __restrict__ F, const float* __restrict__ VV, const bf16_t* __restrict__ X0,
                                           bf16_t* __restrict__ AO, long rowbase, int L, int c, int t0) {
  float y[16], ring[16];
#pragma unroll
  for (int i = 0; i < 16; ++i) { y[i] = 0.f; ring[i] = F[(long)(t0 + i + L - 1) * 512 + c]; }
  const float* vp = VV + rowbase * 512 + c;
  const float* fp = F + (long)(t0 + L - 2) * 512 + c;
  for (int s0 = 0; s0 < L; s0 += 16) {
#pragma unroll
    for (int j = 0; j < 16; ++j) {
      const float vs = vp[(long)(s0 + j) * 512];
      const float nf = fp[-(long)(s0 + j) * 512];
#pragma unroll
      for (int i = 0; i < 16; ++i) y[i] += ring[(i - j) & 15] * vs;
      ring[(15 - j) & 15] = nf;
    }
  }
#pragma unroll
  for (int i = 0; i < 16; ++i) {
    long row = rowbase + t0 + i;
    AO[row * 1024 + 512 + c] = f2bf(y[i] * bf2f(X0[row * 512 + c]));
  }
}

__device__ __forceinline__ void mix0_phase(const int wv, const Params& p, const int zq, const bf16_t* QA, const bf16_t* KA, const bf16_t* VA, const float* VV,
                                           const bf16_t* X0, const float* F256, const float* F2048, bf16_t* AO) {
  extern __shared__ __attribute__((aligned(16))) char shm_raw[];
#ifndef NO_ATTN
  for (int it = blockIdx.x; it < 192; it += gridDim.x) {
    long rowb, krow; int h, seqk;
    if (it < 64) { const int qb = it % 8, b = it / 32; h = (it / 8) % 4; rowb = 8192 + (long)b * 2048 + qb * 256; krow = 8192 + (long)b * 2560; seqk = 2560; }
    else { const int j = it - 64; const int b = j / 4; h = j % 4; rowb = (long)b * 256; krow = rowb; seqk = 256; }
    __syncthreads();
    attn_dense_body(wv, QA + rowb * 512 + h * 128, KA + krow * 256 + (h >> 1) * 128, VA + krow * 256 + (h >> 1) * 128, AO + rowb * 1024 + h * 128, seqk, shm_raw);
  }
#endif
#ifndef NO_HYENA
  const int lane = llane(); const int wid = wv;
  {
    const int G = gridDim.x;
    for (int it = (blockIdx.x + G - 64) % G; it < 256; it += G) {
      const int b = it / 128, cgp = (it / 16) % 8, tg = it % 16;
      hyena_item(F2048, VV, X0, AO, 8192 + (long)b * 2048, 2048, cgp * 64 + lane, tg * 128 + wid * 16);
    }
    const int nl = G > 64 ? G - 64 : G, l0 = G > 64 ? (int)blockIdx.x - 64 : (int)blockIdx.x;
    if (l0 >= 0)
      for (int j = l0; j < 512; j += nl) {
        const int b = j / 16, cgp = (j / 2) % 8, tg = j % 2;
        hyena_item(F256, VV, X0, AO, (long)b * 256, 256, cgp * 64 + lane, tg * 128 + wid * 16);
      }
  }
#endif
  __syncthreads();
}

__device__ __forceinline__ float erf_as(float x) {
  const float ax = fabsf(x);
  const float t = __builtin_amdgcn_rcpf(fmaf(0.3275911f, ax, 1.f));
  float p = fmaf(1.061405429f, t, -1.453152027f);
  p = fmaf(p, t, 1.421413741f); p = fmaf(p, t, -0.284496736f); p = fmaf(p, t, 0.254829592f);
  const float r = 1.f - p * t * __expf(-ax * ax);
  return copysignf(r, x);
}
__device__ __forceinline__ float gelu_f(float x) { return 0.5f * x * (1.f + erf_as(x * 0.70710678118654752f)); }
__device__ __forceinline__ void ffn_act_phase(const int wv, const bf16_t* __restrict__ P, const float* __restrict__ cw, const float* __restrict__ cb, bf16_t* __restrict__ G) {
  const int tidx = ltid(wv);
  const int tid = tidx;
  if (tid >= 352) return;
  const int c8 = tid * 8;
  float w1[3][8], w2[3][8], b1[8], b2[8];
#pragma unroll
  for (int e = 0; e < 8; ++e) {
#pragma unroll
    for (int k = 0; k < 3; ++k) { w1[k][e] = cw[k * 5632 + c8 + e]; w2[k][e] = cw[k * 5632 + 2816 + c8 + e]; }
    b1[e] = cb[c8 + e]; b2[e] = cb[2816 + c8 + e];
  }
  for (int item = blockIdx.x; item < T_TOK / 16; item += gridDim.x) {
    const int r0 = item * 16;
    const int L = r0 < TPR ? 256 : 2048;
    const int tl0 = r0 < TPR ? r0 % 256 : (r0 - TPR) % 2048;
    float am[8], a0[8], ap[8], gm[8], g0[8], gp[8];
    const u32x4 z4 = {0u, 0u, 0u, 0u};
    {
      const bf16_t* b = P + (long)r0 * 5632 + c8;
      u32x4 x = (tl0 > 0) ? *(const u32x4*)(b - 5632) : z4; unpack8(x, am);
      x = (tl0 > 0) ? *(const u32x4*)(b - 5632 + 2816) : z4; unpack8(x, gm);
      x = *(const u32x4*)(b); unpack8(x, a0);
      x = *(const u32x4*)(b + 2816); unpack8(x, g0);
    }
    for (int r = 0; r < 16; ++r) {
      const bf16_t* b = P + (long)(r0 + r) * 5632 + c8;
      const bool vn = (tl0 + r) < L - 1;
      u32x4 x = vn ? *(const u32x4*)(b + 5632) : z4; unpack8(x, ap);
      x = vn ? *(const u32x4*)(b + 5632 + 2816) : z4; unpack8(x, gp);
      float o[8];
#pragma unroll
      for (int e = 0; e < 8; ++e) {
        float h1 = w1[0][e] * am[e] + w1[1][e] * a0[e] + w1[2][e] * ap[e] + b1[e];
        float h2 = w2[0][e] * gm[e] + w2[1][e] * g0[e] + w2[2][e] * gp[e] + b2[e];
        o[e] = gelu_f(h1) * h2;
        am[e] = a0[e]; a0[e] = ap[e]; gm[e] = g0[e]; g0[e] = gp[e];
      }
      *(u32x4*)(G + (long)(r0 + r) * 2816 + c8) = pack8(o);
    }
  }
}

template <int K>
__device__ __forceinline__ f32x16 mma_nt(const bf16_t* A, int lda, const bf16_t* B, int ldb, f32x16 acc, int r32, int hi) {
  bf16x8 a[K / 16], b[K / 16];
#pragma unroll
  for (int k0 = 0; k0 < K / 16; ++k0) {
    a[k0] = *reinterpret_cast<const bf16x8*>(A + r32 * lda + k0 * 16 + 8 * hi);
    b[k0] = *reinterpret_cast<const bf16x8*>(B + r32 * ldb + k0 * 16 + 8 * hi);
  }
#pragma unroll
  for (int k0 = 0; k0 < K / 16; ++k0) acc = __builtin_amdgcn_mfma_f32_32x32x16_bf16(a[k0], b[k0], acc, 0, 0, 0);
  return acc;
}

__device__ __forceinline__ void mlstm_phase(const int wv, const Params& p, const int zq, const bf16_t* __restrict__ P1, const float* __restrict__ GT,
                                            bf16_t* __restrict__ HF, bf16_t* __restrict__ HB) {
  const int tidx = ltid(wv);
  extern __shared__ __attribute__((aligned(16))) char shm_raw[];
  bf16_t* Qs = (bf16_t*)shm_raw;
  bf16_t* Ks = Qs + 64 * 136;
  bf16_t* KwT = Ks + 64 * 136;
  bf16_t* VsT = KwT + 128 * 72;
  bf16_t* Wb = VsT + 128 * 72;
  bf16_t* Cb = Wb + 64 * 72;
  float* gbuf = (float*)(Cb + 128 * 136);
  float* sclv = gbuf + 400; float* wintv = sclv + 64; float* nvec = wintv + 64;
  float* cwl = nvec + 128;
  const int tid = tidx, wid = wv, lane = tid & 63, r32 = lane & 31, hi = lane >> 5;
  const float* cw = p.in[zq + 35]; const float* cbias = p.in[zq + 36]; const float* bg = p.in[zq + 34];
  for (int u = blockIdx.x; u < 544; u += gridDim.x) {
    int seq, h, dir;
    if (u < 32) { seq = 32 + u / 16; h = (u / 2) % 8; dir = u % 2; } else { int j = u - 32; seq = j / 16; h = (j / 2) % 8; dir = j % 2; }
    const int L = seq < 32 ? 256 : 2048;
    const long rowbase = seq < 32 ? (long)seq * 256 : 8192 + (long)(seq - 32) * 2048;
    __syncthreads();
    f32x16 cacc[2]; float m = 0.f;
    const int vb2 = wid >> 1;
    if (seq >= 32) {
      const int b = seq - 32;
      const float* Cin = p.in[zq + 4] + (long)((b * 2 + dir) * 8 + h) * 16384;
#pragma unroll
      for (int i = 0; i < 2; ++i) { const int kb = (wid & 1) * 2 + i;
#pragma unroll
        for (int r = 0; r < 16; ++r) cacc[i][r] = Cin[(vb2 * 32 + crow(r, hi)) * 128 + kb * 32 + r32]; }
      if (tid < 128) nvec[tid] = p.in[zq + 5][((b * 2 + dir) * 8 + h) * 128 + tid];
      m = p.in[zq + 6][(b * 2 + dir) * 8 + h];
    } else {
#pragma unroll
      for (int i = 0; i < 2; ++i)
#pragma unroll
        for (int r = 0; r < 16; ++r) cacc[i][r] = 0.f;
      if (tid < 128) nvec[tid] = 0.f;
    }
#pragma unroll
    for (int i = 0; i < 2; ++i) { const int kb = (wid & 1) * 2 + i;
#pragma unroll
      for (int r = 0; r < 16; ++r) Cb[(vb2 * 32 + crow(r, hi)) * 136 + kb * 32 + r32] = f2bf(cacc[i][r]); }
    if (tid < 256) {
      const int col = (tid < 128) ? (h * 128 + tid) : (1024 + h * 128 + (tid - 128));
      cwl[tid] = cw[col]; cwl[256 + tid] = cw[2048 + col]; cwl[512 + tid] = cw[4096 + col]; cwl[768 + tid] = cbias[col];
    }
    const float bgi = bg[dir * 8 + h], bgf = bg[16 + dir * 8 + h];
    __syncthreads();
    const int nch = L / 64;
    u32x4 rq[2][3], rk[2][3], rv[2]; float g_i = 0.f, g_f = 0.f;
#define ML_LOADRAW(chn) do { \
      const int tcr_ = (chn) * 64 + lane; const int posr_ = dir ? (L - 1 - tcr_) : tcr_; \
      const bf16_t* rp_ = P1 + (rowbase + posr_) * 4096 + h * 128 + wv * 16; \
      const bool hm_ = posr_ > 0, hp_ = posr_ < L - 1; const u32x4 z4_ = {0u, 0u, 0u, 0u}; \
      _Pragma("unroll") for (int hf = 0; hf < 2; ++hf) { \
        rq[hf][0] = hm_ ? *(const u32x4*)(rp_ - 4096 + hf * 8) : z4_; rq[hf][1] = *(const u32x4*)(rp_ + hf * 8); \
        rq[hf][2] = hp_ ? *(const u32x4*)(rp_ + 4096 + hf * 8) : z4_; \
        rk[hf][0] = hm_ ? *(const u32x4*)(rp_ - 4096 + 1024 + hf * 8) : z4_; rk[hf][1] = *(const u32x4*)(rp_ + 1024 + hf * 8); \
        rk[hf][2] = hp_ ? *(const u32x4*)(rp_ + 4096 + 1024 + hf * 8) : z4_; \
        rv[hf] = *(const u32x4*)(rp_ + 2048 + hf * 8); } \
      if (wid == 7) { const float* gr_ = GT + (rowbase + posr_) * 32; g_i = gr_[dir * 8 + h]; g_f = gr_[16 + dir * 8 + h]; } \
    } while (0)
#define ML_GATES(setp, mval) do { float* av_ = gbuf + (setp) * 200; float* Mv_ = av_ + 64; float* bv_ = Mv_ + 64; float* scal_ = bv_ + 64; \
      const float ic_ = g_i + bgi; const float fp_ = g_f + bgf; \
      const float lf_ = fminf(fp_, 0.f) - __logf(1.f + __expf(-fabsf(fp_))); \
      float bc_ = lf_; \
      _Pragma("unroll") for (int off = 1; off < 64; off <<= 1) { float t_ = __shfl_up(bc_, off); if (lane >= off) bc_ += t_; } \
      const float a_ = ic_ - bc_; float pm_ = a_; \
      _Pragma("unroll") for (int off = 1; off < 64; off <<= 1) { float t_ = __shfl_up(pm_, off); if (lane >= off) pm_ = fmaxf(pm_, t_); } \
      const float M_ = fmaxf((mval), pm_); \
      av_[lane] = a_; Mv_[lane] = M_; bv_[lane] = bc_; if (lane == 63) { scal_[0] = M_; scal_[1] = bc_; } } while (0)
    ML_LOADRAW(0);
    if (wid == 7) ML_GATES(0, m);
    for (int ch = 0; ch < nch; ++ch) {
      float* av = gbuf + (ch & 1) * 200; float* Mv = av + 64; float* bv = Mv + 64; float* scal = bv + 64;
      float kf[16];
      {
        const int r = lane, c16 = wv * 16;
#pragma unroll
        for (int hf = 0; hf < 2; ++hf) {
          float um[8], u0[8], up[8], qf[8];
          { unpack8(rq[hf][0], um); unpack8(rq[hf][1], u0); unpack8(rq[hf][2], up);
#pragma unroll
            for (int e = 0; e < 8; ++e) { const int c = c16 + hf * 8 + e;
              qf[e] = silu_f(cwl[c] * um[e] + cwl[256 + c] * u0[e] + cwl[512 + c] * up[e] + cwl[768 + c]); }
            *(u32x4*)(Qs + r * 136 + c16 + hf * 8) = pack8(qf); }
          { unpack8(rk[hf][0], um); unpack8(rk[hf][1], u0); unpack8(rk[hf][2], up);
#pragma unroll
            for (int e = 0; e < 8; ++e) { const int c = 128 + c16 + hf * 8 + e;
              qf[e] = 0.088388347648318440f * silu_f(cwl[c] * um[e] + cwl[256 + c] * u0[e] + cwl[512 + c] * up[e] + cwl[768 + c]);
              kf[hf * 8 + e] = qf[e]; }
            *(u32x4*)(Ks + r * 136 + c16 + hf * 8) = pack8(qf); }
          { const u32x4 wv4 = rv[hf];
            bf16_t* vd = VsT + (c16 + hf * 8) * 72 + r;
            vd[0 * 72] = (bf16_t)(wv4[0] & 0xffff); vd[1 * 72] = (bf16_t)(wv4[0] >> 16);
            vd[2 * 72] = (bf16_t)(wv4[1] & 0xffff); vd[3 * 72] = (bf16_t)(wv4[1] >> 16);
            vd[4 * 72] = (bf16_t)(wv4[2] & 0xffff); vd[5 * 72] = (bf16_t)(wv4[2] >> 16);
            vd[6 * 72] = (bf16_t)(wv4[3] & 0xffff); vd[7 * 72] = (bf16_t)(wv4[3] >> 16); }
        }
      }
      if (ch + 1 < nch) ML_LOADRAW(ch + 1);
      __syncthreads();
      const float M63 = scal[0], b63 = scal[1];
      const float m_new = b63 + M63;
      const float w_state = __expf(m - M63);
      {
        const float wt = __expf(av[lane] - M63);
        bf16_t* kd = KwT + (wv * 16) * 72 + lane;
#pragma unroll
        for (int e = 0; e < 16; ++e) kd[e * 72] = f2bf(kf[e] * wt);
      }
      __syncthreads();
      if (wid == 7 && ch + 1 < nch) ML_GATES((ch + 1) & 1, m_new);
      const int tb = wid & 1, vb = wid >> 1;
      if (wid < 4) {
        const int sb = wid >> 1;
        f32x16 s = {};
        if (sb <= tb) { s = mma_nt<64>(Qs + tb * 32 * 136, 136, Ks + sb * 32 * 136, 136, s, r32, hi); s = mma_nt<64>(Qs + tb * 32 * 136 + 64, 136, Ks + sb * 32 * 136 + 64, 136, s, r32, hi); }
        const int sc = sb * 32 + r32; const float as = av[sc];
#pragma unroll
        for (int r = 0; r < 16; ++r) {
          const int t = tb * 32 + crow(r, hi);
          float w = (sc <= t) ? s[r] * __expf(as - Mv[t]) : 0.f;
          Wb[t * 72 + sc] = f2bf(w);
        }
      }
      f32x16 inter = {};
      inter = mma_nt<64>(Qs + tb * 32 * 136, 136, Cb + vb * 32 * 136, 136, inter, r32, hi); inter = mma_nt<64>(Qs + tb * 32 * 136 + 64, 136, Cb + vb * 32 * 136 + 64, 136, inter, r32, hi);
      __syncthreads();
      {
        const int t = tid >> 3, part = tid & 7;
        float wsum[8]; unpack8(*(const u32x4*)(Wb + t * 72 + part * 8), wsum);
        float dw = 0.f;
#pragma unroll
        for (int e = 0; e < 8; ++e) dw += wsum[e];
        float q0[8], q1[8]; unpack8(*(const u32x4*)(Qs + t * 136 + part * 16), q0); unpack8(*(const u32x4*)(Qs + t * 136 + part * 16 + 8), q1);
        float dq = 0.f;
#pragma unroll
        for (int e = 0; e < 8; ++e) dq += q0[e] * nvec[part * 16 + e] + q1[e] * nvec[part * 16 + 8 + e];
        dw += __shfl_xor(dw, 1); dw += __shfl_xor(dw, 2); dw += __shfl_xor(dw, 4);
        dq += __shfl_xor(dq, 1); dq += __shfl_xor(dq, 2); dq += __shfl_xor(dq, 4);
        if (part == 0) {
          const float Mt = Mv[t];
          const float wint = __expf(m - Mt);
          const float den = wint * dq + dw;
          const float mt = bv[t] + Mt;
          sclv[t] = 1.f / fmaxf(fabsf(den), __expf(-mt));
          wintv[t] = wint;
        }
      }
      __syncthreads();
      {
        f32x16 num;
#pragma unroll
        for (int r = 0; r < 16; ++r) num[r] = inter[r] * wintv[tb * 32 + crow(r, hi)];
        num = mma_nt<64>(Wb + tb * 32 * 72, 72, VsT + vb * 32 * 72, 72, num, r32, hi);
        bf16_t* Hout = dir ? HB : HF;
#pragma unroll
        for (int r = 0; r < 16; ++r) {
          const int t = tb * 32 + crow(r, hi);
          const int tc = ch * 64 + t; const int pos = dir ? (L - 1 - tc) : tc;
          Hout[(rowbase + pos) * 1024 + h * 128 + vb * 32 + r32] = f2bf(num[r] * sclv[t]);
        }
      }
#pragma unroll
      for (int i = 0; i < 2; ++i) {
        const int kb = (wid & 1) * 2 + i;
#pragma unroll
        for (int r = 0; r < 16; ++r) cacc[i][r] *= w_state;
        cacc[i] = mma_nt<64>(VsT + vb2 * 32 * 72, 72, KwT + kb * 32 * 72, 72, cacc[i], r32, hi);
#pragma unroll
        for (int r = 0; r < 16; ++r) Cb[(vb2 * 32 + crow(r, hi)) * 136 + kb * 32 + r32] = f2bf(cacc[i][r]);
      }
      if (tid < 128) {
        float s = 0.f;
#pragma unroll
        for (int q = 0; q < 8; ++q) { float f[8]; unpack8(*(const u32x4*)(KwT + tid * 72 + q * 8), f);
#pragma unroll
          for (int e = 0; e < 8; ++e) s += f[e]; }
        nvec[tid] = w_state * nvec[tid] + s;
      }
      m = m_new;
      __syncthreads();
    }
    if (seq < 32) {
      float* Co = p.out + O_C + (long)((seq * 2 + dir) * 8 + h) * 16384;
#pragma unroll
      for (int i = 0; i < 2; ++i) { const int kb = (wid & 1) * 2 + i;
#pragma unroll
        for (int r = 0; r < 16; ++r) Co[(vb2 * 32 + crow(r, hi)) * 128 + kb * 32 + r32] = cacc[i][r]; }
      if (tid < 128) p.out[O_N + ((seq * 2 + dir) * 8 + h) * 128 + tid] = nvec[tid];
      if (tid == 0) p.out[O_M + (seq * 2 + dir) * 8 + h] = m;
    }
  }
  __syncthreads();
}

#undef ML_LOADRAW
#undef ML_GATES
__device__ __forceinline__ void mlstm_post(const int wv, const Params& p, const int zq, const bf16_t* __restrict__ HF, const bf16_t* __restrict__ HB,
                                           const bf16_t* __restrict__ P1, bf16_t* __restrict__ A) {
  const int tidx = ltid(wv);
  const int wid = wv, lane = tidx & 63;
  const float* hn = p.in[zq + 37];
  for (int row = blockIdx.x * 8 + wid; row < T_TOK; row += gridDim.x * 8) {
    float hv[16], t0[8], t1[8];
    unpack8(*(const u32x4*)(HF + (long)row * 1024 + lane * 16), hv); unpack8(*(const u32x4*)(HF + (long)row * 1024 + lane * 16 + 8), hv + 8);
    unpack8(*(const u32x4*)(HB + (long)row * 1024 + lane * 16), t0); unpack8(*(const u32x4*)(HB + (long)row * 1024 + lane * 16 + 8), t1);
    float ss = 0.f;
#pragma unroll
    for (int e = 0; e < 8; ++e) { hv[e] += t0[e]; hv[8 + e] += t1[e]; }
#pragma unroll
    for (int e = 0; e < 16; ++e) ss += hv[e] * hv[e];
    ss += __shfl_xor(ss, 1); ss += __shfl_xor(ss, 2); ss += __shfl_xor(ss, 4);
    const float rs = rsqrtf(ss * (1.f / 128.f) + 1e-6f);
    float ov[16];
    unpack8(*(const u32x4*)(P1 + (long)row * 4096 + 3072 + lane * 16), ov); unpack8(*(const u32x4*)(P1 + (long)row * 4096 + 3072 + lane * 16 + 8), ov + 8);
    float y[16];
#pragma unroll
    for (int e = 0; e < 16; ++e) y[e] = hv[e] * rs * hn[lane * 16 + e] * (1.f / (1.f + __expf(-ov[e])));
    *(u32x4*)(A + (long)row * 1024 + lane * 16) = pack8(y);
    *(u32x4*)(A + (long)row * 1024 + lane * 16 + 8) = pack8(y + 8);
  }
}

__device__ __forceinline__ void gsync(const int wv, unsigned* bar, const unsigned k) {
  const int tidx = ltid(wv);
  asm volatile("s_waitcnt vmcnt(0)" ::: "memory");
  __syncthreads();
  if (tidx == 0) {
    __builtin_amdgcn_fence(__ATOMIC_RELEASE, "agent");
    asm volatile("s_waitcnt vmcnt(0)" ::: "memory");
    const unsigned g = blockIdx.x & 7u;
    const unsigned ng = (gridDim.x + 7u - g) >> 3;
    const unsigned ngroups = gridDim.x < 8u ? gridDim.x : 8u;
    const unsigned old = __hip_atomic_fetch_add(bar + g * 32, 1u, __ATOMIC_RELAXED, __HIP_MEMORY_SCOPE_AGENT);
    if (old + 1u == k * ng) {
      const unsigned o2 = __hip_atomic_fetch_add(bar + 256, 1u, __ATOMIC_RELAXED, __HIP_MEMORY_SCOPE_AGENT);
      if (o2 + 1u == k * ngroups) {
#pragma unroll
        for (int q = 0; q < 8; ++q) __hip_atomic_store(bar + 512 + q * 32, k, __ATOMIC_RELAXED, __HIP_MEMORY_SCOPE_AGENT);
      }
    }
    while (__hip_atomic_load(bar + 512 + g * 32, __ATOMIC_RELAXED, __HIP_MEMORY_SCOPE_AGENT) < k) __builtin_amdgcn_s_sleep(4);
    __builtin_amdgcn_fence(__ATOMIC_ACQUIRE, "agent");
    asm volatile("s_waitcnt vmcnt(0)" ::: "memory");
  }
  __syncthreads();
}

__global__ void __launch_bounds__(512) mega(Params p, int ph_lo, int ph_hi) {
  const int wv = __builtin_amdgcn_readfirstlane(threadIdx.x >> 6);
  if (ph_hi < 0) { cg::this_grid().sync(); }
  unsigned* bar = (unsigned*)(p.ws + WS_END);
  char* ws = p.ws;
  bf16_t* Wt_in0 = (bf16_t*)(ws + OFF_WIN0); bf16_t* Wt_out0 = (bf16_t*)(ws + OFF_WOUT0);
  bf16_t* Wt_up0 = (bf16_t*)(ws + OFF_WUP0); bf16_t* Wt_up1 = (bf16_t*)(ws + OFF_WUP1);
  bf16_t* Wt_dn0 = (bf16_t*)(ws + OFF_WDN0); bf16_t* Wt_dn1 = (bf16_t*)(ws + OFF_WDN1);
  bf16_t* Wt_in1 = (bf16_t*)(ws + OFF_WIN1); bf16_t* Wt_out1 = (bf16_t*)(ws + OFF_WOUT1);
  float* modv = (float*)(ws + OFF_MOD);
  char* Pr = ws + OFF_P; char* Gr = ws + OFF_G;
  bf16_t* Pb = (bf16_t*)Pr; float* R = (float*)Pr;
  bf16_t* QA = (bf16_t*)(Pr + P_QA); bf16_t* KA = (bf16_t*)(Pr + P_KA); bf16_t* VA = (bf16_t*)(Pr + P_VA); bf16_t* X0 = (bf16_t*)(Pr + P_X0);
  float* GT = (float*)(Pr + P_GT); bf16_t* A2 = (bf16_t*)(Pr + P_A2);
  bf16_t* A = (bf16_t*)Gr; bf16_t* Gb = (bf16_t*)Gr; float* VV = (float*)(Gr + G_VV);
  bf16_t* HF = (bf16_t*)Gr; bf16_t* HB = (bf16_t*)(Gr + G_HB);
  float* X = p.out;
  float* F256 = p.out + O_C + 512; float* F2048 = p.out + O_C + 512 * 512 + 512;
  const float* mod0 = modv; const float* mod1 = modv + 3 * 6144;
  unsigned bk = 0;
#define PH(i, ...) if (ph_lo <= (i) && (i) < ph_hi) { const int zq = opq(); __VA_ARGS__; if ((i) + 1 < ph_hi) gsync(wv, bar, ++bk); }
  PH(0, {
    conv_w(wv, p.in[zq + 19], Wt_in0, 1024, 2560, 2560);
    conv_w(wv, p.in[zq + 20], Wt_out0, 1024, 1024, 1024);
    conv_w(wv, p.in[zq + 15], Wt_up0, 1024, 5632, 5632);
    conv_w(wv, p.in[zq + 15] + (long)1024 * 5632, Wt_up1, 1024, 5632, 5632);
    conv_w(wv, p.in[zq + 18], Wt_dn0, 2816, 1024, 1024);
    conv_w(wv, p.in[zq + 18] + (long)2816 * 1024, Wt_dn1, 2816, 1024, 1024);
    conv_w(wv, p.in[zq + 33], Wt_in1, 1024, 4128, 4352);
    conv_w(wv, p.in[zq + 38], Wt_out1, 1024, 1024, 1024);
    mod_phase(wv, p, zq, modv);
    filt_phase(wv, p, zq, F256, F2048);
  })
  PH(1, (row_phase<true, false, true>(wv, p, zq, nullptr, nullptr, mod0, 0, nullptr, p.in[zq + 11], mod0, 0, A)))
  PH(2, (gemm_phase<0, 2560>(wv, A, Wt_in0, 2560, 1024, Pb, nullptr)))
  PH(3, post_inproj0(wv, p, zq, Pb, QA, KA, VA, VV, X0))
  PH(4, mix0_phase(wv, p, zq, QA, KA, VA, VV, X0, F256, F2048, A))
  PH(5, (gemm_phase<1, 1024>(wv, A, Wt_out0, 1024, 1024, R, nullptr)))
  PH(6, (row_phase<true, true, true>(wv, p, zq, R, p.in[zq + 12], mod0, 2, X, p.in[zq + 13], mod0, 3, A)))
  PH(7, (gemm_phase<0, 5632>(wv, A, Wt_up0, 5632, 1024, Pb, nullptr)))
  PH(8, ffn_act_phase(wv, Pb, p.in[zq + 16], p.in[zq + 17], Gb))
  PH(9, (gemm_phase<1, 1024>(wv, Gb, Wt_dn0, 1024, 2816, R, nullptr)))
  PH(10, (row_phase<false, true, true>(wv, p, zq, R, p.in[zq + 14], mod0, 5, X, p.in[zq + 11] + 1024, mod1, 0, A)))
  PH(11, (gemm_phase<2, 4096>(wv, A, Wt_in1, 4352, 1024, Pb, GT)))
  PH(13, mlstm_phase(wv, p, zq, Pb, GT, HF, HB))
  PH(14, mlstm_post(wv, p, zq, HF, HB, Pb, A2))
  PH(15, (gemm_phase<1, 1024>(wv, A2, Wt_out1, 1024, 1024, R, nullptr)))
  PH(16, (row_phase<false, true, true>(wv, p, zq, R, p.in[zq + 12] + 1024, mod1, 2, X, p.in[zq + 13] + 1024, mod1, 3, A)))
  PH(17, (gemm_phase<0, 5632>(wv, A, Wt_up1, 5632, 1024, Pb, nullptr)))
  PH(18, ffn_act_phase(wv, Pb, p.in[zq + 16] + 3 * 5632, p.in[zq + 17] + 5632, Gb))
  PH(19, (gemm_phase<1, 1024>(wv, Gb, Wt_dn1, 1024, 2816, R, nullptr)))
  PH(20, (row_phase<false, true, false>(wv, p, zq, R, p.in[zq + 14] + 1024, mod1, 5, X, nullptr, mod1, 0, nullptr)))
#undef PH
}

extern "C" void kernel_launch(void* const* d_in, const int* in_sizes, int n_in, void* d_out, int out_size, void* d_ws, size_t ws_size,
                              hipStream_t stream) {
  static int grid_blocks = 0;
  if (!grid_blocks) {
    if (ws_size < WS_END + 4096) fprintf(stderr, "kernel_launch: workspace too small: %zu < %zu\n", ws_size, (size_t)WS_END);
    hipFuncSetAttribute((const void*)mega, hipFuncAttributeMaxDynamicSharedMemorySize, LDS_BYTES);
    int dev = 0, cus = 0, per = 0;
    hipGetDevice(&dev);
    hipDeviceGetAttribute(&cus, hipDeviceAttributeMultiprocessorCount, dev);
    hipOccupancyMaxActiveBlocksPerMultiprocessor(&per, mega, 512, LDS_BYTES);
    if (per < 1) { fprintf(stderr, "kernel_launch: occupancy query returned %d\n", per); per = 1; }
    grid_blocks = cus;
  }
  Params p{};
  for (int i = 0; i < 39; ++i) p.in[i] = (const float*)d_in[i];
  p.out = (float*)d_out; p.ws = (char*)d_ws;
  int lo = 0, hi = NPH;
  (void)hipMemsetAsync((char*)d_ws + WS_END, 0, 4096, stream);
  void* args[] = {&p, &lo, &hi};
  hipError_t e = hipLaunchCooperativeKernel((void*)mega, dim3(grid_blocks), dim3(512), args, LDS_BYTES, stream);
  if (e != hipSuccess) fprintf(stderr, "cooperative launch failed: %s (grid %d)\n", hipGetErrorString(e), grid_blocks);
}
```

```cpp
#include <hip/hip_runtime.h>
#include <hip/hip_cooperative_groups.h>
#include <cstdio>
#include <cstdint>
namespace cg = cooperative_groups;

typedef unsigned short bf16_t;
typedef short bf16x8 __attribute__((ext_vector_type(8)));
typedef short s16x4 __attribute__((ext_vector_type(4)));
typedef float f32x4 __attribute__((ext_vector_type(4)));
typedef float f32x8 __attribute__((ext_vector_type(8)));
typedef float f32x16 __attribute__((ext_vector_type(16)));
typedef unsigned u32x4 __attribute__((ext_vector_type(4)));
typedef unsigned u32x2 __attribute__((ext_vector_type(2)));

constexpr int T_TOK = 12288, TPR = 8192;
constexpr int LDS_BYTES = 131072;
constexpr int NPH = 21;

constexpr size_t OFF_WIN0 = 0, OFF_WOUT0 = 5242880, OFF_WUP0 = 7340032, OFF_WUP1 = 18874368, OFF_WDN0 = 30408704,
                 OFF_WDN1 = 36175872, OFF_WIN1 = 41943040, OFF_WOUT1 = 50855936, OFF_MOD = 52953088, OFF_P = 53100544,
                 OFF_G = 191512576, WS_END = 260718592;
constexpr size_t P_QA = 62914560, P_KA = 75497472, P_VA = 82313216, P_X0 = 89128960;
constexpr size_t P_GT = 100663296, P_A2 = 102236160;
constexpr size_t G_VV = 25165824, G_HB = 25165824;
constexpr size_t O_K = 12582912, O_V = 14680064, O_C = 16777216, O_N = 25165824, O_M = 25231360;

struct Params { const float* in[39]; float* out; char* ws; };

typedef __bf16 nbf16x2 __attribute__((ext_vector_type(2)));
typedef float nf32x2 __attribute__((ext_vector_type(2)));
__device__ __forceinline__ unsigned cvtpk(float lo, float hi) {
  nf32x2 v = {lo, hi};
  nbf16x2 b = __builtin_convertvector(v, nbf16x2);
  return __builtin_bit_cast(unsigned, b);
}
__device__ __forceinline__ bf16_t f2bf(float f) { return (bf16_t)(cvtpk(f, 0.f) & 0xffffu); }
__device__ __forceinline__ float bf2f(bf16_t h) { return __uint_as_float(((unsigned)h) << 16); }
__device__ __forceinline__ float bflo(unsigned w) { return __uint_as_float(w << 16); }
__device__ __forceinline__ float bfhi(unsigned w) { return __uint_as_float(w & 0xffff0000u); }
__device__ __forceinline__ float wave_sum(float v) {
#pragma unroll
  for (int o = 32; o > 0; o >>= 1) v += __shfl_xor(v, o);
  return v;
}
__device__ __forceinline__ int llane() { int l; asm volatile("v_mbcnt_lo_u32_b32 %0, -1, 0\n\tv_mbcnt_hi_u32_b32 %0, -1, %0" : "=v"(l)); return l; }
__device__ __forceinline__ int ltid(int wv) { return (wv << 6) | llane(); }
__device__ __forceinline__ int opq() { int z; asm volatile("s_mov_b32 %0, 0" : "=s"(z)); return z; }
__device__ __forceinline__ float silu_f(float x) { return x * __builtin_amdgcn_rcpf(1.f + __expf(-x)); }
__device__ __forceinline__ int crow(int r, int hi) { return (r & 3) + 8 * (r >> 2) + 4 * hi; }
__device__ __forceinline__ void unpack8(u32x4 w, float* f) {
  f[0] = bflo(w[0]); f[1] = bfhi(w[0]); f[2] = bflo(w[1]); f[3] = bfhi(w[1]);
  f[4] = bflo(w[2]); f[5] = bfhi(w[2]); f[6] = bflo(w[3]); f[7] = bfhi(w[3]);
}
__device__ __forceinline__ u32x4 pack8(const float* f) {
  u32x4 w = {cvtpk(f[0], f[1]), cvtpk(f[2], f[3]), cvtpk(f[4], f[5]), cvtpk(f[6], f[7])}; return w;
}

__device__ __forceinline__ void conv_w(const int wv, const float* __restrict__ W, bf16_t* __restrict__ Wt, int K, int N, int NP) {
  const int tidx = ltid(wv);
  extern __shared__ __attribute__((aligned(16))) char shm_raw[];
  float* tl = (float*)shm_raw;
  const int tid = tidx;
  const int ntn = NP / 64, ntiles = (K / 64) * ntn;
  for (int tile = blockIdx.x; tile < ntiles; tile += gridDim.x) {
    const int k0 = (tile / ntn) * 64, n0 = (tile % ntn) * 64;
    __syncthreads();
#pragma unroll
    for (int i = 0; i < 2; ++i) {
      int kr = (tid >> 4) + 32 * i, nc = (tid & 15) * 4;
      float4 v = make_float4(0.f, 0.f, 0.f, 0.f);
      if (n0 + nc < N) v = *(const float4*)(W + (long)(k0 + kr) * N + n0 + nc);
      float* d = tl + kr * 65 + nc; d[0] = v.x; d[1] = v.y; d[2] = v.z; d[3] = v.w;
    }
    __syncthreads();
    {
      int n = tid >> 3, kg = (tid & 7) * 8;
      u32x4 w;
      w[0] = cvtpk(tl[(kg + 0) * 65 + n], tl[(kg + 1) * 65 + n]);
      w[1] = cvtpk(tl[(kg + 2) * 65 + n], tl[(kg + 3) * 65 + n]);
      w[2] = cvtpk(tl[(kg + 4) * 65 + n], tl[(kg + 5) * 65 + n]);
      w[3] = cvtpk(tl[(kg + 6) * 65 + n], tl[(kg + 7) * 65 + n]);
      *(u32x4*)(Wt + (long)(n0 + n) * K + k0 + kg) = w;
    }
  }
  __syncthreads();
}

__device__ __forceinline__ void mod_phase(const int wv, const Params& p, const int zq, float* modv) {
  const int tidx = ltid(wv);
  extern __shared__ __attribute__((aligned(16))) char shm_raw[];
  float* red = (float*)shm_raw;
  const int tid = tidx;
  const float* cvec = p.in[zq + 7]; const float* cctx = p.in[zq + 8]; const float* bmod = p.in[zq + 10];
  for (int item = blockIdx.x; item < 192; item += gridDim.x) {
    const int l = item / 96, cb = (item % 96) * 64;
    const float* W = p.in[zq + 9] + (long)l * 1024 * 6144;
    const int cl = tid & 15, kg = tid >> 4;
    float a0[4] = {0, 0, 0, 0}, a1[4] = {0, 0, 0, 0}, a2[4] = {0, 0, 0, 0};
#pragma unroll 8
    for (int i = 0; i < 32; ++i) {
      int k = kg + 32 * i;
      float4 w = *(const float4*)(W + (long)k * 6144 + cb + cl * 4);
      float s0 = silu_f(cctx[k]), s1 = silu_f(cvec[k]), s2 = silu_f(cvec[1024 + k]);
      a0[0] += s0 * w.x; a0[1] += s0 * w.y; a0[2] += s0 * w.z; a0[3] += s0 * w.w;
      a1[0] += s1 * w.x; a1[1] += s1 * w.y; a1[2] += s1 * w.z; a1[3] += s1 * w.w;
      a2[0] += s2 * w.x; a2[1] += s2 * w.y; a2[2] += s2 * w.z; a2[3] += s2 * w.w;
    }
    __syncthreads();
#pragma unroll
    for (int j = 0; j < 4; ++j) {
      red[kg * 192 + 0 * 64 + cl * 4 + j] = a0[j];
      red[kg * 192 + 1 * 64 + cl * 4 + j] = a1[j];
      red[kg * 192 + 2 * 64 + cl * 4 + j] = a2[j];
    }
    __syncthreads();
    if (tid < 192) {
      float s = 0.f;
#pragma unroll 8
      for (int q = 0; q < 32; ++q) s += red[q * 192 + tid];
      int g = tid / 64, col = cb + (tid % 64);
      modv[(l * 3 + g) * 6144 + col] = s + bmod[l * 6144 + col];
    }
  }
  __syncthreads();
}

__device__ __forceinline__ void filt_phase(const int wv, const Params& p, const int zq, float* F256, float* F2048) {
  const int tidx = ltid(wv);
  extern __shared__ __attribute__((aligned(16))) char shm_raw[];
  float* z = (float*)shm_raw;
  float* h1 = z + 256;
  float* h2 = h1 + 512;
  const int tid = tidx;
  const float *w1 = p.in[zq + 25], *b1 = p.in[zq + 26], *w2 = p.in[zq + 27], *b2 = p.in[zq + 28], *w3 = p.in[zq + 29], *b3 = p.in[zq + 30], *sf = p.in[zq + 31], *skip = p.in[zq + 32];
  const float DMAX = -15.350567286626973f, DMIN = -3.0701134573253946f;
  for (int item = blockIdx.x; item < 288; item += gridDim.x) {
    const int L = item < 32 ? 256 : 2048; const int i0 = item < 32 ? item * 8 : (item - 32) * 8;
    float* F = item < 32 ? F256 : F2048;
    __syncthreads();
    if (tid < 136) {
      const int q = tid / 17, f = tid % 17;
      const float t = (float)(i0 + q) / (float)(L - 1);
      float v;
      if (f == 0) v = t;
      else if (f <= 8) v = cosf(6.283185307179586f * t * (float)f);
      else v = sinf(6.283185307179586f * t * (float)(f - 8));
      z[q * 32 + f] = v;
    }
    __syncthreads();
    { const int q = tid >> 6, u = tid & 63; float a = b1[u];
#pragma unroll 1
      for (int jj = 0; jj < 17; ++jj) a += z[q * 32 + jj] * w1[jj * 64 + u];
      h1[q * 64 + u] = sinf(sf[u] * a); }
    __syncthreads();
    { const int q = tid >> 6, u = tid & 63; float a = b2[u];
#pragma unroll 8
      for (int jj = 0; jj < 64; ++jj) a += h1[q * 64 + jj] * w2[jj * 64 + u];
      h2[q * 64 + u] = sinf(sf[64 + u] * a); }
    __syncthreads();
    {
      const int ch = tid;
      float af[8], ab[8];
#pragma unroll
      for (int q = 0; q < 8; ++q) { af[q] = b3[ch]; ab[q] = b3[512 + ch]; }
#pragma unroll 4
      for (int jj = 0; jj < 64; ++jj) {
        const float wa = w3[jj * 1024 + ch], wb = w3[jj * 1024 + 512 + ch];
#pragma unroll
        for (int q = 0; q < 8; ++q) { const float hh = h2[q * 64 + jj]; af[q] += hh * wa; ab[q] += hh * wb; }
      }
      const float delta = fabsf(DMIN + (DMAX - DMIN) * ((float)ch / 511.f));
#pragma unroll
      for (int q = 0; q < 8; ++q) {
        const int i = i0 + q;
        const float t = (float)i / (float)(L - 1);
        const float win = expf(-t * delta);
        const float sfw = af[q] * win, sbw = ab[q] * win;
        if (i == 0) F[(long)(L - 1) * 512 + ch] = sfw + sbw + skip[ch];
        else { F[(long)(L - 1 + i) * 512 + ch] = sfw; F[(long)(L - 1 - i) * 512 + ch] = sbw; }
      }
    }
  }
  __syncthreads();
}

template <bool FROM_IN, bool HAS_R, bool HAS_A>
__device__ __forceinline__ void row_phase(const int wv, const Params& p, const int zq, const bf16_t* __restrict__ R, const float* __restrict__ postg,
                                          const float* __restrict__ modg, int gate_m, float* X,
                                          const float* __restrict__ preg, const float* __restrict__ mods, int shift_m, bf16_t* __restrict__ A) {
  const int tidx = ltid(wv);
  const int wid = wv, lane = tidx & 63;
  for (int row = blockIdx.x * 8 + wid; row < T_TOK; row += gridDim.x * 8) {
    const int g = row < TPR ? 0 : 1 + (row - TPR) / 2048;
    const float* mg = modg + g * 6144;
    const float* ms = mods + g * 6144;
    const float* xin = FROM_IN ? (row < TPR ? p.in[zq + 0] + (long)row * 1024 : p.in[zq + 1] + (long)(row - TPR) * 1024) : (const float*)X + (long)row * 1024;
    float4 x[4];
#pragma unroll
    for (int j = 0; j < 4; ++j) x[j] = *(const float4*)(xin + j * 256 + lane * 4);
    if (HAS_R) {
      float4 r[4]; float ss = 0.f;
#pragma unroll
      for (int j = 0; j < 4; ++j) { const u32x2 rw = *(const u32x2*)(R + (long)row * 1024 + j * 256 + lane * 4); r[j] = make_float4(bflo(rw[0]), bfhi(rw[0]), bflo(rw[1]), bfhi(rw[1])); ss += r[j].x * r[j].x + r[j].y * r[j].y + r[j].z * r[j].z + r[j].w * r[j].w; }
      ss = wave_sum(ss); const float rs = rsqrtf(ss * (1.f / 1024.f) + 1e-6f);
#pragma unroll
      for (int j = 0; j < 4; ++j) {
        float4 pg = *(const float4*)(postg + j * 256 + lane * 4);
        float4 gt = *(const float4*)(mg + gate_m * 1024 + j * 256 + lane * 4);
        x[j].x += gt.x * (r[j].x * rs * pg.x); x[j].y += gt.y * (r[j].y * rs * pg.y);
        x[j].z += gt.z * (r[j].z * rs * pg.z); x[j].w += gt.w * (r[j].w * rs * pg.w);
        *(float4*)(X + (long)row * 1024 + j * 256 + lane * 4) = x[j];
      }
    }
    if (HAS_A) {
      float ss = 0.f;
#pragma unroll
      for (int j = 0; j < 4; ++j) ss += x[j].x * x[j].x + x[j].y * x[j].y + x[j].z * x[j].z + x[j].w * x[j].w;
      ss = wave_sum(ss); const float rs = rsqrtf(ss * (1.f / 1024.f) + 1e-6f);
#pragma unroll
      for (int j = 0; j < 4; ++j) {
        float4 pg = *(const float4*)(preg + j * 256 + lane * 4);
        float4 sh = *(const float4*)(ms + shift_m * 1024 + j * 256 + lane * 4);
        float4 sc = *(const float4*)(ms + (shift_m + 1) * 1024 + j * 256 + lane * 4);
        float y0 = x[j].x * rs * pg.x * (1.f + sc.x) + sh.x, y1 = x[j].y * rs * pg.y * (1.f + sc.y) + sh.y;
        float y2 = x[j].z * rs * pg.z * (1.f + sc.z) + sh.z, y3 = x[j].w * rs * pg.w * (1.f + sc.w) + sh.w;
        u32x2 w = {cvtpk(y0, y1), cvtpk(y2, y3)};
        *(u32x2*)(A + (long)row * 1024 + j * 256 + lane * 4) = w;
      }
    }
  }
}

constexpr int BM = 256, BK = 64, HALF = 128, WGM = 8, HT = HALF * BK;
__device__ __forceinline__ int lds_byte(int r, int c) {
  int st = (r >> 4) * 2 + (c >> 5), rr = r & 15, cc = c & 31, ob = rr * 64 + cc * 2;
  return st * 1024 + (ob ^ (((ob >> 9) & 1) << 5));
}
__device__ __forceinline__ void stage_rc(int b, int& R, int& C) {
  int st = b / 1024, sb = b % 1024, swz = sb ^ (((sb >> 9) & 1) << 5);
  R = (st >> 1) * 16 + swz / 64; C = (st & 1) * 32 + (swz % 64) / 2;
}

template <int MODE, int LDC>
__device__ __forceinline__ void gemm_phase(const int wv, const bf16_t* __restrict__ A, const bf16_t* __restrict__ Bt, int N, int K,
                                           void* Cout, float* GT) {
  const int tidx = ltid(wv);
  extern __shared__ __attribute__((aligned(16))) char shm_raw[];
  bf16_t* shm = (bf16_t*)shm_raw;
#define SA(b, h) (shm + ((b) * 2 + (h)) * HT)
#define SB(b, h) (shm + (4 + (b) * 2 + (h)) * HT)
#define STAGE(P, BASE, br, kt) do { const bf16_t* _gb = (BASE) + ((long)(br) * K + (long)(kt) * BK); \
    __builtin_amdgcn_global_load_lds((const unsigned*)(_gb + soff0), (unsigned*)((char*)(P) + sl0), 16, 0, 0); \
    __builtin_amdgcn_global_load_lds((const unsigned*)(_gb + soff1), (unsigned*)((char*)(P) + sl0 + 8192), 16, 0, 0); } while (0)
#define LDA(dst, b, h) _Pragma("unroll") for (int m = 0; m < 4; ++m) _Pragma("unroll") for (int k = 0; k < 2; ++k) \
    dst[m][k] = *reinterpret_cast<const bf16x8*>((char*)SA(b, h) + lds_byte(wr * 64 + m * 16 + fr, k * 32 + fq * 8))
#define LDB(dst, b, h) _Pragma("unroll") for (int n = 0; n < 2; ++n) _Pragma("unroll") for (int k = 0; k < 2; ++k) \
    dst[n][k] = *reinterpret_cast<const bf16x8*>((char*)SB(b, h) + lds_byte(wc * 32 + n * 16 + fr, k * 32 + fq * 8))
#define MMA(ai, bj, At, Bt_) do { __builtin_amdgcn_s_setprio(1); \
    _Pragma("unroll") for (int m = 0; m < 4; ++m) _Pragma("unroll") for (int n = 0; n < 2; ++n) _Pragma("unroll") for (int k = 0; k < 2; ++k) \
      acc[ai][bj][m][n] = __builtin_amdgcn_mfma_f32_16x16x32_bf16(At[m][k], Bt_[n][k], acc[ai][bj][m][n], 0, 0, 0); \
    __builtin_amdgcn_s_setprio(0); } while (0)
#define WAIT_V(n) asm volatile("s_waitcnt vmcnt(" #n ")" ::: "memory")
#define WAIT_L(n) asm volatile("s_waitcnt lgkmcnt(" #n ")" ::: "memory")
#define BAR __builtin_amdgcn_s_barrier()
#define SCHED __builtin_amdgcn_sched_barrier(0)
  const int nM = T_TOK / BM, nN = N / BM, nwg = nM * nN;
  const int wid = wv, lane = tidx & 63, wr = wid >> 2, wc = wid & 3, fr = lane & 15, fq = lane >> 4;
  const int nt = K / BK;
  unsigned soff0, soff1; const int sl0 = tidx * 16;
  { int _r, _c; stage_rc(sl0, _r, _c); soff0 = (unsigned)(_r * K + _c); stage_rc(sl0 + 8192, _r, _c); soff1 = (unsigned)(_r * K + _c); }
  for (int tile = blockIdx.x; tile < nwg; tile += gridDim.x) {
    int wgt = tile;
    { const int q = nwg / 8, r = nwg % 8, xcd = wgt % 8, off = wgt / 8;
      wgt = (xcd < r ? xcd * (q + 1) : r * (q + 1) + (xcd - r) * q) + off; }
    const int nig = WGM * nN, gid = wgt / nig, fm = gid * WGM, gsz = min(nM - fm, WGM);
    const int pm = fm + ((wgt % nig) % gsz), pn = (wgt % nig) / gsz, brow = pm * BM, bcol = pn * BM;
    f32x4 acc[2][2][4][2] = {};
    bf16x8 At[4][2], B0[2][2], B1[2][2];
    STAGE(SB(0, 0), Bt, bcol, 0); STAGE(SA(0, 0), A, brow, 0);
    STAGE(SB(0, 1), Bt, bcol + HALF, 0); STAGE(SA(0, 1), A, brow + HALF, 0);
    if (wr == 1) BAR;
    WAIT_V(4); BAR;
    STAGE(SB(1, 0), Bt, bcol, 1); STAGE(SA(1, 0), A, brow, 1); STAGE(SB(1, 1), Bt, bcol + HALF, 1);
    WAIT_V(6); BAR;
    for (int t = 0; t < nt - 2; t += 2) {
      LDB(B0, 0, 0); SCHED; LDA(At, 0, 0); STAGE(SA(1, 1), A, brow + HALF, t + 1);
      WAIT_L(8); BAR; WAIT_L(0); MMA(0, 0, At, B0); BAR; SCHED;
      LDB(B1, 0, 1); STAGE(SB(0, 0), Bt, bcol, t + 2);
      BAR; WAIT_L(0); MMA(0, 1, At, B1); BAR;
      LDA(At, 0, 1); STAGE(SA(0, 0), A, brow, t + 2);
      BAR; WAIT_L(0); MMA(1, 0, At, B0); BAR; SCHED;
      STAGE(SB(0, 1), Bt, bcol + HALF, t + 2);
      WAIT_V(6); BAR; MMA(1, 1, At, B1); BAR;
      LDB(B0, 1, 0); SCHED; LDA(At, 1, 0); STAGE(SA(0, 1), A, brow + HALF, t + 2);
      WAIT_L(8); BAR; WAIT_L(0); MMA(0, 0, At, B0); BAR; SCHED;
      LDB(B1, 1, 1); STAGE(SB(1, 0), Bt, bcol, t + 3);
      BAR; WAIT_L(0); MMA(0, 1, At, B1); BAR;
      LDA(At, 1, 1); STAGE(SA(1, 0), A, brow, t + 3);
      BAR; WAIT_L(0); MMA(1, 0, At, B0); BAR; SCHED;
      STAGE(SB(1, 1), Bt, bcol + HALF, t + 3);
      WAIT_V(6); BAR; MMA(1, 1, At, B1); BAR;
    }
    { LDB(B0, 0, 0); LDA(At, 0, 0); STAGE(SA(1, 1), A, brow + HALF, nt - 1);
      BAR; WAIT_L(0); MMA(0, 0, At, B0); BAR;
      LDB(B1, 0, 1); BAR; WAIT_L(0); MMA(0, 1, At, B1); BAR;
      LDA(At, 0, 1); WAIT_V(4); BAR; WAIT_L(0); MMA(1, 0, At, B0); MMA(1, 1, At, B1); BAR; }
    { LDB(B0, 1, 0); LDA(At, 1, 0); WAIT_V(2); BAR; WAIT_L(0); MMA(0, 0, At, B0); BAR;
      LDB(B1, 1, 1); WAIT_V(0); BAR; WAIT_L(0); MMA(0, 1, At, B1); BAR;
      LDA(At, 1, 1); BAR; WAIT_L(0); MMA(1, 0, At, B0); MMA(1, 1, At, B1); BAR; }
    if (wr == 0) BAR;
    {
      const int le = llane();
      const int fr = le & 15, fq = le >> 4;
      const long base = (long)(brow + wr * 64) * LDC + bcol + wc * 32 + (unsigned)(fq * 4 * LDC + fr);
      if (MODE == 0 || (MODE == 2 && pn < 16)) {
        bf16_t* cp = (bf16_t*)Cout + base;
#pragma unroll
        for (int ai = 0; ai < 2; ++ai)
#pragma unroll
          for (int m = 0; m < 4; ++m)
#pragma unroll
            for (int j = 0; j < 4; ++j) {
              bf16_t* rp = cp + (ai * HALF + m * 16 + j) * LDC;
#pragma unroll
              for (int bj = 0; bj < 2; ++bj)
#pragma unroll
                for (int n = 0; n < 2; ++n) rp[bj * HALF + n * 16] = f2bf(acc[ai][bj][m][n][j]);
            }
      } else if (MODE == 1) {
        float* cp = (float*)Cout + base;
#pragma unroll
        for (int ai = 0; ai < 2; ++ai)
#pragma unroll
          for (int m = 0; m < 4; ++m)
#pragma unroll
            for (int j = 0; j < 4; ++j) {
              float* rp = cp + (ai * HALF + m * 16 + j) * LDC;
#pragma unroll
              for (int bj = 0; bj < 2; ++bj)
#pragma unroll
                for (int n = 0; n < 2; ++n) rp[bj * HALF + n * 16] = acc[ai][bj][m][n][j];
            }
      } else {
        if (wc == 0) {
          float* gp = GT + (long)(brow + wr * 64) * 32 + (unsigned)(fq * 4 * 32 + fr);
#pragma unroll
          for (int ai = 0; ai < 2; ++ai)
#pragma unroll
            for (int m = 0; m < 4; ++m)
#pragma unroll
              for (int j = 0; j < 4; ++j)
#pragma unroll
                for (int n = 0; n < 2; ++n) gp[(ai * HALF + m * 16 + j) * 32 + n * 16] = acc[ai][0][m][n][j];
        }
      }
    }
    __syncthreads();
  }
#undef SA
#undef SB
#undef STAGE
#undef LDA
#undef LDB
#undef MMA
}

__device__ __forceinline__ void post_inproj0(const int wv, const Params& p, const int zq, const bf16_t* __restrict__ P0, bf16_t* __restrict__ QA, bf16_t* __restrict__ KA,
                                             bf16_t* __restrict__ VA, float* __restrict__ VV, bf16_t* __restrict__ X0) {
  const int tidx = ltid(wv);
  const int wid = wv, lane = tidx & 63;
  const float* qn = p.in[zq + 21]; const float* kn = p.in[zq + 22]; const float* cw = p.in[zq + 23]; const float* cb = p.in[zq + 24];
  float* outK = p.out + O_K; float* outV = p.out + O_V;
  for (int i = blockIdx.x * 512 + tidx; i < 2 * 512 * 256 / 4; i += gridDim.x * 512) {
    int e = i * 4; int b = e / (512 * 256), rem = e % (512 * 256);
    float4 kk = *(const float4*)(p.in[zq + 2] + e); float4 vv = *(const float4*)(p.in[zq + 3] + e);
    long d = (long)(8192 + b * 2560 + 2048) * 256 + rem;
    u32x2 wk = {cvtpk(kk.x, kk.y), cvtpk(kk.z, kk.w)}; u32x2 wv = {cvtpk(vv.x, vv.y), cvtpk(vv.z, vv.w)};
    *(u32x2*)(KA + d) = wk; *(u32x2*)(VA + d) = wv;
  }
  const int fi = lane & 31;
  const float inv = exp2f(-(float)fi * (13.287712379549449f / 32.f));
  for (int row = blockIdx.x * 8 + wid; row < T_TOK; row += gridDim.x * 8) {
    const bool samp = row >= TPR;
    const int L = samp ? 2048 : 256;
    const int tl = samp ? (row - TPR) % 2048 : row % 256;
    const long krow = samp ? (long)(8192 + ((row - TPR) / 2048) * 2560 + tl) : (long)row;
    const bf16_t* base = P0 + (long)row * 2560;
    float cs = 1.f, sn = 0.f;
    if (samp) { float pos = (lane < 32) ? (float)(tl / 64) : (float)(tl % 64); float ang = pos * inv; cs = cosf(ang); sn = sinf(ang); }
#pragma unroll
    for (int hh = 0; hh < 6; ++hh) {
      float x1 = bf2f(base[hh * 128 + lane]), x2 = bf2f(base[hh * 128 + 64 + lane]);
      float ss = wave_sum(x1 * x1 + x2 * x2);
      float rs = rsqrtf(ss * (1.f / 128.f) + 1e-6f);
      const float* gw = hh < 4 ? qn : kn;
      float y1 = x1 * rs * gw[lane], y2 = x2 * rs * gw[64 + lane];
      if (hh >= 4 && !samp) { outK[(long)row * 256 + (hh - 4) * 128 + lane] = y1; outK[(long)row * 256 + (hh - 4) * 128 + 64 + lane] = y2; }
      float o1 = y1 * cs - y2 * sn, o2 = y1 * sn + y2 * cs;
      if (hh < 4) { QA[(long)row * 512 + hh * 128 + lane] = f2bf(o1); QA[(long)row * 512 + hh * 128 + 64 + lane] = f2bf(o2); }
      else { KA[krow * 256 + (hh - 4) * 128 + lane] = f2bf(o1); KA[krow * 256 + (hh - 4) * 128 + 64 + lane] = f2bf(o2); }
    }
    {
      u32x2 w = *(const u32x2*)(base + 768 + lane * 4);
      *(u32x2*)(VA + krow * 256 + lane * 4) = w;
      if (!samp) { float4 f = make_float4(bflo(w[0]), bfhi(w[0]), bflo(w[1]), bfhi(w[1])); *(float4*)(outV + (long)row * 256 + lane * 4) = f; }
    }
    {
      const int c8 = lane * 8;
      float uc[3][8];
#pragma unroll
      for (int g = 0; g < 3; ++g) {
        const int col = g * 512 + c8;
        float um[8], u0[8], up[8];
        u32x4 z4 = {0u, 0u, 0u, 0u};
        u32x4 wm = (tl > 0) ? *(const u32x4*)(base - 2560 + 1024 + col) : z4;
        u32x4 w0 = *(const u32x4*)(base + 1024 + col);
        u32x4 wp = (tl < L - 1) ? *(const u32x4*)(base + 2560 + 1024 + col) : z4;
        unpack8(wm, um); unpack8(w0, u0); unpack8(wp, up);
#pragma unroll
        for (int e = 0; e < 8; ++e)
          uc[g][e] = cw[col + e] * um[e] + cw[1536 + col + e] * u0[e] + cw[3072 + col + e] * up[e] + cb[col + e];
      }
      float vvv[8];
#pragma unroll
      for (int e = 0; e < 8; ++e) vvv[e] = uc[2][e] * uc[1][e];
      *(float4*)(VV + (long)row * 512 + c8) = make_float4(vvv[0], vvv[1], vvv[2], vvv[3]);
      *(float4*)(VV + (long)row * 512 + c8 + 4) = make_float4(vvv[4], vvv[5], vvv[6], vvv[7]);
      *(u32x4*)(X0 + (long)row * 512 + c8) = pack8(uc[0]);
    }
  }
}

constexpr int AD = 128, ANW = 8, QBLK = 32, KVBLK = 64;
constexpr float ASCALE = 0.088388347648318440f;
constexpr float ATHR = 8.f;
constexpr int LDQ = 512, LDK = 256, LDO = 1024;
constexpr size_t SHM_V = KVBLK * AD * 2, SHM_K = KVBLK * AD * 2;
#define KSWZ(row, colB) ((row) * 256 + ((colB) ^ (((row) & 7) << 4)))
#define SBAR() __builtin_amdgcn_sched_barrier(0)

__device__ __forceinline__ void partialSM(f32x16& p0, f32x16& p1, float& m_reg, float& mn, float& alpha) {
  constexpr float C = ASCALE * 1.4426950408889634f;
  float pmax = p0[0];
#pragma unroll
  for (int r = 1; r < 16; ++r) pmax = fmaxf(pmax, p0[r]);
#pragma unroll
  for (int r = 0; r < 16; ++r) pmax = fmaxf(pmax, p1[r]);
  { auto rr = __builtin_amdgcn_permlane32_swap(__float_as_uint(pmax), __float_as_uint(pmax), false, false);
    pmax = fmaxf(__uint_as_float(rr[0]), __uint_as_float(rr[1])); }
  if (__builtin_expect(__all(pmax - m_reg <= ATHR / ASCALE), 1)) { mn = m_reg; alpha = 1.f; }
  else { mn = fmaxf(m_reg, pmax); alpha = __builtin_amdgcn_exp2f((m_reg - mn) * C); m_reg = mn; }
  float mnC = -mn * C;
#pragma unroll
  for (int r = 0; r < 16; ++r) p0[r] = fmaf(p0[r], C, mnC);
#pragma unroll
  for (int r = 0; r < 16; ++r) p1[r] = fmaf(p1[r], C, mnC);
#pragma unroll
  for (int r = 0; r < 16; ++r) p0[r] = __builtin_amdgcn_exp2f(p0[r]);
}
__device__ __forceinline__ void finishSM(f32x16& p0, f32x16& p1, float alpha, float& l_reg, bf16x8& pa0, bf16x8& pa1, bf16x8& pa2, bf16x8& pa3) {
#pragma unroll
  for (int r = 0; r < 16; ++r) p1[r] = __builtin_amdgcn_exp2f(p1[r]);
  float ps = 0;
#pragma unroll
  for (int r = 0; r < 16; ++r) ps += p0[r];
#pragma unroll
  for (int r = 0; r < 16; ++r) ps += p1[r];
  { auto rr = __builtin_amdgcn_permlane32_swap(__float_as_uint(ps), __float_as_uint(ps), false, false);
    ps = __uint_as_float(rr[0]) + __uint_as_float(rr[1]); }
  l_reg = l_reg * alpha + ps;
#define PK4(P, BASE, OUT) do { unsigned a0 = cvtpk(P[BASE + 0], P[BASE + 1]), a1 = cvtpk(P[BASE + 2], P[BASE + 3]);   \
    unsigned b0 = cvtpk(P[BASE + 4], P[BASE + 5]), b1 = cvtpk(P[BASE + 6], P[BASE + 7]);                              \
    auto r0 = __builtin_amdgcn_permlane32_swap(a0, b0, false, false); auto r1 = __builtin_amdgcn_permlane32_swap(a1, b1, false, false); \
    u32x4 w = {r0[0], r1[0], r0[1], r1[1]}; OUT = *reinterpret_cast<bf16x8*>(&w); } while (0)
  PK4(p0, 0, pa0); PK4(p0, 8, pa1); PK4(p1, 0, pa2); PK4(p1, 8, pa3);
#undef PK4
}
__device__ __forceinline__ void qkt(f32x16& p0, f32x16& p1, const bf16_t* Ks, const bf16x8* qr, int r32, int hi) {
  p0 = f32x16{}; p1 = f32x16{};
#pragma unroll
  for (int d0 = 0; d0 < 8; ++d0) { int cb = (d0 * 16 + hi * 8) * 2;
    bf16x8 b0 = *reinterpret_cast<const bf16x8*>((const char*)Ks + KSWZ(r32, cb));
    bf16x8 b1 = *reinterpret_cast<const bf16x8*>((const char*)Ks + KSWZ(32 + r32, cb));
    p0 = __builtin_amdgcn_mfma_f32_32x32x16_bf16(b0, qr[d0], p0, 0, 0, 0);
    p1 = __builtin_amdgcn_mfma_f32_32x32x16_bf16(b1, qr[d0], p1, 0, 0, 0); }
}
__device__ __forceinline__ int v_st(int k, int c) { const int kk = (k & ~0xC) | ((k & 4) << 1) | ((k & 8) >> 1); return ((kk >> 3) * 4 + (c >> 5)) * 512 + ((kk & 7) * 32 + (c & 31)) * 2; }
__device__ __forceinline__ int v_rd_base(int lane) { return ((lane & 3) << 3) | (((lane >> 2) & 3) << 6) | (((lane >> 4) & 1) << 5) | (((lane >> 5) & 1) << 8); }
constexpr int v_rd_off(int d0, int ks, int half) { return d0 * 512 + ks * 4096 + half * 2048; }
template <int OFF> __device__ __forceinline__ s16x4 tr_read(int vb) {
  s16x4 r; asm volatile("ds_read_b64_tr_b16 %0, %1 offset:%2" : "=&v"(r) : "v"(vb), "i"(OFF) : "memory"); return r;
}
template <int D0> __device__ __forceinline__ void pv_one(f32x16& od, int vb, bf16x8 pa0, bf16x8 pa1, bf16x8 pa2, bf16x8 pa3) {
  const s16x4 l0 = tr_read<v_rd_off(D0, 0, 0)>(vb), h0 = tr_read<v_rd_off(D0, 0, 1)>(vb), l1 = tr_read<v_rd_off(D0, 1, 0)>(vb), h1 = tr_read<v_rd_off(D0, 1, 1)>(vb);
  const s16x4 l2 = tr_read<v_rd_off(D0, 2, 0)>(vb), h2 = tr_read<v_rd_off(D0, 2, 1)>(vb), l3 = tr_read<v_rd_off(D0, 3, 0)>(vb), h3 = tr_read<v_rd_off(D0, 3, 1)>(vb);
  asm volatile("s_waitcnt lgkmcnt(0)" ::: "memory"); SBAR();
#define PK(L, H) (bf16x8){L[0], L[1], L[2], L[3], H[0], H[1], H[2], H[3]}
  od = __builtin_amdgcn_mfma_f32_32x32x16_bf16(pa0, PK(l0, h0), od, 0, 0, 0);
  od = __builtin_amdgcn_mfma_f32_32x32x16_bf16(pa1, PK(l1, h1), od, 0, 0, 0);
  od = __builtin_amdgcn_mfma_f32_32x32x16_bf16(pa2, PK(l2, h2), od, 0, 0, 0);
  od = __builtin_amdgcn_mfma_f32_32x32x16_bf16(pa3, PK(l3, h3), od, 0, 0, 0);
#undef PK
}
__device__ __forceinline__ void pv_d0(f32x16* o, int vb, bf16x8 pa0, bf16x8 pa1, bf16x8 pa2, bf16x8 pa3) {
  pv_one<0>(o[0], vb, pa0, pa1, pa2, pa3); pv_one<1>(o[1], vb, pa0, pa1, pa2, pa3); pv_one<2>(o[2], vb, pa0, pa1, pa2, pa3); pv_one<3>(o[3], vb, pa0, pa1, pa2, pa3);
}

__device__ __forceinline__ void attn_dense_body(const int wv, const bf16_t* __restrict__ Qb, const bf16_t* __restrict__ Kh, const bf16_t* __restrict__ Vh,
                                                bf16_t* __restrict__ Ob, int seq, char* lds) {
  const int tidx = ltid(wv);
  const int tid = tidx, wid = wv, lane = tid & 63, r32 = lane & 31, hi = lane >> 5;
  bf16_t* V_lds = (bf16_t*)lds; bf16_t* K_lds = (bf16_t*)(lds + 2 * SHM_V);
  float* ws = (float*)(lds + 2 * SHM_V + 2 * SHM_K) + wid * 64; float* li_l = ws; float* al_l = ws + 32;
  float m_reg = -1e30f, l_reg = 0; f32x16 o[4] = {}; bf16x8 qr[8];
  const bf16_t* Qw = Qb + (long)(wid * QBLK + r32) * LDQ + hi * 8;
#pragma unroll
  for (int d0 = 0; d0 < 8; ++d0) qr[d0] = *reinterpret_cast<const bf16x8*>(Qw + d0 * 16);
  const int sr = tid >> 4, sc = (tid & 15) * 8, vst0 = v_st(sr, sc), vst1 = v_st(32 + sr, sc);
  const int vb0 = (int)(uintptr_t)V_lds + v_rd_base(lane);
  bf16x8 sA_vs0, sA_vs1, sA_ks0, sA_ks1, sB_vs0, sB_vs1, sB_ks0, sB_ks1;
#define SLOADA(k0) do { sA_vs0 = *(const bf16x8*)(&Vh[(long)((k0) + sr) * LDK + sc]); sA_vs1 = *(const bf16x8*)(&Vh[(long)((k0) + 32 + sr) * LDK + sc]); \
    sA_ks0 = *(const bf16x8*)(&Kh[(long)((k0) + sr) * LDK + sc]); sA_ks1 = *(const bf16x8*)(&Kh[(long)((k0) + 32 + sr) * LDK + sc]); } while (0)
#define SLOADB(k0) do { sB_vs0 = *(const bf16x8*)(&Vh[(long)((k0) + sr) * LDK + sc]); sB_vs1 = *(const bf16x8*)(&Vh[(long)((k0) + 32 + sr) * LDK + sc]); \
    sB_ks0 = *(const bf16x8*)(&Kh[(long)((k0) + sr) * LDK + sc]); sB_ks1 = *(const bf16x8*)(&Kh[(long)((k0) + 32 + sr) * LDK + sc]); } while (0)
#define SWRITEA(b) do { *(bf16x8*)((char*)V_lds + (b) * SHM_V + vst0) = sA_vs0; *(bf16x8*)((char*)V_lds + (b) * SHM_V + vst1) = sA_vs1; int kc = sc * 2; \
    *(bf16x8*)((char*)K_lds + (b) * SHM_K + KSWZ(sr, kc)) = sA_ks0; *(bf16x8*)((char*)K_lds + (b) * SHM_K + KSWZ(32 + sr, kc)) = sA_ks1; } while (0)
#define SWRITEB(b) do { *(bf16x8*)((char*)V_lds + (b) * SHM_V + vst0) = sB_vs0; *(bf16x8*)((char*)V_lds + (b) * SHM_V + vst1) = sB_vs1; int kc = sc * 2; \
    *(bf16x8*)((char*)K_lds + (b) * SHM_K + KSWZ(sr, kc)) = sB_ks0; *(bf16x8*)((char*)K_lds + (b) * SHM_K + KSWZ(32 + sr, kc)) = sB_ks1; } while (0)
#define SWAIT() asm volatile("s_waitcnt vmcnt(4)" ::: "memory")
#define RESC(a) do { if (__any((a) < 1.f)) { if (hi == 0) al_l[r32] = (a); asm volatile("s_waitcnt lgkmcnt(0)" ::: "memory"); \
    _Pragma("unroll") for (int d = 0; d < 4; ++d) _Pragma("unroll") for (int r = 0; r < 16; ++r) o[d][r] *= al_l[crow(r, hi)]; } } while (0)
  f32x16 pA0, pA1, pB0, pB1; float mnA, mnB, alA, alB; bf16x8 pa0, pa1, pa2, pa3; const int NT = seq / KVBLK;
  SLOADA(0); asm volatile("s_waitcnt vmcnt(0)" ::: "memory"); SWRITEA(0); __syncthreads();
  qkt(pA0, pA1, K_lds, qr, r32, hi); partialSM(pA0, pA1, m_reg, mnA, alA);
  SLOADB(KVBLK); if (2 < NT) SLOADA(2 * KVBLK);
  SWAIT(); SWRITEB(1); __syncthreads();
  for (int j = 1; j + 1 < NT; j += 2) {
    SBAR(); qkt(pB0, pB1, (bf16_t*)((char*)K_lds + SHM_K), qr, r32, hi);
    finishSM(pA0, pA1, alA, l_reg, pa0, pa1, pa2, pa3); SBAR();
    SLOADB((j + 2) * KVBLK); SBAR();
    pv_d0(o, vb0, pa0, pa1, pa2, pa3); partialSM(pB0, pB1, m_reg, mnB, alB);
    __syncthreads(); SWAIT(); SWRITEA(0);
    RESC(alB); __syncthreads();
    SBAR(); qkt(pA0, pA1, K_lds, qr, r32, hi);
    finishSM(pB0, pB1, alB, l_reg, pa0, pa1, pa2, pa3); SBAR();
    if (j + 3 < NT) SLOADA((j + 3) * KVBLK); SBAR();
    pv_d0(o, vb0 + (int)SHM_V, pa0, pa1, pa2, pa3); partialSM(pA0, pA1, m_reg, mnA, alA);
    __syncthreads(); SWAIT(); SWRITEB(1);
    RESC(alA); __syncthreads();
  }
  SBAR(); qkt(pB0, pB1, (bf16_t*)((char*)K_lds + SHM_K), qr, r32, hi);
  finishSM(pA0, pA1, alA, l_reg, pa0, pa1, pa2, pa3); SBAR();
  pv_d0(o, vb0, pa0, pa1, pa2, pa3); partialSM(pB0, pB1, m_reg, mnB, alB);
  __syncthreads(); RESC(alB);
  finishSM(pB0, pB1, alB, l_reg, pa0, pa1, pa2, pa3); SBAR();
  pv_d0(o, vb0 + (int)SHM_V, pa0, pa1, pa2, pa3);
  if (hi == 0) li_l[r32] = l_reg; asm volatile("s_waitcnt lgkmcnt(0)" ::: "memory");
  float rli[16];
#pragma unroll
  for (int r = 0; r < 16; ++r) rli[r] = __builtin_amdgcn_rcpf(li_l[crow(r, hi)]);
  bf16_t* Ow = Ob + (long)(wid * QBLK) * LDO;
#pragma unroll
  for (int r = 0; r < 16; ++r) { int orow = crow(r, hi);
#pragma unroll
    for (int d0 = 0; d0 < 4; ++d0) Ow[(long)orow * LDO + d0 * 32 + r32] = f2bf(o[d0][r] * rli[r]); }
#undef SLOADA
#undef SLOADB
#undef SWRITEA
#undef SWRITEB
#undef SWAIT
#undef RESC
}

__device__ __forceinline__ void hyena_item(const float* __restrict__ Fu, const float* __restrict__ Vu, const bf16_t* __restrict__ Xu,
                                           bf16_t* __restrict__ Au, int L, int t0, unsigned ln) {
  float y[16], ring[16];
#pragma unroll
  for (int i = 0; i < 16; ++i) { y[i] = 0.f; const float* fr = Fu + (long)(t0 + i + L - 1) * 512; ring[i] = fr[ln]; }
  const float* fp = Fu + (long)(t0 + L - 2) * 512;
  float va[16], fa[16], vb[16], fb[16];
#define HY_LOAD(V, Fq, S) _Pragma("unroll") for (int j = 0; j < 16; ++j) { const float* vr_ = Vu + (long)((S) + j) * 512; const float* fr_ = fp - (long)((S) + j) * 512; V[j] = vr_[ln]; Fq[j] = fr_[ln]; }
#define HY_STEP(V, Fq) _Pragma("unroll") for (int j = 0; j < 16; ++j) { const float vs = V[j]; \
    _Pragma("unroll") for (int i = 0; i < 16; ++i) y[i] += ring[(i - j) & 15] * vs; ring[(15 - j) & 15] = Fq[j]; }
  HY_LOAD(va, fa, 0)
  for (int s0 = 0; s0 < L; s0 += 32) {
    HY_LOAD(vb, fb, s0 + 16)
    HY_STEP(va, fa)
    if (s0 + 32 < L) { HY_LOAD(va, fa, s0 + 32) }
    HY_STEP(vb, fb)
  }
#undef HY_LOAD
#undef HY_STEP
#pragma unroll
  for (int i = 0; i < 16; ++i) {
    const bf16_t* xr = Xu + (long)(t0 + i) * 512; bf16_t* ar = Au + (long)(t0 + i) * 1024;
    ar[ln] = f2bf(y[i] * bf2f(xr[ln]));
  }
}

__device__ __forceinline__ void mix0_phase(const int wv, const Params& p, const int zq, const bf16_t* QA, const bf16_t* KA, const bf16_t* VA, const float* VV,
                                           const bf16_t* X0, const float* F256, const float* F2048, bf16_t* AO) {
  extern __shared__ __attribute__((aligned(16))) char shm_raw[];
#ifndef NO_ATTN
  for (int it = blockIdx.x; it < 192; it += gridDim.x) {
    long rowb, krow; int h, seqk;
    if (it < 64) { const int qb = it % 8, b = it / 32; h = (it / 8) % 4; rowb = 8192 + (long)b * 2048 + qb * 256; krow = 8192 + (long)b * 2560; seqk = 2560; }
    else { const int j = it - 64; const int b = j / 4; h = j % 4; rowb = (long)b * 256; krow = rowb; seqk = 256; }
    __syncthreads();
    attn_dense_body(wv, QA + rowb * 512 + h * 128, KA + krow * 256 + (h >> 1) * 128, VA + krow * 256 + (h >> 1) * 128, AO + rowb * 1024 + h * 128, seqk, shm_raw);
  }
#endif
#ifndef NO_HYENA
  const int lane = llane(); const int wid = wv;
  {
    unsigned* qctr = (unsigned*)(p.ws + WS_END) + 768;
    volatile int* sidx = (volatile int*)(shm_raw + 120000);
    for (;;) {
      __syncthreads();
      if (ltid(wv) == 0) *sidx = (int)__hip_atomic_fetch_add(qctr, 1u, __ATOMIC_RELAXED, __HIP_MEMORY_SCOPE_AGENT);
      __syncthreads();
      const int it = __builtin_amdgcn_readfirstlane(*sidx);
      if (it >= 768) break;
      if (it < 256) {
        const int b = it / 128, cgp = (it / 16) % 8, tg = it % 16;
        { const long rb = 8192 + (long)b * 2048; hyena_item(F2048 + cgp * 64, VV + rb * 512 + cgp * 64, X0 + rb * 512 + cgp * 64, AO + rb * 1024 + 512 + cgp * 64, 2048, tg * 128 + wid * 16, (unsigned)lane); }
      } else {
        const int jj = it - 256; const int b = jj / 16, cgp = (jj / 2) % 8, tg = jj % 2;
        { const long rb = (long)b * 256; hyena_item(F256 + cgp * 64, VV + rb * 512 + cgp * 64, X0 + rb * 512 + cgp * 64, AO + rb * 1024 + 512 + cgp * 64, 256, tg * 128 + wid * 16, (unsigned)lane); }
      }
    }
  }
#endif
  __syncthreads();
}

__device__ __forceinline__ float erf_as(float x) {
  const float ax = fabsf(x);
  const float t = __builtin_amdgcn_rcpf(fmaf(0.3275911f, ax, 1.f));
  float p = fmaf(1.061405429f, t, -1.453152027f);
  p = fmaf(p, t, 1.421413741f); p = fmaf(p, t, -0.284496736f); p = fmaf(p, t, 0.254829592f);
  const float r = 1.f - p * t * __expf(-ax * ax);
  return copysignf(r, x);
}
__device__ __forceinline__ float gelu_f(float x) { return 0.5f * x * (1.f + erf_as(x * 0.70710678118654752f)); }
__device__ __forceinline__ void ffn_act_phase(const int wv, const bf16_t* __restrict__ P, const float* __restrict__ cw, const float* __restrict__ cb, bf16_t* __restrict__ G) {
  const int tidx = ltid(wv);
  const int tid = tidx;
  if (tid >= 352) return;
  const int c8 = tid * 8;
  float w1[3][8], w2[3][8], b1[8], b2[8];
#pragma unroll
  for (int e = 0; e < 8; ++e) {
#pragma unroll
    for (int k = 0; k < 3; ++k) { w1[k][e] = cw[k * 5632 + c8 + e]; w2[k][e] = cw[k * 5632 + 2816 + c8 + e]; }
    b1[e] = cb[c8 + e]; b2[e] = cb[2816 + c8 + e];
  }
  for (int item = blockIdx.x; item < T_TOK / 16; item += gridDim.x) {
    const int r0 = item * 16;
    const int L = r0 < TPR ? 256 : 2048;
    const int tl0 = r0 < TPR ? r0 % 256 : (r0 - TPR) % 2048;
    float am[8], a0[8], ap[8], gm[8], g0[8], gp[8];
    const u32x4 z4 = {0u, 0u, 0u, 0u};
    {
      const bf16_t* b = P + (long)r0 * 5632 + c8;
      u32x4 x = (tl0 > 0) ? *(const u32x4*)(b - 5632) : z4; unpack8(x, am);
      x = (tl0 > 0) ? *(const u32x4*)(b - 5632 + 2816) : z4; unpack8(x, gm);
      x = *(const u32x4*)(b); unpack8(x, a0);
      x = *(const u32x4*)(b + 2816); unpack8(x, g0);
    }
    for (int r = 0; r < 16; ++r) {
      const bf16_t* b = P + (long)(r0 + r) * 5632 + c8;
      const bool vn = (tl0 + r) < L - 1;
      u32x4 x = vn ? *(const u32x4*)(b + 5632) : z4; unpack8(x, ap);
      x = vn ? *(const u32x4*)(b + 5632 + 2816) : z4; unpack8(x, gp);
      float o[8];
#pragma unroll
      for (int e = 0; e < 8; ++e) {
        float h1 = w1[0][e] * am[e] + w1[1][e] * a0[e] + w1[2][e] * ap[e] + b1[e];
        float h2 = w2[0][e] * gm[e] + w2[1][e] * g0[e] + w2[2][e] * gp[e] + b2[e];
        o[e] = gelu_f(h1) * h2;
        am[e] = a0[e]; a0[e] = ap[e]; gm[e] = g0[e]; g0[e] = gp[e];
      }
      *(u32x4*)(G + (long)(r0 + r) * 2816 + c8) = pack8(o);
    }
  }
}

template <int K>
__device__ __forceinline__ f32x16 mma_nt(const bf16_t* A, int lda, const bf16_t* B, int ldb, f32x16 acc, int r32, int hi) {
  bf16x8 a[K / 16], b[K / 16];
#pragma unroll
  for (int k0 = 0; k0 < K / 16; ++k0) {
    a[k0] = *reinterpret_cast<const bf16x8*>(A + r32 * lda + k0 * 16 + 8 * hi);
    b[k0] = *reinterpret_cast<const bf16x8*>(B + r32 * ldb + k0 * 16 + 8 * hi);
  }
#pragma unroll
  for (int k0 = 0; k0 < K / 16; ++k0) acc = __builtin_amdgcn_mfma_f32_32x32x16_bf16(a[k0], b[k0], acc, 0, 0, 0);
  return acc;
}

__device__ __forceinline__ void mlstm_phase(const int wv, const Params& p, const int zq, const bf16_t* __restrict__ P1, const float* __restrict__ GT,
                                            bf16_t* __restrict__ HF, bf16_t* __restrict__ HB) {
  const int tidx = ltid(wv);
  extern __shared__ __attribute__((aligned(16))) char shm_raw[];
  bf16_t* Qs = (bf16_t*)shm_raw;
  bf16_t* Ks = Qs + 64 * 136;
  bf16_t* KwT = Ks + 64 * 136;
  bf16_t* VsT = KwT + 128 * 72;
  bf16_t* Wb = VsT + 128 * 72;
  bf16_t* Cb = Wb + 64 * 72;
  float* gbuf = (float*)(Cb + 128 * 136);
  float* sclv = gbuf + 400; float* wintv = sclv + 64; float* nvec = wintv + 64;
  float* cwl = nvec + 128;
  const int tid = tidx, wid = wv, lane = tid & 63, r32 = lane & 31, hi = lane >> 5;
  const float* cw = p.in[zq + 35]; const float* cbias = p.in[zq + 36]; const float* bg = p.in[zq + 34];
  for (int u = blockIdx.x; u < 544; u += gridDim.x) {
    int seq, h, dir;
    if (u < 32) { seq = 32 + u / 16; h = (u / 2) % 8; dir = u % 2; } else { int j = u - 32; seq = j / 16; h = (j / 2) % 8; dir = j % 2; }
    const int L = seq < 32 ? 256 : 2048;
    const long rowbase = seq < 32 ? (long)seq * 256 : 8192 + (long)(seq - 32) * 2048;
    __syncthreads();
    f32x16 cacc[2]; float m = 0.f;
    const int vb2 = wid >> 1;
    if (seq >= 32) {
      const int b = seq - 32;
      const float* Cin = p.in[zq + 4] + (long)((b * 2 + dir) * 8 + h) * 16384;
#pragma unroll
      for (int i = 0; i < 2; ++i) { const int kb = (wid & 1) * 2 + i;
#pragma unroll
        for (int r = 0; r < 16; ++r) cacc[i][r] = Cin[(vb2 * 32 + crow(r, hi)) * 128 + kb * 32 + r32]; }
      if (tid < 128) nvec[tid] = p.in[zq + 5][((b * 2 + dir) * 8 + h) * 128 + tid];
      m = p.in[zq + 6][(b * 2 + dir) * 8 + h];
    } else {
#pragma unroll
      for (int i = 0; i < 2; ++i)
#pragma unroll
        for (int r = 0; r < 16; ++r) cacc[i][r] = 0.f;
      if (tid < 128) nvec[tid] = 0.f;
    }
#pragma unroll
    for (int i = 0; i < 2; ++i) { const int kb = (wid & 1) * 2 + i;
#pragma unroll
      for (int r = 0; r < 16; ++r) Cb[(vb2 * 32 + crow(r, hi)) * 136 + kb * 32 + r32] = f2bf(cacc[i][r]); }
    if (tid < 256) {
      const int col = (tid < 128) ? (h * 128 + tid) : (1024 + h * 128 + (tid - 128));
      cwl[tid] = cw[col]; cwl[256 + tid] = cw[2048 + col]; cwl[512 + tid] = cw[4096 + col]; cwl[768 + tid] = cbias[col];
    }
    const float bgi = bg[dir * 8 + h], bgf = bg[16 + dir * 8 + h];
    __syncthreads();
    const int nch = L / 64;
    u32x4 rq[2][3], rk[2][3], rv[2]; float g_i = 0.f, g_f = 0.f;
#define ML_LOADRAW(chn) do { \
      const int tcr_ = (chn) * 64 + lane; const int posr_ = dir ? (L - 1 - tcr_) : tcr_; \
      const bf16_t* rp_ = P1 + (rowbase + posr_) * 4096 + h * 128 + wv * 16; \
      const bool hm_ = posr_ > 0, hp_ = posr_ < L - 1; const u32x4 z4_ = {0u, 0u, 0u, 0u}; \
      _Pragma("unroll") for (int hf = 0; hf < 2; ++hf) { \
        rq[hf][0] = hm_ ? *(const u32x4*)(rp_ - 4096 + hf * 8) : z4_; rq[hf][1] = *(const u32x4*)(rp_ + hf * 8); \
        rq[hf][2] = hp_ ? *(const u32x4*)(rp_ + 4096 + hf * 8) : z4_; \
        rk[hf][0] = hm_ ? *(const u32x4*)(rp_ - 4096 + 1024 + hf * 8) : z4_; rk[hf][1] = *(const u32x4*)(rp_ + 1024 + hf * 8); \
        rk[hf][2] = hp_ ? *(const u32x4*)(rp_ + 4096 + 1024 + hf * 8) : z4_; \
        rv[hf] = *(const u32x4*)(rp_ + 2048 + hf * 8); } \
      if (wid == 7) { const float* gr_ = GT + (rowbase + posr_) * 32; g_i = gr_[dir * 8 + h]; g_f = gr_[16 + dir * 8 + h]; } \
    } while (0)
#define ML_GATES(setp, mval) do { float* av_ = gbuf + (setp) * 200; float* Mv_ = av_ + 64; float* bv_ = Mv_ + 64; float* scal_ = bv_ + 64; \
      const float ic_ = g_i + bgi; const float fp_ = g_f + bgf; \
      const float lf_ = fminf(fp_, 0.f) - __logf(1.f + __expf(-fabsf(fp_))); \
      float bc_ = lf_; \
      _Pragma("unroll") for (int off = 1; off < 64; off <<= 1) { float t_ = __shfl_up(bc_, off); if (lane >= off) bc_ += t_; } \
      const float a_ = ic_ - bc_; float pm_ = a_; \
      _Pragma("unroll") for (int off = 1; off < 64; off <<= 1) { float t_ = __shfl_up(pm_, off); if (lane >= off) pm_ = fmaxf(pm_, t_); } \
      const float M_ = fmaxf((mval), pm_); \
      av_[lane] = a_; Mv_[lane] = M_; bv_[lane] = bc_; if (lane == 63) { scal_[0] = M_; scal_[1] = bc_; } } while (0)
    ML_LOADRAW(0);
    if (wid == 7) ML_GATES(0, m);
    for (int ch = 0; ch < nch; ++ch) {
      float* av = gbuf + (ch & 1) * 200; float* Mv = av + 64; float* bv = Mv + 64; float* scal = bv + 64;
      float kf[16];
      {
        const int r = lane, c16 = wv * 16;
#pragma unroll
        for (int hf = 0; hf < 2; ++hf) {
          float um[8], u0[8], up[8], qf[8];
          { unpack8(rq[hf][0], um); unpack8(rq[hf][1], u0); unpack8(rq[hf][2], up);
#pragma unroll
            for (int e = 0; e < 8; ++e) { const int c = c16 + hf * 8 + e;
              qf[e] = silu_f(cwl[c] * um[e] + cwl[256 + c] * u0[e] + cwl[512 + c] * up[e] + cwl[768 + c]); }
            *(u32x4*)(Qs + r * 136 + c16 + hf * 8) = pack8(qf); }
          { unpack8(rk[hf][0], um); unpack8(rk[hf][1], u0); unpack8(rk[hf][2], up);
#pragma unroll
            for (int e = 0; e < 8; ++e) { const int c = 128 + c16 + hf * 8 + e;
              qf[e] = 0.088388347648318440f * silu_f(cwl[c] * um[e] + cwl[256 + c] * u0[e] + cwl[512 + c] * up[e] + cwl[768 + c]);
              kf[hf * 8 + e] = qf[e]; }
            *(u32x4*)(Ks + r * 136 + c16 + hf * 8) = pack8(qf); }
          { const u32x4 wv4 = rv[hf];
            bf16_t* vd = VsT + (c16 + hf * 8) * 72 + r;
            vd[0 * 72] = (bf16_t)(wv4[0] & 0xffff); vd[1 * 72] = (bf16_t)(wv4[0] >> 16);
            vd[2 * 72] = (bf16_t)(wv4[1] & 0xffff); vd[3 * 72] = (bf16_t)(wv4[1] >> 16);
            vd[4 * 72] = (bf16_t)(wv4[2] & 0xffff); vd[5 * 72] = (bf16_t)(wv4[2] >> 16);
            vd[6 * 72] = (bf16_t)(wv4[3] & 0xffff); vd[7 * 72] = (bf16_t)(wv4[3] >> 16); }
        }
      }
      if (ch + 1 < nch) ML_LOADRAW(ch + 1);
      __syncthreads();
      const float M63 = scal[0], b63 = scal[1];
      const float m_new = b63 + M63;
      const float w_state = __expf(m - M63);
      {
        const float wt = __expf(av[lane] - M63);
        bf16_t* kd = KwT + (wv * 16) * 72 + lane;
#pragma unroll
        for (int e = 0; e < 16; ++e) kd[e * 72] = f2bf(kf[e] * wt);
      }
      __syncthreads();
      if (wid == 7 && ch + 1 < nch) ML_GATES((ch + 1) & 1, m_new);
      const int tb = wid & 1, vb = wid >> 1;
      if (wid < 4) {
        const int sb = wid >> 1;
        f32x16 s = {};
        if (sb <= tb) { s = mma_nt<64>(Qs + tb * 32 * 136, 136, Ks + sb * 32 * 136, 136, s, r32, hi); s = mma_nt<64>(Qs + tb * 32 * 136 + 64, 136, Ks + sb * 32 * 136 + 64, 136, s, r32, hi); }
        const int sc = sb * 32 + r32; const float as = av[sc];
#pragma unroll
        for (int r = 0; r < 16; ++r) {
          const int t = tb * 32 + crow(r, hi);
          float w = (sc <= t) ? s[r] * __expf(as - Mv[t]) : 0.f;
          Wb[t * 72 + sc] = f2bf(w);
        }
      }
      f32x16 inter = {};
      inter = mma_nt<64>(Qs + tb * 32 * 136, 136, Cb + vb * 32 * 136, 136, inter, r32, hi); inter = mma_nt<64>(Qs + tb * 32 * 136 + 64, 136, Cb + vb * 32 * 136 + 64, 136, inter, r32, hi);
      __syncthreads();
      {
        const int t = tid >> 3, part = tid & 7;
        float wsum[8]; unpack8(*(const u32x4*)(Wb + t * 72 + part * 8), wsum);
        float dw = 0.f;
#pragma unroll
        for (int e = 0; e < 8; ++e) dw += wsum[e];
        float q0[8], q1[8]; unpack8(*(const u32x4*)(Qs + t * 136 + part * 16), q0); unpack8(*(const u32x4*)(Qs + t * 136 + part * 16 + 8), q1);
        float dq = 0.f;
#pragma unroll
        for (int e = 0; e < 8; ++e) dq += q0[e] * nvec[part * 16 + e] + q1[e] * nvec[part * 16 + 8 + e];
        dw += __shfl_xor(dw, 1); dw += __shfl_xor(dw, 2); dw += __shfl_xor(dw, 4);
        dq += __shfl_xor(dq, 1); dq += __shfl_xor(dq, 2); dq += __shfl_xor(dq, 4);
        if (part == 0) {
          const float Mt = Mv[t];
          const float wint = __expf(m - Mt);
          const float den = wint * dq + dw;
          const float mt = bv[t] + Mt;
          sclv[t] = 1.f / fmaxf(fabsf(den), __expf(-mt));
          wintv[t] = wint;
        }
      }
      __syncthreads();
      {
        f32x16 num;
#pragma unroll
        for (int r = 0; r < 16; ++r) num[r] = inter[r] * wintv[tb * 32 + crow(r, hi)];
        num = mma_nt<64>(Wb + tb * 32 * 72, 72, VsT + vb * 32 * 72, 72, num, r32, hi);
        bf16_t* Hout = dir ? HB : HF;
#pragma unroll
        for (int r = 0; r < 16; ++r) {
          const int t = tb * 32 + crow(r, hi);
          const int tc = ch * 64 + t; const int pos = dir ? (L - 1 - tc) : tc;
          Hout[(rowbase + pos) * 1024 + h * 128 + vb * 32 + r32] = f2bf(num[r] * sclv[t]);
        }
      }
#pragma unroll
      for (int i = 0; i < 2; ++i) {
        const int kb = (wid & 1) * 2 + i;
#pragma unroll
        for (int r = 0; r < 16; ++r) cacc[i][r] *= w_state;
        cacc[i] = mma_nt<64>(VsT + vb2 * 32 * 72, 72, KwT + kb * 32 * 72, 72, cacc[i], r32, hi);
#pragma unroll
        for (int r = 0; r < 16; ++r) Cb[(vb2 * 32 + crow(r, hi)) * 136 + kb * 32 + r32] = f2bf(cacc[i][r]);
      }
      if (tid < 128) {
        float s = 0.f;
#pragma unroll
        for (int q = 0; q < 8; ++q) { float f[8]; unpack8(*(const u32x4*)(KwT + tid * 72 + q * 8), f);
#pragma unroll
          for (int e = 0; e < 8; ++e) s += f[e]; }
        nvec[tid] = w_state * nvec[tid] + s;
      }
      m = m_new;
      __syncthreads();
    }
    if (seq < 32) {
      float* Co = p.out + O_C + (long)((seq * 2 + dir) * 8 + h) * 16384;
#pragma unroll
      for (int i = 0; i < 2; ++i) { const int kb = (wid & 1) * 2 + i;
#pragma unroll
        for (int r = 0; r < 16; ++r) Co[(vb2 * 32 + crow(r, hi)) * 128 + kb * 32 + r32] = cacc[i][r]; }
      if (tid < 128) p.out[O_N + ((seq * 2 + dir) * 8 + h) * 128 + tid] = nvec[tid];
      if (tid == 0) p.out[O_M + (seq * 2 + dir) * 8 + h] = m;
    }
  }
  __syncthreads();
}

#undef ML_LOADRAW
#undef ML_GATES
__device__ __forceinline__ void mlstm_post(const int wv, const Params& p, const int zq, const bf16_t* __restrict__ HF, const bf16_t* __restrict__ HB,
                                           const bf16_t* __restrict__ P1, bf16_t* __restrict__ A) {
  const int tidx = ltid(wv);
  const int wid = wv, lane = tidx & 63;
  const float* hn = p.in[zq + 37];
  for (int row = blockIdx.x * 8 + wid; row < T_TOK; row += gridDim.x * 8) {
    float hv[16], t0[8], t1[8];
    unpack8(*(const u32x4*)(HF + (long)row * 1024 + lane * 16), hv); unpack8(*(const u32x4*)(HF + (long)row * 1024 + lane * 16 + 8), hv + 8);
    unpack8(*(const u32x4*)(HB + (long)row * 1024 + lane * 16), t0); unpack8(*(const u32x4*)(HB + (long)row * 1024 + lane * 16 + 8), t1);
    float ss = 0.f;
#pragma unroll
    for (int e = 0; e < 8; ++e) { hv[e] += t0[e]; hv[8 + e] += t1[e]; }
#pragma unroll
    for (int e = 0; e < 16; ++e) ss += hv[e] * hv[e];
    ss += __shfl_xor(ss, 1); ss += __shfl_xor(ss, 2); ss += __shfl_xor(ss, 4);
    const float rs = rsqrtf(ss * (1.f / 128.f) + 1e-6f);
    float ov[16];
    unpack8(*(const u32x4*)(P1 + (long)row * 4096 + 3072 + lane * 16), ov); unpack8(*(const u32x4*)(P1 + (long)row * 4096 + 3072 + lane * 16 + 8), ov + 8);
    float y[16];
#pragma unroll
    for (int e = 0; e < 16; ++e) y[e] = hv[e] * rs * hn[lane * 16 + e] * (1.f / (1.f + __expf(-ov[e])));
    *(u32x4*)(A + (long)row * 1024 + lane * 16) = pack8(y);
    *(u32x4*)(A + (long)row * 1024 + lane * 16 + 8) = pack8(y + 8);
  }
}

__device__ __forceinline__ void gsync(const int wv, unsigned* bar, const unsigned k) {
  const int tidx = ltid(wv);
  asm volatile("s_waitcnt vmcnt(0)" ::: "memory");
  __syncthreads();
  if (tidx == 0) {
    __builtin_amdgcn_fence(__ATOMIC_RELEASE, "agent");
    asm volatile("s_waitcnt vmcnt(0)" ::: "memory");
    const unsigned g = blockIdx.x & 7u;
    const unsigned ng = (gridDim.x + 7u - g) >> 3;
    const unsigned ngroups = gridDim.x < 8u ? gridDim.x : 8u;
    const unsigned old = __hip_atomic_fetch_add(bar + g * 32, 1u, __ATOMIC_RELAXED, __HIP_MEMORY_SCOPE_AGENT);
    if (old + 1u == k * ng) {
      const unsigned o2 = __hip_atomic_fetch_add(bar + 256, 1u, __ATOMIC_RELAXED, __HIP_MEMORY_SCOPE_AGENT);
      if (o2 + 1u == k * ngroups) {
#pragma unroll
        for (int q = 0; q < 8; ++q) __hip_atomic_store(bar + 512 + q * 32, k, __ATOMIC_RELAXED, __HIP_MEMORY_SCOPE_AGENT);
      }
    }
    while (__hip_atomic_load(bar + 512 + g * 32, __ATOMIC_RELAXED, __HIP_MEMORY_SCOPE_AGENT) < k) __builtin_amdgcn_s_sleep(4);
    __builtin_amdgcn_fence(__ATOMIC_ACQUIRE, "agent");
    asm volatile("s_waitcnt vmcnt(0)" ::: "memory");
  }
  __syncthreads();
}

__global__ void __launch_bounds__(512) mega(Params p, int ph_lo, int ph_hi) {
  const int wv = __builtin_amdgcn_readfirstlane(threadIdx.x >> 6);
  if (ph_hi < 0) { cg::this_grid().sync(); }
  unsigned* bar = (unsigned*)(p.ws + WS_END);
  char* ws = p.ws;
  bf16_t* Wt_in0 = (bf16_t*)(ws + OFF_WIN0); bf16_t* Wt_out0 = (bf16_t*)(ws + OFF_WOUT0);
  bf16_t* Wt_up0 = (bf16_t*)(ws + OFF_WUP0); bf16_t* Wt_up1 = (bf16_t*)(ws + OFF_WUP1);
  bf16_t* Wt_dn0 = (bf16_t*)(ws + OFF_WDN0); bf16_t* Wt_dn1 = (bf16_t*)(ws + OFF_WDN1);
  bf16_t* Wt_in1 = (bf16_t*)(ws + OFF_WIN1); bf16_t* Wt_out1 = (bf16_t*)(ws + OFF_WOUT1);
  float* modv = (float*)(ws + OFF_MOD);
  char* Pr = ws + OFF_P; char* Gr = ws + OFF_G;
  bf16_t* Pb = (bf16_t*)Pr; bf16_t* R = (bf16_t*)Pr;
  bf16_t* QA = (bf16_t*)(Pr + P_QA); bf16_t* KA = (bf16_t*)(Pr + P_KA); bf16_t* VA = (bf16_t*)(Pr + P_VA); bf16_t* X0 = (bf16_t*)(Pr + P_X0);
  float* GT = (float*)(Pr + P_GT); bf16_t* A2 = (bf16_t*)(Pr + P_A2);
  bf16_t* A = (bf16_t*)Gr; bf16_t* Gb = (bf16_t*)Gr; float* VV = (float*)(Gr + G_VV);
  bf16_t* HF = (bf16_t*)Gr; bf16_t* HB = (bf16_t*)(Gr + G_HB);
  float* X = p.out;
  float* F256 = p.out + O_C + 512; float* F2048 = p.out + O_C + 512 * 512 + 512;
  const float* mod0 = modv; const float* mod1 = modv + 3 * 6144;
  unsigned bk = 0;
#define PH(i, ...) if (ph_lo <= (i) && (i) < ph_hi) { const int zq = opq(); __VA_ARGS__; if ((i) + 1 < ph_hi) gsync(wv, bar, ++bk); }
  PH(0, {
    conv_w(wv, p.in[zq + 19], Wt_in0, 1024, 2560, 2560);
    conv_w(wv, p.in[zq + 20], Wt_out0, 1024, 1024, 1024);
    conv_w(wv, p.in[zq + 15], Wt_up0, 1024, 5632, 5632);
    conv_w(wv, p.in[zq + 15] + (long)1024 * 5632, Wt_up1, 1024, 5632, 5632);
    conv_w(wv, p.in[zq + 18], Wt_dn0, 2816, 1024, 1024);
    conv_w(wv, p.in[zq + 18] + (long)2816 * 1024, Wt_dn1, 2816, 1024, 1024);
    conv_w(wv, p.in[zq + 33], Wt_in1, 1024, 4128, 4352);
    conv_w(wv, p.in[zq + 38], Wt_out1, 1024, 1024, 1024);
    mod_phase(wv, p, zq, modv);
    filt_phase(wv, p, zq, F256, F2048);
  })
  PH(1, (row_phase<true, false, true>(wv, p, zq, nullptr, nullptr, mod0, 0, nullptr, p.in[zq + 11], mod0, 0, A)))
  PH(2, (gemm_phase<0, 2560>(wv, A, Wt_in0, 2560, 1024, Pb, nullptr)))
  PH(3, post_inproj0(wv, p, zq, Pb, QA, KA, VA, VV, X0))
  PH(4, mix0_phase(wv, p, zq, QA, KA, VA, VV, X0, F256, F2048, A))
  PH(5, (gemm_phase<0, 1024>(wv, A, Wt_out0, 1024, 1024, R, nullptr)))
  PH(6, (row_phase<true, true, true>(wv, p, zq, R, p.in[zq + 12], mod0, 2, X, p.in[zq + 13], mod0, 3, A)))
  PH(7, (gemm_phase<0, 5632>(wv, A, Wt_up0, 5632, 1024, Pb, nullptr)))
  PH(8, ffn_act_phase(wv, Pb, p.in[zq + 16], p.in[zq + 17], Gb))
  PH(9, (gemm_phase<0, 1024>(wv, Gb, Wt_dn0, 1024, 2816, R, nullptr)))
  PH(10, (row_phase<false, true, true>(wv, p, zq, R, p.in[zq + 14], mod0, 5, X, p.in[zq + 11] + 1024, mod1, 0, A)))
  PH(11, (gemm_phase<2, 4096>(wv, A, Wt_in1, 4352, 1024, Pb, GT)))
  PH(13, mlstm_phase(wv, p, zq, Pb, GT, HF, HB))
  PH(14, mlstm_post(wv, p, zq, HF, HB, Pb, A2))
  PH(15, (gemm_phase<0, 1024>(wv, A2, Wt_out1, 1024, 1024, R, nullptr)))
  PH(16, (row_phase<false, true, true>(wv, p, zq, R, p.in[zq + 12] + 1024, mod1, 2, X, p.in[zq + 13] + 1024, mod1, 3, A)))
  PH(17, (gemm_phase<0, 5632>(wv, A, Wt_up1, 5632, 1024, Pb, nullptr)))
  PH(18, ffn_act_phase(wv, Pb, p.in[zq + 16] + 3 * 5632, p.in[zq + 17] + 5632, Gb))
  PH(19, (gemm_phase<0, 1024>(wv, Gb, Wt_dn1, 1024, 2816, R, nullptr)))
  PH(20, (row_phase<false, true, false>(wv, p, zq, R, p.in[zq + 14] + 1024, mod1, 5, X, nullptr, mod1, 0, nullptr)))
#undef PH
}

extern "C" void kernel_launch(void* const* d_in, const int* in_sizes, int n_in, void* d_out, int out_size, void* d_ws, size_t ws_size,
                              hipStream_t stream) {
  static int grid_blocks = 0;
  if (!grid_blocks) {
    if (ws_size < WS_END + 4096) fprintf(stderr, "kernel_launch: workspace too small: %zu < %zu\n", ws_size, (size_t)WS_END);
    hipFuncSetAttribute((const void*)mega, hipFuncAttributeMaxDynamicSharedMemorySize, LDS_BYTES);
    int dev = 0, cus = 0, per = 0;
    hipGetDevice(&dev);
    hipDeviceGetAttribute(&cus, hipDeviceAttributeMultiprocessorCount, dev);
    hipOccupancyMaxActiveBlocksPerMultiprocessor(&per, mega, 512, LDS_BYTES);
    if (per < 1) { fprintf(stderr, "kernel_launch: occupancy query returned %d\n", per); per = 1; }
    grid_blocks = cus;
  }
  Params p{};
  for (int i = 0; i < 39; ++i) p.in[i] = (const float*)d_in[i];
  p.out = (float*)d_out; p.ws = (char*)d_ws;
  int lo = 0, hi = NPH;
  (void)hipMemsetAsync((char*)d_ws + WS_END, 0, 4096, stream);
  void* args[] = {&p, &lo, &hi};
  hipError_t e = hipLaunchCooperativeKernel((void*)mega, dim3(grid_blocks), dim3(512), args, LDS_BYTES, stream);
  if (e != hipSuccess) fprintf(stderr, "cooperative launch failed: %s (grid %d)\n", hipGetErrorString(e), grid_blocks);
}
```

```cpp
#include <hip/hip_runtime.h>
#include <hip/hip_cooperative_groups.h>
#include <cstdio>
#include <cstdint>
namespace cg = cooperative_groups;

typedef unsigned short bf16_t;
typedef short bf16x8 __attribute__((ext_vector_type(8)));
typedef short s16x4 __attribute__((ext_vector_type(4)));
typedef float f32x4 __attribute__((ext_vector_type(4)));
typedef float f32x8 __attribute__((ext_vector_type(8)));
typedef float f32x16 __attribute__((ext_vector_type(16)));
typedef unsigned u32x4 __attribute__((ext_vector_type(4)));
typedef unsigned u32x2 __attribute__((ext_vector_type(2)));

constexpr int T_TOK = 12288, TPR = 8192;
constexpr int LDS_BYTES = 131072;
constexpr int NPH = 21;

constexpr size_t OFF_WIN0 = 0, OFF_WOUT0 = 5242880, OFF_WUP0 = 7340032, OFF_WUP1 = 18874368, OFF_WDN0 = 30408704,
                 OFF_WDN1 = 36175872, OFF_WIN1 = 41943040, OFF_WOUT1 = 50855936, OFF_MOD = 52953088, OFF_P = 53100544,
                 OFF_G = 191512576, WS_END = 260718592;
constexpr size_t P_QA = 62914560, P_KA = 75497472, P_VA = 82313216, P_X0 = 89128960;
constexpr size_t P_GT = 100663296, P_A2 = 102236160;
constexpr size_t G_VV = 25165824, G_HB = 25165824;
constexpr size_t O_K = 12582912, O_V = 14680064, O_C = 16777216, O_N = 25165824, O_M = 25231360;

struct Params { const float* in[39]; float* out; char* ws; };

typedef __bf16 nbf16x2 __attribute__((ext_vector_type(2)));
typedef float nf32x2 __attribute__((ext_vector_type(2)));
__device__ __forceinline__ unsigned cvtpk(float lo, float hi) {
  nf32x2 v = {lo, hi};
  nbf16x2 b = __builtin_convertvector(v, nbf16x2);
  return __builtin_bit_cast(unsigned, b);
}
__device__ __forceinline__ bf16_t f2bf(float f) { return (bf16_t)(cvtpk(f, 0.f) & 0xffffu); }
__device__ __forceinline__ float bf2f(bf16_t h) { return __uint_as_float(((unsigned)h) << 16); }
__device__ __forceinline__ float bflo(unsigned w) { return __uint_as_float(w << 16); }
__device__ __forceinline__ float bfhi(unsigned w) { return __uint_as_float(w & 0xffff0000u); }
__device__ __forceinline__ float wave_sum(float v) {
#pragma unroll
  for (int o = 32; o > 0; o >>= 1) v += __shfl_xor(v, o);
  return v;
}
__device__ __forceinline__ int llane() { int l; asm volatile("v_mbcnt_lo_u32_b32 %0, -1, 0\n\tv_mbcnt_hi_u32_b32 %0, -1, %0" : "=v"(l)); return l; }
__device__ __forceinline__ int ltid(int wv) { return (wv << 6) | llane(); }
__device__ __forceinline__ int opq() { int z; asm volatile("s_mov_b32 %0, 0" : "=s"(z)); return z; }
__device__ __forceinline__ float silu_f(float x) { return x * __builtin_amdgcn_rcpf(1.f + __expf(-x)); }
__device__ __forceinline__ int crow(int r, int hi) { return (r & 3) + 8 * (r >> 2) + 4 * hi; }
__device__ __forceinline__ void unpack8(u32x4 w, float* f) {
  f[0] = bflo(w[0]); f[1] = bfhi(w[0]); f[2] = bflo(w[1]); f[3] = bfhi(w[1]);
  f[4] = bflo(w[2]); f[5] = bfhi(w[2]); f[6] = bflo(w[3]); f[7] = bfhi(w[3]);
}
__device__ __forceinline__ u32x4 pack8(const float* f) {
  u32x4 w = {cvtpk(f[0], f[1]), cvtpk(f[2], f[3]), cvtpk(f[4], f[5]), cvtpk(f[6], f[7])}; return w;
}

__device__ __forceinline__ void conv_w(const int wv, const float* __restrict__ W, bf16_t* __restrict__ Wt, int K, int N, int NP) {
  const int tidx = ltid(wv);
  extern __shared__ __attribute__((aligned(16))) char shm_raw[];
  float* tl = (float*)shm_raw;
  const int tid = tidx;
  const int ntn = NP / 64, ntiles = (K / 64) * ntn;
  for (int tile = blockIdx.x; tile < ntiles; tile += gridDim.x) {
    const int k0 = (tile / ntn) * 64, n0 = (tile % ntn) * 64;
    __syncthreads();
#pragma unroll
    for (int i = 0; i < 2; ++i) {
      int kr = (tid >> 4) + 32 * i, nc = (tid & 15) * 4;
      float4 v = make_float4(0.f, 0.f, 0.f, 0.f);
      if (n0 + nc < N) v = *(const float4*)(W + (long)(k0 + kr) * N + n0 + nc);
      float* d = tl + kr * 65 + nc; d[0] = v.x; d[1] = v.y; d[2] = v.z; d[3] = v.w;
    }
    __syncthreads();
    {
      int n = tid >> 3, kg = (tid & 7) * 8;
      u32x4 w;
      w[0] = cvtpk(tl[(kg + 0) * 65 + n], tl[(kg + 1) * 65 + n]);
      w[1] = cvtpk(tl[(kg + 2) * 65 + n], tl[(kg + 3) * 65 + n]);
      w[2] = cvtpk(tl[(kg + 4) * 65 + n], tl[(kg + 5) * 65 + n]);
      w[3] = cvtpk(tl[(kg + 6) * 65 + n], tl[(kg + 7) * 65 + n]);
      *(u32x4*)(Wt + (long)(n0 + n) * K + k0 + kg) = w;
    }
  }
  __syncthreads();
}

__device__ __forceinline__ void mod_phase(const int wv, const Params& p, const int zq, float* modv) {
  const int tidx = ltid(wv);
  extern __shared__ __attribute__((aligned(16))) char shm_raw[];
  float* red = (float*)shm_raw;
  const int tid = tidx;
  const float* cvec = p.in[zq + 7]; const float* cctx = p.in[zq + 8]; const float* bmod = p.in[zq + 10];
  for (int item = blockIdx.x; item < 192; item += gridDim.x) {
    const int l = item / 96, cb = (item % 96) * 64;
    const float* W = p.in[zq + 9] + (long)l * 1024 * 6144;
    const int cl = tid & 15, kg = tid >> 4;
    float a0[4] = {0, 0, 0, 0}, a1[4] = {0, 0, 0, 0}, a2[4] = {0, 0, 0, 0};
#pragma unroll 8
    for (int i = 0; i < 32; ++i) {
      int k = kg + 32 * i;
      float4 w = *(const float4*)(W + (long)k * 6144 + cb + cl * 4);
      float s0 = silu_f(cctx[k]), s1 = silu_f(cvec[k]), s2 = silu_f(cvec[1024 + k]);
      a0[0] += s0 * w.x; a0[1] += s0 * w.y; a0[2] += s0 * w.z; a0[3] += s0 * w.w;
      a1[0] += s1 * w.x; a1[1] += s1 * w.y; a1[2] += s1 * w.z; a1[3] += s1 * w.w;
      a2[0] += s2 * w.x; a2[1] += s2 * w.y; a2[2] += s2 * w.z; a2[3] += s2 * w.w;
    }
    __syncthreads();
#pragma unroll
    for (int j = 0; j < 4; ++j) {
      red[kg * 192 + 0 * 64 + cl * 4 + j] = a0[j];
      red[kg * 192 + 1 * 64 + cl * 4 + j] = a1[j];
      red[kg * 192 + 2 * 64 + cl * 4 + j] = a2[j];
    }
    __syncthreads();
    if (tid < 192) {
      float s = 0.f;
#pragma unroll 8
      for (int q = 0; q < 32; ++q) s += red[q * 192 + tid];
      int g = tid / 64, col = cb + (tid % 64);
      modv[(l * 3 + g) * 6144 + col] = s + bmod[l * 6144 + col];
    }
  }
  __syncthreads();
}

__device__ __forceinline__ void filt_phase(const int wv, const Params& p, const int zq, float* F256, float* F2048) {
  const int tidx = ltid(wv);
  extern __shared__ __attribute__((aligned(16))) char shm_raw[];
  float* z = (float*)shm_raw;
  float* h1 = z + 256;
  float* h2 = h1 + 512;
  const int tid = tidx;
  const float *w1 = p.in[zq + 25], *b1 = p.in[zq + 26], *w2 = p.in[zq + 27], *b2 = p.in[zq + 28], *w3 = p.in[zq + 29], *b3 = p.in[zq + 30], *sf = p.in[zq + 31], *skip = p.in[zq + 32];
  const float DMAX = -15.350567286626973f, DMIN = -3.0701134573253946f;
  for (int item = blockIdx.x; item < 288; item += gridDim.x) {
    const int L = item < 32 ? 256 : 2048; const int i0 = item < 32 ? item * 8 : (item - 32) * 8;
    float* F = item < 32 ? F256 : F2048;
    __syncthreads();
    if (tid < 136) {
      const int q = tid / 17, f = tid % 17;
      const float t = (float)(i0 + q) / (float)(L - 1);
      float v;
      if (f == 0) v = t;
      else if (f <= 8) v = cosf(6.283185307179586f * t * (float)f);
      else v = sinf(6.283185307179586f * t * (float)(f - 8));
      z[q * 32 + f] = v;
    }
    __syncthreads();
    { const int q = tid >> 6, u = tid & 63; float a = b1[u];
#pragma unroll 1
      for (int jj = 0; jj < 17; ++jj) a += z[q * 32 + jj] * w1[jj * 64 + u];
      h1[q * 64 + u] = sinf(sf[u] * a); }
    __syncthreads();
    { const int q = tid >> 6, u = tid & 63; float a = b2[u];
#pragma unroll 8
      for (int jj = 0; jj < 64; ++jj) a += h1[q * 64 + jj] * w2[jj * 64 + u];
      h2[q * 64 + u] = sinf(sf[64 + u] * a); }
    __syncthreads();
    {
      const int ch = tid;
      float af[8], ab[8];
#pragma unroll
      for (int q = 0; q < 8; ++q) { af[q] = b3[ch]; ab[q] = b3[512 + ch]; }
#pragma unroll 4
      for (int jj = 0; jj < 64; ++jj) {
        const float wa = w3[jj * 1024 + ch], wb = w3[jj * 1024 + 512 + ch];
#pragma unroll
        for (int q = 0; q < 8; ++q) { const float hh = h2[q * 64 + jj]; af[q] += hh * wa; ab[q] += hh * wb; }
      }
      const float delta = fabsf(DMIN + (DMAX - DMIN) * ((float)ch / 511.f));
#pragma unroll
      for (int q = 0; q < 8; ++q) {
        const int i = i0 + q;
        const float t = (float)i / (float)(L - 1);
        const float win = expf(-t * delta);
        const float sfw = af[q] * win, sbw = ab[q] * win;
        if (i == 0) F[(long)(L - 1) * 512 + ch] = sfw + sbw + skip[ch];
        else { F[(long)(L - 1 + i) * 512 + ch] = sfw; F[(long)(L - 1 - i) * 512 + ch] = sbw; }
      }
    }
  }
  __syncthreads();
}

template <bool FROM_IN, bool HAS_R, bool HAS_A>
__device__ __forceinline__ void row_phase(const int wv, const Params& p, const int zq, const bf16_t* __restrict__ R, const float* __restrict__ postg,
                                          const float* __restrict__ modg, int gate_m, float* X,
                                          const float* __restrict__ preg, const float* __restrict__ mods, int shift_m, bf16_t* __restrict__ A) {
  const int tidx = ltid(wv);
  const int wid = wv, lane = tidx & 63;
  for (int row = blockIdx.x * 8 + wid; row < T_TOK; row += gridDim.x * 8) {
    const int g = row < TPR ? 0 : 1 + (row - TPR) / 2048;
    const float* mg = modg + g * 6144;
    const float* ms = mods + g * 6144;
    const float* xin = FROM_IN ? (row < TPR ? p.in[zq + 0] + (long)row * 1024 : p.in[zq + 1] + (long)(row - TPR) * 1024) : (const float*)X + (long)row * 1024;
    float4 x[4];
#pragma unroll
    for (int j = 0; j < 4; ++j) x[j] = *(const float4*)(xin + j * 256 + lane * 4);
    if (HAS_R) {
      float4 r[4]; float ss = 0.f;
#pragma unroll
      for (int j = 0; j < 4; ++j) { const u32x2 rw = *(const u32x2*)(R + (long)row * 1024 + j * 256 + lane * 4); r[j] = make_float4(bflo(rw[0]), bfhi(rw[0]), bflo(rw[1]), bfhi(rw[1])); ss += r[j].x * r[j].x + r[j].y * r[j].y + r[j].z * r[j].z + r[j].w * r[j].w; }
      ss = wave_sum(ss); const float rs = rsqrtf(ss * (1.f / 1024.f) + 1e-6f);
#pragma unroll
      for (int j = 0; j < 4; ++j) {
        float4 pg = *(const float4*)(postg + j * 256 + lane * 4);
        float4 gt = *(const float4*)(mg + gate_m * 1024 + j * 256 + lane * 4);
        x[j].x += gt.x * (r[j].x * rs * pg.x); x[j].y += gt.y * (r[j].y * rs * pg.y);
        x[j].z += gt.z * (r[j].z * rs * pg.z); x[j].w += gt.w * (r[j].w * rs * pg.w);
        *(float4*)(X + (long)row * 1024 + j * 256 + lane * 4) = x[j];
      }
    }
    if (HAS_A) {
      float ss = 0.f;
#pragma unroll
      for (int j = 0; j < 4; ++j) ss += x[j].x * x[j].x + x[j].y * x[j].y + x[j].z * x[j].z + x[j].w * x[j].w;
      ss = wave_sum(ss); const float rs = rsqrtf(ss * (1.f / 1024.f) + 1e-6f);
#pragma unroll
      for (int j = 0; j < 4; ++j) {
        float4 pg = *(const float4*)(preg + j * 256 + lane * 4);
        float4 sh = *(const float4*)(ms + shift_m * 1024 + j * 256 + lane * 4);
        float4 sc = *(const float4*)(ms + (shift_m + 1) * 1024 + j * 256 + lane * 4);
        float y0 = x[j].x * rs * pg.x * (1.f + sc.x) + sh.x, y1 = x[j].y * rs * pg.y * (1.f + sc.y) + sh.y;
        float y2 = x[j].z * rs * pg.z * (1.f + sc.z) + sh.z, y3 = x[j].w * rs * pg.w * (1.f + sc.w) + sh.w;
        u32x2 w = {cvtpk(y0, y1), cvtpk(y2, y3)};
        *(u32x2*)(A + (long)row * 1024 + j * 256 + lane * 4) = w;
      }
    }
  }
}

constexpr int BM = 256, BK = 64, HALF = 128, WGM = 8, HT = HALF * BK;
__device__ __forceinline__ int lds_byte(int r, int c) {
  int st = (r >> 4) * 2 + (c >> 5), rr = r & 15, cc = c & 31, ob = rr * 64 + cc * 2;
  return st * 1024 + (ob ^ (((ob >> 9) & 1) << 5));
}
__device__ __forceinline__ void stage_rc(int b, int& R, int& C) {
  int st = b / 1024, sb = b % 1024, swz = sb ^ (((sb >> 9) & 1) << 5);
  R = (st >> 1) * 16 + swz / 64; C = (st & 1) * 32 + (swz % 64) / 2;
}

template <int MODE, int LDC>
__device__ __forceinline__ void gemm_phase(const int wv, const bf16_t* __restrict__ A, const bf16_t* __restrict__ Bt, int N, int K,
                                           void* Cout, float* GT) {
  const int tidx = ltid(wv);
  extern __shared__ __attribute__((aligned(16))) char shm_raw[];
  bf16_t* shm = (bf16_t*)shm_raw;
#define SA(b, h) (shm + ((b) * 2 + (h)) * HT)
#define SB(b, h) (shm + (4 + (b) * 2 + (h)) * HT)
#define STAGE(P, BASE, br, kt) do { const bf16_t* _gb = (BASE) + ((long)(br) * K + (long)(kt) * BK); \
    __builtin_amdgcn_global_load_lds((const unsigned*)(_gb + soff0), (unsigned*)((char*)(P) + sl0), 16, 0, 0); \
    __builtin_amdgcn_global_load_lds((const unsigned*)(_gb + soff1), (unsigned*)((char*)(P) + sl0 + 8192), 16, 0, 0); } while (0)
#define LDA(dst, b, h) _Pragma("unroll") for (int m = 0; m < 4; ++m) _Pragma("unroll") for (int k = 0; k < 2; ++k) \
    dst[m][k] = *reinterpret_cast<const bf16x8*>((char*)SA(b, h) + lds_byte(wr * 64 + m * 16 + fr, k * 32 + fq * 8))
#define LDB(dst, b, h) _Pragma("unroll") for (int n = 0; n < 2; ++n) _Pragma("unroll") for (int k = 0; k < 2; ++k) \
    dst[n][k] = *reinterpret_cast<const bf16x8*>((char*)SB(b, h) + lds_byte(wc * 32 + n * 16 + fr, k * 32 + fq * 8))
#define MMA(ai, bj, At, Bt_) do { __builtin_amdgcn_s_setprio(1); \
    _Pragma("unroll") for (int m = 0; m < 4; ++m) _Pragma("unroll") for (int n = 0; n < 2; ++n) _Pragma("unroll") for (int k = 0; k < 2; ++k) \
      acc[ai][bj][m][n] = __builtin_amdgcn_mfma_f32_16x16x32_bf16(At[m][k], Bt_[n][k], acc[ai][bj][m][n], 0, 0, 0); \
    __builtin_amdgcn_s_setprio(0); } while (0)
#define WAIT_V(n) asm volatile("s_waitcnt vmcnt(" #n ")" ::: "memory")
#define WAIT_L(n) asm volatile("s_waitcnt lgkmcnt(" #n ")" ::: "memory")
#define BAR __builtin_amdgcn_s_barrier()
#define SCHED __builtin_amdgcn_sched_barrier(0)
  const int nM = T_TOK / BM, nN = N / BM, nwg = nM * nN;
  const int wid = wv, lane = tidx & 63, wr = wid >> 2, wc = wid & 3, fr = lane & 15, fq = lane >> 4;
  const int nt = K / BK;
  unsigned soff0, soff1; const int sl0 = tidx * 16;
  { int _r, _c; stage_rc(sl0, _r, _c); soff0 = (unsigned)(_r * K + _c); stage_rc(sl0 + 8192, _r, _c); soff1 = (unsigned)(_r * K + _c); }
  for (int tile = blockIdx.x; tile < nwg; tile += gridDim.x) {
    int wgt = tile;
    { const int q = nwg / 8, r = nwg % 8, xcd = wgt % 8, off = wgt / 8;
      wgt = (xcd < r ? xcd * (q + 1) : r * (q + 1) + (xcd - r) * q) + off; }
    const int nig = WGM * nN, gid = wgt / nig, fm = gid * WGM, gsz = min(nM - fm, WGM);
    const int pm = fm + ((wgt % nig) % gsz), pn = (wgt % nig) / gsz, brow = pm * BM, bcol = pn * BM;
    f32x4 acc[2][2][4][2] = {};
    bf16x8 At[4][2], B0[2][2], B1[2][2];
    STAGE(SB(0, 0), Bt, bcol, 0); STAGE(SA(0, 0), A, brow, 0);
    STAGE(SB(0, 1), Bt, bcol + HALF, 0); STAGE(SA(0, 1), A, brow + HALF, 0);
    if (wr == 1) BAR;
    WAIT_V(4); BAR;
    STAGE(SB(1, 0), Bt, bcol, 1); STAGE(SA(1, 0), A, brow, 1); STAGE(SB(1, 1), Bt, bcol + HALF, 1);
    WAIT_V(6); BAR;
    for (int t = 0; t < nt - 2; t += 2) {
      LDB(B0, 0, 0); SCHED; LDA(At, 0, 0); STAGE(SA(1, 1), A, brow + HALF, t + 1);
      WAIT_L(8); BAR; WAIT_L(0); MMA(0, 0, At, B0); BAR; SCHED;
      LDB(B1, 0, 1); STAGE(SB(0, 0), Bt, bcol, t + 2);
      BAR; WAIT_L(0); MMA(0, 1, At, B1); BAR;
      LDA(At, 0, 1); STAGE(SA(0, 0), A, brow, t + 2);
      BAR; WAIT_L(0); MMA(1, 0, At, B0); BAR; SCHED;
      STAGE(SB(0, 1), Bt, bcol + HALF, t + 2);
      WAIT_V(6); BAR; MMA(1, 1, At, B1); BAR;
      LDB(B0, 1, 0); SCHED; LDA(At, 1, 0); STAGE(SA(0, 1), A, brow + HALF, t + 2);
      WAIT_L(8); BAR; WAIT_L(0); MMA(0, 0, At, B0); BAR; SCHED;
      LDB(B1, 1, 1); STAGE(SB(1, 0), Bt, bcol, t + 3);
      BAR; WAIT_L(0); MMA(0, 1, At, B1); BAR;
      LDA(At, 1, 1); STAGE(SA(1, 0), A, brow, t + 3);
      BAR; WAIT_L(0); MMA(1, 0, At, B0); BAR; SCHED;
      STAGE(SB(1, 1), Bt, bcol + HALF, t + 3);
      WAIT_V(6); BAR; MMA(1, 1, At, B1); BAR;
    }
    { LDB(B0, 0, 0); LDA(At, 0, 0); STAGE(SA(1, 1), A, brow + HALF, nt - 1);
      BAR; WAIT_L(0); MMA(0, 0, At, B0); BAR;
      LDB(B1, 0, 1); BAR; WAIT_L(0); MMA(0, 1, At, B1); BAR;
      LDA(At, 0, 1); WAIT_V(4); BAR; WAIT_L(0); MMA(1, 0, At, B0); MMA(1, 1, At, B1); BAR; }
    { LDB(B0, 1, 0); LDA(At, 1, 0); WAIT_V(2); BAR; WAIT_L(0); MMA(0, 0, At, B0); BAR;
      LDB(B1, 1, 1); WAIT_V(0); BAR; WAIT_L(0); MMA(0, 1, At, B1); BAR;
      LDA(At, 1, 1); BAR; WAIT_L(0); MMA(1, 0, At, B0); MMA(1, 1, At, B1); BAR; }
    if (wr == 0) BAR;
    {
      const int le = llane();
      const int fr = le & 15, fq = le >> 4;
      const long base = (long)(brow + wr * 64) * LDC + bcol + wc * 32 + (unsigned)(fq * 4 * LDC + fr);
      if (MODE == 0 || (MODE == 2 && pn < 16)) {
        bf16_t* cp = (bf16_t*)Cout + base;
#pragma unroll
        for (int ai = 0; ai < 2; ++ai)
#pragma unroll
          for (int m = 0; m < 4; ++m)
#pragma unroll
            for (int j = 0; j < 4; ++j) {
              bf16_t* rp = cp + (ai * HALF + m * 16 + j) * LDC;
#pragma unroll
              for (int bj = 0; bj < 2; ++bj)
#pragma unroll
                for (int n = 0; n < 2; ++n) rp[bj * HALF + n * 16] = f2bf(acc[ai][bj][m][n][j]);
            }
      } else if (MODE == 1) {
        float* cp = (float*)Cout + base;
#pragma unroll
        for (int ai = 0; ai < 2; ++ai)
#pragma unroll
          for (int m = 0; m < 4; ++m)
#pragma unroll
            for (int j = 0; j < 4; ++j) {
              float* rp = cp + (ai * HALF + m * 16 + j) * LDC;
#pragma unroll
              for (int bj = 0; bj < 2; ++bj)
#pragma unroll
                for (int n = 0; n < 2; ++n) rp[bj * HALF + n * 16] = acc[ai][bj][m][n][j];
            }
      } else {
        if (wc == 0) {
          float* gp = GT + (long)(brow + wr * 64) * 32 + (unsigned)(fq * 4 * 32 + fr);
#pragma unroll
          for (int ai = 0; ai < 2; ++ai)
#pragma unroll
            for (int m = 0; m < 4; ++m)
#pragma unroll
              for (int j = 0; j < 4; ++j)
#pragma unroll
                for (int n = 0; n < 2; ++n) gp[(ai * HALF + m * 16 + j) * 32 + n * 16] = acc[ai][0][m][n][j];
        }
      }
    }
    __syncthreads();
  }
#undef SA
#undef SB
#undef STAGE
#undef LDA
#undef LDB
#undef MMA
}

__device__ __forceinline__ void post_inproj0(const int wv, const Params& p, const int zq, const bf16_t* __restrict__ P0, bf16_t* __restrict__ QA, bf16_t* __restrict__ KA,
                                             bf16_t* __restrict__ VA, float* __restrict__ VV, bf16_t* __restrict__ X0) {
  const int tidx = ltid(wv);
  const int wid = wv, lane = tidx & 63;
  const float* qn = p.in[zq + 21]; const float* kn = p.in[zq + 22]; const float* cw = p.in[zq + 23]; const float* cb = p.in[zq + 24];
  float* outK = p.out + O_K; float* outV = p.out + O_V;
  for (int i = blockIdx.x * 512 + tidx; i < 2 * 512 * 256 / 4; i += gridDim.x * 512) {
    int e = i * 4; int b = e / (512 * 256), rem = e % (512 * 256);
    float4 kk = *(const float4*)(p.in[zq + 2] + e); float4 vv = *(const float4*)(p.in[zq + 3] + e);
    long d = (long)(8192 + b * 2560 + 2048) * 256 + rem;
    u32x2 wk = {cvtpk(kk.x, kk.y), cvtpk(kk.z, kk.w)}; u32x2 wv = {cvtpk(vv.x, vv.y), cvtpk(vv.z, vv.w)};
    *(u32x2*)(KA + d) = wk; *(u32x2*)(VA + d) = wv;
  }
  const int fi = lane & 31;
  const float inv = exp2f(-(float)fi * (13.287712379549449f / 32.f));
  for (int row = blockIdx.x * 8 + wid; row < T_TOK; row += gridDim.x * 8) {
    const bool samp = row >= TPR;
    const int L = samp ? 2048 : 256;
    const int tl = samp ? (row - TPR) % 2048 : row % 256;
    const long krow = samp ? (long)(8192 + ((row - TPR) / 2048) * 2560 + tl) : (long)row;
    const bf16_t* base = P0 + (long)row * 2560;
    float cs = 1.f, sn = 0.f;
    if (samp) { float pos = (lane < 32) ? (float)(tl / 64) : (float)(tl % 64); float ang = pos * inv; cs = cosf(ang); sn = sinf(ang); }
#pragma unroll
    for (int hh = 0; hh < 6; ++hh) {
      float x1 = bf2f(base[hh * 128 + lane]), x2 = bf2f(base[hh * 128 + 64 + lane]);
      float ss = wave_sum(x1 * x1 + x2 * x2);
      float rs = rsqrtf(ss * (1.f / 128.f) + 1e-6f);
      const float* gw = hh < 4 ? qn : kn;
      float y1 = x1 * rs * gw[lane], y2 = x2 * rs * gw[64 + lane];
      if (hh >= 4 && !samp) { outK[(long)row * 256 + (hh - 4) * 128 + lane] = y1; outK[(long)row * 256 + (hh - 4) * 128 + 64 + lane] = y2; }
      float o1 = y1 * cs - y2 * sn, o2 = y1 * sn + y2 * cs;
      if (hh < 4) { QA[(long)row * 512 + hh * 128 + lane] = f2bf(o1); QA[(long)row * 512 + hh * 128 + 64 + lane] = f2bf(o2); }
      else { KA[krow * 256 + (hh - 4) * 128 + lane] = f2bf(o1); KA[krow * 256 + (hh - 4) * 128 + 64 + lane] = f2bf(o2); }
    }
    {
      u32x2 w = *(const u32x2*)(base + 768 + lane * 4);
      *(u32x2*)(VA + krow * 256 + lane * 4) = w;
      if (!samp) { float4 f = make_float4(bflo(w[0]), bfhi(w[0]), bflo(w[1]), bfhi(w[1])); *(float4*)(outV + (long)row * 256 + lane * 4) = f; }
    }
    {
      const int c8 = lane * 8;
      float uc[3][8];
#pragma unroll
      for (int g = 0; g < 3; ++g) {
        const int col = g * 512 + c8;
        float um[8], u0[8], up[8];
        u32x4 z4 = {0u, 0u, 0u, 0u};
        u32x4 wm = (tl > 0) ? *(const u32x4*)(base - 2560 + 1024 + col) : z4;
        u32x4 w0 = *(const u32x4*)(base + 1024 + col);
        u32x4 wp = (tl < L - 1) ? *(const u32x4*)(base + 2560 + 1024 + col) : z4;
        unpack8(wm, um); unpack8(w0, u0); unpack8(wp, up);
#pragma unroll
        for (int e = 0; e < 8; ++e)
          uc[g][e] = cw[col + e] * um[e] + cw[1536 + col + e] * u0[e] + cw[3072 + col + e] * up[e] + cb[col + e];
      }
      float vvv[8];
#pragma unroll
      for (int e = 0; e < 8; ++e) vvv[e] = uc[2][e] * uc[1][e];
      *(float4*)(VV + (long)row * 512 + c8) = make_float4(vvv[0], vvv[1], vvv[2], vvv[3]);
      *(float4*)(VV + (long)row * 512 + c8 + 4) = make_float4(vvv[4], vvv[5], vvv[6], vvv[7]);
      *(u32x4*)(X0 + (long)row * 512 + c8) = pack8(uc[0]);
    }
  }
}

constexpr int AD = 128, ANW = 8, QBLK = 32, KVBLK = 64;
constexpr float ASCALE = 0.088388347648318440f;
constexpr float ATHR = 8.f;
constexpr int LDQ = 512, LDK = 256, LDO = 1024;
constexpr size_t SHM_V = KVBLK * AD * 2, SHM_K = KVBLK * AD * 2;
#define KSWZ(row, colB) ((row) * 256 + ((colB) ^ (((row) & 7) << 4)))
#define SBAR() __builtin_amdgcn_sched_barrier(0)

__device__ __forceinline__ void partialSM(f32x16& p0, f32x16& p1, float& m_reg, float& mn, float& alpha) {
  constexpr float C = ASCALE * 1.4426950408889634f;
  float pmax = p0[0];
#pragma unroll
  for (int r = 1; r < 16; ++r) pmax = fmaxf(pmax, p0[r]);
#pragma unroll
  for (int r = 0; r < 16; ++r) pmax = fmaxf(pmax, p1[r]);
  { auto rr = __builtin_amdgcn_permlane32_swap(__float_as_uint(pmax), __float_as_uint(pmax), false, false);
    pmax = fmaxf(__uint_as_float(rr[0]), __uint_as_float(rr[1])); }
  if (__builtin_expect(__all(pmax - m_reg <= ATHR / ASCALE), 1)) { mn = m_reg; alpha = 1.f; }
  else { mn = fmaxf(m_reg, pmax); alpha = __builtin_amdgcn_exp2f((m_reg - mn) * C); m_reg = mn; }
  float mnC = -mn * C;
#pragma unroll
  for (int r = 0; r < 16; ++r) p0[r] = fmaf(p0[r], C, mnC);
#pragma unroll
  for (int r = 0; r < 16; ++r) p1[r] = fmaf(p1[r], C, mnC);
#pragma unroll
  for (int r = 0; r < 16; ++r) p0[r] = __builtin_amdgcn_exp2f(p0[r]);
}
__device__ __forceinline__ void finishSM(f32x16& p0, f32x16& p1, float alpha, float& l_reg, bf16x8& pa0, bf16x8& pa1, bf16x8& pa2, bf16x8& pa3) {
#pragma unroll
  for (int r = 0; r < 16; ++r) p1[r] = __builtin_amdgcn_exp2f(p1[r]);
  float ps = 0;
#pragma unroll
  for (int r = 0; r < 16; ++r) ps += p0[r];
#pragma unroll
  for (int r = 0; r < 16; ++r) ps += p1[r];
  { auto rr = __builtin_amdgcn_permlane32_swap(__float_as_uint(ps), __float_as_uint(ps), false, false);
    ps = __uint_as_float(rr[0]) + __uint_as_float(rr[1]); }
  l_reg = l_reg * alpha + ps;
#define PK4(P, BASE, OUT) do { unsigned a0 = cvtpk(P[BASE + 0], P[BASE + 1]), a1 = cvtpk(P[BASE + 2], P[BASE + 3]);   \
    unsigned b0 = cvtpk(P[BASE + 4], P[BASE + 5]), b1 = cvtpk(P[BASE + 6], P[BASE + 7]);                              \
    auto r0 = __builtin_amdgcn_permlane32_swap(a0, b0, false, false); auto r1 = __builtin_amdgcn_permlane32_swap(a1, b1, false, false); \
    u32x4 w = {r0[0], r1[0], r0[1], r1[1]}; OUT = *reinterpret_cast<bf16x8*>(&w); } while (0)
  PK4(p0, 0, pa0); PK4(p0, 8, pa1); PK4(p1, 0, pa2); PK4(p1, 8, pa3);
#undef PK4
}
__device__ __forceinline__ void qkt(f32x16& p0, f32x16& p1, const bf16_t* Ks, const bf16x8* qr, int r32, int hi) {
  p0 = f32x16{}; p1 = f32x16{};
#pragma unroll
  for (int d0 = 0; d0 < 8; ++d0) { int cb = (d0 * 16 + hi * 8) * 2;
    bf16x8 b0 = *reinterpret_cast<const bf16x8*>((const char*)Ks + KSWZ(r32, cb));
    bf16x8 b1 = *reinterpret_cast<const bf16x8*>((const char*)Ks + KSWZ(32 + r32, cb));
    p0 = __builtin_amdgcn_mfma_f32_32x32x16_bf16(b0, qr[d0], p0, 0, 0, 0);
    p1 = __builtin_amdgcn_mfma_f32_32x32x16_bf16(b1, qr[d0], p1, 0, 0, 0); }
}
__device__ __forceinline__ int v_st(int k, int c) { const int kk = (k & ~0xC) | ((k & 4) << 1) | ((k & 8) >> 1); return ((kk >> 3) * 4 + (c >> 5)) * 512 + ((kk & 7) * 32 + (c & 31)) * 2; }
__device__ __forceinline__ int v_rd_base(int lane) { return ((lane & 3) << 3) | (((lane >> 2) & 3) << 6) | (((lane >> 4) & 1) << 5) | (((lane >> 5) & 1) << 8); }
constexpr int v_rd_off(int d0, int ks, int half) { return d0 * 512 + ks * 4096 + half * 2048; }
template <int OFF> __device__ __forceinline__ s16x4 tr_read(int vb) {
  s16x4 r; asm volatile("ds_read_b64_tr_b16 %0, %1 offset:%2" : "=&v"(r) : "v"(vb), "i"(OFF) : "memory"); return r;
}
template <int D0> __device__ __forceinline__ void pv_one(f32x16& od, int vb, bf16x8 pa0, bf16x8 pa1, bf16x8 pa2, bf16x8 pa3) {
  const s16x4 l0 = tr_read<v_rd_off(D0, 0, 0)>(vb), h0 = tr_read<v_rd_off(D0, 0, 1)>(vb), l1 = tr_read<v_rd_off(D0, 1, 0)>(vb), h1 = tr_read<v_rd_off(D0, 1, 1)>(vb);
  const s16x4 l2 = tr_read<v_rd_off(D0, 2, 0)>(vb), h2 = tr_read<v_rd_off(D0, 2, 1)>(vb), l3 = tr_read<v_rd_off(D0, 3, 0)>(vb), h3 = tr_read<v_rd_off(D0, 3, 1)>(vb);
  asm volatile("s_waitcnt lgkmcnt(0)" ::: "memory"); SBAR();
#define PK(L, H) (bf16x8){L[0], L[1], L[2], L[3], H[0], H[1], H[2], H[3]}
  od = __builtin_amdgcn_mfma_f32_32x32x16_bf16(pa0, PK(l0, h0), od, 0, 0, 0);
  od = __builtin_amdgcn_mfma_f32_32x32x16_bf16(pa1, PK(l1, h1), od, 0, 0, 0);
  od = __builtin_amdgcn_mfma_f32_32x32x16_bf16(pa2, PK(l2, h2), od, 0, 0, 0);
  od = __builtin_amdgcn_mfma_f32_32x32x16_bf16(pa3, PK(l3, h3), od, 0, 0, 0);
#undef PK
}
__device__ __forceinline__ void pv_d0(f32x16* o, int vb, bf16x8 pa0, bf16x8 pa1, bf16x8 pa2, bf16x8 pa3) {
  pv_one<0>(o[0], vb, pa0, pa1, pa2, pa3); pv_one<1>(o[1], vb, pa0, pa1, pa2, pa3); pv_one<2>(o[2], vb, pa0, pa1, pa2, pa3); pv_one<3>(o[3], vb, pa0, pa1, pa2, pa3);
}

__device__ __forceinline__ void attn_dense_body(const int wv, const bf16_t* __restrict__ Qb, const bf16_t* __restrict__ Kh, const bf16_t* __restrict__ Vh,
                                                bf16_t* __restrict__ Ob, int seq, char* lds) {
  const int tidx = ltid(wv);
  const int tid = tidx, wid = wv, lane = tid & 63, r32 = lane & 31, hi = lane >> 5;
  bf16_t* V_lds = (bf16_t*)lds; bf16_t* K_lds = (bf16_t*)(lds + 2 * SHM_V);
  float* ws = (float*)(lds + 2 * SHM_V + 2 * SHM_K) + wid * 64; float* li_l = ws; float* al_l = ws + 32;
  float m_reg = -1e30f, l_reg = 0; f32x16 o[4] = {}; bf16x8 qr[8];
  const bf16_t* Qw = Qb + (long)(wid * QBLK + r32) * LDQ + hi * 8;
#pragma unroll
  for (int d0 = 0; d0 < 8; ++d0) qr[d0] = *reinterpret_cast<const bf16x8*>(Qw + d0 * 16);
  const int sr = tid >> 4, sc = (tid & 15) * 8, vst0 = v_st(sr, sc), vst1 = v_st(32 + sr, sc);
  const int vb0 = (int)(uintptr_t)V_lds + v_rd_base(lane);
  bf16x8 sA_vs0, sA_vs1, sA_ks0, sA_ks1, sB_vs0, sB_vs1, sB_ks0, sB_ks1;
#define SLOADA(k0) do { sA_vs0 = *(const bf16x8*)(&Vh[(long)((k0) + sr) * LDK + sc]); sA_vs1 = *(const bf16x8*)(&Vh[(long)((k0) + 32 + sr) * LDK + sc]); \
    sA_ks0 = *(const bf16x8*)(&Kh[(long)((k0) + sr) * LDK + sc]); sA_ks1 = *(const bf16x8*)(&Kh[(long)((k0) + 32 + sr) * LDK + sc]); } while (0)
#define SLOADB(k0) do { sB_vs0 = *(const bf16x8*)(&Vh[(long)((k0) + sr) * LDK + sc]); sB_vs1 = *(const bf16x8*)(&Vh[(long)((k0) + 32 + sr) * LDK + sc]); \
    sB_ks0 = *(const bf16x8*)(&Kh[(long)((k0) + sr) * LDK + sc]); sB_ks1 = *(const bf16x8*)(&Kh[(long)((k0) + 32 + sr) * LDK + sc]); } while (0)
#define SWRITEA(b) do { *(bf16x8*)((char*)V_lds + (b) * SHM_V + vst0) = sA_vs0; *(bf16x8*)((char*)V_lds + (b) * SHM_V + vst1) = sA_vs1; int kc = sc * 2; \
    *(bf16x8*)((char*)K_lds + (b) * SHM_K + KSWZ(sr, kc)) = sA_ks0; *(bf16x8*)((char*)K_lds + (b) * SHM_K + KSWZ(32 + sr, kc)) = sA_ks1; } while (0)
#define SWRITEB(b) do { *(bf16x8*)((char*)V_lds + (b) * SHM_V + vst0) = sB_vs0; *(bf16x8*)((char*)V_lds + (b) * SHM_V + vst1) = sB_vs1; int kc = sc * 2; \
    *(bf16x8*)((char*)K_lds + (b) * SHM_K + KSWZ(sr, kc)) = sB_ks0; *(bf16x8*)((char*)K_lds + (b) * SHM_K + KSWZ(32 + sr, kc)) = sB_ks1; } while (0)
#define SWAIT() asm volatile("s_waitcnt vmcnt(4)" ::: "memory")
#define RESC(a) do { if (__any((a) < 1.f)) { if (hi == 0) al_l[r32] = (a); asm volatile("s_waitcnt lgkmcnt(0)" ::: "memory"); \
    _Pragma("unroll") for (int d = 0; d < 4; ++d) _Pragma("unroll") for (int r = 0; r < 16; ++r) o[d][r] *= al_l[crow(r, hi)]; } } while (0)
  f32x16 pA0, pA1, pB0, pB1; float mnA, mnB, alA, alB; bf16x8 pa0, pa1, pa2, pa3; const int NT = seq / KVBLK;
  SLOADA(0); asm volatile("s_waitcnt vmcnt(0)" ::: "memory"); SWRITEA(0); __syncthreads();
  qkt(pA0, pA1, K_lds, qr, r32, hi); partialSM(pA0, pA1, m_reg, mnA, alA);
  SLOADB(KVBLK); if (2 < NT) SLOADA(2 * KVBLK);
  SWAIT(); SWRITEB(1); __syncthreads();
  for (int j = 1; j + 1 < NT; j += 2) {
    SBAR(); qkt(pB0, pB1, (bf16_t*)((char*)K_lds + SHM_K), qr, r32, hi);
    finishSM(pA0, pA1, alA, l_reg, pa0, pa1, pa2, pa3); SBAR();
    SLOADB((j + 2) * KVBLK); SBAR();
    pv_d0(o, vb0, pa0, pa1, pa2, pa3); partialSM(pB0, pB1, m_reg, mnB, alB);
    __syncthreads(); SWAIT(); SWRITEA(0);
    RESC(alB); __syncthreads();
    SBAR(); qkt(pA0, pA1, K_lds, qr, r32, hi);
    finishSM(pB0, pB1, alB, l_reg, pa0, pa1, pa2, pa3); SBAR();
    if (j + 3 < NT) SLOADA((j + 3) * KVBLK); SBAR();
    pv_d0(o, vb0 + (int)SHM_V, pa0, pa1, pa2, pa3); partialSM(pA0, pA1, m_reg, mnA, alA);
    __syncthreads(); SWAIT(); SWRITEB(1);
    RESC(alA); __syncthreads();
  }
  SBAR(); qkt(pB0, pB1, (bf16_t*)((char*)K_lds + SHM_K), qr, r32, hi);
  finishSM(pA0, pA1, alA, l_reg, pa0, pa1, pa2, pa3); SBAR();
  pv_d0(o, vb0, pa0, pa1, pa2, pa3); partialSM(pB0, pB1, m_reg, mnB, alB);
  __syncthreads(); RESC(alB);
  finishSM(pB0, pB1, alB, l_reg, pa0, pa1, pa2, pa3); SBAR();
  pv_d0(o, vb0 + (int)SHM_V, pa0, pa1, pa2, pa3);
  if (hi == 0) li_l[r32] = l_reg; asm volatile("s_waitcnt lgkmcnt(0)" ::: "memory");
  float rli[16];
#pragma unroll
  for (int r = 0; r < 16; ++r) rli[r] = __builtin_amdgcn_rcpf(li_l[crow(r, hi)]);
  bf16_t* Ow = Ob + (long)(wid * QBLK) * LDO;
#pragma unroll
  for (int r = 0; r < 16; ++r) { int orow = crow(r, hi);
#pragma unroll
    for (int d0 = 0; d0 < 4; ++d0) Ow[(long)orow * LDO + d0 * 32 + r32] = f2bf(o[d0][r] * rli[r]); }
#undef SLOADA
#undef SLOADB
#undef SWRITEA
#undef SWRITEB
#undef SWAIT
#undef RESC
}

__device__ __forceinline__ void hyena_item(const float* __restrict__ Fu, const float* __restrict__ Vu, const bf16_t* __restrict__ Xu,
                                           bf16_t* __restrict__ Au, int L, int t0, unsigned ln) {
  float y[16], ring[16];
#pragma unroll
  for (int i = 0; i < 16; ++i) { y[i] = 0.f; const float* fr = Fu + (long)(t0 + i + L - 1) * 512; ring[i] = fr[ln]; }
  const float* fp = Fu + (long)(t0 + L - 2) * 512;
  float va[16], fa[16], vb[16], fb[16];
#define HY_LOAD(V, Fq, S) _Pragma("unroll") for (int j = 0; j < 16; ++j) { const float* vr_ = Vu + (long)((S) + j) * 512; const float* fr_ = fp - (long)((S) + j) * 512; V[j] = vr_[ln]; Fq[j] = fr_[ln]; }
#define HY_STEP(V, Fq) _Pragma("unroll") for (int j = 0; j < 16; ++j) { const float vs = V[j]; \
    _Pragma("unroll") for (int i = 0; i < 16; ++i) y[i] += ring[(i - j) & 15] * vs; ring[(15 - j) & 15] = Fq[j]; }
  HY_LOAD(va, fa, 0)
  for (int s0 = 0; s0 < L; s0 += 32) {
    HY_LOAD(vb, fb, s0 + 16)
    HY_STEP(va, fa)
    if (s0 + 32 < L) { HY_LOAD(va, fa, s0 + 32) }
    HY_STEP(vb, fb)
  }
#undef HY_LOAD
#undef HY_STEP
#pragma unroll
  for (int i = 0; i < 16; ++i) {
    const bf16_t* xr = Xu + (long)(t0 + i) * 512; bf16_t* ar = Au + (long)(t0 + i) * 1024;
    ar[ln] = f2bf(y[i] * bf2f(xr[ln]));
  }
}

__device__ __forceinline__ void mix0_phase(const int wv, const Params& p, const int zq, const bf16_t* QA, const bf16_t* KA, const bf16_t* VA, const float* VV,
                                           const bf16_t* X0, const float* F256, const float* F2048, bf16_t* AO) {
  extern __shared__ __attribute__((aligned(16))) char shm_raw[];
#ifndef NO_ATTN
  for (int it = blockIdx.x; it < 192; it += gridDim.x) {
    long rowb, krow; int h, seqk;
    if (it < 64) { const int qb = it % 8, b = it / 32; h = (it / 8) % 4; rowb = 8192 + (long)b * 2048 + qb * 256; krow = 8192 + (long)b * 2560; seqk = 2560; }
    else { const int j = it - 64; const int b = j / 4; h = j % 4; rowb = (long)b * 256; krow = rowb; seqk = 256; }
    __syncthreads();
    attn_dense_body(wv, QA + rowb * 512 + h * 128, KA + krow * 256 + (h >> 1) * 128, VA + krow * 256 + (h >> 1) * 128, AO + rowb * 1024 + h * 128, seqk, shm_raw);
  }
#endif
#ifndef NO_HYENA
  const int lane = llane(); const int wid = wv;
  {
    unsigned* qctr = (unsigned*)(p.ws + WS_END) + 768;
    volatile int* sidx = (volatile int*)(shm_raw + 120000);
    for (;;) {
      __syncthreads();
      if (ltid(wv) == 0) *sidx = (int)__hip_atomic_fetch_add(qctr, 1u, __ATOMIC_RELAXED, __HIP_MEMORY_SCOPE_AGENT);
      __syncthreads();
      const int it = __builtin_amdgcn_readfirstlane(*sidx);
      if (it >= 768) break;
      if (it < 256) {
        const int b = it / 128, cgp = (it / 16) % 8, tg = it % 16;
        { const long rb = 8192 + (long)b * 2048; hyena_item(F2048 + cgp * 64, VV + rb * 512 + cgp * 64, X0 + rb * 512 + cgp * 64, AO + rb * 1024 + 512 + cgp * 64, 2048, tg * 128 + wid * 16, (unsigned)lane); }
      } else {
        const int jj = it - 256; const int b = jj / 16, cgp = (jj / 2) % 8, tg = jj % 2;
        { const long rb = (long)b * 256; hyena_item(F256 + cgp * 64, VV + rb * 512 + cgp * 64, X0 + rb * 512 + cgp * 64, AO + rb * 1024 + 512 + cgp * 64, 256, tg * 128 + wid * 16, (unsigned)lane); }
      }
    }
  }
#endif
  __syncthreads();
}

__device__ __forceinline__ float erf_as(float x) {
  const float ax = fabsf(x);
  const float t = __builtin_amdgcn_rcpf(fmaf(0.3275911f, ax, 1.f));
  float p = fmaf(1.061405429f, t, -1.453152027f);
  p = fmaf(p, t, 1.421413741f); p = fmaf(p, t, -0.284496736f); p = fmaf(p, t, 0.254829592f);
  const float r = 1.f - p * t * __expf(-ax * ax);
  return copysignf(r, x);
}
__device__ __forceinline__ float gelu_f(float x) { return 0.5f * x * (1.f + erf_as(x * 0.70710678118654752f)); }
__device__ __forceinline__ void ffn_act_phase(const int wv, const bf16_t* __restrict__ P, const float* __restrict__ cw, const float* __restrict__ cb, bf16_t* __restrict__ G) {
  const int tidx = ltid(wv);
  const int tid = tidx;
  if (tid >= 352) return;
  const int c8 = tid * 8;
  float w1[3][8], w2[3][8], b1[8], b2[8];
#pragma unroll
  for (int e = 0; e < 8; ++e) {
#pragma unroll
    for (int k = 0; k < 3; ++k) { w1[k][e] = cw[k * 5632 + c8 + e]; w2[k][e] = cw[k * 5632 + 2816 + c8 + e]; }
    b1[e] = cb[c8 + e]; b2[e] = cb[2816 + c8 + e];
  }
  for (int item = blockIdx.x; item < T_TOK / 16; item += gridDim.x) {
    const int r0 = item * 16;
    const int L = r0 < TPR ? 256 : 2048;
    const int tl0 = r0 < TPR ? r0 % 256 : (r0 - TPR) % 2048;
    float am[8], a0[8], ap[8], gm[8], g0[8], gp[8];
    const u32x4 z4 = {0u, 0u, 0u, 0u};
    {
      const bf16_t* b = P + (long)r0 * 5632 + c8;
      u32x4 x = (tl0 > 0) ? *(const u32x4*)(b - 5632) : z4; unpack8(x, am);
      x = (tl0 > 0) ? *(const u32x4*)(b - 5632 + 2816) : z4; unpack8(x, gm);
      x = *(const u32x4*)(b); unpack8(x, a0);
      x = *(const u32x4*)(b + 2816); unpack8(x, g0);
    }
    for (int r = 0; r < 16; ++r) {
      const bf16_t* b = P + (long)(r0 + r) * 5632 + c8;
      const bool vn = (tl0 + r) < L - 1;
      u32x4 x = vn ? *(const u32x4*)(b + 5632) : z4; unpack8(x, ap);
      x = vn ? *(const u32x4*)(b + 5632 + 2816) : z4; unpack8(x, gp);
      float o[8];
#pragma unroll
      for (int e = 0; e < 8; ++e) {
        float h1 = w1[0][e] * am[e] + w1[1][e] * a0[e] + w1[2][e] * ap[e] + b1[e];
        float h2 = w2[0][e] * gm[e] + w2[1][e] * g0[e] + w2[2][e] * gp[e] + b2[e];
        o[e] = gelu_f(h1) * h2;
        am[e] = a0[e]; a0[e] = ap[e]; gm[e] = g0[e]; g0[e] = gp[e];
      }
      *(u32x4*)(G + (long)(r0 + r) * 2816 + c8) = pack8(o);
    }
  }
}

template <int K>
__device__ __forceinline__ f32x16 mma_nt(const bf16_t* A, int lda, const bf16_t* B, int ldb, f32x16 acc, int r32, int hi) {
  bf16x8 a[K / 16], b[K / 16];
#pragma unroll
  for (int k0 = 0; k0 < K / 16; ++k0) {
    a[k0] = *reinterpret_cast<const bf16x8*>(A + r32 * lda + k0 * 16 + 8 * hi);
    b[k0] = *reinterpret_cast<const bf16x8*>(B + r32 * ldb + k0 * 16 + 8 * hi);
  }
#pragma unroll
  for (int k0 = 0; k0 < K / 16; ++k0) acc = __builtin_amdgcn_mfma_f32_32x32x16_bf16(a[k0], b[k0], acc, 0, 0, 0);
  return acc;
}

__device__ __forceinline__ void mlstm_phase(const int wv, const Params& p, const int zq, const bf16_t* __restrict__ P1, const float* __restrict__ GT,
                                            bf16_t* __restrict__ HF, bf16_t* __restrict__ HB) {
  const int tidx = ltid(wv);
  extern __shared__ __attribute__((aligned(16))) char shm_raw[];
  bf16_t* Qs = (bf16_t*)shm_raw;
  bf16_t* Ks = Qs + 64 * 136;
  bf16_t* KwT = Ks + 64 * 136;
  bf16_t* VsT = KwT + 128 * 72;
  bf16_t* Wb = VsT + 128 * 72;
  bf16_t* Cb = Wb + 64 * 72;
  float* gbuf = (float*)(Cb + 128 * 136);
  float* sclv = gbuf + 400; float* wintv = sclv + 64; float* nvec = wintv + 64;
  float* cwl = nvec + 128;
  const int tid = tidx, wid = wv, lane = tid & 63, r32 = lane & 31, hi = lane >> 5;
  const float* cw = p.in[zq + 35]; const float* cbias = p.in[zq + 36]; const float* bg = p.in[zq + 34];
  const bool usplit = gridDim.x > 64;
  const int ustep = usplit ? ((int)blockIdx.x < 32 ? 544 : (int)gridDim.x - 32) : (int)gridDim.x;
  for (int u = blockIdx.x; u < 544; u += ustep) {
    int seq, h, dir;
    if (u < 32) { seq = 32 + u / 16; h = (u / 2) % 8; dir = u % 2; } else { int j = u - 32; seq = j / 16; h = (j / 2) % 8; dir = j % 2; }
    const int L = seq < 32 ? 256 : 2048;
    const long rowbase = seq < 32 ? (long)seq * 256 : 8192 + (long)(seq - 32) * 2048;
    __syncthreads();
    f32x16 cacc[2]; float m = 0.f;
    const int vb2 = wid >> 1;
    if (seq >= 32) {
      const int b = seq - 32;
      const float* Cin = p.in[zq + 4] + (long)((b * 2 + dir) * 8 + h) * 16384;
#pragma unroll
      for (int i = 0; i < 2; ++i) { const int kb = (wid & 1) * 2 + i;
#pragma unroll
        for (int r = 0; r < 16; ++r) cacc[i][r] = Cin[(vb2 * 32 + crow(r, hi)) * 128 + kb * 32 + r32]; }
      if (tid < 128) nvec[tid] = p.in[zq + 5][((b * 2 + dir) * 8 + h) * 128 + tid];
      m = p.in[zq + 6][(b * 2 + dir) * 8 + h];
    } else {
#pragma unroll
      for (int i = 0; i < 2; ++i)
#pragma unroll
        for (int r = 0; r < 16; ++r) cacc[i][r] = 0.f;
      if (tid < 128) nvec[tid] = 0.f;
    }
#pragma unroll
    for (int i = 0; i < 2; ++i) { const int kb = (wid & 1) * 2 + i;
#pragma unroll
      for (int r = 0; r < 16; ++r) Cb[(vb2 * 32 + crow(r, hi)) * 136 + kb * 32 + r32] = f2bf(cacc[i][r]); }
    if (tid < 256) {
      const int col = (tid < 128) ? (h * 128 + tid) : (1024 + h * 128 + (tid - 128));
      cwl[tid] = cw[col]; cwl[256 + tid] = cw[2048 + col]; cwl[512 + tid] = cw[4096 + col]; cwl[768 + tid] = cbias[col];
    }
    const float bgi = bg[dir * 8 + h], bgf = bg[16 + dir * 8 + h];
    __syncthreads();
    const int nch = L / 64;
    u32x4 rq[2][3], rk[2][3], rv[2]; float g_i = 0.f, g_f = 0.f;
#define ML_LOADRAW(chn) do { \
      const int tcr_ = (chn) * 64 + lane; const int posr_ = dir ? (L - 1 - tcr_) : tcr_; \
      const bf16_t* rp_ = P1 + (rowbase + posr_) * 4096 + h * 128 + wv * 16; \
      const bool hm_ = posr_ > 0, hp_ = posr_ < L - 1; const u32x4 z4_ = {0u, 0u, 0u, 0u}; \
      _Pragma("unroll") for (int hf = 0; hf < 2; ++hf) { \
        rq[hf][0] = hm_ ? *(const u32x4*)(rp_ - 4096 + hf * 8) : z4_; rq[hf][1] = *(const u32x4*)(rp_ + hf * 8); \
        rq[hf][2] = hp_ ? *(const u32x4*)(rp_ + 4096 + hf * 8) : z4_; \
        rk[hf][0] = hm_ ? *(const u32x4*)(rp_ - 4096 + 1024 + hf * 8) : z4_; rk[hf][1] = *(const u32x4*)(rp_ + 1024 + hf * 8); \
        rk[hf][2] = hp_ ? *(const u32x4*)(rp_ + 4096 + 1024 + hf * 8) : z4_; \
        rv[hf] = *(const u32x4*)(rp_ + 2048 + hf * 8); } \
      if (wid == 7) { const float* gr_ = GT + (rowbase + posr_) * 32; g_i = gr_[dir * 8 + h]; g_f = gr_[16 + dir * 8 + h]; } \
    } while (0)
#define ML_GATES(setp, mval) do { float* av_ = gbuf + (setp) * 200; float* Mv_ = av_ + 64; float* bv_ = Mv_ + 64; float* scal_ = bv_ + 64; \
      const float ic_ = g_i + bgi; const float fp_ = g_f + bgf; \
      const float lf_ = fminf(fp_, 0.f) - __logf(1.f + __expf(-fabsf(fp_))); \
      float bc_ = lf_; \
      _Pragma("unroll") for (int off = 1; off < 64; off <<= 1) { float t_ = __shfl_up(bc_, off); if (lane >= off) bc_ += t_; } \
      const float a_ = ic_ - bc_; float pm_ = a_; \
      _Pragma("unroll") for (int off = 1; off < 64; off <<= 1) { float t_ = __shfl_up(pm_, off); if (lane >= off) pm_ = fmaxf(pm_, t_); } \
      const float M_ = fmaxf((mval), pm_); \
      av_[lane] = a_; Mv_[lane] = M_; bv_[lane] = bc_; if (lane == 63) { scal_[0] = M_; scal_[1] = bc_; } } while (0)
    ML_LOADRAW(0);
    if (wid == 7) ML_GATES(0, m);
    for (int ch = 0; ch < nch; ++ch) {
      float* av = gbuf + (ch & 1) * 200; float* Mv = av + 64; float* bv = Mv + 64; float* scal = bv + 64;
      float kf[16];
      {
        const int r = lane, c16 = wv * 16;
#pragma unroll
        for (int hf = 0; hf < 2; ++hf) {
          float um[8], u0[8], up[8], qf[8];
          { unpack8(rq[hf][0], um); unpack8(rq[hf][1], u0); unpack8(rq[hf][2], up);
#pragma unroll
            for (int e = 0; e < 8; ++e) { const int c = c16 + hf * 8 + e;
              qf[e] = silu_f(cwl[c] * um[e] + cwl[256 + c] * u0[e] + cwl[512 + c] * up[e] + cwl[768 + c]); }
            *(u32x4*)(Qs + r * 136 + c16 + hf * 8) = pack8(qf); }
          { unpack8(rk[hf][0], um); unpack8(rk[hf][1], u0); unpack8(rk[hf][2], up);
#pragma unroll
            for (int e = 0; e < 8; ++e) { const int c = 128 + c16 + hf * 8 + e;
              qf[e] = 0.088388347648318440f * silu_f(cwl[c] * um[e] + cwl[256 + c] * u0[e] + cwl[512 + c] * up[e] + cwl[768 + c]);
              kf[hf * 8 + e] = qf[e]; }
            *(u32x4*)(Ks + r * 136 + c16 + hf * 8) = pack8(qf); }
          { const u32x4 wv4 = rv[hf];
            bf16_t* vd = VsT + (c16 + hf * 8) * 72 + r;
            vd[0 * 72] = (bf16_t)(wv4[0] & 0xffff); vd[1 * 72] = (bf16_t)(wv4[0] >> 16);
            vd[2 * 72] = (bf16_t)(wv4[1] & 0xffff); vd[3 * 72] = (bf16_t)(wv4[1] >> 16);
            vd[4 * 72] = (bf16_t)(wv4[2] & 0xffff); vd[5 * 72] = (bf16_t)(wv4[2] >> 16);
            vd[6 * 72] = (bf16_t)(wv4[3] & 0xffff); vd[7 * 72] = (bf16_t)(wv4[3] >> 16); }
        }
      }
      if (ch + 1 < nch) ML_LOADRAW(ch + 1);
      __syncthreads();
      const float M63 = scal[0], b63 = scal[1];
      const float m_new = b63 + M63;
      const float w_state = __expf(m - M63);
      {
        const float wt = __expf(av[lane] - M63);
        bf16_t* kd = KwT + (wv * 16) * 72 + lane;
#pragma unroll
        for (int e = 0; e < 16; ++e) kd[e * 72] = f2bf(kf[e] * wt);
      }
      __syncthreads();
      if (wid == 7 && ch + 1 < nch) ML_GATES((ch + 1) & 1, m_new);
      const int tb = wid & 1, vb = wid >> 1;
      if (wid < 4) {
        const int sb = wid >> 1;
        f32x16 s = {};
        if (sb <= tb) { s = mma_nt<64>(Qs + tb * 32 * 136, 136, Ks + sb * 32 * 136, 136, s, r32, hi); s = mma_nt<64>(Qs + tb * 32 * 136 + 64, 136, Ks + sb * 32 * 136 + 64, 136, s, r32, hi); }
        const int sc = sb * 32 + r32; const float as = av[sc];
#pragma unroll
        for (int r = 0; r < 16; ++r) {
          const int t = tb * 32 + crow(r, hi);
          float w = (sc <= t) ? s[r] * __expf(as - Mv[t]) : 0.f;
          Wb[t * 72 + sc] = f2bf(w);
        }
      }
      f32x16 inter = {};
      inter = mma_nt<64>(Qs + tb * 32 * 136, 136, Cb + vb * 32 * 136, 136, inter, r32, hi); inter = mma_nt<64>(Qs + tb * 32 * 136 + 64, 136, Cb + vb * 32 * 136 + 64, 136, inter, r32, hi);
      __syncthreads();
      {
        const int t = tid >> 3, part = tid & 7;
        float wsum[8]; unpack8(*(const u32x4*)(Wb + t * 72 + part * 8), wsum);
        float dw = 0.f;
#pragma unroll
        for (int e = 0; e < 8; ++e) dw += wsum[e];
        float q0[8], q1[8]; unpack8(*(const u32x4*)(Qs + t * 136 + part * 16), q0); unpack8(*(const u32x4*)(Qs + t * 136 + part * 16 + 8), q1);
        float dq = 0.f;
#pragma unroll
        for (int e = 0; e < 8; ++e) dq += q0[e] * nvec[part * 16 + e] + q1[e] * nvec[part * 16 + 8 + e];
        dw += __shfl_xor(dw, 1); dw += __shfl_xor(dw, 2); dw += __shfl_xor(dw, 4);
        dq += __shfl_xor(dq, 1); dq += __shfl_xor(dq, 2); dq += __shfl_xor(dq, 4);
        if (part == 0) {
          const float Mt = Mv[t];
          const float wint = __expf(m - Mt);
          const float den = wint * dq + dw;
          const float mt = bv[t] + Mt;
          sclv[t] = 1.f / fmaxf(fabsf(den), __expf(-mt));
          wintv[t] = wint;
        }
      }
      __syncthreads();
      {
        f32x16 num;
#pragma unroll
        for (int r = 0; r < 16; ++r) num[r] = inter[r] * wintv[tb * 32 + crow(r, hi)];
        num = mma_nt<64>(Wb + tb * 32 * 72, 72, VsT + vb * 32 * 72, 72, num, r32, hi);
        bf16_t* Hout = dir ? HB : HF;
#pragma unroll
        for (int r = 0; r < 16; ++r) {
          const int t = tb * 32 + crow(r, hi);
          const int tc = ch * 64 + t; const int pos = dir ? (L - 1 - tc) : tc;
          Hout[(rowbase + pos) * 1024 + h * 128 + vb * 32 + r32] = f2bf(num[r] * sclv[t]);
        }
      }
#pragma unroll
      for (int i = 0; i < 2; ++i) {
        const int kb = (wid & 1) * 2 + i;
#pragma unroll
        for (int r = 0; r < 16; ++r) cacc[i][r] *= w_state;
        cacc[i] = mma_nt<64>(VsT + vb2 * 32 * 72, 72, KwT + kb * 32 * 72, 72, cacc[i], r32, hi);
#pragma unroll
        for (int r = 0; r < 16; ++r) Cb[(vb2 * 32 + crow(r, hi)) * 136 + kb * 32 + r32] = f2bf(cacc[i][r]);
      }
      if (tid < 128) {
        float s = 0.f;
#pragma unroll
        for (int q = 0; q < 8; ++q) { float f[8]; unpack8(*(const u32x4*)(KwT + tid * 72 + q * 8), f);
#pragma unroll
          for (int e = 0; e < 8; ++e) s += f[e]; }
        nvec[tid] = w_state * nvec[tid] + s;
      }
      m = m_new;
      __syncthreads();
    }
    if (seq < 32) {
      float* Co = p.out + O_C + (long)((seq * 2 + dir) * 8 + h) * 16384;
#pragma unroll
      for (int i = 0; i < 2; ++i) { const int kb = (wid & 1) * 2 + i;
#pragma unroll
        for (int r = 0; r < 16; ++r) Co[(vb2 * 32 + crow(r, hi)) * 128 + kb * 32 + r32] = cacc[i][r]; }
      if (tid < 128) p.out[O_N + ((seq * 2 + dir) * 8 + h) * 128 + tid] = nvec[tid];
      if (tid == 0) p.out[O_M + (seq * 2 + dir) * 8 + h] = m;
    }
  }
  __syncthreads();
}

#undef ML_LOADRAW
#undef ML_GATES
__device__ __forceinline__ void mlstm_post(const int wv, const Params& p, const int zq, const bf16_t* __restrict__ HF, const bf16_t* __restrict__ HB,
                                           const bf16_t* __restrict__ P1, bf16_t* __restrict__ A) {
  const int tidx = ltid(wv);
  const int wid = wv, lane = tidx & 63;
  const float* hn = p.in[zq + 37];
  for (int row = blockIdx.x * 8 + wid; row < T_TOK; row += gridDim.x * 8) {
    float hv[16], t0[8], t1[8];
    unpack8(*(const u32x4*)(HF + (long)row * 1024 + lane * 16), hv); unpack8(*(const u32x4*)(HF + (long)row * 1024 + lane * 16 + 8), hv + 8);
    unpack8(*(const u32x4*)(HB + (long)row * 1024 + lane * 16), t0); unpack8(*(const u32x4*)(HB + (long)row * 1024 + lane * 16 + 8), t1);
    float ss = 0.f;
#pragma unroll
    for (int e = 0; e < 8; ++e) { hv[e] += t0[e]; hv[8 + e] += t1[e]; }
#pragma unroll
    for (int e = 0; e < 16; ++e) ss += hv[e] * hv[e];
    ss += __shfl_xor(ss, 1); ss += __shfl_xor(ss, 2); ss += __shfl_xor(ss, 4);
    const float rs = rsqrtf(ss * (1.f / 128.f) + 1e-6f);
    float ov[16];
    unpack8(*(const u32x4*)(P1 + (long)row * 4096 + 3072 + lane * 16), ov); unpack8(*(const u32x4*)(P1 + (long)row * 4096 + 3072 + lane * 16 + 8), ov + 8);
    float y[16];
#pragma unroll
    for (int e = 0; e < 16; ++e) y[e] = hv[e] * rs * hn[lane * 16 + e] * (1.f / (1.f + __expf(-ov[e])));
    *(u32x4*)(A + (long)row * 1024 + lane * 16) = pack8(y);
    *(u32x4*)(A + (long)row * 1024 + lane * 16 + 8) = pack8(y + 8);
  }
}

__device__ __forceinline__ void gsync(const int wv, unsigned* bar, const unsigned k) {
  const int tidx = ltid(wv);
  asm volatile("s_waitcnt vmcnt(0)" ::: "memory");
  __syncthreads();
  if (tidx == 0) {
    __builtin_amdgcn_fence(__ATOMIC_RELEASE, "agent");
    asm volatile("s_waitcnt vmcnt(0)" ::: "memory");
    const unsigned g = blockIdx.x & 7u;
    const unsigned ng = (gridDim.x + 7u - g) >> 3;
    const unsigned ngroups = gridDim.x < 8u ? gridDim.x : 8u;
    const unsigned old = __hip_atomic_fetch_add(bar + g * 32, 1u, __ATOMIC_RELAXED, __HIP_MEMORY_SCOPE_AGENT);
    if (old + 1u == k * ng) {
      const unsigned o2 = __hip_atomic_fetch_add(bar + 256, 1u, __ATOMIC_RELAXED, __HIP_MEMORY_SCOPE_AGENT);
      if (o2 + 1u == k * ngroups) {
#pragma unroll
        for (int q = 0; q < 8; ++q) __hip_atomic_store(bar + 512 + q * 32, k, __ATOMIC_RELAXED, __HIP_MEMORY_SCOPE_AGENT);
      }
    }
    while (__hip_atomic_load(bar + 512 + g * 32, __ATOMIC_RELAXED, __HIP_MEMORY_SCOPE_AGENT) < k) __builtin_amdgcn_s_sleep(4);
    __builtin_amdgcn_fence(__ATOMIC_ACQUIRE, "agent");
    asm volatile("s_waitcnt vmcnt(0)" ::: "memory");
  }
  __syncthreads();
}

__global__ void __launch_bounds__(512) mega(Params p, int ph_lo, int ph_hi) {
  const int wv = __builtin_amdgcn_readfirstlane(threadIdx.x >> 6);
  if (ph_hi < 0) { cg::this_grid().sync(); }
  unsigned* bar = (unsigned*)(p.ws + WS_END);
  char* ws = p.ws;
  bf16_t* Wt_in0 = (bf16_t*)(ws + OFF_WIN0); bf16_t* Wt_out0 = (bf16_t*)(ws + OFF_WOUT0);
  bf16_t* Wt_up0 = (bf16_t*)(ws + OFF_WUP0); bf16_t* Wt_up1 = (bf16_t*)(ws + OFF_WUP1);
  bf16_t* Wt_dn0 = (bf16_t*)(ws + OFF_WDN0); bf16_t* Wt_dn1 = (bf16_t*)(ws + OFF_WDN1);
  bf16_t* Wt_in1 = (bf16_t*)(ws + OFF_WIN1); bf16_t* Wt_out1 = (bf16_t*)(ws + OFF_WOUT1);
  float* modv = (float*)(ws + OFF_MOD);
  char* Pr = ws + OFF_P; char* Gr = ws + OFF_G;
  bf16_t* Pb = (bf16_t*)Pr; bf16_t* R = (bf16_t*)Pr;
  bf16_t* QA = (bf16_t*)(Pr + P_QA); bf16_t* KA = (bf16_t*)(Pr + P_KA); bf16_t* VA = (bf16_t*)(Pr + P_VA); bf16_t* X0 = (bf16_t*)(Pr + P_X0);
  float* GT = (float*)(Pr + P_GT); bf16_t* A2 = (bf16_t*)(Pr + P_A2);
  bf16_t* A = (bf16_t*)Gr; bf16_t* Gb = (bf16_t*)Gr; float* VV = (float*)(Gr + G_VV);
  bf16_t* HF = (bf16_t*)Gr; bf16_t* HB = (bf16_t*)(Gr + G_HB);
  float* X = p.out;
  float* F256 = p.out + O_C + 512; float* F2048 = p.out + O_C + 512 * 512 + 512;
  const float* mod0 = modv; const float* mod1 = modv + 3 * 6144;
  unsigned bk = 0;
#define PH(i, ...) if (ph_lo <= (i) && (i) < ph_hi) { const int zq = opq(); __VA_ARGS__; if ((i) + 1 < ph_hi) gsync(wv, bar, ++bk); }
  PH(0, {
    conv_w(wv, p.in[zq + 19], Wt_in0, 1024, 2560, 2560);
    conv_w(wv, p.in[zq + 20], Wt_out0, 1024, 1024, 1024);
    conv_w(wv, p.in[zq + 15], Wt_up0, 1024, 5632, 5632);
    conv_w(wv, p.in[zq + 15] + (long)1024 * 5632, Wt_up1, 1024, 5632, 5632);
    conv_w(wv, p.in[zq + 18], Wt_dn0, 2816, 1024, 1024);
    conv_w(wv, p.in[zq + 18] + (long)2816 * 1024, Wt_dn1, 2816, 1024, 1024);
    conv_w(wv, p.in[zq + 33], Wt_in1, 1024, 4128, 4352);
    conv_w(wv, p.in[zq + 38], Wt_out1, 1024, 1024, 1024);
    mod_phase(wv, p, zq, modv);
    filt_phase(wv, p, zq, F256, F2048);
  })
  PH(1, (row_phase<true, false, true>(wv, p, zq, nullptr, nullptr, mod0, 0, nullptr, p.in[zq + 11], mod0, 0, A)))
  PH(2, (gemm_phase<0, 2560>(wv, A, Wt_in0, 2560, 1024, Pb, nullptr)))
  PH(3, post_inproj0(wv, p, zq, Pb, QA, KA, VA, VV, X0))
  PH(4, mix0_phase(wv, p, zq, QA, KA, VA, VV, X0, F256, F2048, A))
  PH(5, (gemm_phase<0, 1024>(wv, A, Wt_out0, 1024, 1024, R, nullptr)))
  PH(6, (row_phase<true, true, true>(wv, p, zq, R, p.in[zq + 12], mod0, 2, X, p.in[zq + 13], mod0, 3, A)))
  PH(7, (gemm_phase<0, 5632>(wv, A, Wt_up0, 5632, 1024, Pb, nullptr)))
  PH(8, ffn_act_phase(wv, Pb, p.in[zq + 16], p.in[zq + 17], Gb))
  PH(9, (gemm_phase<0, 1024>(wv, Gb, Wt_dn0, 1024, 2816, R, nullptr)))
  PH(10, (row_phase<false, true, true>(wv, p, zq, R, p.in[zq + 14], mod0, 5, X, p.in[zq + 11] + 1024, mod1, 0, A)))
  PH(11, (gemm_phase<2, 4096>(wv, A, Wt_in1, 4352, 1024, Pb, GT)))
  PH(13, mlstm_phase(wv, p, zq, Pb, GT, HF, HB))
  PH(14, mlstm_post(wv, p, zq, HF, HB, Pb, A2))
  PH(15, (gemm_phase<0, 1024>(wv, A2, Wt_out1, 1024, 1024, R, nullptr)))
  PH(16, (row_phase<false, true, true>(wv, p, zq, R, p.in[zq + 12] + 1024, mod1, 2, X, p.in[zq + 13] + 1024, mod1, 3, A)))
  PH(17, (gemm_phase<0, 5632>(wv, A, Wt_up1, 5632, 1024, Pb, nullptr)))
  PH(18, ffn_act_phase(wv, Pb, p.in[zq + 16] + 3 * 5632, p.in[zq + 17] + 5632, Gb))
  PH(19, (gemm_phase<0, 1024>(wv, Gb, Wt_dn1, 1024, 2816, R, nullptr)))
  PH(20, (row_phase<false, true, false>(wv, p, zq, R, p.in[zq + 14] + 1024, mod1, 5, X, nullptr, mod1, 0, nullptr)))
#undef PH
}

extern "C" void kernel_launch(void* const* d_in, const int* in_sizes, int n_in, void* d_out, int out_size, void* d_ws, size_t ws_size,
                              hipStream_t stream) {
  static int grid_blocks = 0;
  if (!grid_blocks) {
    if (ws_size < WS_END + 4096) fprintf(stderr, "kernel_launch: workspace too small: %zu < %zu\n", ws_size, (size_t)WS_END);
    hipFuncSetAttribute((const void*)mega, hipFuncAttributeMaxDynamicSharedMemorySize, LDS_BYTES);
    int dev = 0, cus = 0, per = 0;
    hipGetDevice(&dev);
    hipDeviceGetAttribute(&cus, hipDeviceAttributeMultiprocessorCount, dev);
    hipOccupancyMaxActiveBlocksPerMultiprocessor(&per, mega, 512, LDS_BYTES);
    if (per < 1) { fprintf(stderr, "kernel_launch: occupancy query returned %d\n", per); per = 1; }
    grid_blocks = cus;
  }
  Params p{};
  for (int i = 0; i < 39; ++i) p.in[i] = (const float*)d_in[i];
  p.out = (float*)d_out; p.ws = (char*)d_ws;
  int lo = 0, hi = NPH;
  (void)hipMemsetAsync((char*)d_ws + WS_END, 0, 4096, stream);
  void* args[] = {&p, &lo, &hi};
  hipError_t e = hipLaunchCooperativeKernel((void*)mega, dim3(grid_blocks), dim3(512), args, LDS_BYTES, stream);
  if (e != hipSuccess) fprintf(stderr, "cooperative launch failed: %s (grid %d)\n", hipGetErrorString(e), grid_blocks);
}
```

```cpp
#include <hip/hip_runtime.h>
#include <hip/hip_cooperative_groups.h>
#include <cstdio>
#include <cstdint>
namespace cg = cooperative_groups;

typedef unsigned short bf16_t;
typedef short bf16x8 __attribute__((ext_vector_type(8)));
typedef short s16x4 __attribute__((ext_vector_type(4)));
typedef float f32x4 __attribute__((ext_vector_type(4)));
typedef float f32x8 __attribute__((ext_vector_type(8)));
typedef float f32x16 __attribute__((ext_vector_type(16)));
typedef unsigned u32x4 __attribute__((ext_vector_type(4)));
typedef unsigned u32x2 __attribute__((ext_vector_type(2)));

constexpr int T_TOK = 12288, TPR = 8192;
constexpr int LDS_BYTES = 131072;
constexpr int NPH = 21;

constexpr size_t OFF_WIN0 = 0, OFF_WOUT0 = 5242880, OFF_WUP0 = 7340032, OFF_WUP1 = 18874368, OFF_WDN0 = 30408704,
                 OFF_WDN1 = 36175872, OFF_WIN1 = 41943040, OFF_WOUT1 = 50855936, OFF_MOD = 52953088, OFF_P = 53100544,
                 OFF_G = 191512576, WS_END = 260718592;
constexpr size_t P_QA = 62914560, P_KA = 75497472, P_VA = 82313216, P_X0 = 89128960;
constexpr size_t P_GT = 100663296, P_A2 = 102236160;
constexpr size_t G_VV = 25165824, G_HB = 25165824;
constexpr size_t O_K = 12582912, O_V = 14680064, O_C = 16777216, O_N = 25165824, O_M = 25231360;

struct Params { const float* in[39]; float* out; char* ws; };

typedef __bf16 nbf16x2 __attribute__((ext_vector_type(2)));
typedef float nf32x2 __attribute__((ext_vector_type(2)));
__device__ __forceinline__ unsigned cvtpk(float lo, float hi) {
  nf32x2 v = {lo, hi};
  nbf16x2 b = __builtin_convertvector(v, nbf16x2);
  return __builtin_bit_cast(unsigned, b);
}
__device__ __forceinline__ bf16_t f2bf(float f) { return (bf16_t)(cvtpk(f, 0.f) & 0xffffu); }
__device__ __forceinline__ float bf2f(bf16_t h) { return __uint_as_float(((unsigned)h) << 16); }
__device__ __forceinline__ float bflo(unsigned w) { return __uint_as_float(w << 16); }
__device__ __forceinline__ float bfhi(unsigned w) { return __uint_as_float(w & 0xffff0000u); }
__device__ __forceinline__ float wave_sum(float v) {
#pragma unroll
  for (int o = 32; o > 0; o >>= 1) v += __shfl_xor(v, o);
  return v;
}
__device__ __forceinline__ int llane() { int l; asm volatile("v_mbcnt_lo_u32_b32 %0, -1, 0\n\tv_mbcnt_hi_u32_b32 %0, -1, %0" : "=v"(l)); return l; }
__device__ __forceinline__ int ltid(int wv) { return (wv << 6) | llane(); }
__device__ __forceinline__ int opq() { int z; asm volatile("s_mov_b32 %0, 0" : "=s"(z)); return z; }
__device__ __forceinline__ float silu_f(float x) { return x * __builtin_amdgcn_rcpf(1.f + __expf(-x)); }
__device__ __forceinline__ int crow(int r, int hi) { return (r & 3) + 8 * (r >> 2) + 4 * hi; }
__device__ __forceinline__ void unpack8(u32x4 w, float* f) {
  f[0] = bflo(w[0]); f[1] = bfhi(w[0]); f[2] = bflo(w[1]); f[3] = bfhi(w[1]);
  f[4] = bflo(w[2]); f[5] = bfhi(w[2]); f[6] = bflo(w[3]); f[7] = bfhi(w[3]);
}
__device__ __forceinline__ u32x4 pack8(const float* f) {
  u32x4 w = {cvtpk(f[0], f[1]), cvtpk(f[2], f[3]), cvtpk(f[4], f[5]), cvtpk(f[6], f[7])}; return w;
}

__device__ __forceinline__ void conv_w(const int wv, const float* __restrict__ W, bf16_t* __restrict__ Wt, int K, int N, int NP, int b0 = 0) {
  const int tidx = ltid(wv);
  extern __shared__ __attribute__((aligned(16))) char shm_raw[];
  float* tl = (float*)shm_raw;
  const int tid = tidx;
  const int ntn = NP / 64, ntiles = (K / 64) * ntn;
  if ((int)blockIdx.x < b0) return;
  for (int tile = (int)blockIdx.x - b0; tile < ntiles; tile += (int)gridDim.x - b0) {
    const int k0 = (tile / ntn) * 64, n0 = (tile % ntn) * 64;
    __syncthreads();
#pragma unroll
    for (int i = 0; i < 2; ++i) {
      int kr = (tid >> 4) + 32 * i, nc = (tid & 15) * 4;
      float4 v = make_float4(0.f, 0.f, 0.f, 0.f);
      if (n0 + nc < N) v = *(const float4*)(W + (long)(k0 + kr) * N + n0 + nc);
      float* d = tl + kr * 65 + nc; d[0] = v.x; d[1] = v.y; d[2] = v.z; d[3] = v.w;
    }
    __syncthreads();
    {
      int n = tid >> 3, kg = (tid & 7) * 8;
      u32x4 w;
      w[0] = cvtpk(tl[(kg + 0) * 65 + n], tl[(kg + 1) * 65 + n]);
      w[1] = cvtpk(tl[(kg + 2) * 65 + n], tl[(kg + 3) * 65 + n]);
      w[2] = cvtpk(tl[(kg + 4) * 65 + n], tl[(kg + 5) * 65 + n]);
      w[3] = cvtpk(tl[(kg + 6) * 65 + n], tl[(kg + 7) * 65 + n]);
      *(u32x4*)(Wt + (long)(n0 + n) * K + k0 + kg) = w;
    }
  }
  __syncthreads();
}

__device__ __forceinline__ void mod_phase(const int wv, const Params& p, const int zq, float* modv) {
  const int tidx = ltid(wv);
  extern __shared__ __attribute__((aligned(16))) char shm_raw[];
  float* red = (float*)shm_raw;
  const int tid = tidx;
  const float* cvec = p.in[zq + 7]; const float* cctx = p.in[zq + 8]; const float* bmod = p.in[zq + 10];
  for (int item = blockIdx.x; item < 192; item += gridDim.x) {
    const int l = item / 96, cb = (item % 96) * 64;
    const float* W = p.in[zq + 9] + (long)l * 1024 * 6144;
    const int cl = tid & 15, kg = tid >> 4;
    float a0[4] = {0, 0, 0, 0}, a1[4] = {0, 0, 0, 0}, a2[4] = {0, 0, 0, 0};
#pragma unroll 8
    for (int i = 0; i < 32; ++i) {
      int k = kg + 32 * i;
      float4 w = *(const float4*)(W + (long)k * 6144 + cb + cl * 4);
      float s0 = silu_f(cctx[k]), s1 = silu_f(cvec[k]), s2 = silu_f(cvec[1024 + k]);
      a0[0] += s0 * w.x; a0[1] += s0 * w.y; a0[2] += s0 * w.z; a0[3] += s0 * w.w;
      a1[0] += s1 * w.x; a1[1] += s1 * w.y; a1[2] += s1 * w.z; a1[3] += s1 * w.w;
      a2[0] += s2 * w.x; a2[1] += s2 * w.y; a2[2] += s2 * w.z; a2[3] += s2 * w.w;
    }
    __syncthreads();
#pragma unroll
    for (int j = 0; j < 4; ++j) {
      red[kg * 192 + 0 * 64 + cl * 4 + j] = a0[j];
      red[kg * 192 + 1 * 64 + cl * 4 + j] = a1[j];
      red[kg * 192 + 2 * 64 + cl * 4 + j] = a2[j];
    }
    __syncthreads();
    if (tid < 192) {
      float s = 0.f;
#pragma unroll 8
      for (int q = 0; q < 32; ++q) s += red[q * 192 + tid];
      int g = tid / 64, col = cb + (tid % 64);
      modv[(l * 3 + g) * 6144 + col] = s + bmod[l * 6144 + col];
    }
  }
  __syncthreads();
}

__device__ __forceinline__ void filt_phase(const int wv, const Params& p, const int zq, float* F256, float* F2048) {
  const int tidx = ltid(wv);
  extern __shared__ __attribute__((aligned(16))) char shm_raw[];
  float* z = (float*)shm_raw;
  float* h1 = z + 256;
  float* h2 = h1 + 512;
  const int tid = tidx;
  const float *w1 = p.in[zq + 25], *b1 = p.in[zq + 26], *w2 = p.in[zq + 27], *b2 = p.in[zq + 28], *w3 = p.in[zq + 29], *b3 = p.in[zq + 30], *sf = p.in[zq + 31], *skip = p.in[zq + 32];
  const float DMAX = -15.350567286626973f, DMIN = -3.0701134573253946f;
  for (int item = blockIdx.x; item < 288; item += gridDim.x) {
    const int L = item < 32 ? 256 : 2048; const int i0 = item < 32 ? item * 8 : (item - 32) * 8;
    float* F = item < 32 ? F256 : F2048;
    __syncthreads();
    if (tid < 136) {
      const int q = tid / 17, f = tid % 17;
      const float t = (float)(i0 + q) / (float)(L - 1);
      float v;
      if (f == 0) v = t;
      else if (f <= 8) v = cosf(6.283185307179586f * t * (float)f);
      else v = sinf(6.283185307179586f * t * (float)(f - 8));
      z[q * 32 + f] = v;
    }
    __syncthreads();
    { const int q = tid >> 6, u = tid & 63; float a = b1[u];
#pragma unroll 1
      for (int jj = 0; jj < 17; ++jj) a += z[q * 32 + jj] * w1[jj * 64 + u];
      h1[q * 64 + u] = sinf(sf[u] * a); }
    __syncthreads();
    { const int q = tid >> 6, u = tid & 63; float a = b2[u];
#pragma unroll 8
      for (int jj = 0; jj < 64; ++jj) a += h1[q * 64 + jj] * w2[jj * 64 + u];
      h2[q * 64 + u] = sinf(sf[64 + u] * a); }
    __syncthreads();
    {
      const int ch = tid;
      float af[8], ab[8];
#pragma unroll
      for (int q = 0; q < 8; ++q) { af[q] = b3[ch]; ab[q] = b3[512 + ch]; }
#pragma unroll 4
      for (int jj = 0; jj < 64; ++jj) {
        const float wa = w3[jj * 1024 + ch], wb = w3[jj * 1024 + 512 + ch];
#pragma unroll
        for (int q = 0; q < 8; ++q) { const float hh = h2[q * 64 + jj]; af[q] += hh * wa; ab[q] += hh * wb; }
      }
      const float delta = fabsf(DMIN + (DMAX - DMIN) * ((float)ch / 511.f));
#pragma unroll
      for (int q = 0; q < 8; ++q) {
        const int i = i0 + q;
        const float t = (float)i / (float)(L - 1);
        const float win = expf(-t * delta);
        const float sfw = af[q] * win, sbw = ab[q] * win;
        if (i == 0) F[(long)(L - 1) * 512 + ch] = sfw + sbw + skip[ch];
        else { F[(long)(L - 1 + i) * 512 + ch] = sfw; F[(long)(L - 1 - i) * 512 + ch] = sbw; }
      }
    }
  }
  __syncthreads();
}

template <bool FROM_IN, bool HAS_R, bool HAS_A>
__device__ __forceinline__ void row_phase(const int wv, const Params& p, const int zq, const bf16_t* __restrict__ R, const float* __restrict__ postg,
                                          const float* __restrict__ modg, int gate_m, float* X,
                                          const float* __restrict__ preg, const float* __restrict__ mods, int shift_m, bf16_t* __restrict__ A) {
  const int tidx = ltid(wv);
  const int wid = wv, lane = tidx & 63;
  for (int row = blockIdx.x * 8 + wid; row < T_TOK; row += gridDim.x * 8) {
    const int g = row < TPR ? 0 : 1 + (row - TPR) / 2048;
    const float* mg = modg + g * 6144;
    const float* ms = mods + g * 6144;
    const float* xin = FROM_IN ? (row < TPR ? p.in[zq + 0] + (long)row * 1024 : p.in[zq + 1] + (long)(row - TPR) * 1024) : (const float*)X + (long)row * 1024;
    float4 x[4];
#pragma unroll
    for (int j = 0; j < 4; ++j) x[j] = *(const float4*)(xin + j * 256 + lane * 4);
    if (HAS_R) {
      float4 r[4]; float ss = 0.f;
#pragma unroll
      for (int j = 0; j < 4; ++j) { const u32x2 rw = *(const u32x2*)(R + (long)row * 1024 + j * 256 + lane * 4); r[j] = make_float4(bflo(rw[0]), bfhi(rw[0]), bflo(rw[1]), bfhi(rw[1])); ss += r[j].x * r[j].x + r[j].y * r[j].y + r[j].z * r[j].z + r[j].w * r[j].w; }
      ss = wave_sum(ss); const float rs = rsqrtf(ss * (1.f / 1024.f) + 1e-6f);
#pragma unroll
      for (int j = 0; j < 4; ++j) {
        float4 pg = *(const float4*)(postg + j * 256 + lane * 4);
        float4 gt = *(const float4*)(mg + gate_m * 1024 + j * 256 + lane * 4);
        x[j].x += gt.x * (r[j].x * rs * pg.x); x[j].y += gt.y * (r[j].y * rs * pg.y);
        x[j].z += gt.z * (r[j].z * rs * pg.z); x[j].w += gt.w * (r[j].w * rs * pg.w);
        *(float4*)(X + (long)row * 1024 + j * 256 + lane * 4) = x[j];
      }
    }
    if (HAS_A) {
      float ss = 0.f;
#pragma unroll
      for (int j = 0; j < 4; ++j) ss += x[j].x * x[j].x + x[j].y * x[j].y + x[j].z * x[j].z + x[j].w * x[j].w;
      ss = wave_sum(ss); const float rs = rsqrtf(ss * (1.f / 1024.f) + 1e-6f);
#pragma unroll
      for (int j = 0; j < 4; ++j) {
        float4 pg = *(const float4*)(preg + j * 256 + lane * 4);
        float4 sh = *(const float4*)(ms + shift_m * 1024 + j * 256 + lane * 4);
        float4 sc = *(const float4*)(ms + (shift_m + 1) * 1024 + j * 256 + lane * 4);
        float y0 = x[j].x * rs * pg.x * (1.f + sc.x) + sh.x, y1 = x[j].y * rs * pg.y * (1.f + sc.y) + sh.y;
        float y2 = x[j].z * rs * pg.z * (1.f + sc.z) + sh.z, y3 = x[j].w * rs * pg.w * (1.f + sc.w) + sh.w;
        u32x2 w = {cvtpk(y0, y1), cvtpk(y2, y3)};
        *(u32x2*)(A + (long)row * 1024 + j * 256 + lane * 4) = w;
      }
    }
  }
}

constexpr int BM = 256, BK = 64, HALF = 128, WGM = 8, HT = HALF * BK;
__device__ __forceinline__ int lds_byte(int r, int c) {
  int st = (r >> 4) * 2 + (c >> 5), rr = r & 15, cc = c & 31, ob = rr * 64 + cc * 2;
  return st * 1024 + (ob ^ (((ob >> 9) & 1) << 5));
}
__device__ __forceinline__ void stage_rc(int b, int& R, int& C) {
  int st = b / 1024, sb = b % 1024, swz = sb ^ (((sb >> 9) & 1) << 5);
  R = (st >> 1) * 16 + swz / 64; C = (st & 1) * 32 + (swz % 64) / 2;
}

template <int MODE, int LDC>
__device__ __forceinline__ void gemm_phase(const int wv, const bf16_t* __restrict__ A, const bf16_t* __restrict__ Bt, int N, int K,
                                           void* Cout, float* GT) {
  const int tidx = ltid(wv);
  extern __shared__ __attribute__((aligned(16))) char shm_raw[];
  bf16_t* shm = (bf16_t*)shm_raw;
#define SA(b, h) (shm + ((b) * 2 + (h)) * HT)
#define SB(b, h) (shm + (4 + (b) * 2 + (h)) * HT)
#define STAGE(P, BASE, br, kt) do { const bf16_t* _gb = (BASE) + ((long)(br) * K + (long)(kt) * BK); \
    __builtin_amdgcn_global_load_lds((const unsigned*)(_gb + soff0), (unsigned*)((char*)(P) + sl0), 16, 0, 0); \
    __builtin_amdgcn_global_load_lds((const unsigned*)(_gb + soff1), (unsigned*)((char*)(P) + sl0 + 8192), 16, 0, 0); } while (0)
#define LDA(dst, b, h) _Pragma("unroll") for (int m = 0; m < 4; ++m) _Pragma("unroll") for (int k = 0; k < 2; ++k) \
    dst[m][k] = *reinterpret_cast<const bf16x8*>((char*)SA(b, h) + lds_byte(wr * 64 + m * 16 + fr, k * 32 + fq * 8))
#define LDB(dst, b, h) _Pragma("unroll") for (int n = 0; n < 2; ++n) _Pragma("unroll") for (int k = 0; k < 2; ++k) \
    dst[n][k] = *reinterpret_cast<const bf16x8*>((char*)SB(b, h) + lds_byte(wc * 32 + n * 16 + fr, k * 32 + fq * 8))
#define MMA(ai, bj, At, Bt_) do { __builtin_amdgcn_s_setprio(1); \
    _Pragma("unroll") for (int m = 0; m < 4; ++m) _Pragma("unroll") for (int n = 0; n < 2; ++n) _Pragma("unroll") for (int k = 0; k < 2; ++k) \
      acc[ai][bj][m][n] = __builtin_amdgcn_mfma_f32_16x16x32_bf16(At[m][k], Bt_[n][k], acc[ai][bj][m][n], 0, 0, 0); \
    __builtin_amdgcn_s_setprio(0); } while (0)
#define WAIT_V(n) asm volatile("s_waitcnt vmcnt(" #n ")" ::: "memory")
#define WAIT_L(n) asm volatile("s_waitcnt lgkmcnt(" #n ")" ::: "memory")
#define BAR __builtin_amdgcn_s_barrier()
#define SCHED __builtin_amdgcn_sched_barrier(0)
  const int nM = T_TOK / BM, nN = N / BM, nwg = nM * nN;
  const int wid = wv, lane = tidx & 63, wr = wid >> 2, wc = wid & 3, fr = lane & 15, fq = lane >> 4;
  const int nt = K / BK;
  unsigned soff0, soff1; const int sl0 = tidx * 16;
  { int _r, _c; stage_rc(sl0, _r, _c); soff0 = (unsigned)(_r * K + _c); stage_rc(sl0 + 8192, _r, _c); soff1 = (unsigned)(_r * K + _c); }
  for (int tile = blockIdx.x; tile < nwg; tile += gridDim.x) {
    int wgt = tile;
    { const int q = nwg / 8, r = nwg % 8, xcd = wgt % 8, off = wgt / 8;
      wgt = (xcd < r ? xcd * (q + 1) : r * (q + 1) + (xcd - r) * q) + off; }
    const int nig = WGM * nN, gid = wgt / nig, fm = gid * WGM, gsz = min(nM - fm, WGM);
    const int pm = fm + ((wgt % nig) % gsz), pn = (wgt % nig) / gsz, brow = pm * BM, bcol = pn * BM;
    f32x4 acc[2][2][4][2] = {};
    bf16x8 At[4][2], B0[2][2], B1[2][2];
    STAGE(SB(0, 0), Bt, bcol, 0); STAGE(SA(0, 0), A, brow, 0);
    STAGE(SB(0, 1), Bt, bcol + HALF, 0); STAGE(SA(0, 1), A, brow + HALF, 0);
    if (wr == 1) BAR;
    WAIT_V(4); BAR;
    STAGE(SB(1, 0), Bt, bcol, 1); STAGE(SA(1, 0), A, brow, 1); STAGE(SB(1, 1), Bt, bcol + HALF, 1);
    WAIT_V(6); BAR;
    for (int t = 0; t < nt - 2; t += 2) {
      LDB(B0, 0, 0); SCHED; LDA(At, 0, 0); STAGE(SA(1, 1), A, brow + HALF, t + 1);
      WAIT_L(8); BAR; WAIT_L(0); MMA(0, 0, At, B0); BAR; SCHED;
      LDB(B1, 0, 1); STAGE(SB(0, 0), Bt, bcol, t + 2);
      BAR; WAIT_L(0); MMA(0, 1, At, B1); BAR;
      LDA(At, 0, 1); STAGE(SA(0, 0), A, brow, t + 2);
      BAR; WAIT_L(0); MMA(1, 0, At, B0); BAR; SCHED;
      STAGE(SB(0, 1), Bt, bcol + HALF, t + 2);
      WAIT_V(6); BAR; MMA(1, 1, At, B1); BAR;
      LDB(B0, 1, 0); SCHED; LDA(At, 1, 0); STAGE(SA(0, 1), A, brow + HALF, t + 2);
      WAIT_L(8); BAR; WAIT_L(0); MMA(0, 0, At, B0); BAR; SCHED;
      LDB(B1, 1, 1); STAGE(SB(1, 0), Bt, bcol, t + 3);
      BAR; WAIT_L(0); MMA(0, 1, At, B1); BAR;
      LDA(At, 1, 1); STAGE(SA(1, 0), A, brow, t + 3);
      BAR; WAIT_L(0); MMA(1, 0, At, B0); BAR; SCHED;
      STAGE(SB(1, 1), Bt, bcol + HALF, t + 3);
      WAIT_V(6); BAR; MMA(1, 1, At, B1); BAR;
    }
    { LDB(B0, 0, 0); LDA(At, 0, 0); STAGE(SA(1, 1), A, brow + HALF, nt - 1);
      BAR; WAIT_L(0); MMA(0, 0, At, B0); BAR;
      LDB(B1, 0, 1); BAR; WAIT_L(0); MMA(0, 1, At, B1); BAR;
      LDA(At, 0, 1); WAIT_V(4); BAR; WAIT_L(0); MMA(1, 0, At, B0); MMA(1, 1, At, B1); BAR; }
    { LDB(B0, 1, 0); LDA(At, 1, 0); WAIT_V(2); BAR; WAIT_L(0); MMA(0, 0, At, B0); BAR;
      LDB(B1, 1, 1); WAIT_V(0); BAR; WAIT_L(0); MMA(0, 1, At, B1); BAR;
      LDA(At, 1, 1); BAR; WAIT_L(0); MMA(1, 0, At, B0); MMA(1, 1, At, B1); BAR; }
    if (wr == 0) BAR;
    {
      const int le = llane();
      const int fr = le & 15, fq = le >> 4;
      const long base = (long)(brow + wr * 64) * LDC + bcol + wc * 32 + (unsigned)(fq * 4 * LDC + fr);
      if (MODE == 0 || (MODE == 2 && pn < 16)) {
        bf16_t* cp = (bf16_t*)Cout + base;
#pragma unroll
        for (int ai = 0; ai < 2; ++ai)
#pragma unroll
          for (int m = 0; m < 4; ++m)
#pragma unroll
            for (int j = 0; j < 4; ++j) {
              bf16_t* rp = cp + (ai * HALF + m * 16 + j) * LDC;
#pragma unroll
              for (int bj = 0; bj < 2; ++bj)
#pragma unroll
                for (int n = 0; n < 2; ++n) rp[bj * HALF + n * 16] = f2bf(acc[ai][bj][m][n][j]);
            }
      } else if (MODE == 1) {
        float* cp = (float*)Cout + base;
#pragma unroll
        for (int ai = 0; ai < 2; ++ai)
#pragma unroll
          for (int m = 0; m < 4; ++m)
#pragma unroll
            for (int j = 0; j < 4; ++j) {
              float* rp = cp + (ai * HALF + m * 16 + j) * LDC;
#pragma unroll
              for (int bj = 0; bj < 2; ++bj)
#pragma unroll
                for (int n = 0; n < 2; ++n) rp[bj * HALF + n * 16] = acc[ai][bj][m][n][j];
            }
      } else {
        if (wc == 0) {
          float* gp = GT + (long)(brow + wr * 64) * 32 + (unsigned)(fq * 4 * 32 + fr);
#pragma unroll
          for (int ai = 0; ai < 2; ++ai)
#pragma unroll
            for (int m = 0; m < 4; ++m)
#pragma unroll
              for (int j = 0; j < 4; ++j)
#pragma unroll
                for (int n = 0; n < 2; ++n) gp[(ai * HALF + m * 16 + j) * 32 + n * 16] = acc[ai][0][m][n][j];
        }
      }
    }
    __syncthreads();
  }
#undef SA
#undef SB
#undef STAGE
#undef LDA
#undef LDB
#undef MMA
}

__device__ __forceinline__ void post_inproj0(const int wv, const Params& p, const int zq, const bf16_t* __restrict__ P0, bf16_t* __restrict__ QA, bf16_t* __restrict__ KA,
                                             bf16_t* __restrict__ VA, float* __restrict__ VV, bf16_t* __restrict__ X0) {
  const int tidx = ltid(wv);
  const int wid = wv, lane = tidx & 63;
  const float* qn = p.in[zq + 21]; const float* kn = p.in[zq + 22]; const float* cw = p.in[zq + 23]; const float* cb = p.in[zq + 24];
  float* outK = p.out + O_K; float* outV = p.out + O_V;
  for (int i = blockIdx.x * 512 + tidx; i < 2 * 512 * 256 / 4; i += gridDim.x * 512) {
    int e = i * 4; int b = e / (512 * 256), rem = e % (512 * 256);
    float4 kk = *(const float4*)(p.in[zq + 2] + e); float4 vv = *(const float4*)(p.in[zq + 3] + e);
    long d = (long)(8192 + b * 2560 + 2048) * 256 + rem;
    u32x2 wk = {cvtpk(kk.x, kk.y), cvtpk(kk.z, kk.w)}; u32x2 wv = {cvtpk(vv.x, vv.y), cvtpk(vv.z, vv.w)};
    *(u32x2*)(KA + d) = wk; *(u32x2*)(VA + d) = wv;
  }
  const int fi = lane & 31;
  const float inv = exp2f(-(float)fi * (13.287712379549449f / 32.f));
  for (int row = blockIdx.x * 8 + wid; row < T_TOK; row += gridDim.x * 8) {
    const bool samp = row >= TPR;
    const int L = samp ? 2048 : 256;
    const int tl = samp ? (row - TPR) % 2048 : row % 256;
    const long krow = samp ? (long)(8192 + ((row - TPR) / 2048) * 2560 + tl) : (long)row;
    const bf16_t* base = P0 + (long)row * 2560;
    float cs = 1.f, sn = 0.f;
    if (samp) { float pos = (lane < 32) ? (float)(tl / 64) : (float)(tl % 64); float ang = pos * inv; cs = cosf(ang); sn = sinf(ang); }
#pragma unroll
    for (int hh = 0; hh < 6; ++hh) {
      float x1 = bf2f(base[hh * 128 + lane]), x2 = bf2f(base[hh * 128 + 64 + lane]);
      float ss = wave_sum(x1 * x1 + x2 * x2);
      float rs = rsqrtf(ss * (1.f / 128.f) + 1e-6f);
      const float* gw = hh < 4 ? qn : kn;
      float y1 = x1 * rs * gw[lane], y2 = x2 * rs * gw[64 + lane];
      if (hh >= 4 && !samp) { outK[(long)row * 256 + (hh - 4) * 128 + lane] = y1; outK[(long)row * 256 + (hh - 4) * 128 + 64 + lane] = y2; }
      float o1 = y1 * cs - y2 * sn, o2 = y1 * sn + y2 * cs;
      if (hh < 4) { QA[(long)row * 512 + hh * 128 + lane] = f2bf(o1); QA[(long)row * 512 + hh * 128 + 64 + lane] = f2bf(o2); }
      else { KA[krow * 256 + (hh - 4) * 128 + lane] = f2bf(o1); KA[krow * 256 + (hh - 4) * 128 + 64 + lane] = f2bf(o2); }
    }
    {
      u32x2 w = *(const u32x2*)(base + 768 + lane * 4);
      *(u32x2*)(VA + krow * 256 + lane * 4) = w;
      if (!samp) { float4 f = make_float4(bflo(w[0]), bfhi(w[0]), bflo(w[1]), bfhi(w[1])); *(float4*)(outV + (long)row * 256 + lane * 4) = f; }
    }
    {
      const int c8 = lane * 8;
      float uc[3][8];
#pragma unroll
      for (int g = 0; g < 3; ++g) {
        const int col = g * 512 + c8;
        float um[8], u0[8], up[8];
        u32x4 z4 = {0u, 0u, 0u, 0u};
        u32x4 wm = (tl > 0) ? *(const u32x4*)(base - 2560 + 1024 + col) : z4;
        u32x4 w0 = *(const u32x4*)(base + 1024 + col);
        u32x4 wp = (tl < L - 1) ? *(const u32x4*)(base + 2560 + 1024 + col) : z4;
        unpack8(wm, um); unpack8(w0, u0); unpack8(wp, up);
#pragma unroll
        for (int e = 0; e < 8; ++e)
          uc[g][e] = cw[col + e] * um[e] + cw[1536 + col + e] * u0[e] + cw[3072 + col + e] * up[e] + cb[col + e];
      }
      float vvv[8];
#pragma unroll
      for (int e = 0; e < 8; ++e) vvv[e] = uc[2][e] * uc[1][e];
      *(float4*)(VV + (long)row * 512 + c8) = make_float4(vvv[0], vvv[1], vvv[2], vvv[3]);
      *(float4*)(VV + (long)row * 512 + c8 + 4) = make_float4(vvv[4], vvv[5], vvv[6], vvv[7]);
      *(u32x4*)(X0 + (long)row * 512 + c8) = pack8(uc[0]);
    }
  }
}

constexpr int AD = 128, ANW = 8, QBLK = 32, KVBLK = 64;
constexpr float ASCALE = 0.088388347648318440f;
constexpr float ATHR = 8.f;
constexpr int LDQ = 512, LDK = 256, LDO = 1024;
constexpr size_t SHM_V = KVBLK * AD * 2, SHM_K = KVBLK * AD * 2;
#define KSWZ(row, colB) ((row) * 256 + ((colB) ^ (((row) & 7) << 4)))
#define SBAR() __builtin_amdgcn_sched_barrier(0)

__device__ __forceinline__ void partialSM(f32x16& p0, f32x16& p1, float& m_reg, float& mn, float& alpha) {
  constexpr float C = ASCALE * 1.4426950408889634f;
  float pmax = p0[0];
#pragma unroll
  for (int r = 1; r < 16; ++r) pmax = fmaxf(pmax, p0[r]);
#pragma unroll
  for (int r = 0; r < 16; ++r) pmax = fmaxf(pmax, p1[r]);
  { auto rr = __builtin_amdgcn_permlane32_swap(__float_as_uint(pmax), __float_as_uint(pmax), false, false);
    pmax = fmaxf(__uint_as_float(rr[0]), __uint_as_float(rr[1])); }
  if (__builtin_expect(__all(pmax - m_reg <= ATHR / ASCALE), 1)) { mn = m_reg; alpha = 1.f; }
  else { mn = fmaxf(m_reg, pmax); alpha = __builtin_amdgcn_exp2f((m_reg - mn) * C); m_reg = mn; }
  float mnC = -mn * C;
#pragma unroll
  for (int r = 0; r < 16; ++r) p0[r] = fmaf(p0[r], C, mnC);
#pragma unroll
  for (int r = 0; r < 16; ++r) p1[r] = fmaf(p1[r], C, mnC);
#pragma unroll
  for (int r = 0; r < 16; ++r) p0[r] = __builtin_amdgcn_exp2f(p0[r]);
}
__device__ __forceinline__ void finishSM(f32x16& p0, f32x16& p1, float alpha, float& l_reg, bf16x8& pa0, bf16x8& pa1, bf16x8& pa2, bf16x8& pa3) {
#pragma unroll
  for (int r = 0; r < 16; ++r) p1[r] = __builtin_amdgcn_exp2f(p1[r]);
  float ps = 0;
#pragma unroll
  for (int r = 0; r < 16; ++r) ps += p0[r];
#pragma unroll
  for (int r = 0; r < 16; ++r) ps += p1[r];
  { auto rr = __builtin_amdgcn_permlane32_swap(__float_as_uint(ps), __float_as_uint(ps), false, false);
    ps = __uint_as_float(rr[0]) + __uint_as_float(rr[1]); }
  l_reg = l_reg * alpha + ps;
#define PK4(P, BASE, OUT) do { unsigned a0 = cvtpk(P[BASE + 0], P[BASE + 1]), a1 = cvtpk(P[BASE + 2], P[BASE + 3]);   \
    unsigned b0 = cvtpk(P[BASE + 4], P[BASE + 5]), b1 = cvtpk(P[BASE + 6], P[BASE + 7]);                              \
    auto r0 = __builtin_amdgcn_permlane32_swap(a0, b0, false, false); auto r1 = __builtin_amdgcn_permlane32_swap(a1, b1, false, false); \
    u32x4 w = {r0[0], r1[0], r0[1], r1[1]}; OUT = *reinterpret_cast<bf16x8*>(&w); } while (0)
  PK4(p0, 0, pa0); PK4(p0, 8, pa1); PK4(p1, 0, pa2); PK4(p1, 8, pa3);
#undef PK4
}
__device__ __forceinline__ void qkt(f32x16& p0, f32x16& p1, const bf16_t* Ks, const bf16x8* qr, int r32, int hi) {
  p0 = f32x16{}; p1 = f32x16{};
#pragma unroll
  for (int d0 = 0; d0 < 8; ++d0) { int cb = (d0 * 16 + hi * 8) * 2;
    bf16x8 b0 = *reinterpret_cast<const bf16x8*>((const char*)Ks + KSWZ(r32, cb));
    bf16x8 b1 = *reinterpret_cast<const bf16x8*>((const char*)Ks + KSWZ(32 + r32, cb));
    p0 = __builtin_amdgcn_mfma_f32_32x32x16_bf16(b0, qr[d0], p0, 0, 0, 0);
    p1 = __builtin_amdgcn_mfma_f32_32x32x16_bf16(b1, qr[d0], p1, 0, 0, 0); }
}
__device__ __forceinline__ int v_st(int k, int c) { const int kk = (k & ~0xC) | ((k & 4) << 1) | ((k & 8) >> 1); return ((kk >> 3) * 4 + (c >> 5)) * 512 + ((kk & 7) * 32 + (c & 31)) * 2; }
__device__ __forceinline__ int v_rd_base(int lane) { return ((lane & 3) << 3) | (((lane >> 2) & 3) << 6) | (((lane >> 4) & 1) << 5) | (((lane >> 5) & 1) << 8); }
constexpr int v_rd_off(int d0, int ks, int half) { return d0 * 512 + ks * 4096 + half * 2048; }
template <int OFF> __device__ __forceinline__ s16x4 tr_read(int vb) {
  s16x4 r; asm volatile("ds_read_b64_tr_b16 %0, %1 offset:%2" : "=&v"(r) : "v"(vb), "i"(OFF) : "memory"); return r;
}
template <int D0> __device__ __forceinline__ void pv_one(f32x16& od, int vb, bf16x8 pa0, bf16x8 pa1, bf16x8 pa2, bf16x8 pa3) {
  const s16x4 l0 = tr_read<v_rd_off(D0, 0, 0)>(vb), h0 = tr_read<v_rd_off(D0, 0, 1)>(vb), l1 = tr_read<v_rd_off(D0, 1, 0)>(vb), h1 = tr_read<v_rd_off(D0, 1, 1)>(vb);
  const s16x4 l2 = tr_read<v_rd_off(D0, 2, 0)>(vb), h2 = tr_read<v_rd_off(D0, 2, 1)>(vb), l3 = tr_read<v_rd_off(D0, 3, 0)>(vb), h3 = tr_read<v_rd_off(D0, 3, 1)>(vb);
  asm volatile("s_waitcnt lgkmcnt(0)" ::: "memory"); SBAR();
#define PK(L, H) (bf16x8){L[0], L[1], L[2], L[3], H[0], H[1], H[2], H[3]}
  od = __builtin_amdgcn_mfma_f32_32x32x16_bf16(pa0, PK(l0, h0), od, 0, 0, 0);
  od = __builtin_amdgcn_mfma_f32_32x32x16_bf16(pa1, PK(l1, h1), od, 0, 0, 0);
  od = __builtin_amdgcn_mfma_f32_32x32x16_bf16(pa2, PK(l2, h2), od, 0, 0, 0);
  od = __builtin_amdgcn_mfma_f32_32x32x16_bf16(pa3, PK(l3, h3), od, 0, 0, 0);
#undef PK
}
__device__ __forceinline__ void pv_d0(f32x16* o, int vb, bf16x8 pa0, bf16x8 pa1, bf16x8 pa2, bf16x8 pa3) {
  pv_one<0>(o[0], vb, pa0, pa1, pa2, pa3); pv_one<1>(o[1], vb, pa0, pa1, pa2, pa3); pv_one<2>(o[2], vb, pa0, pa1, pa2, pa3); pv_one<3>(o[3], vb, pa0, pa1, pa2, pa3);
}

__device__ __forceinline__ void attn_dense_body(const int wv, const bf16_t* __restrict__ Qb, const bf16_t* __restrict__ Kh, const bf16_t* __restrict__ Vh,
                                                bf16_t* __restrict__ Ob, int seq, char* lds) {
  const int tidx = ltid(wv);
  const int tid = tidx, wid = wv, lane = tid & 63, r32 = lane & 31, hi = lane >> 5;
  bf16_t* V_lds = (bf16_t*)lds; bf16_t* K_lds = (bf16_t*)(lds + 2 * SHM_V);
  float* ws = (float*)(lds + 2 * SHM_V + 2 * SHM_K) + wid * 64; float* li_l = ws; float* al_l = ws + 32;
  float m_reg = -1e30f, l_reg = 0; f32x16 o[4] = {}; bf16x8 qr[8];
  const bf16_t* Qw = Qb + (long)(wid * QBLK + r32) * LDQ + hi * 8;
#pragma unroll
  for (int d0 = 0; d0 < 8; ++d0) qr[d0] = *reinterpret_cast<const bf16x8*>(Qw + d0 * 16);
  const int sr = tid >> 4, sc = (tid & 15) * 8, vst0 = v_st(sr, sc), vst1 = v_st(32 + sr, sc);
  const int vb0 = (int)(uintptr_t)V_lds + v_rd_base(lane);
  bf16x8 sA_vs0, sA_vs1, sA_ks0, sA_ks1, sB_vs0, sB_vs1, sB_ks0, sB_ks1;
#define SLOADA(k0) do { sA_vs0 = *(const bf16x8*)(&Vh[(long)((k0) + sr) * LDK + sc]); sA_vs1 = *(const bf16x8*)(&Vh[(long)((k0) + 32 + sr) * LDK + sc]); \
    sA_ks0 = *(const bf16x8*)(&Kh[(long)((k0) + sr) * LDK + sc]); sA_ks1 = *(const bf16x8*)(&Kh[(long)((k0) + 32 + sr) * LDK + sc]); } while (0)
#define SLOADB(k0) do { sB_vs0 = *(const bf16x8*)(&Vh[(long)((k0) + sr) * LDK + sc]); sB_vs1 = *(const bf16x8*)(&Vh[(long)((k0) + 32 + sr) * LDK + sc]); \
    sB_ks0 = *(const bf16x8*)(&Kh[(long)((k0) + sr) * LDK + sc]); sB_ks1 = *(const bf16x8*)(&Kh[(long)((k0) + 32 + sr) * LDK + sc]); } while (0)
#define SWRITEA(b) do { *(bf16x8*)((char*)V_lds + (b) * SHM_V + vst0) = sA_vs0; *(bf16x8*)((char*)V_lds + (b) * SHM_V + vst1) = sA_vs1; int kc = sc * 2; \
    *(bf16x8*)((char*)K_lds + (b) * SHM_K + KSWZ(sr, kc)) = sA_ks0; *(bf16x8*)((char*)K_lds + (b) * SHM_K + KSWZ(32 + sr, kc)) = sA_ks1; } while (0)
#define SWRITEB(b) do { *(bf16x8*)((char*)V_lds + (b) * SHM_V + vst0) = sB_vs0; *(bf16x8*)((char*)V_lds + (b) * SHM_V + vst1) = sB_vs1; int kc = sc * 2; \
    *(bf16x8*)((char*)K_lds + (b) * SHM_K + KSWZ(sr, kc)) = sB_ks0; *(bf16x8*)((char*)K_lds + (b) * SHM_K + KSWZ(32 + sr, kc)) = sB_ks1; } while (0)
#define SWAIT() asm volatile("s_waitcnt vmcnt(4)" ::: "memory")
#define RESC(a) do { if (__any((a) < 1.f)) { if (hi == 0) al_l[r32] = (a); asm volatile("s_waitcnt lgkmcnt(0)" ::: "memory"); \
    _Pragma("unroll") for (int d = 0; d < 4; ++d) _Pragma("unroll") for (int r = 0; r < 16; ++r) o[d][r] *= al_l[crow(r, hi)]; } } while (0)
  f32x16 pA0, pA1, pB0, pB1; float mnA, mnB, alA, alB; bf16x8 pa0, pa1, pa2, pa3; const int NT = seq / KVBLK;
  SLOADA(0); asm volatile("s_waitcnt vmcnt(0)" ::: "memory"); SWRITEA(0); __syncthreads();
  qkt(pA0, pA1, K_lds, qr, r32, hi); partialSM(pA0, pA1, m_reg, mnA, alA);
  SLOADB(KVBLK); if (2 < NT) SLOADA(2 * KVBLK);
  SWAIT(); SWRITEB(1); __syncthreads();
  for (int j = 1; j + 1 < NT; j += 2) {
    SBAR(); qkt(pB0, pB1, (bf16_t*)((char*)K_lds + SHM_K), qr, r32, hi);
    finishSM(pA0, pA1, alA, l_reg, pa0, pa1, pa2, pa3); SBAR();
    SLOADB((j + 2) * KVBLK); SBAR();
    pv_d0(o, vb0, pa0, pa1, pa2, pa3); partialSM(pB0, pB1, m_reg, mnB, alB);
    __syncthreads(); SWAIT(); SWRITEA(0);
    RESC(alB); __syncthreads();
    SBAR(); qkt(pA0, pA1, K_lds, qr, r32, hi);
    finishSM(pB0, pB1, alB, l_reg, pa0, pa1, pa2, pa3); SBAR();
    if (j + 3 < NT) SLOADA((j + 3) * KVBLK); SBAR();
    pv_d0(o, vb0 + (int)SHM_V, pa0, pa1, pa2, pa3); partialSM(pA0, pA1, m_reg, mnA, alA);
    __syncthreads(); SWAIT(); SWRITEB(1);
    RESC(alA); __syncthreads();
  }
  SBAR(); qkt(pB0, pB1, (bf16_t*)((char*)K_lds + SHM_K), qr, r32, hi);
  finishSM(pA0, pA1, alA, l_reg, pa0, pa1, pa2, pa3); SBAR();
  pv_d0(o, vb0, pa0, pa1, pa2, pa3); partialSM(pB0, pB1, m_reg, mnB, alB);
  __syncthreads(); RESC(alB);
  finishSM(pB0, pB1, alB, l_reg, pa0, pa1, pa2, pa3); SBAR();
  pv_d0(o, vb0 + (int)SHM_V, pa0, pa1, pa2, pa3);
  if (hi == 0) li_l[r32] = l_reg; asm volatile("s_waitcnt lgkmcnt(0)" ::: "memory");
  float rli[16];
#pragma unroll
  for (int r = 0; r < 16; ++r) rli[r] = __builtin_amdgcn_rcpf(li_l[crow(r, hi)]);
  bf16_t* Ow = Ob + (long)(wid * QBLK) * LDO;
#pragma unroll
  for (int r = 0; r < 16; ++r) { int orow = crow(r, hi);
#pragma unroll
    for (int d0 = 0; d0 < 4; ++d0) Ow[(long)orow * LDO + d0 * 32 + r32] = f2bf(o[d0][r] * rli[r]); }
#undef SLOADA
#undef SLOADB
#undef SWRITEA
#undef SWRITEB
#undef SWAIT
#undef RESC
}

__device__ __forceinline__ void hyena_item(const float* __restrict__ Fu, const float* __restrict__ Vu, const bf16_t* __restrict__ Xu,
                                           bf16_t* __restrict__ Au, int L, int t0, unsigned ln) {
  float y[16], ring[16];
#pragma unroll
  for (int i = 0; i < 16; ++i) { y[i] = 0.f; const float* fr = Fu + (long)(t0 + i + L - 1) * 512; ring[i] = fr[ln]; }
  const float* fp = Fu + (long)(t0 + L - 2) * 512;
  float va[16], fa[16], vb[16], fb[16];
#define HY_LOAD(V, Fq, S) _Pragma("unroll") for (int j = 0; j < 16; ++j) { const float* vr_ = Vu + (long)((S) + j) * 512; const float* fr_ = fp - (long)((S) + j) * 512; V[j] = vr_[ln]; Fq[j] = fr_[ln]; }
#define HY_STEP(V, Fq) _Pragma("unroll") for (int j = 0; j < 16; ++j) { const float vs = V[j]; \
    _Pragma("unroll") for (int i = 0; i < 16; ++i) y[i] += ring[(i - j) & 15] * vs; ring[(15 - j) & 15] = Fq[j]; }
  HY_LOAD(va, fa, 0)
  for (int s0 = 0; s0 < L; s0 += 32) {
    HY_LOAD(vb, fb, s0 + 16)
    HY_STEP(va, fa)
    if (s0 + 32 < L) { HY_LOAD(va, fa, s0 + 32) }
    HY_STEP(vb, fb)
  }
#undef HY_LOAD
#undef HY_STEP
#pragma unroll
  for (int i = 0; i < 16; ++i) {
    const bf16_t* xr = Xu + (long)(t0 + i) * 512; bf16_t* ar = Au + (long)(t0 + i) * 1024;
    ar[ln] = f2bf(y[i] * bf2f(xr[ln]));
  }
}

__device__ __forceinline__ void mix0_phase(const int wv, const Params& p, const int zq, const bf16_t* QA, const bf16_t* KA, const bf16_t* VA, const float* VV,
                                           const bf16_t* X0, const float* F256, const float* F2048, bf16_t* AO) {
  extern __shared__ __attribute__((aligned(16))) char shm_raw[];
#ifndef NO_ATTN
  for (int it = blockIdx.x; it < 192; it += gridDim.x) {
    long rowb, krow; int h, seqk;
    if (it < 64) { const int qb = it % 8, b = it / 32; h = (it / 8) % 4; rowb = 8192 + (long)b * 2048 + qb * 256; krow = 8192 + (long)b * 2560; seqk = 2560; }
    else { const int j = it - 64; const int b = j / 4; h = j % 4; rowb = (long)b * 256; krow = rowb; seqk = 256; }
    __syncthreads();
    attn_dense_body(wv, QA + rowb * 512 + h * 128, KA + krow * 256 + (h >> 1) * 128, VA + krow * 256 + (h >> 1) * 128, AO + rowb * 1024 + h * 128, seqk, shm_raw);
  }
#endif
#ifndef NO_HYENA
  const int lane = llane(); const int wid = wv;
  {
    unsigned* qctr = (unsigned*)(p.ws + WS_END) + 768;
    volatile int* sidx = (volatile int*)(shm_raw + 120000);
    for (;;) {
      __syncthreads();
      if (ltid(wv) == 0) *sidx = (int)__hip_atomic_fetch_add(qctr, 1u, __ATOMIC_RELAXED, __HIP_MEMORY_SCOPE_AGENT);
      __syncthreads();
      const int it = __builtin_amdgcn_readfirstlane(*sidx);
      if (it >= 768) break;
      if (it < 256) {
        const int b = it / 128, cgp = (it / 16) % 8, tg = it % 16;
        { const long rb = 8192 + (long)b * 2048; hyena_item(F2048 + cgp * 64, VV + rb * 512 + cgp * 64, X0 + rb * 512 + cgp * 64, AO + rb * 1024 + 512 + cgp * 64, 2048, tg * 128 + wid * 16, (unsigned)lane); }
      } else {
        const int jj = it - 256; const int b = jj / 16, cgp = (jj / 2) % 8, tg = jj % 2;
        { const long rb = (long)b * 256; hyena_item(F256 + cgp * 64, VV + rb * 512 + cgp * 64, X0 + rb * 512 + cgp * 64, AO + rb * 1024 + 512 + cgp * 64, 256, tg * 128 + wid * 16, (unsigned)lane); }
      }
    }
  }
#endif
  __syncthreads();
}

__device__ __forceinline__ float erf_as(float x) {
  const float ax = fabsf(x);
  const float t = __builtin_amdgcn_rcpf(fmaf(0.3275911f, ax, 1.f));
  float p = fmaf(1.061405429f, t, -1.453152027f);
  p = fmaf(p, t, 1.421413741f); p = fmaf(p, t, -0.284496736f); p = fmaf(p, t, 0.254829592f);
  const float r = 1.f - p * t * __expf(-ax * ax);
  return copysignf(r, x);
}
__device__ __forceinline__ float gelu_f(float x) { return 0.5f * x * (1.f + erf_as(x * 0.70710678118654752f)); }
__device__ __forceinline__ void ffn_act_phase(const int wv, const bf16_t* __restrict__ P, const float* __restrict__ cw, const float* __restrict__ cb, bf16_t* __restrict__ G) {
  const int tidx = ltid(wv);
  const int tid = tidx;
  if (tid >= 352) return;
  const int c8 = tid * 8;
  float w1[3][8], w2[3][8], b1[8], b2[8];
#pragma unroll
  for (int e = 0; e < 8; ++e) {
#pragma unroll
    for (int k = 0; k < 3; ++k) { w1[k][e] = cw[k * 5632 + c8 + e]; w2[k][e] = cw[k * 5632 + 2816 + c8 + e]; }
    b1[e] = cb[c8 + e]; b2[e] = cb[2816 + c8 + e];
  }
  for (int item = blockIdx.x; item < T_TOK / 16; item += gridDim.x) {
    const int r0 = item * 16;
    const int L = r0 < TPR ? 256 : 2048;
    const int tl0 = r0 < TPR ? r0 % 256 : (r0 - TPR) % 2048;
    float am[8], a0[8], ap[8], gm[8], g0[8], gp[8];
    const u32x4 z4 = {0u, 0u, 0u, 0u};
    {
      const bf16_t* b = P + (long)r0 * 5632 + c8;
      u32x4 x = (tl0 > 0) ? *(const u32x4*)(b - 5632) : z4; unpack8(x, am);
      x = (tl0 > 0) ? *(const u32x4*)(b - 5632 + 2816) : z4; unpack8(x, gm);
      x = *(const u32x4*)(b); unpack8(x, a0);
      x = *(const u32x4*)(b + 2816); unpack8(x, g0);
    }
    for (int r = 0; r < 16; ++r) {
      const bf16_t* b = P + (long)(r0 + r) * 5632 + c8;
      const bool vn = (tl0 + r) < L - 1;
      u32x4 x = vn ? *(const u32x4*)(b + 5632) : z4; unpack8(x, ap);
      x = vn ? *(const u32x4*)(b + 5632 + 2816) : z4; unpack8(x, gp);
      float o[8];
#pragma unroll
      for (int e = 0; e < 8; ++e) {
        float h1 = w1[0][e] * am[e] + w1[1][e] * a0[e] + w1[2][e] * ap[e] + b1[e];
        float h2 = w2[0][e] * gm[e] + w2[1][e] * g0[e] + w2[2][e] * gp[e] + b2[e];
        o[e] = gelu_f(h1) * h2;
        am[e] = a0[e]; a0[e] = ap[e]; gm[e] = g0[e]; g0[e] = gp[e];
      }
      *(u32x4*)(G + (long)(r0 + r) * 2816 + c8) = pack8(o);
    }
  }
}

template <int K>
__device__ __forceinline__ f32x16 mma_nt(const bf16_t* A, int lda, const bf16_t* B, int ldb, f32x16 acc, int r32, int hi) {
  bf16x8 a[K / 16], b[K / 16];
#pragma unroll
  for (int k0 = 0; k0 < K / 16; ++k0) {
    a[k0] = *reinterpret_cast<const bf16x8*>(A + r32 * lda + k0 * 16 + 8 * hi);
    b[k0] = *reinterpret_cast<const bf16x8*>(B + r32 * ldb + k0 * 16 + 8 * hi);
  }
#pragma unroll
  for (int k0 = 0; k0 < K / 16; ++k0) acc = __builtin_amdgcn_mfma_f32_32x32x16_bf16(a[k0], b[k0], acc, 0, 0, 0);
  return acc;
}

__device__ __forceinline__ void mlstm_phase(const int wv, const Params& p, const int zq, const bf16_t* __restrict__ P1, const float* __restrict__ GT,
                                            bf16_t* __restrict__ HF, bf16_t* __restrict__ HB) {
  const int tidx = ltid(wv);
  extern __shared__ __attribute__((aligned(16))) char shm_raw[];
  bf16_t* Qs = (bf16_t*)shm_raw;
  bf16_t* Ks = Qs + 64 * 136;
  bf16_t* KwT = Ks + 64 * 136;
  bf16_t* VsT = KwT + 128 * 72;
  bf16_t* Wb = VsT + 128 * 72;
  bf16_t* Cb = Wb + 64 * 72;
  float* gbuf = (float*)(Cb + 128 * 136);
  float* sclv = gbuf + 400; float* wintv = sclv + 64; float* nvec = wintv + 64;
  float* cwl = nvec + 128;
  const int tid = tidx, wid = wv, lane = tid & 63, r32 = lane & 31, hi = lane >> 5;
  const float* cw = p.in[zq + 35]; const float* cbias = p.in[zq + 36]; const float* bg = p.in[zq + 34];
  const bool usplit = gridDim.x > 64;
  const int ustep = usplit ? ((int)blockIdx.x < 32 ? 544 : (int)gridDim.x - 32) : (int)gridDim.x;
  for (int u = blockIdx.x; u < 544; u += ustep) {
    int seq, h, dir;
    if (u < 32) { seq = 32 + u / 16; h = (u / 2) % 8; dir = u % 2; } else { int j = u - 32; seq = j / 16; h = (j / 2) % 8; dir = j % 2; }
    const int L = seq < 32 ? 256 : 2048;
    const long rowbase = seq < 32 ? (long)seq * 256 : 8192 + (long)(seq - 32) * 2048;
    __syncthreads();
    f32x16 cacc[2]; float m = 0.f;
    const int vb2 = wid >> 1;
    if (seq >= 32) {
      const int b = seq - 32;
      const float* Cin = p.in[zq + 4] + (long)((b * 2 + dir) * 8 + h) * 16384;
#pragma unroll
      for (int i = 0; i < 2; ++i) { const int kb = (wid & 1) * 2 + i;
#pragma unroll
        for (int r = 0; r < 16; ++r) cacc[i][r] = Cin[(vb2 * 32 + crow(r, hi)) * 128 + kb * 32 + r32]; }
      if (tid < 128) nvec[tid] = p.in[zq + 5][((b * 2 + dir) * 8 + h) * 128 + tid];
      m = p.in[zq + 6][(b * 2 + dir) * 8 + h];
    } else {
#pragma unroll
      for (int i = 0; i < 2; ++i)
#pragma unroll
        for (int r = 0; r < 16; ++r) cacc[i][r] = 0.f;
      if (tid < 128) nvec[tid] = 0.f;
    }
#pragma unroll
    for (int i = 0; i < 2; ++i) { const int kb = (wid & 1) * 2 + i;
#pragma unroll
      for (int r = 0; r < 16; ++r) Cb[(vb2 * 32 + crow(r, hi)) * 136 + kb * 32 + r32] = f2bf(cacc[i][r]); }
    if (tid < 256) {
      const int col = (tid < 128) ? (h * 128 + tid) : (1024 + h * 128 + (tid - 128));
      cwl[tid] = cw[col]; cwl[256 + tid] = cw[2048 + col]; cwl[512 + tid] = cw[4096 + col]; cwl[768 + tid] = cbias[col];
    }
    const float bgi = bg[dir * 8 + h], bgf = bg[16 + dir * 8 + h];
    __syncthreads();
    const int nch = L / 64;
    u32x4 rq[2][3], rk[2][3], rv[2]; float g_i = 0.f, g_f = 0.f;
#define ML_LOADRAW(chn) do { \
      const int tcr_ = (chn) * 64 + lane; const int posr_ = dir ? (L - 1 - tcr_) : tcr_; \
      const bf16_t* rp_ = P1 + (rowbase + posr_) * 4096 + h * 128 + wv * 16; \
      const bool hm_ = posr_ > 0, hp_ = posr_ < L - 1; const u32x4 z4_ = {0u, 0u, 0u, 0u}; \
      _Pragma("unroll") for (int hf = 0; hf < 2; ++hf) { \
        rq[hf][0] = hm_ ? *(const u32x4*)(rp_ - 4096 + hf * 8) : z4_; rq[hf][1] = *(const u32x4*)(rp_ + hf * 8); \
        rq[hf][2] = hp_ ? *(const u32x4*)(rp_ + 4096 + hf * 8) : z4_; \
        rk[hf][0] = hm_ ? *(const u32x4*)(rp_ - 4096 + 1024 + hf * 8) : z4_; rk[hf][1] = *(const u32x4*)(rp_ + 1024 + hf * 8); \
        rk[hf][2] = hp_ ? *(const u32x4*)(rp_ + 4096 + 1024 + hf * 8) : z4_; \
        rv[hf] = *(const u32x4*)(rp_ + 2048 + hf * 8); } \
      if (wid == 7) { const float* gr_ = GT + (rowbase + posr_) * 32; g_i = gr_[dir * 8 + h]; g_f = gr_[16 + dir * 8 + h]; } \
    } while (0)
#define ML_GATES(setp, mval) do { float* av_ = gbuf + (setp) * 200; float* Mv_ = av_ + 64; float* bv_ = Mv_ + 64; float* scal_ = bv_ + 64; \
      const float ic_ = g_i + bgi; const float fp_ = g_f + bgf; \
      const float lf_ = fminf(fp_, 0.f) - __logf(1.f + __expf(-fabsf(fp_))); \
      float bc_ = lf_; \
      _Pragma("unroll") for (int off = 1; off < 64; off <<= 1) { float t_ = __shfl_up(bc_, off); if (lane >= off) bc_ += t_; } \
      const float a_ = ic_ - bc_; float pm_ = a_; \
      _Pragma("unroll") for (int off = 1; off < 64; off <<= 1) { float t_ = __shfl_up(pm_, off); if (lane >= off) pm_ = fmaxf(pm_, t_); } \
      const float M_ = fmaxf((mval), pm_); \
      av_[lane] = a_; Mv_[lane] = M_; bv_[lane] = bc_; if (lane == 63) { scal_[0] = M_; scal_[1] = bc_; } } while (0)
    ML_LOADRAW(0);
    if (wid == 7) ML_GATES(0, m);
    for (int ch = 0; ch < nch; ++ch) {
      float* av = gbuf + (ch & 1) * 200; float* Mv = av + 64; float* bv = Mv + 64; float* scal = bv + 64;
      float kf[16];
      {
        const int r = lane, c16 = wv * 16;
#pragma unroll
        for (int hf = 0; hf < 2; ++hf) {
          float um[8], u0[8], up[8], qf[8];
          { unpack8(rq[hf][0], um); unpack8(rq[hf][1], u0); unpack8(rq[hf][2], up);
#pragma unroll
            for (int e = 0; e < 8; ++e) { const int c = c16 + hf * 8 + e;
              qf[e] = silu_f(cwl[c] * um[e] + cwl[256 + c] * u0[e] + cwl[512 + c] * up[e] + cwl[768 + c]); }
            *(u32x4*)(Qs + r * 136 + c16 + hf * 8) = pack8(qf); }
          { unpack8(rk[hf][0], um); unpack8(rk[hf][1], u0); unpack8(rk[hf][2], up);
#pragma unroll
            for (int e = 0; e < 8; ++e) { const int c = 128 + c16 + hf * 8 + e;
              qf[e] = 0.088388347648318440f * silu_f(cwl[c] * um[e] + cwl[256 + c] * u0[e] + cwl[512 + c] * up[e] + cwl[768 + c]);
              kf[hf * 8 + e] = qf[e]; }
            *(u32x4*)(Ks + r * 136 + c16 + hf * 8) = pack8(qf); }
          { const u32x4 wv4 = rv[hf];
            bf16_t* vd = VsT + (c16 + hf * 8) * 72 + r;
            vd[0 * 72] = (bf16_t)(wv4[0] & 0xffff); vd[1 * 72] = (bf16_t)(wv4[0] >> 16);
            vd[2 * 72] = (bf16_t)(wv4[1] & 0xffff); vd[3 * 72] = (bf16_t)(wv4[1] >> 16);
            vd[4 * 72] = (bf16_t)(wv4[2] & 0xffff); vd[5 * 72] = (bf16_t)(wv4[2] >> 16);
            vd[6 * 72] = (bf16_t)(wv4[3] & 0xffff); vd[7 * 72] = (bf16_t)(wv4[3] >> 16); }
        }
      }
      if (ch + 1 < nch) ML_LOADRAW(ch + 1);
      __syncthreads();
      const float M63 = scal[0], b63 = scal[1];
      const float m_new = b63 + M63;
      const float w_state = __expf(m - M63);
      {
        const float wt = __expf(av[lane] - M63);
        bf16_t* kd = KwT + (wv * 16) * 72 + lane;
#pragma unroll
        for (int e = 0; e < 16; ++e) kd[e * 72] = f2bf(kf[e] * wt);
      }
      __syncthreads();
      if (wid == 7 && ch + 1 < nch) ML_GATES((ch + 1) & 1, m_new);
      const int tb = wid & 1, vb = wid >> 1;
      if (wid < 4) {
        const int sb = wid >> 1;
        f32x16 s = {};
        if (sb <= tb) { s = mma_nt<64>(Qs + tb * 32 * 136, 136, Ks + sb * 32 * 136, 136, s, r32, hi); s = mma_nt<64>(Qs + tb * 32 * 136 + 64, 136, Ks + sb * 32 * 136 + 64, 136, s, r32, hi); }
        const int sc = sb * 32 + r32; const float as = av[sc];
#pragma unroll
        for (int r = 0; r < 16; ++r) {
          const int t = tb * 32 + crow(r, hi);
          float w = (sc <= t) ? s[r] * __expf(as - Mv[t]) : 0.f;
          Wb[t * 72 + sc] = f2bf(w);
        }
      }
      f32x16 inter = {};
      inter = mma_nt<64>(Qs + tb * 32 * 136, 136, Cb + vb * 32 * 136, 136, inter, r32, hi); inter = mma_nt<64>(Qs + tb * 32 * 136 + 64, 136, Cb + vb * 32 * 136 + 64, 136, inter, r32, hi);
      __syncthreads();
      {
        const int t = tid >> 3, part = tid & 7;
        float wsum[8]; unpack8(*(const u32x4*)(Wb + t * 72 + part * 8), wsum);
        float dw = 0.f;
#pragma unroll
        for (int e = 0; e < 8; ++e) dw += wsum[e];
        float q0[8], q1[8]; unpack8(*(const u32x4*)(Qs + t * 136 + part * 16), q0); unpack8(*(const u32x4*)(Qs + t * 136 + part * 16 + 8), q1);
        float dq = 0.f;
#pragma unroll
        for (int e = 0; e < 8; ++e) dq += q0[e] * nvec[part * 16 + e] + q1[e] * nvec[part * 16 + 8 + e];
        dw += __shfl_xor(dw, 1); dw += __shfl_xor(dw, 2); dw += __shfl_xor(dw, 4);
        dq += __shfl_xor(dq, 1); dq += __shfl_xor(dq, 2); dq += __shfl_xor(dq, 4);
        if (part == 0) {
          const float Mt = Mv[t];
          const float wint = __expf(m - Mt);
          const float den = wint * dq + dw;
          const float mt = bv[t] + Mt;
          sclv[t] = 1.f / fmaxf(fabsf(den), __expf(-mt));
          wintv[t] = wint;
        }
      }
      __syncthreads();
      {
        f32x16 num;
#pragma unroll
        for (int r = 0; r < 16; ++r) num[r] = inter[r] * wintv[tb * 32 + crow(r, hi)];
        num = mma_nt<64>(Wb + tb * 32 * 72, 72, VsT + vb * 32 * 72, 72, num, r32, hi);
        bf16_t* Hout = dir ? HB : HF;
#pragma unroll
        for (int r = 0; r < 16; ++r) {
          const int t = tb * 32 + crow(r, hi);
          const int tc = ch * 64 + t; const int pos = dir ? (L - 1 - tc) : tc;
          Hout[(rowbase + pos) * 1024 + h * 128 + vb * 32 + r32] = f2bf(num[r] * sclv[t]);
        }
      }
#pragma unroll
      for (int i = 0; i < 2; ++i) {
        const int kb = (wid & 1) * 2 + i;
#pragma unroll
        for (int r = 0; r < 16; ++r) cacc[i][r] *= w_state;
        cacc[i] = mma_nt<64>(VsT + vb2 * 32 * 72, 72, KwT + kb * 32 * 72, 72, cacc[i], r32, hi);
#pragma unroll
        for (int r = 0; r < 16; ++r) Cb[(vb2 * 32 + crow(r, hi)) * 136 + kb * 32 + r32] = f2bf(cacc[i][r]);
      }
      if (tid < 128) {
        float s = 0.f;
#pragma unroll
        for (int q = 0; q < 8; ++q) { float f[8]; unpack8(*(const u32x4*)(KwT + tid * 72 + q * 8), f);
#pragma unroll
          for (int e = 0; e < 8; ++e) s += f[e]; }
        nvec[tid] = w_state * nvec[tid] + s;
      }
      m = m_new;
      __syncthreads();
    }
    if (seq < 32) {
      float* Co = p.out + O_C + (long)((seq * 2 + dir) * 8 + h) * 16384;
#pragma unroll
      for (int i = 0; i < 2; ++i) { const int kb = (wid & 1) * 2 + i;
#pragma unroll
        for (int r = 0; r < 16; ++r) Co[(vb2 * 32 + crow(r, hi)) * 128 + kb * 32 + r32] = cacc[i][r]; }
      if (tid < 128) p.out[O_N + ((seq * 2 + dir) * 8 + h) * 128 + tid] = nvec[tid];
      if (tid == 0) p.out[O_M + (seq * 2 + dir) * 8 + h] = m;
    }
  }
  __syncthreads();
}

#undef ML_LOADRAW
#undef ML_GATES
__device__ __forceinline__ void mlstm_post(const int wv, const Params& p, const int zq, const bf16_t* __restrict__ HF, const bf16_t* __restrict__ HB,
                                           const bf16_t* __restrict__ P1, bf16_t* __restrict__ A) {
  const int tidx = ltid(wv);
  const int wid = wv, lane = tidx & 63;
  const float* hn = p.in[zq + 37];
  for (int row = blockIdx.x * 8 + wid; row < T_TOK; row += gridDim.x * 8) {
    float hv[16], t0[8], t1[8];
    unpack8(*(const u32x4*)(HF + (long)row * 1024 + lane * 16), hv); unpack8(*(const u32x4*)(HF + (long)row * 1024 + lane * 16 + 8), hv + 8);
    unpack8(*(const u32x4*)(HB + (long)row * 1024 + lane * 16), t0); unpack8(*(const u32x4*)(HB + (long)row * 1024 + lane * 16 + 8), t1);
    float ss = 0.f;
#pragma unroll
    for (int e = 0; e < 8; ++e) { hv[e] += t0[e]; hv[8 + e] += t1[e]; }
#pragma unroll
    for (int e = 0; e < 16; ++e) ss += hv[e] * hv[e];
    ss += __shfl_xor(ss, 1); ss += __shfl_xor(ss, 2); ss += __shfl_xor(ss, 4);
    const float rs = rsqrtf(ss * (1.f / 128.f) + 1e-6f);
    float ov[16];
    unpack8(*(const u32x4*)(P1 + (long)row * 4096 + 3072 + lane * 16), ov); unpack8(*(const u32x4*)(P1 + (long)row * 4096 + 3072 + lane * 16 + 8), ov + 8);
    float y[16];
#pragma unroll
    for (int e = 0; e < 16; ++e) y[e] = hv[e] * rs * hn[lane * 16 + e] * (1.f / (1.f + __expf(-ov[e])));
    *(u32x4*)(A + (long)row * 1024 + lane * 16) = pack8(y);
    *(u32x4*)(A + (long)row * 1024 + lane * 16 + 8) = pack8(y + 8);
  }
}

__device__ __forceinline__ void gsync(const int wv, unsigned* bar, const unsigned k) {
  const int tidx = ltid(wv);
  asm volatile("s_waitcnt vmcnt(0)" ::: "memory");
  __syncthreads();
  if (tidx == 0) {
    __builtin_amdgcn_fence(__ATOMIC_RELEASE, "agent");
    asm volatile("s_waitcnt vmcnt(0)" ::: "memory");
    const unsigned g = blockIdx.x & 7u;
    const unsigned ng = (gridDim.x + 7u - g) >> 3;
    const unsigned ngroups = gridDim.x < 8u ? gridDim.x : 8u;
    const unsigned old = __hip_atomic_fetch_add(bar + g * 32, 1u, __ATOMIC_RELAXED, __HIP_MEMORY_SCOPE_AGENT);
    if (old + 1u == k * ng) {
      const unsigned o2 = __hip_atomic_fetch_add(bar + 256, 1u, __ATOMIC_RELAXED, __HIP_MEMORY_SCOPE_AGENT);
      if (o2 + 1u == k * ngroups) {
#pragma unroll
        for (int q = 0; q < 8; ++q) __hip_atomic_store(bar + 512 + q * 32, k, __ATOMIC_RELAXED, __HIP_MEMORY_SCOPE_AGENT);
      }
    }
    while (__hip_atomic_load(bar + 512 + g * 32, __ATOMIC_RELAXED, __HIP_MEMORY_SCOPE_AGENT) < k) __builtin_amdgcn_s_sleep(4);
    __builtin_amdgcn_fence(__ATOMIC_ACQUIRE, "agent");
    asm volatile("s_waitcnt vmcnt(0)" ::: "memory");
  }
  __syncthreads();
}

__global__ void __launch_bounds__(512) mega(Params p, int ph_lo, int ph_hi) {
  const int wv = __builtin_amdgcn_readfirstlane(threadIdx.x >> 6);
  if (ph_hi < 0) { cg::this_grid().sync(); }
  unsigned* bar = (unsigned*)(p.ws + WS_END);
  char* ws = p.ws;
  bf16_t* Wt_in0 = (bf16_t*)(ws + OFF_WIN0); bf16_t* Wt_out0 = (bf16_t*)(ws + OFF_WOUT0);
  bf16_t* Wt_up0 = (bf16_t*)(ws + OFF_WUP0); bf16_t* Wt_up1 = (bf16_t*)(ws + OFF_WUP1);
  bf16_t* Wt_dn0 = (bf16_t*)(ws + OFF_WDN0); bf16_t* Wt_dn1 = (bf16_t*)(ws + OFF_WDN1);
  bf16_t* Wt_in1 = (bf16_t*)(ws + OFF_WIN1); bf16_t* Wt_out1 = (bf16_t*)(ws + OFF_WOUT1);
  float* modv = (float*)(ws + OFF_MOD);
  char* Pr = ws + OFF_P; char* Gr = ws + OFF_G;
  bf16_t* Pb = (bf16_t*)Pr; bf16_t* R = (bf16_t*)Pr;
  bf16_t* QA = (bf16_t*)(Pr + P_QA); bf16_t* KA = (bf16_t*)(Pr + P_KA); bf16_t* VA = (bf16_t*)(Pr + P_VA); bf16_t* X0 = (bf16_t*)(Pr + P_X0);
  float* GT = (float*)(Pr + P_GT); bf16_t* A2 = (bf16_t*)(Pr + P_A2);
  bf16_t* A = (bf16_t*)Gr; bf16_t* Gb = (bf16_t*)Gr; float* VV = (float*)(Gr + G_VV);
  bf16_t* HF = (bf16_t*)Gr; bf16_t* HB = (bf16_t*)(Gr + G_HB);
  float* X = p.out;
  float* F256 = p.out + O_C + 512; float* F2048 = p.out + O_C + 512 * 512 + 512;
  const float* mod0 = modv; const float* mod1 = modv + 3 * 6144;
  unsigned bk = 0;
#define PH(i, ...) if (ph_lo <= (i) && (i) < ph_hi) { const int zq = opq(); __VA_ARGS__; if ((i) + 1 < ph_hi) gsync(wv, bar, ++bk); }
  PH(0, {
    conv_w(wv, p.in[zq + 19], Wt_in0, 1024, 2560, 2560);
    conv_w(wv, p.in[zq + 20], Wt_out0, 1024, 1024, 1024);
    conv_w(wv, p.in[zq + 15], Wt_up0, 1024, 5632, 5632);
    conv_w(wv, p.in[zq + 18], Wt_dn0, 2816, 1024, 1024);
    conv_w(wv, p.in[zq + 33], Wt_in1, 1024, 4128, 4352);
    mod_phase(wv, p, zq, modv);
    filt_phase(wv, p, zq, F256, F2048);
  })
  PH(1, (row_phase<true, false, true>(wv, p, zq, nullptr, nullptr, mod0, 0, nullptr, p.in[zq + 11], mod0, 0, A)))
  PH(2, (gemm_phase<0, 2560>(wv, A, Wt_in0, 2560, 1024, Pb, nullptr)))
  PH(3, post_inproj0(wv, p, zq, Pb, QA, KA, VA, VV, X0))
  PH(4, mix0_phase(wv, p, zq, QA, KA, VA, VV, X0, F256, F2048, A))
  PH(5, (gemm_phase<0, 1024>(wv, A, Wt_out0, 1024, 1024, R, nullptr)))
  PH(6, (row_phase<true, true, true>(wv, p, zq, R, p.in[zq + 12], mod0, 2, X, p.in[zq + 13], mod0, 3, A)))
  PH(7, (gemm_phase<0, 5632>(wv, A, Wt_up0, 5632, 1024, Pb, nullptr)))
  PH(8, ffn_act_phase(wv, Pb, p.in[zq + 16], p.in[zq + 17], Gb))
  PH(9, (gemm_phase<0, 1024>(wv, Gb, Wt_dn0, 1024, 2816, R, nullptr)))
  PH(10, (row_phase<false, true, true>(wv, p, zq, R, p.in[zq + 14], mod0, 5, X, p.in[zq + 11] + 1024, mod1, 0, A)))
  PH(11, (gemm_phase<2, 4096>(wv, A, Wt_in1, 4352, 1024, Pb, GT)))
  PH(13, {
    mlstm_phase(wv, p, zq, Pb, GT, HF, HB);
    const int cb0 = gridDim.x > 64 ? 32 : 0;
    conv_w(wv, p.in[zq + 15] + (long)1024 * 5632, Wt_up1, 1024, 5632, 5632, cb0);
    conv_w(wv, p.in[zq + 18] + (long)2816 * 1024, Wt_dn1, 2816, 1024, 1024, cb0);
    conv_w(wv, p.in[zq + 38], Wt_out1, 1024, 1024, 1024, cb0);
  })
  PH(14, mlstm_post(wv, p, zq, HF, HB, Pb, A2))
  PH(15, (gemm_phase<0, 1024>(wv, A2, Wt_out1, 1024, 1024, R, nullptr)))
  PH(16, (row_phase<false, true, true>(wv, p, zq, R, p.in[zq + 12] + 1024, mod1, 2, X, p.in[zq + 13] + 1024, mod1, 3, A)))
  PH(17, (gemm_phase<0, 5632>(wv, A, Wt_up1, 5632, 1024, Pb, nullptr)))
  PH(18, ffn_act_phase(wv, Pb, p.in[zq + 16] + 3 * 5632, p.in[zq + 17] + 5632, Gb))
  PH(19, (gemm_phase<0, 1024>(wv, Gb, Wt_dn1, 1024, 2816, R, nullptr)))
  PH(20, (row_phase<false, true, false>(wv, p, zq, R, p.in[zq + 14] + 1024, mod1, 5, X, nullptr, mod1, 0, nullptr)))
#undef PH
}

extern "C" void kernel_launch(void* const* d_in, const int* in_sizes, int n_in, void* d_out, int out_size, void* d_ws, size_t ws_size,
                              hipStream_t stream) {
  static int grid_blocks = 0;
  if (!grid_blocks) {
    if (ws_size < WS_END + 4096) fprintf(stderr, "kernel_launch: workspace too small: %zu < %zu\n", ws_size, (size_t)WS_END);
    hipFuncSetAttribute((const void*)mega, hipFuncAttributeMaxDynamicSharedMemorySize, LDS_BYTES);
    int dev = 0, cus = 0, per = 0;
    hipGetDevice(&dev);
    hipDeviceGetAttribute(&cus, hipDeviceAttributeMultiprocessorCount, dev);
    hipOccupancyMaxActiveBlocksPerMultiprocessor(&per, mega, 512, LDS_BYTES);
    if (per < 1) { fprintf(stderr, "kernel_launch: occupancy query returned %d\n", per); per = 1; }
    grid_blocks = cus;
  }
  Params p{};
  for (int i = 0; i < 39; ++i) p.in[i] = (const float*)d_in[i];
  p.out = (float*)d_out; p.ws = (char*)d_ws;
  int lo = 0, hi = NPH;
  (void)hipMemsetAsync((char*)d_ws + WS_END, 0, 4096, stream);
  void* args[] = {&p, &lo, &hi};
  hipError_t e = hipLaunchCooperativeKernel((void*)mega, dim3(grid_blocks), dim3(512), args, LDS_BYTES, stream);
  if (e != hipSuccess) fprintf(stderr, "cooperative launch failed: %s (grid %d)\n", hipGetErrorString(e), grid_blocks);
}
```

```cpp
#include <hip/hip_runtime.h>
#include <hip/hip_cooperative_groups.h>
#include <cstdio>
#include <cstdint>
namespace cg = cooperative_groups;

typedef unsigned short bf16_t;
typedef short bf16x8 __attribute__((ext_vector_type(8)));
typedef short s16x4 __attribute__((ext_vector_type(4)));
typedef float f32x4 __attribute__((ext_vector_type(4)));
typedef float f32x8 __attribute__((ext_vector_type(8)));
typedef float f32x16 __attribute__((ext_vector_type(16)));
typedef unsigned u32x4 __attribute__((ext_vector_type(4)));
typedef unsigned u32x2 __attribute__((ext_vector_type(2)));

constexpr int T_TOK = 12288, TPR = 8192;
constexpr int LDS_BYTES = 131072;
constexpr int NPH = 40;

constexpr size_t OFF_WIN0 = 0, OFF_WOUT0 = 5242880, OFF_WUP0 = 7340032, OFF_WUP1 = 18874368, OFF_WDN0 = 30408704,
                 OFF_WDN1 = 36175872, OFF_WIN1 = 41943040, OFF_WOUT1 = 50855936, OFF_MOD = 52953088, OFF_P = 53100544,
                 OFF_G = 191512576, WS_END = 260718592;
constexpr size_t P_QA = 62914560, P_KA = 75497472, P_VA = 82313216, P_X0 = 89128960;
constexpr size_t P_GT = 100663296, P_A2 = 102236160;
constexpr size_t G_VV = 25165824, G_HB = 25165824;
constexpr size_t O_K = 12582912, O_V = 14680064, O_C = 16777216, O_N = 25165824, O_M = 25231360;

struct Params { const float* in[39]; float* out; char* ws; };

typedef __bf16 nbf16x2 __attribute__((ext_vector_type(2)));
typedef float nf32x2 __attribute__((ext_vector_type(2)));
__device__ __forceinline__ unsigned cvtpk(float lo, float hi) {
  nf32x2 v = {lo, hi};
  nbf16x2 b = __builtin_convertvector(v, nbf16x2);
  return __builtin_bit_cast(unsigned, b);
}
__device__ __forceinline__ bf16_t f2bf(float f) { return (bf16_t)(cvtpk(f, 0.f) & 0xffffu); }
__device__ __forceinline__ float bf2f(bf16_t h) { return __uint_as_float(((unsigned)h) << 16); }
__device__ __forceinline__ float bflo(unsigned w) { return __uint_as_float(w << 16); }
__device__ __forceinline__ float bfhi(unsigned w) { return __uint_as_float(w & 0xffff0000u); }
__device__ __forceinline__ float wave_sum(float v) {
#pragma unroll
  for (int o = 32; o > 0; o >>= 1) v += __shfl_xor(v, o);
  return v;
}
__device__ __forceinline__ int llane() { int l; asm volatile("v_mbcnt_lo_u32_b32 %0, -1, 0\n\tv_mbcnt_hi_u32_b32 %0, -1, %0" : "=v"(l)); return l; }
__device__ __forceinline__ int ltid(int wv) { return (wv << 6) | llane(); }
__device__ __forceinline__ int opq() { int z; asm volatile("s_mov_b32 %0, 0" : "=s"(z)); return z; }
__device__ __forceinline__ float silu_f(float x) { return x * __builtin_amdgcn_rcpf(1.f + __expf(-x)); }
__device__ __forceinline__ int crow(int r, int hi) { return (r & 3) + 8 * (r >> 2) + 4 * hi; }
__device__ __forceinline__ void unpack8(u32x4 w, float* f) {
  f[0] = bflo(w[0]); f[1] = bfhi(w[0]); f[2] = bflo(w[1]); f[3] = bfhi(w[1]);
  f[4] = bflo(w[2]); f[5] = bfhi(w[2]); f[6] = bflo(w[3]); f[7] = bfhi(w[3]);
}
__device__ __forceinline__ u32x4 pack8(const float* f) {
  u32x4 w = {cvtpk(f[0], f[1]), cvtpk(f[2], f[3]), cvtpk(f[4], f[5]), cvtpk(f[6], f[7])}; return w;
}

__device__ __forceinline__ void conv_w(const int wv, const float* __restrict__ W, bf16_t* __restrict__ Wt, int K, int N, int NP, int b0 = 0) {
  const int tidx = ltid(wv);
  extern __shared__ __attribute__((aligned(16))) char shm_raw[];
  float* tl = (float*)shm_raw;
  const int tid = tidx;
  const int ntn = NP / 64, ntiles = (K / 64) * ntn;
  if ((int)blockIdx.x < b0) return;
  for (int tile = (int)blockIdx.x - b0; tile < ntiles; tile += (int)gridDim.x - b0) {
    const int k0 = (tile / ntn) * 64, n0 = (tile % ntn) * 64;
    __syncthreads();
#pragma unroll
    for (int i = 0; i < 2; ++i) {
      int kr = (tid >> 4) + 32 * i, nc = (tid & 15) * 4;
      float4 v = make_float4(0.f, 0.f, 0.f, 0.f);
      if (n0 + nc < N) v = *(const float4*)(W + (long)(k0 + kr) * N + n0 + nc);
      float* d = tl + kr * 65 + nc; d[0] = v.x; d[1] = v.y; d[2] = v.z; d[3] = v.w;
    }
    __syncthreads();
    {
      int n = tid >> 3, kg = (tid & 7) * 8;
      u32x4 w;
      w[0] = cvtpk(tl[(kg + 0) * 65 + n], tl[(kg + 1) * 65 + n]);
      w[1] = cvtpk(tl[(kg + 2) * 65 + n], tl[(kg + 3) * 65 + n]);
      w[2] = cvtpk(tl[(kg + 4) * 65 + n], tl[(kg + 5) * 65 + n]);
      w[3] = cvtpk(tl[(kg + 6) * 65 + n], tl[(kg + 7) * 65 + n]);
      *(u32x4*)(Wt + (long)(n0 + n) * K + k0 + kg) = w;
    }
  }
  __syncthreads();
}

__device__ __forceinline__ void mod_phase(const int wv, const Params& p, const int zq, float* modv) {
  const int tidx = ltid(wv);
  extern __shared__ __attribute__((aligned(16))) char shm_raw[];
  float* red = (float*)shm_raw;
  const int tid = tidx;
  const float* cvec = p.in[zq + 7]; const float* cctx = p.in[zq + 8]; const float* bmod = p.in[zq + 10];
  for (int item = blockIdx.x; item < 192; item += gridDim.x) {
    const int l = item / 96, cb = (item % 96) * 64;
    const float* W = p.in[zq + 9] + (long)l * 1024 * 6144;
    const int cl = tid & 15, kg = tid >> 4;
    float a0[4] = {0, 0, 0, 0}, a1[4] = {0, 0, 0, 0}, a2[4] = {0, 0, 0, 0};
#pragma unroll 8
    for (int i = 0; i < 32; ++i) {
      int k = kg + 32 * i;
      float4 w = *(const float4*)(W + (long)k * 6144 + cb + cl * 4);
      float s0 = silu_f(cctx[k]), s1 = silu_f(cvec[k]), s2 = silu_f(cvec[1024 + k]);
      a0[0] += s0 * w.x; a0[1] += s0 * w.y; a0[2] += s0 * w.z; a0[3] += s0 * w.w;
      a1[0] += s1 * w.x; a1[1] += s1 * w.y; a1[2] += s1 * w.z; a1[3] += s1 * w.w;
      a2[0] += s2 * w.x; a2[1] += s2 * w.y; a2[2] += s2 * w.z; a2[3] += s2 * w.w;
    }
    __syncthreads();
#pragma unroll
    for (int j = 0; j < 4; ++j) {
      red[kg * 192 + 0 * 64 + cl * 4 + j] = a0[j];
      red[kg * 192 + 1 * 64 + cl * 4 + j] = a1[j];
      red[kg * 192 + 2 * 64 + cl * 4 + j] = a2[j];
    }
    __syncthreads();
    if (tid < 192) {
      float s = 0.f;
#pragma unroll 8
      for (int q = 0; q < 32; ++q) s += red[q * 192 + tid];
      int g = tid / 64, col = cb + (tid % 64);
      modv[(l * 3 + g) * 6144 + col] = s + bmod[l * 6144 + col];
    }
  }
  __syncthreads();
}

__device__ __forceinline__ void filt_phase(const int wv, const Params& p, const int zq, float* F256, float* F2048) {
  const int tidx = ltid(wv);
  extern __shared__ __attribute__((aligned(16))) char shm_raw[];
  float* z = (float*)shm_raw;
  float* h1 = z + 256;
  float* h2 = h1 + 512;
  const int tid = tidx;
  const float *w1 = p.in[zq + 25], *b1 = p.in[zq + 26], *w2 = p.in[zq + 27], *b2 = p.in[zq + 28], *w3 = p.in[zq + 29], *b3 = p.in[zq + 30], *sf = p.in[zq + 31], *skip = p.in[zq + 32];
  const float DMAX = -15.350567286626973f, DMIN = -3.0701134573253946f;
  for (int item = blockIdx.x; item < 288; item += gridDim.x) {
    const int L = item < 32 ? 256 : 2048; const int i0 = item < 32 ? item * 8 : (item - 32) * 8;
    float* F = item < 32 ? F256 : F2048;
    __syncthreads();
    if (tid < 136) {
      const int q = tid / 17, f = tid % 17;
      const float t = (float)(i0 + q) / (float)(L - 1);
      float v;
      if (f == 0) v = t;
      else if (f <= 8) v = cosf(6.283185307179586f * t * (float)f);
      else v = sinf(6.283185307179586f * t * (float)(f - 8));
      z[q * 32 + f] = v;
    }
    __syncthreads();
    { const int q = tid >> 6, u = tid & 63; float a = b1[u];
#pragma unroll 1
      for (int jj = 0; jj < 17; ++jj) a += z[q * 32 + jj] * w1[jj * 64 + u];
      h1[q * 64 + u] = sinf(sf[u] * a); }
    __syncthreads();
    { const int q = tid >> 6, u = tid & 63; float a = b2[u];
#pragma unroll 8
      for (int jj = 0; jj < 64; ++jj) a += h1[q * 64 + jj] * w2[jj * 64 + u];
      h2[q * 64 + u] = sinf(sf[64 + u] * a); }
    __syncthreads();
    {
      const int ch = tid;
      float af[8], ab[8];
#pragma unroll
      for (int q = 0; q < 8; ++q) { af[q] = b3[ch]; ab[q] = b3[512 + ch]; }
#pragma unroll 4
      for (int jj = 0; jj < 64; ++jj) {
        const float wa = w3[jj * 1024 + ch], wb = w3[jj * 1024 + 512 + ch];
#pragma unroll
        for (int q = 0; q < 8; ++q) { const float hh = h2[q * 64 + jj]; af[q] += hh * wa; ab[q] += hh * wb; }
      }
      const float delta = fabsf(DMIN + (DMAX - DMIN) * ((float)ch / 511.f));
#pragma unroll
      for (int q = 0; q < 8; ++q) {
        const int i = i0 + q;
        const float t = (float)i / (float)(L - 1);
        const float win = expf(-t * delta);
        const float sfw = af[q] * win, sbw = ab[q] * win;
        if (i == 0) F[(long)(L - 1) * 512 + ch] = sfw + sbw + skip[ch];
        else { F[(long)(L - 1 + i) * 512 + ch] = sfw; F[(long)(L - 1 - i) * 512 + ch] = sbw; }
      }
    }
  }
  __syncthreads();
}

template <bool FROM_IN, bool HAS_R, bool HAS_A>
__device__ __forceinline__ void row_phase(const int wv, const Params& p, const int zq, const bf16_t* __restrict__ R, const float* __restrict__ postg,
                                          const float* __restrict__ modg, int gate_m, float* X,
                                          const float* __restrict__ preg, const float* __restrict__ mods, int shift_m, bf16_t* __restrict__ A) {
  const int tidx = ltid(wv);
  const int wid = wv, lane = tidx & 63;
  for (int row = blockIdx.x * 8 + wid; row < T_TOK; row += gridDim.x * 8) {
    const int g = row < TPR ? 0 : 1 + (row - TPR) / 2048;
    const float* mg = modg + g * 6144;
    const float* ms = mods + g * 6144;
    const float* xin = FROM_IN ? (row < TPR ? p.in[zq + 0] + (long)row * 1024 : p.in[zq + 1] + (long)(row - TPR) * 1024) : (const float*)X + (long)row * 1024;
    float4 x[4];
#pragma unroll
    for (int j = 0; j < 4; ++j) x[j] = *(const float4*)(xin + j * 256 + lane * 4);
    if (HAS_R) {
      float4 r[4]; float ss = 0.f;
#pragma unroll
      for (int j = 0; j < 4; ++j) { const u32x2 rw = *(const u32x2*)(R + (long)row * 1024 + j * 256 + lane * 4); r[j] = make_float4(bflo(rw[0]), bfhi(rw[0]), bflo(rw[1]), bfhi(rw[1])); ss += r[j].x * r[j].x + r[j].y * r[j].y + r[j].z * r[j].z + r[j].w * r[j].w; }
      ss = wave_sum(ss); const float rs = rsqrtf(ss * (1.f / 1024.f) + 1e-6f);
#pragma unroll
      for (int j = 0; j < 4; ++j) {
        float4 pg = *(const float4*)(postg + j * 256 + lane * 4);
        float4 gt = *(const float4*)(mg + gate_m * 1024 + j * 256 + lane * 4);
        x[j].x += gt.x * (r[j].x * rs * pg.x); x[j].y += gt.y * (r[j].y * rs * pg.y);
        x[j].z += gt.z * (r[j].z * rs * pg.z); x[j].w += gt.w * (r[j].w * rs * pg.w);
        *(float4*)(X + (long)row * 1024 + j * 256 + lane * 4) = x[j];
      }
    }
    if (HAS_A) {
      float ss = 0.f;
#pragma unroll
      for (int j = 0; j < 4; ++j) ss += x[j].x * x[j].x + x[j].y * x[j].y + x[j].z * x[j].z + x[j].w * x[j].w;
      ss = wave_sum(ss); const float rs = rsqrtf(ss * (1.f / 1024.f) + 1e-6f);
#pragma unroll
      for (int j = 0; j < 4; ++j) {
        float4 pg = *(const float4*)(preg + j * 256 + lane * 4);
        float4 sh = *(const float4*)(ms + shift_m * 1024 + j * 256 + lane * 4);
        float4 sc = *(const float4*)(ms + (shift_m + 1) * 1024 + j * 256 + lane * 4);
        float y0 = x[j].x * rs * pg.x * (1.f + sc.x) + sh.x, y1 = x[j].y * rs * pg.y * (1.f + sc.y) + sh.y;
        float y2 = x[j].z * rs * pg.z * (1.f + sc.z) + sh.z, y3 = x[j].w * rs * pg.w * (1.f + sc.w) + sh.w;
        u32x2 w = {cvtpk(y0, y1), cvtpk(y2, y3)};
        *(u32x2*)(A + (long)row * 1024 + j * 256 + lane * 4) = w;
      }
    }
  }
}

constexpr int BM = 256, BK = 64, HALF = 128, WGM = 8, HT = HALF * BK;
__device__ __forceinline__ int lds_byte(int r, int c) {
  int st = (r >> 4) * 2 + (c >> 5), rr = r & 15, cc = c & 31, ob = rr * 64 + cc * 2;
  return st * 1024 + (ob ^ (((ob >> 9) & 1) << 5));
}
__device__ __forceinline__ void stage_rc(int b, int& R, int& C) {
  int st = b / 1024, sb = b % 1024, swz = sb ^ (((sb >> 9) & 1) << 5);
  R = (st >> 1) * 16 + swz / 64; C = (st & 1) * 32 + (swz % 64) / 2;
}

template <int MODE, int LDC>
__device__ __forceinline__ void gemm_phase(const int wv, const bf16_t* __restrict__ A, const bf16_t* __restrict__ Bt, int N, int K,
                                           void* Cout, float* GT) {
  const int tidx = ltid(wv);
  extern __shared__ __attribute__((aligned(16))) char shm_raw[];
  bf16_t* shm = (bf16_t*)shm_raw;
#define SA(b, h) (shm + ((b) * 2 + (h)) * HT)
#define SB(b, h) (shm + (4 + (b) * 2 + (h)) * HT)
#define STAGE(P, BASE, br, kt) do { const bf16_t* _gb = (BASE) + ((long)(br) * K + (long)(kt) * BK); \
    __builtin_amdgcn_global_load_lds((const unsigned*)(_gb + soff0), (unsigned*)((char*)(P) + sl0), 16, 0, 0); \
    __builtin_amdgcn_global_load_lds((const unsigned*)(_gb + soff1), (unsigned*)((char*)(P) + sl0 + 8192), 16, 0, 0); } while (0)
#define LDA(dst, b, h) _Pragma("unroll") for (int m = 0; m < 4; ++m) _Pragma("unroll") for (int k = 0; k < 2; ++k) \
    dst[m][k] = *reinterpret_cast<const bf16x8*>((char*)SA(b, h) + lds_byte(wr * 64 + m * 16 + fr, k * 32 + fq * 8))
#define LDB(dst, b, h) _Pragma("unroll") for (int n = 0; n < 2; ++n) _Pragma("unroll") for (int k = 0; k < 2; ++k) \
    dst[n][k] = *reinterpret_cast<const bf16x8*>((char*)SB(b, h) + lds_byte(wc * 32 + n * 16 + fr, k * 32 + fq * 8))
#define MMA(ai, bj, At, Bt_) do { __builtin_amdgcn_s_setprio(1); \
    _Pragma("unroll") for (int m = 0; m < 4; ++m) _Pragma("unroll") for (int n = 0; n < 2; ++n) _Pragma("unroll") for (int k = 0; k < 2; ++k) \
      acc[ai][bj][m][n] = __builtin_amdgcn_mfma_f32_16x16x32_bf16(At[m][k], Bt_[n][k], acc[ai][bj][m][n], 0, 0, 0); \
    __builtin_amdgcn_s_setprio(0); } while (0)
#define WAIT_V(n) asm volatile("s_waitcnt vmcnt(" #n ")" ::: "memory")
#define WAIT_L(n) asm volatile("s_waitcnt lgkmcnt(" #n ")" ::: "memory")
#define BAR __builtin_amdgcn_s_barrier()
#define SCHED __builtin_amdgcn_sched_barrier(0)
  const int nM = T_TOK / BM, nN = N / BM, nwg = nM * nN;
  const int wid = wv, lane = tidx & 63, wr = wid >> 2, wc = wid & 3, fr = lane & 15, fq = lane >> 4;
  const int nt = K / BK;
  unsigned soff0, soff1; const int sl0 = tidx * 16;
  { int _r, _c; stage_rc(sl0, _r, _c); soff0 = (unsigned)(_r * K + _c); stage_rc(sl0 + 8192, _r, _c); soff1 = (unsigned)(_r * K + _c); }
  for (int tile = blockIdx.x; tile < nwg; tile += gridDim.x) {
    int wgt = tile;
    { const int q = nwg / 8, r = nwg % 8, xcd = wgt % 8, off = wgt / 8;
      wgt = (xcd < r ? xcd * (q + 1) : r * (q + 1) + (xcd - r) * q) + off; }
    const int nig = WGM * nN, gid = wgt / nig, fm = gid * WGM, gsz = min(nM - fm, WGM);
    const int pm = fm + ((wgt % nig) % gsz), pn = (wgt % nig) / gsz, brow = pm * BM, bcol = pn * BM;
    f32x4 acc[2][2][4][2] = {};
    bf16x8 At[4][2], B0[2][2], B1[2][2];
    STAGE(SB(0, 0), Bt, bcol, 0); STAGE(SA(0, 0), A, brow, 0);
    STAGE(SB(0, 1), Bt, bcol + HALF, 0); STAGE(SA(0, 1), A, brow + HALF, 0);
    if (wr == 1) BAR;
    WAIT_V(4); BAR;
    STAGE(SB(1, 0), Bt, bcol, 1); STAGE(SA(1, 0), A, brow, 1); STAGE(SB(1, 1), Bt, bcol + HALF, 1);
    WAIT_V(6); BAR;
    for (int t = 0; t < nt - 2; t += 2) {
      LDB(B0, 0, 0); SCHED; LDA(At, 0, 0); STAGE(SA(1, 1), A, brow + HALF, t + 1);
      WAIT_L(8); BAR; WAIT_L(0); MMA(0, 0, At, B0); BAR; SCHED;
      LDB(B1, 0, 1); STAGE(SB(0, 0), Bt, bcol, t + 2);
      BAR; WAIT_L(0); MMA(0, 1, At, B1); BAR;
      LDA(At, 0, 1); STAGE(SA(0, 0), A, brow, t + 2);
      BAR; WAIT_L(0); MMA(1, 0, At, B0); BAR; SCHED;
      STAGE(SB(0, 1), Bt, bcol + HALF, t + 2);
      WAIT_V(6); BAR; MMA(1, 1, At, B1); BAR;
      LDB(B0, 1, 0); SCHED; LDA(At, 1, 0); STAGE(SA(0, 1), A, brow + HALF, t + 2);
      WAIT_L(8); BAR; WAIT_L(0); MMA(0, 0, At, B0); BAR; SCHED;
      LDB(B1, 1, 1); STAGE(SB(1, 0), Bt, bcol, t + 3);
      BAR; WAIT_L(0); MMA(0, 1, At, B1); BAR;
      LDA(At, 1, 1); STAGE(SA(1, 0), A, brow, t + 3);
      BAR; WAIT_L(0); MMA(1, 0, At, B0); BAR; SCHED;
      STAGE(SB(1, 1), Bt, bcol + HALF, t + 3);
      WAIT_V(6); BAR; MMA(1, 1, At, B1); BAR;
    }
    { LDB(B0, 0, 0); LDA(At, 0, 0); STAGE(SA(1, 1), A, brow + HALF, nt - 1);
      BAR; WAIT_L(0); MMA(0, 0, At, B0); BAR;
      LDB(B1, 0, 1); BAR; WAIT_L(0); MMA(0, 1, At, B1); BAR;
      LDA(At, 0, 1); WAIT_V(4); BAR; WAIT_L(0); MMA(1, 0, At, B0); MMA(1, 1, At, B1); BAR; }
    { LDB(B0, 1, 0); LDA(At, 1, 0); WAIT_V(2); BAR; WAIT_L(0); MMA(0, 0, At, B0); BAR;
      LDB(B1, 1, 1); WAIT_V(0); BAR; WAIT_L(0); MMA(0, 1, At, B1); BAR;
      LDA(At, 1, 1); BAR; WAIT_L(0); MMA(1, 0, At, B0); MMA(1, 1, At, B1); BAR; }
    if (wr == 0) BAR;
    {
      const int le = llane();
      const int fr = le & 15, fq = le >> 4;
      const long base = (long)(brow + wr * 64) * LDC + bcol + wc * 32 + (unsigned)(fq * 4 * LDC + fr);
      if (MODE == 0 || (MODE == 2 && pn < 16)) {
        bf16_t* cp = (bf16_t*)Cout + base;
#pragma unroll
        for (int ai = 0; ai < 2; ++ai)
#pragma unroll
          for (int m = 0; m < 4; ++m)
#pragma unroll
            for (int j = 0; j < 4; ++j) {
              bf16_t* rp = cp + (ai * HALF + m * 16 + j) * LDC;
#pragma unroll
              for (int bj = 0; bj < 2; ++bj)
#pragma unroll
                for (int n = 0; n < 2; ++n) rp[bj * HALF + n * 16] = f2bf(acc[ai][bj][m][n][j]);
            }
      } else if (MODE == 1) {
        float* cp = (float*)Cout + base;
#pragma unroll
        for (int ai = 0; ai < 2; ++ai)
#pragma unroll
          for (int m = 0; m < 4; ++m)
#pragma unroll
            for (int j = 0; j < 4; ++j) {
              float* rp = cp + (ai * HALF + m * 16 + j) * LDC;
#pragma unroll
              for (int bj = 0; bj < 2; ++bj)
#pragma unroll
                for (int n = 0; n < 2; ++n) rp[bj * HALF + n * 16] = acc[ai][bj][m][n][j];
            }
      } else {
        if (wc == 0) {
          float* gp = GT + (long)(brow + wr * 64) * 32 + (unsigned)(fq * 4 * 32 + fr);
#pragma unroll
          for (int ai = 0; ai < 2; ++ai)
#pragma unroll
            for (int m = 0; m < 4; ++m)
#pragma unroll
              for (int j = 0; j < 4; ++j)
#pragma unroll
                for (int n = 0; n < 2; ++n) gp[(ai * HALF + m * 16 + j) * 32 + n * 16] = acc[ai][0][m][n][j];
        }
      }
    }
    __syncthreads();
  }
#undef SA
#undef SB
#undef STAGE
#undef LDA
#undef LDB
#undef MMA
}

__device__ __forceinline__ void post_inproj0(const int wv, const Params& p, const int zq, const bf16_t* __restrict__ P0, bf16_t* __restrict__ QA, bf16_t* __restrict__ KA,
                                             bf16_t* __restrict__ VA, float* __restrict__ VV, bf16_t* __restrict__ X0) {
  const int tidx = ltid(wv);
  const int wid = wv, lane = tidx & 63;
  const float* qn = p.in[zq + 21]; const float* kn = p.in[zq + 22]; const float* cw = p.in[zq + 23]; const float* cb = p.in[zq + 24];
  float* outK = p.out + O_K; float* outV = p.out + O_V;
  for (int i = blockIdx.x * 512 + tidx; i < 2 * 512 * 256 / 4; i += gridDim.x * 512) {
    int e = i * 4; int b = e / (512 * 256), rem = e % (512 * 256);
    float4 kk = *(const float4*)(p.in[zq + 2] + e); float4 vv = *(const float4*)(p.in[zq + 3] + e);
    long d = (long)(8192 + b * 2560 + 2048) * 256 + rem;
    u32x2 wk = {cvtpk(kk.x, kk.y), cvtpk(kk.z, kk.w)}; u32x2 wv = {cvtpk(vv.x, vv.y), cvtpk(vv.z, vv.w)};
    *(u32x2*)(KA + d) = wk; *(u32x2*)(VA + d) = wv;
  }
  const int fi = lane & 31;
  const float inv = exp2f(-(float)fi * (13.287712379549449f / 32.f));
  for (int row = blockIdx.x * 8 + wid; row < T_TOK; row += gridDim.x * 8) {
    const bool samp = row >= TPR;
    const int L = samp ? 2048 : 256;
    const int tl = samp ? (row - TPR) % 2048 : row % 256;
    const long krow = samp ? (long)(8192 + ((row - TPR) / 2048) * 2560 + tl) : (long)row;
    const bf16_t* base = P0 + (long)row * 2560;
    float cs = 1.f, sn = 0.f;
    if (samp) { float pos = (lane < 32) ? (float)(tl / 64) : (float)(tl % 64); float ang = pos * inv; cs = cosf(ang); sn = sinf(ang); }
#pragma unroll
    for (int hh = 0; hh < 6; ++hh) {
      float x1 = bf2f(base[hh * 128 + lane]), x2 = bf2f(base[hh * 128 + 64 + lane]);
      float ss = wave_sum(x1 * x1 + x2 * x2);
      float rs = rsqrtf(ss * (1.f / 128.f) + 1e-6f);
      const float* gw = hh < 4 ? qn : kn;
      float y1 = x1 * rs * gw[lane], y2 = x2 * rs * gw[64 + lane];
      if (hh >= 4 && !samp) { outK[(long)row * 256 + (hh - 4) * 128 + lane] = y1; outK[(long)row * 256 + (hh - 4) * 128 + 64 + lane] = y2; }
      float o1 = y1 * cs - y2 * sn, o2 = y1 * sn + y2 * cs;
      if (hh < 4) { QA[(long)row * 512 + hh * 128 + lane] = f2bf(o1); QA[(long)row * 512 + hh * 128 + 64 + lane] = f2bf(o2); }
      else { KA[krow * 256 + (hh - 4) * 128 + lane] = f2bf(o1); KA[krow * 256 + (hh - 4) * 128 + 64 + lane] = f2bf(o2); }
    }
    {
      u32x2 w = *(const u32x2*)(base + 768 + lane * 4);
      *(u32x2*)(VA + krow * 256 + lane * 4) = w;
      if (!samp) { float4 f = make_float4(bflo(w[0]), bfhi(w[0]), bflo(w[1]), bfhi(w[1])); *(float4*)(outV + (long)row * 256 + lane * 4) = f; }
    }
    {
      const int c8 = lane * 8;
      float uc[3][8];
#pragma unroll
      for (int g = 0; g < 3; ++g) {
        const int col = g * 512 + c8;
        float um[8], u0[8], up[8];
        u32x4 z4 = {0u, 0u, 0u, 0u};
        u32x4 wm = (tl > 0) ? *(const u32x4*)(base - 2560 + 1024 + col) : z4;
        u32x4 w0 = *(const u32x4*)(base + 1024 + col);
        u32x4 wp = (tl < L - 1) ? *(const u32x4*)(base + 2560 + 1024 + col) : z4;
        unpack8(wm, um); unpack8(w0, u0); unpack8(wp, up);
#pragma unroll
        for (int e = 0; e < 8; ++e)
          uc[g][e] = cw[col + e] * um[e] + cw[1536 + col + e] * u0[e] + cw[3072 + col + e] * up[e] + cb[col + e];
      }
      float vvv[8];
#pragma unroll
      for (int e = 0; e < 8; ++e) vvv[e] = uc[2][e] * uc[1][e];
      *(float4*)(VV + (long)row * 512 + c8) = make_float4(vvv[0], vvv[1], vvv[2], vvv[3]);
      *(float4*)(VV + (long)row * 512 + c8 + 4) = make_float4(vvv[4], vvv[5], vvv[6], vvv[7]);
      *(u32x4*)(X0 + (long)row * 512 + c8) = pack8(uc[0]);
    }
  }
}

constexpr int AD = 128, ANW = 8, QBLK = 32, KVBLK = 64;
constexpr float ASCALE = 0.088388347648318440f;
constexpr float ATHR = 8.f;
constexpr int LDQ = 512, LDK = 256, LDO = 1024;
constexpr size_t SHM_V = KVBLK * AD * 2, SHM_K = KVBLK * AD * 2;
#define KSWZ(row, colB) ((row) * 256 + ((colB) ^ (((row) & 7) << 4)))
#define SBAR() __builtin_amdgcn_sched_barrier(0)

__device__ __forceinline__ void partialSM(f32x16& p0, f32x16& p1, float& m_reg, float& mn, float& alpha) {
  constexpr float C = ASCALE * 1.4426950408889634f;
  float pmax = p0[0];
#pragma unroll
  for (int r = 1; r < 16; ++r) pmax = fmaxf(pmax, p0[r]);
#pragma unroll
  for (int r = 0; r < 16; ++r) pmax = fmaxf(pmax, p1[r]);
  { auto rr = __builtin_amdgcn_permlane32_swap(__float_as_uint(pmax), __float_as_uint(pmax), false, false);
    pmax = fmaxf(__uint_as_float(rr[0]), __uint_as_float(rr[1])); }
  if (__builtin_expect(__all(pmax - m_reg <= ATHR / ASCALE), 1)) { mn = m_reg; alpha = 1.f; }
  else { mn = fmaxf(m_reg, pmax); alpha = __builtin_amdgcn_exp2f((m_reg - mn) * C); m_reg = mn; }
  float mnC = -mn * C;
#pragma unroll
  for (int r = 0; r < 16; ++r) p0[r] = fmaf(p0[r], C, mnC);
#pragma unroll
  for (int r = 0; r < 16; ++r) p1[r] = fmaf(p1[r], C, mnC);
#pragma unroll
  for (int r = 0; r < 16; ++r) p0[r] = __builtin_amdgcn_exp2f(p0[r]);
}
__device__ __forceinline__ void finishSM(f32x16& p0, f32x16& p1, float alpha, float& l_reg, bf16x8& pa0, bf16x8& pa1, bf16x8& pa2, bf16x8& pa3) {
#pragma unroll
  for (int r = 0; r < 16; ++r) p1[r] = __builtin_amdgcn_exp2f(p1[r]);
  float ps = 0;
#pragma unroll
  for (int r = 0; r < 16; ++r) ps += p0[r];
#pragma unroll
  for (int r = 0; r < 16; ++r) ps += p1[r];
  { auto rr = __builtin_amdgcn_permlane32_swap(__float_as_uint(ps), __float_as_uint(ps), false, false);
    ps = __uint_as_float(rr[0]) + __uint_as_float(rr[1]); }
  l_reg = l_reg * alpha + ps;
#define PK4(P, BASE, OUT) do { unsigned a0 = cvtpk(P[BASE + 0], P[BASE + 1]), a1 = cvtpk(P[BASE + 2], P[BASE + 3]);   \
    unsigned b0 = cvtpk(P[BASE + 4], P[BASE + 5]), b1 = cvtpk(P[BASE + 6], P[BASE + 7]);                              \
    auto r0 = __builtin_amdgcn_permlane32_swap(a0, b0, false, false); auto r1 = __builtin_amdgcn_permlane32_swap(a1, b1, false, false); \
    u32x4 w = {r0[0], r1[0], r0[1], r1[1]}; OUT = *reinterpret_cast<bf16x8*>(&w); } while (0)
  PK4(p0, 0, pa0); PK4(p0, 8, pa1); PK4(p1, 0, pa2); PK4(p1, 8, pa3);
#undef PK4
}
__device__ __forceinline__ void qkt(f32x16& p0, f32x16& p1, const bf16_t* Ks, const bf16x8* qr, int r32, int hi) {
  p0 = f32x16{}; p1 = f32x16{};
#pragma unroll
  for (int d0 = 0; d0 < 8; ++d0) { int cb = (d0 * 16 + hi * 8) * 2;
    bf16x8 b0 = *reinterpret_cast<const bf16x8*>((const char*)Ks + KSWZ(r32, cb));
    bf16x8 b1 = *reinterpret_cast<const bf16x8*>((const char*)Ks + KSWZ(32 + r32, cb));
    p0 = __builtin_amdgcn_mfma_f32_32x32x16_bf16(b0, qr[d0], p0, 0, 0, 0);
    p1 = __builtin_amdgcn_mfma_f32_32x32x16_bf16(b1, qr[d0], p1, 0, 0, 0); }
}
__device__ __forceinline__ int v_st(int k, int c) { const int kk = (k & ~0xC) | ((k & 4) << 1) | ((k & 8) >> 1); return ((kk >> 3) * 4 + (c >> 5)) * 512 + ((kk & 7) * 32 + (c & 31)) * 2; }
__device__ __forceinline__ int v_rd_base(int lane) { return ((lane & 3) << 3) | (((lane >> 2) & 3) << 6) | (((lane >> 4) & 1) << 5) | (((lane >> 5) & 1) << 8); }
constexpr int v_rd_off(int d0, int ks, int half) { return d0 * 512 + ks * 4096 + half * 2048; }
template <int OFF> __device__ __forceinline__ s16x4 tr_read(int vb) {
  s16x4 r; asm volatile("ds_read_b64_tr_b16 %0, %1 offset:%2" : "=&v"(r) : "v"(vb), "i"(OFF) : "memory"); return r;
}
template <int D0> __device__ __forceinline__ void pv_one(f32x16& od, int vb, bf16x8 pa0, bf16x8 pa1, bf16x8 pa2, bf16x8 pa3) {
  const s16x4 l0 = tr_read<v_rd_off(D0, 0, 0)>(vb), h0 = tr_read<v_rd_off(D0, 0, 1)>(vb), l1 = tr_read<v_rd_off(D0, 1, 0)>(vb), h1 = tr_read<v_rd_off(D0, 1, 1)>(vb);
  const s16x4 l2 = tr_read<v_rd_off(D0, 2, 0)>(vb), h2 = tr_read<v_rd_off(D0, 2, 1)>(vb), l3 = tr_read<v_rd_off(D0, 3, 0)>(vb), h3 = tr_read<v_rd_off(D0, 3, 1)>(vb);
  asm volatile("s_waitcnt lgkmcnt(0)" ::: "memory"); SBAR();
#define PK(L, H) (bf16x8){L[0], L[1], L[2], L[3], H[0], H[1], H[2], H[3]}
  od = __builtin_amdgcn_mfma_f32_32x32x16_bf16(pa0, PK(l0, h0), od, 0, 0, 0);
  od = __builtin_amdgcn_mfma_f32_32x32x16_bf16(pa1, PK(l1, h1), od, 0, 0, 0);
  od = __builtin_amdgcn_mfma_f32_32x32x16_bf16(pa2, PK(l2, h2), od, 0, 0, 0);
  od = __builtin_amdgcn_mfma_f32_32x32x16_bf16(pa3, PK(l3, h3), od, 0, 0, 0);
#undef PK
}
__device__ __forceinline__ void pv_d0(f32x16* o, int vb, bf16x8 pa0, bf16x8 pa1, bf16x8 pa2, bf16x8 pa3) {
  pv_one<0>(o[0], vb, pa0, pa1, pa2, pa3); pv_one<1>(o[1], vb, pa0, pa1, pa2, pa3); pv_one<2>(o[2], vb, pa0, pa1, pa2, pa3); pv_one<3>(o[3], vb, pa0, pa1, pa2, pa3);
}

__device__ __forceinline__ void attn_dense_body(const int wv, const bf16_t* __restrict__ Qb, const bf16_t* __restrict__ Kh, const bf16_t* __restrict__ Vh,
                                                bf16_t* __restrict__ Ob, int seq, char* lds) {
  const int tidx = ltid(wv);
  const int tid = tidx, wid = wv, lane = tid & 63, r32 = lane & 31, hi = lane >> 5;
  bf16_t* V_lds = (bf16_t*)lds; bf16_t* K_lds = (bf16_t*)(lds + 2 * SHM_V);
  float* ws = (float*)(lds + 2 * SHM_V + 2 * SHM_K) + wid * 64; float* li_l = ws; float* al_l = ws + 32;
  float m_reg = -1e30f, l_reg = 0; f32x16 o[4] = {}; bf16x8 qr[8];
  const bf16_t* Qw = Qb + (long)(wid * QBLK + r32) * LDQ + hi * 8;
#pragma unroll
  for (int d0 = 0; d0 < 8; ++d0) qr[d0] = *reinterpret_cast<const bf16x8*>(Qw + d0 * 16);
  const int sr = tid >> 4, sc = (tid & 15) * 8, vst0 = v_st(sr, sc), vst1 = v_st(32 + sr, sc);
  const int vb0 = (int)(uintptr_t)V_lds + v_rd_base(lane);
  bf16x8 sA_vs0, sA_vs1, sA_ks0, sA_ks1, sB_vs0, sB_vs1, sB_ks0, sB_ks1;
#define SLOADA(k0) do { sA_vs0 = *(const bf16x8*)(&Vh[(long)((k0) + sr) * LDK + sc]); sA_vs1 = *(const bf16x8*)(&Vh[(long)((k0) + 32 + sr) * LDK + sc]); \
    sA_ks0 = *(const bf16x8*)(&Kh[(long)((k0) + sr) * LDK + sc]); sA_ks1 = *(const bf16x8*)(&Kh[(long)((k0) + 32 + sr) * LDK + sc]); } while (0)
#define SLOADB(k0) do { sB_vs0 = *(const bf16x8*)(&Vh[(long)((k0) + sr) * LDK + sc]); sB_vs1 = *(const bf16x8*)(&Vh[(long)((k0) + 32 + sr) * LDK + sc]); \
    sB_ks0 = *(const bf16x8*)(&Kh[(long)((k0) + sr) * LDK + sc]); sB_ks1 = *(const bf16x8*)(&Kh[(long)((k0) + 32 + sr) * LDK + sc]); } while (0)
#define SWRITEA(b) do { *(bf16x8*)((char*)V_lds + (b) * SHM_V + vst0) = sA_vs0; *(bf16x8*)((char*)V_lds + (b) * SHM_V + vst1) = sA_vs1; int kc = sc * 2; \
    *(bf16x8*)((char*)K_lds + (b) * SHM_K + KSWZ(sr, kc)) = sA_ks0; *(bf16x8*)((char*)K_lds + (b) * SHM_K + KSWZ(32 + sr, kc)) = sA_ks1; } while (0)
#define SWRITEB(b) do { *(bf16x8*)((char*)V_lds + (b) * SHM_V + vst0) = sB_vs0; *(bf16x8*)((char*)V_lds + (b) * SHM_V + vst1) = sB_vs1; int kc = sc * 2; \
    *(bf16x8*)((char*)K_lds + (b) * SHM_K + KSWZ(sr, kc)) = sB_ks0; *(bf16x8*)((char*)K_lds + (b) * SHM_K + KSWZ(32 + sr, kc)) = sB_ks1; } while (0)
#define SWAIT() asm volatile("s_waitcnt vmcnt(4)" ::: "memory")
#define RESC(a) do { if (__any((a) < 1.f)) { if (hi == 0) al_l[r32] = (a); asm volatile("s_waitcnt lgkmcnt(0)" ::: "memory"); \
    _Pragma("unroll") for (int d = 0; d < 4; ++d) _Pragma("unroll") for (int r = 0; r < 16; ++r) o[d][r] *= al_l[crow(r, hi)]; } } while (0)
  f32x16 pA0, pA1, pB0, pB1; float mnA, mnB, alA, alB; bf16x8 pa0, pa1, pa2, pa3; const int NT = seq / KVBLK;
  SLOADA(0); asm volatile("s_waitcnt vmcnt(0)" ::: "memory"); SWRITEA(0); __syncthreads();
  qkt(pA0, pA1, K_lds, qr, r32, hi); partialSM(pA0, pA1, m_reg, mnA, alA);
  SLOADB(KVBLK); if (2 < NT) SLOADA(2 * KVBLK);
  SWAIT(); SWRITEB(1); __syncthreads();
  for (int j = 1; j + 1 < NT; j += 2) {
    SBAR(); qkt(pB0, pB1, (bf16_t*)((char*)K_lds + SHM_K), qr, r32, hi);
    finishSM(pA0, pA1, alA, l_reg, pa0, pa1, pa2, pa3); SBAR();
    SLOADB((j + 2) * KVBLK); SBAR();
    pv_d0(o, vb0, pa0, pa1, pa2, pa3); partialSM(pB0, pB1, m_reg, mnB, alB);
    __syncthreads(); SWAIT(); SWRITEA(0);
    RESC(alB); __syncthreads();
    SBAR(); qkt(pA0, pA1, K_lds, qr, r32, hi);
    finishSM(pB0, pB1, alB, l_reg, pa0, pa1, pa2, pa3); SBAR();
    if (j + 3 < NT) SLOADA((j + 3) * KVBLK); SBAR();
    pv_d0(o, vb0 + (int)SHM_V, pa0, pa1, pa2, pa3); partialSM(pA0, pA1, m_reg, mnA, alA);
    __syncthreads(); SWAIT(); SWRITEB(1);
    RESC(alA); __syncthreads();
  }
  SBAR(); qkt(pB0, pB1, (bf16_t*)((char*)K_lds + SHM_K), qr, r32, hi);
  finishSM(pA0, pA1, alA, l_reg, pa0, pa1, pa2, pa3); SBAR();
  pv_d0(o, vb0, pa0, pa1, pa2, pa3); partialSM(pB0, pB1, m_reg, mnB, alB);
  __syncthreads(); RESC(alB);
  finishSM(pB0, pB1, alB, l_reg, pa0, pa1, pa2, pa3); SBAR();
  pv_d0(o, vb0 + (int)SHM_V, pa0, pa1, pa2, pa3);
  if (hi == 0) li_l[r32] = l_reg; asm volatile("s_waitcnt lgkmcnt(0)" ::: "memory");
  float rli[16];
#pragma unroll
  for (int r = 0; r < 16; ++r) rli[r] = __builtin_amdgcn_rcpf(li_l[crow(r, hi)]);
  bf16_t* Ow = Ob + (long)(wid * QBLK) * LDO;
#pragma unroll
  for (int r = 0; r < 16; ++r) { int orow = crow(r, hi);
#pragma unroll
    for (int d0 = 0; d0 < 4; ++d0) Ow[(long)orow * LDO + d0 * 32 + r32] = f2bf(o[d0][r] * rli[r]); }
#undef SLOADA
#undef SLOADB
#undef SWRITEA
#undef SWRITEB
#undef SWAIT
#undef RESC
}

__device__ __forceinline__ void hyena_item(const float* __restrict__ Fu, const float* __restrict__ Vu, const bf16_t* __restrict__ Xu,
                                           bf16_t* __restrict__ Au, int L, int t0, unsigned ln) {
  float y[16], ring[16];
#pragma unroll
  for (int i = 0; i < 16; ++i) { y[i] = 0.f; const float* fr = Fu + (long)(t0 + i + L - 1) * 512; ring[i] = fr[ln]; }
  const float* fp = Fu + (long)(t0 + L - 2) * 512;
  float va[16], fa[16], vb[16], fb[16];
#define HY_LOAD(V, Fq, S) _Pragma("unroll") for (int j = 0; j < 16; ++j) { const float* vr_ = Vu + (long)((S) + j) * 512; const float* fr_ = fp - (long)((S) + j) * 512; V[j] = vr_[ln]; Fq[j] = fr_[ln]; }
#define HY_STEP(V, Fq) _Pragma("unroll") for (int j = 0; j < 16; ++j) { const float vs = V[j]; \
    _Pragma("unroll") for (int i = 0; i < 16; ++i) y[i] += ring[(i - j) & 15] * vs; ring[(15 - j) & 15] = Fq[j]; }
  HY_LOAD(va, fa, 0)
  for (int s0 = 0; s0 < L; s0 += 32) {
    HY_LOAD(vb, fb, s0 + 16)
    HY_STEP(va, fa)
    if (s0 + 32 < L) { HY_LOAD(va, fa, s0 + 32) }
    HY_STEP(vb, fb)
  }
#undef HY_LOAD
#undef HY_STEP
#pragma unroll
  for (int i = 0; i < 16; ++i) {
    const bf16_t* xr = Xu + (long)(t0 + i) * 512; bf16_t* ar = Au + (long)(t0 + i) * 1024;
    ar[ln] = f2bf(y[i] * bf2f(xr[ln]));
  }
}

__device__ __forceinline__ void mix0_phase(const int wv, const Params& p, const int zq, const bf16_t* QA, const bf16_t* KA, const bf16_t* VA, const float* VV,
                                           const bf16_t* X0, const float* F256, const float* F2048, bf16_t* AO) {
  extern __shared__ __attribute__((aligned(16))) char shm_raw[];
#ifndef NO_ATTN
  for (int it = blockIdx.x; it < 192; it += gridDim.x) {
    long rowb, krow; int h, seqk;
    if (it < 64) { const int qb = it % 8, b = it / 32; h = (it / 8) % 4; rowb = 8192 + (long)b * 2048 + qb * 256; krow = 8192 + (long)b * 2560; seqk = 2560; }
    else { const int j = it - 64; const int b = j / 4; h = j % 4; rowb = (long)b * 256; krow = rowb; seqk = 256; }
    __syncthreads();
    attn_dense_body(wv, QA + rowb * 512 + h * 128, KA + krow * 256 + (h >> 1) * 128, VA + krow * 256 + (h >> 1) * 128, AO + rowb * 1024 + h * 128, seqk, shm_raw);
  }
#endif
#ifndef NO_HYENA
  const int lane = llane(); const int wid = wv;
  {
    unsigned* qctr = (unsigned*)(p.ws + WS_END) + 768;
    volatile int* sidx = (volatile int*)(shm_raw + 120000);
    for (;;) {
      __syncthreads();
      if (ltid(wv) == 0) *sidx = (int)__hip_atomic_fetch_add(qctr, 1u, __ATOMIC_RELAXED, __HIP_MEMORY_SCOPE_AGENT);
      __syncthreads();
      const int it = __builtin_amdgcn_readfirstlane(*sidx);
      if (it >= 768) break;
      if (it < 256) {
        const int b = it / 128, cgp = (it / 16) % 8, tg = it % 16;
        { const long rb = 8192 + (long)b * 2048; hyena_item(F2048 + cgp * 64, VV + rb * 512 + cgp * 64, X0 + rb * 512 + cgp * 64, AO + rb * 1024 + 512 + cgp * 64, 2048, tg * 128 + wid * 16, (unsigned)lane); }
      } else {
        const int jj = it - 256; const int b = jj / 16, cgp = (jj / 2) % 8, tg = jj % 2;
        { const long rb = (long)b * 256; hyena_item(F256 + cgp * 64, VV + rb * 512 + cgp * 64, X0 + rb * 512 + cgp * 64, AO + rb * 1024 + 512 + cgp * 64, 256, tg * 128 + wid * 16, (unsigned)lane); }
      }
    }
  }
#endif
  __syncthreads();
}

__device__ __forceinline__ float erf_as(float x) {
  const float ax = fabsf(x);
  const float t = __builtin_amdgcn_rcpf(fmaf(0.3275911f, ax, 1.f));
  float p = fmaf(1.061405429f, t, -1.453152027f);
  p = fmaf(p, t, 1.421413741f); p = fmaf(p, t, -0.284496736f); p = fmaf(p, t, 0.254829592f);
  const float r = 1.f - p * t * __expf(-ax * ax);
  return copysignf(r, x);
}
__device__ __forceinline__ float gelu_f(float x) { return 0.5f * x * (1.f + erf_as(x * 0.70710678118654752f)); }
__device__ __forceinline__ void ffn_act_phase(const int wv, const bf16_t* __restrict__ P, const float* __restrict__ cw, const float* __restrict__ cb, bf16_t* __restrict__ G) {
  const int tidx = ltid(wv);
  const int tid = tidx;
  if (tid >= 352) return;
  const int c8 = tid * 8;
  float w1[3][8], w2[3][8], b1[8], b2[8];
#pragma unroll
  for (int e = 0; e < 8; ++e) {
#pragma unroll
    for (int k = 0; k < 3; ++k) { w1[k][e] = cw[k * 5632 + c8 + e]; w2[k][e] = cw[k * 5632 + 2816 + c8 + e]; }
    b1[e] = cb[c8 + e]; b2[e] = cb[2816 + c8 + e];
  }
  for (int item = blockIdx.x; item < T_TOK / 16; item += gridDim.x) {
    const int r0 = item * 16;
    const int L = r0 < TPR ? 256 : 2048;
    const int tl0 = r0 < TPR ? r0 % 256 : (r0 - TPR) % 2048;
    float am[8], a0[8], ap[8], gm[8], g0[8], gp[8];
    const u32x4 z4 = {0u, 0u, 0u, 0u};
    {
      const bf16_t* b = P + (long)r0 * 5632 + c8;
      u32x4 x = (tl0 > 0) ? *(const u32x4*)(b - 5632) : z4; unpack8(x, am);
      x = (tl0 > 0) ? *(const u32x4*)(b - 5632 + 2816) : z4; unpack8(x, gm);
      x = *(const u32x4*)(b); unpack8(x, a0);
      x = *(const u32x4*)(b + 2816); unpack8(x, g0);
    }
    for (int r = 0; r < 16; ++r) {
      const bf16_t* b = P + (long)(r0 + r) * 5632 + c8;
      const bool vn = (tl0 + r) < L - 1;
      u32x4 x = vn ? *(const u32x4*)(b + 5632) : z4; unpack8(x, ap);
      x = vn ? *(const u32x4*)(b + 5632 + 2816) : z4; unpack8(x, gp);
      float o[8];
#pragma unroll
      for (int e = 0; e < 8; ++e) {
        float h1 = w1[0][e] * am[e] + w1[1][e] * a0[e] + w1[2][e] * ap[e] + b1[e];
        float h2 = w2[0][e] * gm[e] + w2[1][e] * g0[e] + w2[2][e] * gp[e] + b2[e];
        o[e] = gelu_f(h1) * h2;
        am[e] = a0[e]; a0[e] = ap[e]; gm[e] = g0[e]; g0[e] = gp[e];
      }
      *(u32x4*)(G + (long)(r0 + r) * 2816 + c8) = pack8(o);
    }
  }
}

template <int K>
__device__ __forceinline__ f32x16 mma_nt(const bf16_t* A, int lda, const bf16_t* B, int ldb, f32x16 acc, int r32, int hi) {
  bf16x8 a[K / 16], b[K / 16];
#pragma unroll
  for (int k0 = 0; k0 < K / 16; ++k0) {
    a[k0] = *reinterpret_cast<const bf16x8*>(A + r32 * lda + k0 * 16 + 8 * hi);
    b[k0] = *reinterpret_cast<const bf16x8*>(B + r32 * ldb + k0 * 16 + 8 * hi);
  }
#pragma unroll
  for (int k0 = 0; k0 < K / 16; ++k0) acc = __builtin_amdgcn_mfma_f32_32x32x16_bf16(a[k0], b[k0], acc, 0, 0, 0);
  return acc;
}

__device__ __forceinline__ void mlstm_phase(const int wv, const Params& p, const int zq, const bf16_t* __restrict__ P1, const float* __restrict__ GT,
                                            bf16_t* __restrict__ HF, bf16_t* __restrict__ HB,
                                            bf16_t* DC, float* DN, float* SC, const int pass) {
  const int tidx = ltid(wv);
  extern __shared__ __attribute__((aligned(16))) char shm_raw[];
  bf16_t* Qs = (bf16_t*)shm_raw;
  bf16_t* Ks = Qs + 64 * 136;
  bf16_t* KwT = Ks + 64 * 136;
  bf16_t* VsT = KwT + 128 * 72;
  bf16_t* Wb = VsT + 128 * 72;
  bf16_t* Cb = Wb + 64 * 72;
  float* gbuf = (float*)(Cb + 128 * 136);
  float* sclv = gbuf + 400; float* wintv = sclv + 64; float* nvec = wintv + 64;
  float* cwl = nvec + 128;
  const int tid = tidx, wid = wv, lane = tid & 63, r32 = lane & 31, hi = lane >> 5;
  const float* cw = p.in[zq + 35]; const float* cbias = p.in[zq + 36]; const float* bg = p.in[zq + 34];
  const int nitems = pass == 0 ? 1536 : 1024;
  for (int it = blockIdx.x; it < nitems; it += gridDim.x) {
    int mode, seq, h, dir, c0, c1, su = 0;
    if (pass == 0 && it < 512) { mode = 0; seq = it / 16; h = (it / 2) % 8; dir = it % 2; c0 = 0; c1 = 4; }
    else { su = pass == 0 ? it - 512 : it; const int sidx = su >> 5; mode = pass == 0 ? 1 : 2;
           seq = 32 + sidx / 16; h = (sidx / 2) % 8; dir = sidx % 2; c0 = su & 31; c1 = c0 + 1; }
    const bool do_out = mode != 1;
    const int L = seq < 32 ? 256 : 2048;
    const long rowbase = seq < 32 ? (long)seq * 256 : 8192 + (long)(seq - 32) * 2048;
    __syncthreads();
    f32x16 cacc[2]; float m = (mode == 1) ? -1e30f : 0.f;
    const int vb2 = wid >> 1;
#pragma unroll
    for (int i = 0; i < 2; ++i)
#pragma unroll
      for (int r = 0; r < 16; ++r) cacc[i][r] = 0.f;
    if (mode == 2) {
#pragma unroll
      for (int i = 0; i < 4; ++i) { const int id = tid + 512 * i, row = id >> 4, ck = id & 15;
        *(u32x4*)(Cb + row * 136 + ck * 8) = *(const u32x4*)(DC + (long)su * 16384 + row * 128 + ck * 8); }
      if (tid < 128) nvec[tid] = DN[su * 128 + tid];
      m = SC[su * 4 + 2];
    } else {
#pragma unroll
      for (int i = 0; i < 2; ++i) { const int kb = (wid & 1) * 2 + i;
#pragma unroll
        for (int r = 0; r < 16; ++r) Cb[(vb2 * 32 + crow(r, hi)) * 136 + kb * 32 + r32] = 0; }
      if (tid < 128) nvec[tid] = 0.f;
    }
    if (tid < 256) {
      const int col = (tid < 128) ? (h * 128 + tid) : (1024 + h * 128 + (tid - 128));
      cwl[tid] = cw[col]; cwl[256 + tid] = cw[2048 + col]; cwl[512 + tid] = cw[4096 + col]; cwl[768 + tid] = cbias[col];
    }
    const float bgi = bg[dir * 8 + h], bgf = bg[16 + dir * 8 + h];
    __syncthreads();
    u32x4 rq[2][3], rk[2][3], rv[2]; float g_i = 0.f, g_f = 0.f;
#define ML_LOADRAW(chn) do { \
      const int tcr_ = (chn) * 64 + lane; const int posr_ = dir ? (L - 1 - tcr_) : tcr_; \
      const bf16_t* rp_ = P1 + (rowbase + posr_) * 4096 + h * 128 + wv * 16; \
      const bool hm_ = posr_ > 0, hp_ = posr_ < L - 1; const u32x4 z4_ = {0u, 0u, 0u, 0u}; \
      _Pragma("unroll") for (int hf = 0; hf < 2; ++hf) { \
        rq[hf][0] = hm_ ? *(const u32x4*)(rp_ - 4096 + hf * 8) : z4_; rq[hf][1] = *(const u32x4*)(rp_ + hf * 8); \
        rq[hf][2] = hp_ ? *(const u32x4*)(rp_ + 4096 + hf * 8) : z4_; \
        rk[hf][0] = hm_ ? *(const u32x4*)(rp_ - 4096 + 1024 + hf * 8) : z4_; rk[hf][1] = *(const u32x4*)(rp_ + 1024 + hf * 8); \
        rk[hf][2] = hp_ ? *(const u32x4*)(rp_ + 4096 + 1024 + hf * 8) : z4_; \
        rv[hf] = *(const u32x4*)(rp_ + 2048 + hf * 8); } \
      if (wid == 7) { const float* gr_ = GT + (rowbase + posr_) * 32; g_i = gr_[dir * 8 + h]; g_f = gr_[16 + dir * 8 + h]; } \
    } while (0)
#define ML_GATES(setp, mval) do { float* av_ = gbuf + (setp) * 200; float* Mv_ = av_ + 64; float* bv_ = Mv_ + 64; float* scal_ = bv_ + 64; \
      const float ic_ = g_i + bgi; const float fp_ = g_f + bgf; \
      const float lf_ = fminf(fp_, 0.f) - __logf(1.f + __expf(-fabsf(fp_))); \
      float bc_ = lf_; \
      _Pragma("unroll") for (int off = 1; off < 64; off <<= 1) { float t_ = __shfl_up(bc_, off); if (lane >= off) bc_ += t_; } \
      const float a_ = ic_ - bc_; float pm_ = a_; \
      _Pragma("unroll") for (int off = 1; off < 64; off <<= 1) { float t_ = __shfl_up(pm_, off); if (lane >= off) pm_ = fmaxf(pm_, t_); } \
      const float M_ = fmaxf((mval), pm_); \
      av_[lane] = a_; Mv_[lane] = M_; bv_[lane] = bc_; if (lane == 63) { scal_[0] = M_; scal_[1] = bc_; } } while (0)
    float sv_M = 0.f, sv_b = 0.f;
    ML_LOADRAW(c0);
    if (wid == 7) ML_GATES(c0 & 1, m);
    for (int ch = c0; ch < c1; ++ch) {
      float* av = gbuf + (ch & 1) * 200; float* Mv = av + 64; float* bv = Mv + 64; float* scal = bv + 64;
      float kf[16];
      {
        const int r = lane, c16 = wv * 16;
#pragma unroll
        for (int hf = 0; hf < 2; ++hf) {
          float um[8], u0[8], up[8], qf[8];
          if (do_out) { unpack8(rq[hf][0], um); unpack8(rq[hf][1], u0); unpack8(rq[hf][2], up);
#pragma unroll
            for (int e = 0; e < 8; ++e) { const int c = c16 + hf * 8 + e;
              qf[e] = silu_f(cwl[c] * um[e] + cwl[256 + c] * u0[e] + cwl[512 + c] * up[e] + cwl[768 + c]); }
            *(u32x4*)(Qs + r * 136 + c16 + hf * 8) = pack8(qf); }
          { unpack8(rk[hf][0], um); unpack8(rk[hf][1], u0); unpack8(rk[hf][2], up);
#pragma unroll
            for (int e = 0; e < 8; ++e) { const int c = 128 + c16 + hf * 8 + e;
              qf[e] = 0.088388347648318440f * silu_f(cwl[c] * um[e] + cwl[256 + c] * u0[e] + cwl[512 + c] * up[e] + cwl[768 + c]);
              kf[hf * 8 + e] = qf[e]; }
            *(u32x4*)(Ks + r * 136 + c16 + hf * 8) = pack8(qf); }
          { const u32x4 wv4 = rv[hf];
            bf16_t* vd = VsT + (c16 + hf * 8) * 72 + r;
            vd[0 * 72] = (bf16_t)(wv4[0] & 0xffff); vd[1 * 72] = (bf16_t)(wv4[0] >> 16);
            vd[2 * 72] = (bf16_t)(wv4[1] & 0xffff); vd[3 * 72] = (bf16_t)(wv4[1] >> 16);
            vd[4 * 72] = (bf16_t)(wv4[2] & 0xffff); vd[5 * 72] = (bf16_t)(wv4[2] >> 16);
            vd[6 * 72] = (bf16_t)(wv4[3] & 0xffff); vd[7 * 72] = (bf16_t)(wv4[3] >> 16); }
        }
      }
      if (ch + 1 < c1) ML_LOADRAW(ch + 1);
      __syncthreads();
      const float M63 = scal[0], b63 = scal[1];
      sv_M = M63; sv_b = b63;
      const float m_new = b63 + M63;
      const float w_state = __expf(m - M63);
      {
        const float wt = __expf(av[lane] - M63);
        bf16_t* kd = KwT + (wv * 16) * 72 + lane;
#pragma unroll
        for (int e = 0; e < 16; ++e) kd[e * 72] = f2bf(kf[e] * wt);
      }
      __syncthreads();
      if (wid == 7 && ch + 1 < c1) ML_GATES((ch + 1) & 1, m_new);
      const int tb = wid & 1, vb = wid >> 1;
      if (do_out && wid < 4) {
        const int sb = wid >> 1;
        f32x16 s = {};
        if (sb <= tb) { s = mma_nt<64>(Qs + tb * 32 * 136, 136, Ks + sb * 32 * 136, 136, s, r32, hi); s = mma_nt<64>(Qs + tb * 32 * 136 + 64, 136, Ks + sb * 32 * 136 + 64, 136, s, r32, hi); }
        const int sc = sb * 32 + r32; const float as = av[sc];
#pragma unroll
        for (int r = 0; r < 16; ++r) {
          const int t = tb * 32 + crow(r, hi);
          float w = (sc <= t) ? s[r] * __expf(as - Mv[t]) : 0.f;
          Wb[t * 72 + sc] = f2bf(w);
        }
      }
      f32x16 inter = {};
      if (do_out) inter = mma_nt<64>(Qs + tb * 32 * 136, 136, Cb + vb * 32 * 136, 136, inter, r32, hi); if (do_out) inter = mma_nt<64>(Qs + tb * 32 * 136 + 64, 136, Cb + vb * 32 * 136 + 64, 136, inter, r32, hi);
      __syncthreads();
      if (do_out) {
        const int t = tid >> 3, part = tid & 7;
        float wsum[8]; unpack8(*(const u32x4*)(Wb + t * 72 + part * 8), wsum);
        float dw = 0.f;
#pragma unroll
        for (int e = 0; e < 8; ++e) dw += wsum[e];
        float q0[8], q1[8]; unpack8(*(const u32x4*)(Qs + t * 136 + part * 16), q0); unpack8(*(const u32x4*)(Qs + t * 136 + part * 16 + 8), q1);
        float dq = 0.f;
#pragma unroll
        for (int e = 0; e < 8; ++e) dq += q0[e] * nvec[part * 16 + e] + q1[e] * nvec[part * 16 + 8 + e];
        dw += __shfl_xor(dw, 1); dw += __shfl_xor(dw, 2); dw += __shfl_xor(dw, 4);
        dq += __shfl_xor(dq, 1); dq += __shfl_xor(dq, 2); dq += __shfl_xor(dq, 4);
        if (part == 0) {
          const float Mt = Mv[t];
          const float wint = __expf(m - Mt);
          const float den = wint * dq + dw;
          const float mt = bv[t] + Mt;
          sclv[t] = 1.f / fmaxf(fabsf(den), __expf(-mt));
          wintv[t] = wint;
        }
      }
      __syncthreads();
      if (do_out) {
        f32x16 num;
#pragma unroll
        for (int r = 0; r < 16; ++r) num[r] = inter[r] * wintv[tb * 32 + crow(r, hi)];
        num = mma_nt<64>(Wb + tb * 32 * 72, 72, VsT + vb * 32 * 72, 72, num, r32, hi);
        bf16_t* Hout = dir ? HB : HF;
#pragma unroll
        for (int r = 0; r < 16; ++r) {
          const int t = tb * 32 + crow(r, hi);
          const int tc = ch * 64 + t; const int pos = dir ? (L - 1 - tc) : tc;
          Hout[(rowbase + pos) * 1024 + h * 128 + vb * 32 + r32] = f2bf(num[r] * sclv[t]);
        }
      }
#pragma unroll
      for (int i = 0; i < 2; ++i) {
        const int kb = (wid & 1) * 2 + i;
#pragma unroll
        for (int r = 0; r < 16; ++r) cacc[i][r] *= w_state;
        cacc[i] = mma_nt<64>(VsT + vb2 * 32 * 72, 72, KwT + kb * 32 * 72, 72, cacc[i], r32, hi);
#pragma unroll
        for (int r = 0; r < 16; ++r) Cb[(vb2 * 32 + crow(r, hi)) * 136 + kb * 32 + r32] = f2bf(cacc[i][r]);
      }
      if (tid < 128) {
        float s = 0.f;
#pragma unroll
        for (int q = 0; q < 8; ++q) { float f[8]; unpack8(*(const u32x4*)(KwT + tid * 72 + q * 8), f);
#pragma unroll
          for (int e = 0; e < 8; ++e) s += f[e]; }
        nvec[tid] = w_state * nvec[tid] + s;
      }
      m = m_new;
      __syncthreads();
    }
    if (mode == 0) {
      float* Co = p.out + O_C + (long)((seq * 2 + dir) * 8 + h) * 16384;
#pragma unroll
      for (int i = 0; i < 2; ++i) { const int kb = (wid & 1) * 2 + i;
#pragma unroll
        for (int r = 0; r < 16; ++r) Co[(vb2 * 32 + crow(r, hi)) * 128 + kb * 32 + r32] = cacc[i][r]; }
      if (tid < 128) p.out[O_N + ((seq * 2 + dir) * 8 + h) * 128 + tid] = nvec[tid];
      if (tid == 0) p.out[O_M + (seq * 2 + dir) * 8 + h] = m;
    } else if (mode == 1) {
#pragma unroll
      for (int i = 0; i < 4; ++i) { const int id = tid + 512 * i, row = id >> 4, ck = id & 15;
        *(u32x4*)(DC + (long)su * 16384 + row * 128 + ck * 8) = *(const u32x4*)(Cb + row * 136 + ck * 8); }
      if (tid < 128) DN[su * 128 + tid] = nvec[tid];
      if (tid == 0) { SC[su * 4] = sv_M; SC[su * 4 + 1] = sv_b; }
    }
  }
  __syncthreads();
}

__device__ __forceinline__ void mlstm_scan(const int wv, const Params& p, const int zq, bf16_t* DC, float* DN, float* SC) {
  const int tidx = ltid(wv);
  for (int g = blockIdx.x * 512 + tidx; g < 32 * 4096; g += gridDim.x * 512) {
    const int sidx = g >> 12, e4 = (g & 4095) * 4;
    const int b = sidx >> 4, h = (sidx >> 1) & 7, dir = sidx & 1;
    const float4 c0 = *(const float4*)(p.in[zq + 4] + (long)((b * 2 + dir) * 8 + h) * 16384 + e4);
    float C0 = c0.x, C1 = c0.y, C2 = c0.z, C3 = c0.w;
    float m = p.in[zq + 6][(b * 2 + dir) * 8 + h];
#pragma unroll 4
    for (int c = 0; c < 32; ++c) {
      const int u = sidx * 32 + c;
      const float amax = SC[u * 4], b63 = SC[u * 4 + 1];
      const float Mc = fmaxf(m, amax);
      const float ws = __expf(m - Mc), wd = __expf(amax - Mc);
      u32x2* dp = (u32x2*)(DC + (long)u * 16384 + e4);
      const u32x2 d = *dp;
      u32x2 o = {cvtpk(C0, C1), cvtpk(C2, C3)};
      *dp = o;
      C0 = ws * C0 + wd * bflo(d[0]); C1 = ws * C1 + wd * bfhi(d[0]); C2 = ws * C2 + wd * bflo(d[1]); C3 = ws * C3 + wd * bfhi(d[1]);
      m = b63 + Mc;
    }
  }
  for (int g = blockIdx.x * 512 + tidx; g < 32 * 128; g += gridDim.x * 512) {
    const int sidx = g >> 7, k = g & 127;
    const int b = sidx >> 4, h = (sidx >> 1) & 7, dir = sidx & 1;
    float n = p.in[zq + 5][((b * 2 + dir) * 8 + h) * 128 + k];
    float m = p.in[zq + 6][(b * 2 + dir) * 8 + h];
    for (int c = 0; c < 32; ++c) {
      const int u = sidx * 32 + c;
      const float amax = SC[u * 4], b63 = SC[u * 4 + 1];
      const float Mc = fmaxf(m, amax);
      const float ws = __expf(m - Mc), wd = __expf(amax - Mc);
      const float dn = DN[u * 128 + k];
      DN[u * 128 + k] = n;
      if (k == 0) SC[u * 4 + 2] = m;
      n = ws * n + wd * dn;
      m = b63 + Mc;
    }
  }
}

#undef ML_LOADRAW
#undef ML_GATES
__device__ __forceinline__ void mlstm_post(const int wv, const Params& p, const int zq, const bf16_t* __restrict__ HF, const bf16_t* __restrict__ HB,
                                           const bf16_t* __restrict__ P1, bf16_t* __restrict__ A) {
  const int tidx = ltid(wv);
  const int wid = wv, lane = tidx & 63;
  const float* hn = p.in[zq + 37];
  for (int row = blockIdx.x * 8 + wid; row < T_TOK; row += gridDim.x * 8) {
    float hv[16], t0[8], t1[8];
    unpack8(*(const u32x4*)(HF + (long)row * 1024 + lane * 16), hv); unpack8(*(const u32x4*)(HF + (long)row * 1024 + lane * 16 + 8), hv + 8);
    unpack8(*(const u32x4*)(HB + (long)row * 1024 + lane * 16), t0); unpack8(*(const u32x4*)(HB + (long)row * 1024 + lane * 16 + 8), t1);
    float ss = 0.f;
#pragma unroll
    for (int e = 0; e < 8; ++e) { hv[e] += t0[e]; hv[8 + e] += t1[e]; }
#pragma unroll
    for (int e = 0; e < 16; ++e) ss += hv[e] * hv[e];
    ss += __shfl_xor(ss, 1); ss += __shfl_xor(ss, 2); ss += __shfl_xor(ss, 4);
    const float rs = rsqrtf(ss * (1.f / 128.f) + 1e-6f);
    float ov[16];
    unpack8(*(const u32x4*)(P1 + (long)row * 4096 + 3072 + lane * 16), ov); unpack8(*(const u32x4*)(P1 + (long)row * 4096 + 3072 + lane * 16 + 8), ov + 8);
    float y[16];
#pragma unroll
    for (int e = 0; e < 16; ++e) y[e] = hv[e] * rs * hn[lane * 16 + e] * (1.f / (1.f + __expf(-ov[e])));
    *(u32x4*)(A + (long)row * 1024 + lane * 16) = pack8(y);
    *(u32x4*)(A + (long)row * 1024 + lane * 16 + 8) = pack8(y + 8);
  }
}

__device__ __forceinline__ void gsync(const int wv, unsigned* bar, const unsigned k) {
  const int tidx = ltid(wv);
  asm volatile("s_waitcnt vmcnt(0)" ::: "memory");
  __syncthreads();
  if (tidx == 0) {
    __builtin_amdgcn_fence(__ATOMIC_RELEASE, "agent");
    asm volatile("s_waitcnt vmcnt(0)" ::: "memory");
    const unsigned g = blockIdx.x & 7u;
    const unsigned ng = (gridDim.x + 7u - g) >> 3;
    const unsigned ngroups = gridDim.x < 8u ? gridDim.x : 8u;
    const unsigned old = __hip_atomic_fetch_add(bar + g * 32, 1u, __ATOMIC_RELAXED, __HIP_MEMORY_SCOPE_AGENT);
    if (old + 1u == k * ng) {
      const unsigned o2 = __hip_atomic_fetch_add(bar + 256, 1u, __ATOMIC_RELAXED, __HIP_MEMORY_SCOPE_AGENT);
      if (o2 + 1u == k * ngroups) {
#pragma unroll
        for (int q = 0; q < 8; ++q) __hip_atomic_store(bar + 512 + q * 32, k, __ATOMIC_RELAXED, __HIP_MEMORY_SCOPE_AGENT);
      }
    }
    while (__hip_atomic_load(bar + 512 + g * 32, __ATOMIC_RELAXED, __HIP_MEMORY_SCOPE_AGENT) < k) __builtin_amdgcn_s_sleep(4);
    __builtin_amdgcn_fence(__ATOMIC_ACQUIRE, "agent");
    asm volatile("s_waitcnt vmcnt(0)" ::: "memory");
  }
  __syncthreads();
}

__global__ void __launch_bounds__(512) mega(Params p, int ph_lo, int ph_hi) {
  const int wv = __builtin_amdgcn_readfirstlane(threadIdx.x >> 6);
  if (ph_hi < 0) { cg::this_grid().sync(); }
  unsigned* bar = (unsigned*)(p.ws + WS_END);
  char* ws = p.ws;
  bf16_t* Wt_in0 = (bf16_t*)(ws + OFF_WIN0); bf16_t* Wt_out0 = (bf16_t*)(ws + OFF_WOUT0);
  bf16_t* Wt_up0 = (bf16_t*)(ws + OFF_WUP0); bf16_t* Wt_up1 = (bf16_t*)(ws + OFF_WUP1);
  bf16_t* Wt_dn0 = (bf16_t*)(ws + OFF_WDN0); bf16_t* Wt_dn1 = (bf16_t*)(ws + OFF_WDN1);
  bf16_t* Wt_in1 = (bf16_t*)(ws + OFF_WIN1); bf16_t* Wt_out1 = (bf16_t*)(ws + OFF_WOUT1);
  float* modv = (float*)(ws + OFF_MOD);
  char* Pr = ws + OFF_P; char* Gr = ws + OFF_G;
  bf16_t* Pb = (bf16_t*)Pr; bf16_t* R = (bf16_t*)Pr;
  bf16_t* QA = (bf16_t*)(Pr + P_QA); bf16_t* KA = (bf16_t*)(Pr + P_KA); bf16_t* VA = (bf16_t*)(Pr + P_VA); bf16_t* X0 = (bf16_t*)(Pr + P_X0);
  float* GT = (float*)(Pr + P_GT); bf16_t* A2 = (bf16_t*)(Pr + P_A2);
  bf16_t* A = (bf16_t*)Gr; bf16_t* Gb = (bf16_t*)Gr; float* VV = (float*)(Gr + G_VV);
  bf16_t* HF = (bf16_t*)Gr; bf16_t* HB = (bf16_t*)(Gr + G_HB);
  bf16_t* DCb = (bf16_t*)(Pr + P_A2); float* DNb = (float*)(Gr + 50331648); float* SCb = DNb + 1024 * 128;
  float* X = p.out;
  float* F256 = p.out + O_C + 512; float* F2048 = p.out + O_C + 512 * 512 + 512;
  const float* mod0 = modv; const float* mod1 = modv + 3 * 6144;
  unsigned bk = 0;
#define PH(i, ...) if (ph_lo <= (i) && (i) < ph_hi) { const int zq = opq(); __VA_ARGS__; if ((i) + 1 < ph_hi) gsync(wv, bar, ++bk); }
  PH(0, {
    conv_w(wv, p.in[zq + 19], Wt_in0, 1024, 2560, 2560);
    conv_w(wv, p.in[zq + 20], Wt_out0, 1024, 1024, 1024);
    conv_w(wv, p.in[zq + 15], Wt_up0, 1024, 5632, 5632);
    conv_w(wv, p.in[zq + 18], Wt_dn0, 2816, 1024, 1024);
    conv_w(wv, p.in[zq + 33], Wt_in1, 1024, 4128, 4352);
    mod_phase(wv, p, zq, modv);
    filt_phase(wv, p, zq, F256, F2048);
  })
  PH(1, (row_phase<true, false, true>(wv, p, zq, nullptr, nullptr, mod0, 0, nullptr, p.in[zq + 11], mod0, 0, A)))
  PH(2, (gemm_phase<0, 2560>(wv, A, Wt_in0, 2560, 1024, Pb, nullptr)))
  PH(3, post_inproj0(wv, p, zq, Pb, QA, KA, VA, VV, X0))
  PH(4, mix0_phase(wv, p, zq, QA, KA, VA, VV, X0, F256, F2048, A))
  PH(5, (gemm_phase<0, 1024>(wv, A, Wt_out0, 1024, 1024, R, nullptr)))
  PH(6, (row_phase<true, true, true>(wv, p, zq, R, p.in[zq + 12], mod0, 2, X, p.in[zq + 13], mod0, 3, A)))
  PH(7, (gemm_phase<0, 5632>(wv, A, Wt_up0, 5632, 1024, Pb, nullptr)))
  PH(8, ffn_act_phase(wv, Pb, p.in[zq + 16], p.in[zq + 17], Gb))
  PH(9, (gemm_phase<0, 1024>(wv, Gb, Wt_dn0, 1024, 2816, R, nullptr)))
  PH(10, (row_phase<false, true, true>(wv, p, zq, R, p.in[zq + 14], mod0, 5, X, p.in[zq + 11] + 1024, mod1, 0, A)))
  PH(11, (gemm_phase<2, 4096>(wv, A, Wt_in1, 4352, 1024, Pb, GT)))
  PH(12, {
    mlstm_phase(wv, p, zq, Pb, GT, HF, HB, DCb, DNb, SCb, 0);
    conv_w(wv, p.in[zq + 15] + (long)1024 * 5632, Wt_up1, 1024, 5632, 5632);
    conv_w(wv, p.in[zq + 18] + (long)2816 * 1024, Wt_dn1, 2816, 1024, 1024);
    conv_w(wv, p.in[zq + 38], Wt_out1, 1024, 1024, 1024);
  })
  PH(13, mlstm_scan(wv, p, zq, DCb, DNb, SCb))
  PH(21, mlstm_phase(wv, p, zq, Pb, GT, HF, HB, DCb, DNb, SCb, 1))
  PH(14, mlstm_post(wv, p, zq, HF, HB, Pb, A2))
  PH(15, (gemm_phase<0, 1024>(wv, A2, Wt_out1, 1024, 1024, R, nullptr)))
  PH(16, (row_phase<false, true, true>(wv, p, zq, R, p.in[zq + 12] + 1024, mod1, 2, X, p.in[zq + 13] + 1024, mod1, 3, A)))
  PH(17, (gemm_phase<0, 5632>(wv, A, Wt_up1, 5632, 1024, Pb, nullptr)))
  PH(18, ffn_act_phase(wv, Pb, p.in[zq + 16] + 3 * 5632, p.in[zq + 17] + 5632, Gb))
  PH(19, (gemm_phase<0, 1024>(wv, Gb, Wt_dn1, 1024, 2816, R, nullptr)))
  PH(39, (row_phase<false, true, false>(wv, p, zq, R, p.in[zq + 14] + 1024, mod1, 5, X, nullptr, mod1, 0, nullptr)))
#undef PH
}

extern "C" void kernel_launch(void* const* d_in, const int* in_sizes, int n_in, void* d_out, int out_size, void* d_ws, size_t ws_size,
                              hipStream_t stream) {
  static int grid_blocks = 0;
  if (!grid_blocks) {
    if (ws_size < WS_END + 4096) fprintf(stderr, "kernel_launch: workspace too small: %zu < %zu\n", ws_size, (size_t)WS_END);
    hipFuncSetAttribute((const void*)mega, hipFuncAttributeMaxDynamicSharedMemorySize, LDS_BYTES);
    int dev = 0, cus = 0, per = 0;
    hipGetDevice(&dev);
    hipDeviceGetAttribute(&cus, hipDeviceAttributeMultiprocessorCount, dev);
    hipOccupancyMaxActiveBlocksPerMultiprocessor(&per, mega, 512, LDS_BYTES);
    if (per < 1) { fprintf(stderr, "kernel_launch: occupancy query returned %d\n", per); per = 1; }
    grid_blocks = cus;
  }
  Params p{};
  for (int i = 0; i < 39; ++i) p.in[i] = (const float*)d_in[i];
  p.out = (float*)d_out; p.ws = (char*)d_ws;
  int lo = 0, hi = NPH;
  (void)hipMemsetAsync((char*)d_ws + WS_END, 0, 4096, stream);
  void* args[] = {&p, &lo, &hi};
  hipError_t e = hipLaunchCooperativeKernel((void*)mega, dim3(grid_blocks), dim3(512), args, LDS_BYTES, stream);
  if (e != hipSuccess) fprintf(stderr, "cooperative launch failed: %s (grid %d)\n", hipGetErrorString(e), grid_blocks);
}
```

```cpp
#include <hip/hip_runtime.h>
#include <hip/hip_cooperative_groups.h>
#include <cstdio>
#include <cstdint>
namespace cg = cooperative_groups;

typedef unsigned short bf16_t;
typedef short bf16x8 __attribute__((ext_vector_type(8)));
typedef short s16x4 __attribute__((ext_vector_type(4)));
typedef float f32x4 __attribute__((ext_vector_type(4)));
typedef float f32x8 __attribute__((ext_vector_type(8)));
typedef float f32x16 __attribute__((ext_vector_type(16)));
typedef unsigned u32x4 __attribute__((ext_vector_type(4)));
typedef unsigned u32x2 __attribute__((ext_vector_type(2)));

constexpr int T_TOK = 12288, TPR = 8192;
constexpr int LDS_BYTES = 131072;
constexpr int NPH = 40;

constexpr size_t OFF_WIN0 = 0, OFF_WOUT0 = 5242880, OFF_WUP0 = 7340032, OFF_WUP1 = 18874368, OFF_WDN0 = 30408704,
                 OFF_WDN1 = 36175872, OFF_WIN1 = 41943040, OFF_WOUT1 = 50855936, OFF_MOD = 52953088, OFF_P = 53100544,
                 OFF_G = 191512576, WS_END = 260718592;
constexpr size_t P_QA = 62914560, P_KA = 75497472, P_VA = 82313216, P_X0 = 89128960;
constexpr size_t P_GT = 100663296, P_A2 = 102236160;
constexpr size_t G_VV = 25165824, G_HB = 25165824;
constexpr size_t O_K = 12582912, O_V = 14680064, O_C = 16777216, O_N = 25165824, O_M = 25231360;

struct Params { const float* in[39]; float* out; char* ws; };

typedef __bf16 nbf16x2 __attribute__((ext_vector_type(2)));
typedef float nf32x2 __attribute__((ext_vector_type(2)));
__device__ __forceinline__ unsigned cvtpk(float lo, float hi) {
  nf32x2 v = {lo, hi};
  nbf16x2 b = __builtin_convertvector(v, nbf16x2);
  return __builtin_bit_cast(unsigned, b);
}
__device__ __forceinline__ bf16_t f2bf(float f) { return (bf16_t)(cvtpk(f, 0.f) & 0xffffu); }
__device__ __forceinline__ float bf2f(bf16_t h) { return __uint_as_float(((unsigned)h) << 16); }
__device__ __forceinline__ float bflo(unsigned w) { return __uint_as_float(w << 16); }
__device__ __forceinline__ float bfhi(unsigned w) { return __uint_as_float(w & 0xffff0000u); }
__device__ __forceinline__ float wave_sum(float v) {
#pragma unroll
  for (int o = 32; o > 0; o >>= 1) v += __shfl_xor(v, o);
  return v;
}
__device__ __forceinline__ int llane() { int l; asm volatile("v_mbcnt_lo_u32_b32 %0, -1, 0\n\tv_mbcnt_hi_u32_b32 %0, -1, %0" : "=v"(l)); return l; }
__device__ __forceinline__ int ltid(int wv) { return (wv << 6) | llane(); }
__device__ __forceinline__ int opq() { int z; asm volatile("s_mov_b32 %0, 0" : "=s"(z)); return z; }
__device__ __forceinline__ float silu_f(float x) { return x * __builtin_amdgcn_rcpf(1.f + __expf(-x)); }
__device__ __forceinline__ int crow(int r, int hi) { return (r & 3) + 8 * (r >> 2) + 4 * hi; }
__device__ __forceinline__ void unpack8(u32x4 w, float* f) {
  f[0] = bflo(w[0]); f[1] = bfhi(w[0]); f[2] = bflo(w[1]); f[3] = bfhi(w[1]);
  f[4] = bflo(w[2]); f[5] = bfhi(w[2]); f[6] = bflo(w[3]); f[7] = bfhi(w[3]);
}
__device__ __forceinline__ u32x4 pack8(const float* f) {
  u32x4 w = {cvtpk(f[0], f[1]), cvtpk(f[2], f[3]), cvtpk(f[4], f[5]), cvtpk(f[6], f[7])}; return w;
}

__device__ __forceinline__ void conv_w(const int wv, const float* __restrict__ W, bf16_t* __restrict__ Wt, int K, int N, int NP, int b0 = 0) {
  const int tidx = ltid(wv);
  extern __shared__ __attribute__((aligned(16))) char shm_raw[];
  float* tl = (float*)shm_raw;
  const int tid = tidx;
  const int ntn = NP / 64, ntiles = (K / 64) * ntn;
  if ((int)blockIdx.x < b0) return;
  for (int tile = (int)blockIdx.x - b0; tile < ntiles; tile += (int)gridDim.x - b0) {
    const int k0 = (tile / ntn) * 64, n0 = (tile % ntn) * 64;
    __syncthreads();
#pragma unroll
    for (int i = 0; i < 2; ++i) {
      int kr = (tid >> 4) + 32 * i, nc = (tid & 15) * 4;
      float4 v = make_float4(0.f, 0.f, 0.f, 0.f);
      if (n0 + nc < N) v = *(const float4*)(W + (long)(k0 + kr) * N + n0 + nc);
      float* d = tl + kr * 65 + nc; d[0] = v.x; d[1] = v.y; d[2] = v.z; d[3] = v.w;
    }
    __syncthreads();
    {
      int n = tid >> 3, kg = (tid & 7) * 8;
      u32x4 w;
      w[0] = cvtpk(tl[(kg + 0) * 65 + n], tl[(kg + 1) * 65 + n]);
      w[1] = cvtpk(tl[(kg + 2) * 65 + n], tl[(kg + 3) * 65 + n]);
      w[2] = cvtpk(tl[(kg + 4) * 65 + n], tl[(kg + 5) * 65 + n]);
      w[3] = cvtpk(tl[(kg + 6) * 65 + n], tl[(kg + 7) * 65 + n]);
      *(u32x4*)(Wt + (long)(n0 + n) * K + k0 + kg) = w;
    }
  }
  __syncthreads();
}

__device__ __forceinline__ void mod_phase(const int wv, const Params& p, const int zq, float* modv) {
  const int tidx = ltid(wv);
  extern __shared__ __attribute__((aligned(16))) char shm_raw[];
  float* red = (float*)shm_raw;
  const int tid = tidx;
  const float* cvec = p.in[zq + 7]; const float* cctx = p.in[zq + 8]; const float* bmod = p.in[zq + 10];
  for (int item = blockIdx.x; item < 192; item += gridDim.x) {
    const int l = item / 96, cb = (item % 96) * 64;
    const float* W = p.in[zq + 9] + (long)l * 1024 * 6144;
    const int cl = tid & 15, kg = tid >> 4;
    float a0[4] = {0, 0, 0, 0}, a1[4] = {0, 0, 0, 0}, a2[4] = {0, 0, 0, 0};
#pragma unroll 8
    for (int i = 0; i < 32; ++i) {
      int k = kg + 32 * i;
      float4 w = *(const float4*)(W + (long)k * 6144 + cb + cl * 4);
      float s0 = silu_f(cctx[k]), s1 = silu_f(cvec[k]), s2 = silu_f(cvec[1024 + k]);
      a0[0] += s0 * w.x; a0[1] += s0 * w.y; a0[2] += s0 * w.z; a0[3] += s0 * w.w;
      a1[0] += s1 * w.x; a1[1] += s1 * w.y; a1[2] += s1 * w.z; a1[3] += s1 * w.w;
      a2[0] += s2 * w.x; a2[1] += s2 * w.y; a2[2] += s2 * w.z; a2[3] += s2 * w.w;
    }
    __syncthreads();
#pragma unroll
    for (int j = 0; j < 4; ++j) {
      red[kg * 192 + 0 * 64 + cl * 4 + j] = a0[j];
      red[kg * 192 + 1 * 64 + cl * 4 + j] = a1[j];
      red[kg * 192 + 2 * 64 + cl * 4 + j] = a2[j];
    }
    __syncthreads();
    if (tid < 192) {
      float s = 0.f;
#pragma unroll 8
      for (int q = 0; q < 32; ++q) s += red[q * 192 + tid];
      int g = tid / 64, col = cb + (tid % 64);
      modv[(l * 3 + g) * 6144 + col] = s + bmod[l * 6144 + col];
    }
  }
  __syncthreads();
}

__device__ __forceinline__ void filt_phase(const int wv, const Params& p, const int zq, float* F256, float* F2048) {
  const int tidx = ltid(wv);
  extern __shared__ __attribute__((aligned(16))) char shm_raw[];
  float* z = (float*)shm_raw;
  float* h1 = z + 256;
  float* h2 = h1 + 512;
  const int tid = tidx;
  const float *w1 = p.in[zq + 25], *b1 = p.in[zq + 26], *w2 = p.in[zq + 27], *b2 = p.in[zq + 28], *w3 = p.in[zq + 29], *b3 = p.in[zq + 30], *sf = p.in[zq + 31], *skip = p.in[zq + 32];
  const float DMAX = -15.350567286626973f, DMIN = -3.0701134573253946f;
  for (int item = blockIdx.x; item < 288; item += gridDim.x) {
    const int L = item < 32 ? 256 : 2048; const int i0 = item < 32 ? item * 8 : (item - 32) * 8;
    float* F = item < 32 ? F256 : F2048;
    __syncthreads();
    if (tid < 136) {
      const int q = tid / 17, f = tid % 17;
      const float t = (float)(i0 + q) / (float)(L - 1);
      float v;
      if (f == 0) v = t;
      else if (f <= 8) v = cosf(6.283185307179586f * t * (float)f);
      else v = sinf(6.283185307179586f * t * (float)(f - 8));
      z[q * 32 + f] = v;
    }
    __syncthreads();
    { const int q = tid >> 6, u = tid & 63; float a = b1[u];
#pragma unroll 1
      for (int jj = 0; jj < 17; ++jj) a += z[q * 32 + jj] * w1[jj * 64 + u];
      h1[q * 64 + u] = sinf(sf[u] * a); }
    __syncthreads();
    { const int q = tid >> 6, u = tid & 63; float a = b2[u];
#pragma unroll 8
      for (int jj = 0; jj < 64; ++jj) a += h1[q * 64 + jj] * w2[jj * 64 + u];
      h2[q * 64 + u] = sinf(sf[64 + u] * a); }
    __syncthreads();
    {
      const int ch = tid;
      float af[8], ab[8];
#pragma unroll
      for (int q = 0; q < 8; ++q) { af[q] = b3[ch]; ab[q] = b3[512 + ch]; }
#pragma unroll 4
      for (int jj = 0; jj < 64; ++jj) {
        const float wa = w3[jj * 1024 + ch], wb = w3[jj * 1024 + 512 + ch];
#pragma unroll
        for (int q = 0; q < 8; ++q) { const float hh = h2[q * 64 + jj]; af[q] += hh * wa; ab[q] += hh * wb; }
      }
      const float delta = fabsf(DMIN + (DMAX - DMIN) * ((float)ch / 511.f));
#pragma unroll
      for (int q = 0; q < 8; ++q) {
        const int i = i0 + q;
        const float t = (float)i / (float)(L - 1);
        const float win = expf(-t * delta);
        const float sfw = af[q] * win, sbw = ab[q] * win;
        if (i == 0) F[(long)(L - 1) * 512 + ch] = sfw + sbw + skip[ch];
        else { F[(long)(L - 1 + i) * 512 + ch] = sfw; F[(long)(L - 1 - i) * 512 + ch] = sbw; }
      }
    }
  }
  __syncthreads();
}

template <bool FROM_IN, bool HAS_R, bool HAS_A>
__device__ __forceinline__ void row_phase(const int wv, const Params& p, const int zq, const bf16_t* __restrict__ R, const float* __restrict__ postg,
                                          const float* __restrict__ modg, int gate_m, float* X,
                                          const float* __restrict__ preg, const float* __restrict__ mods, int shift_m, bf16_t* __restrict__ A) {
  const int tidx = ltid(wv);
  const int wid = wv, lane = tidx & 63;
  for (int row = blockIdx.x * 8 + wid; row < T_TOK; row += gridDim.x * 8) {
    const int g = row < TPR ? 0 : 1 + (row - TPR) / 2048;
    const float* mg = modg + g * 6144;
    const float* ms = mods + g * 6144;
    const float* xin = FROM_IN ? (row < TPR ? p.in[zq + 0] + (long)row * 1024 : p.in[zq + 1] + (long)(row - TPR) * 1024) : (const float*)X + (long)row * 1024;
    float4 x[4];
#pragma unroll
    for (int j = 0; j < 4; ++j) x[j] = *(const float4*)(xin + j * 256 + lane * 4);
    if (HAS_R) {
      float4 r[4]; float ss = 0.f;
#pragma unroll
      for (int j = 0; j < 4; ++j) { const u32x2 rw = *(const u32x2*)(R + (long)row * 1024 + j * 256 + lane * 4); r[j] = make_float4(bflo(rw[0]), bfhi(rw[0]), bflo(rw[1]), bfhi(rw[1])); ss += r[j].x * r[j].x + r[j].y * r[j].y + r[j].z * r[j].z + r[j].w * r[j].w; }
      ss = wave_sum(ss); const float rs = rsqrtf(ss * (1.f / 1024.f) + 1e-6f);
#pragma unroll
      for (int j = 0; j < 4; ++j) {
        float4 pg = *(const float4*)(postg + j * 256 + lane * 4);
        float4 gt = *(const float4*)(mg + gate_m * 1024 + j * 256 + lane * 4);
        x[j].x += gt.x * (r[j].x * rs * pg.x); x[j].y += gt.y * (r[j].y * rs * pg.y);
        x[j].z += gt.z * (r[j].z * rs * pg.z); x[j].w += gt.w * (r[j].w * rs * pg.w);
        *(float4*)(X + (long)row * 1024 + j * 256 + lane * 4) = x[j];
      }
    }
    if (HAS_A) {
      float ss = 0.f;
#pragma unroll
      for (int j = 0; j < 4; ++j) ss += x[j].x * x[j].x + x[j].y * x[j].y + x[j].z * x[j].z + x[j].w * x[j].w;
      ss = wave_sum(ss); const float rs = rsqrtf(ss * (1.f / 1024.f) + 1e-6f);
#pragma unroll
      for (int j = 0; j < 4; ++j) {
        float4 pg = *(const float4*)(preg + j * 256 + lane * 4);
        float4 sh = *(const float4*)(ms + shift_m * 1024 + j * 256 + lane * 4);
        float4 sc = *(const float4*)(ms + (shift_m + 1) * 1024 + j * 256 + lane * 4);
        float y0 = x[j].x * rs * pg.x * (1.f + sc.x) + sh.x, y1 = x[j].y * rs * pg.y * (1.f + sc.y) + sh.y;
        float y2 = x[j].z * rs * pg.z * (1.f + sc.z) + sh.z, y3 = x[j].w * rs * pg.w * (1.f + sc.w) + sh.w;
        u32x2 w = {cvtpk(y0, y1), cvtpk(y2, y3)};
        *(u32x2*)(A + (long)row * 1024 + j * 256 + lane * 4) = w;
      }
    }
  }
}

constexpr int BM = 256, BK = 64, HALF = 128, WGM = 8, HT = HALF * BK;
__device__ __forceinline__ int lds_byte(int r, int c) {
  int st = (r >> 4) * 2 + (c >> 5), rr = r & 15, cc = c & 31, ob = rr * 64 + cc * 2;
  return st * 1024 + (ob ^ (((ob >> 9) & 1) << 5));
}
__device__ __forceinline__ void stage_rc(int b, int& R, int& C) {
  int st = b / 1024, sb = b % 1024, swz = sb ^ (((sb >> 9) & 1) << 5);
  R = (st >> 1) * 16 + swz / 64; C = (st & 1) * 32 + (swz % 64) / 2;
}

template <int MODE, int LDC>
__device__ __forceinline__ void gemm_phase(const int wv, const bf16_t* __restrict__ A, const bf16_t* __restrict__ Bt, int N, int K,
                                           void* Cout, float* GT) {
  const int tidx = ltid(wv);
  extern __shared__ __attribute__((aligned(16))) char shm_raw[];
  bf16_t* shm = (bf16_t*)shm_raw;
#define SA(b, h) (shm + ((b) * 2 + (h)) * HT)
#define SB(b, h) (shm + (4 + (b) * 2 + (h)) * HT)
#define STAGE(P, BASE, br, kt) do { const bf16_t* _gb = (BASE) + ((long)(br) * K + (long)(kt) * BK); \
    __builtin_amdgcn_global_load_lds((const unsigned*)(_gb + soff0), (unsigned*)((char*)(P) + sl0), 16, 0, 0); \
    __builtin_amdgcn_global_load_lds((const unsigned*)(_gb + soff1), (unsigned*)((char*)(P) + sl0 + 8192), 16, 0, 0); } while (0)
#define LDA(dst, b, h) _Pragma("unroll") for (int m = 0; m < 4; ++m) _Pragma("unroll") for (int k = 0; k < 2; ++k) \
    dst[m][k] = *reinterpret_cast<const bf16x8*>((char*)SA(b, h) + lds_byte(wr * 64 + m * 16 + fr, k * 32 + fq * 8))
#define LDB(dst, b, h) _Pragma("unroll") for (int n = 0; n < 2; ++n) _Pragma("unroll") for (int k = 0; k < 2; ++k) \
    dst[n][k] = *reinterpret_cast<const bf16x8*>((char*)SB(b, h) + lds_byte(wc * 32 + n * 16 + fr, k * 32 + fq * 8))
#define MMA(ai, bj, At, Bt_) do { __builtin_amdgcn_s_setprio(1); \
    _Pragma("unroll") for (int m = 0; m < 4; ++m) _Pragma("unroll") for (int n = 0; n < 2; ++n) _Pragma("unroll") for (int k = 0; k < 2; ++k) \
      acc[ai][bj][m][n] = __builtin_amdgcn_mfma_f32_16x16x32_bf16(At[m][k], Bt_[n][k], acc[ai][bj][m][n], 0, 0, 0); \
    __builtin_amdgcn_s_setprio(0); } while (0)
#define WAIT_V(n) asm volatile("s_waitcnt vmcnt(" #n ")" ::: "memory")
#define WAIT_L(n) asm volatile("s_waitcnt lgkmcnt(" #n ")" ::: "memory")
#define BAR __builtin_amdgcn_s_barrier()
#define SCHED __builtin_amdgcn_sched_barrier(0)
  const int nM = T_TOK / BM, nN = N / BM, nwg = nM * nN;
  const int wid = wv, lane = tidx & 63, wr = wid >> 2, wc = wid & 3, fr = lane & 15, fq = lane >> 4;
  const int nt = K / BK;
  unsigned soff0, soff1; const int sl0 = tidx * 16;
  { int _r, _c; stage_rc(sl0, _r, _c); soff0 = (unsigned)(_r * K + _c); stage_rc(sl0 + 8192, _r, _c); soff1 = (unsigned)(_r * K + _c); }
  for (int tile = blockIdx.x; tile < nwg; tile += gridDim.x) {
    int wgt = tile;
    { const int q = nwg / 8, r = nwg % 8, xcd = wgt % 8, off = wgt / 8;
      wgt = (xcd < r ? xcd * (q + 1) : r * (q + 1) + (xcd - r) * q) + off; }
    const int nig = WGM * nN, gid = wgt / nig, fm = gid * WGM, gsz = min(nM - fm, WGM);
    const int pm = fm + ((wgt % nig) % gsz), pn = (wgt % nig) / gsz, brow = pm * BM, bcol = pn * BM;
    f32x4 acc[2][2][4][2] = {};
    bf16x8 At[4][2], B0[2][2], B1[2][2];
    STAGE(SB(0, 0), Bt, bcol, 0); STAGE(SA(0, 0), A, brow, 0);
    STAGE(SB(0, 1), Bt, bcol + HALF, 0); STAGE(SA(0, 1), A, brow + HALF, 0);
    if (wr == 1) BAR;
    WAIT_V(4); BAR;
    STAGE(SB(1, 0), Bt, bcol, 1); STAGE(SA(1, 0), A, brow, 1); STAGE(SB(1, 1), Bt, bcol + HALF, 1);
    WAIT_V(6); BAR;
    for (int t = 0; t < nt - 2; t += 2) {
      LDB(B0, 0, 0); SCHED; LDA(At, 0, 0); STAGE(SA(1, 1), A, brow + HALF, t + 1);
      WAIT_L(8); BAR; WAIT_L(0); MMA(0, 0, At, B0); BAR; SCHED;
      LDB(B1, 0, 1); STAGE(SB(0, 0), Bt, bcol, t + 2);
      BAR; WAIT_L(0); MMA(0, 1, At, B1); BAR;
      LDA(At, 0, 1); STAGE(SA(0, 0), A, brow, t + 2);
      BAR; WAIT_L(0); MMA(1, 0, At, B0); BAR; SCHED;
      STAGE(SB(0, 1), Bt, bcol + HALF, t + 2);
      WAIT_V(6); BAR; MMA(1, 1, At, B1); BAR;
      LDB(B0, 1, 0); SCHED; LDA(At, 1, 0); STAGE(SA(0, 1), A, brow + HALF, t + 2);
      WAIT_L(8); BAR; WAIT_L(0); MMA(0, 0, At, B0); BAR; SCHED;
      LDB(B1, 1, 1); STAGE(SB(1, 0), Bt, bcol, t + 3);
      BAR; WAIT_L(0); MMA(0, 1, At, B1); BAR;
      LDA(At, 1, 1); STAGE(SA(1, 0), A, brow, t + 3);
      BAR; WAIT_L(0); MMA(1, 0, At, B0); BAR; SCHED;
      STAGE(SB(1, 1), Bt, bcol + HALF, t + 3);
      WAIT_V(6); BAR; MMA(1, 1, At, B1); BAR;
    }
    { LDB(B0, 0, 0); LDA(At, 0, 0); STAGE(SA(1, 1), A, brow + HALF, nt - 1);
      BAR; WAIT_L(0); MMA(0, 0, At, B0); BAR;
      LDB(B1, 0, 1); BAR; WAIT_L(0); MMA(0, 1, At, B1); BAR;
      LDA(At, 0, 1); WAIT_V(4); BAR; WAIT_L(0); MMA(1, 0, At, B0); MMA(1, 1, At, B1); BAR; }
    { LDB(B0, 1, 0); LDA(At, 1, 0); WAIT_V(2); BAR; WAIT_L(0); MMA(0, 0, At, B0); BAR;
      LDB(B1, 1, 1); WAIT_V(0); BAR; WAIT_L(0); MMA(0, 1, At, B1); BAR;
      LDA(At, 1, 1); BAR; WAIT_L(0); MMA(1, 0, At, B0); MMA(1, 1, At, B1); BAR; }
    if (wr == 0) BAR;
    {
      const int le = llane();
      const int fr = le & 15, fq = le >> 4;
      const long base = (long)(brow + wr * 64) * LDC + bcol + wc * 32 + (unsigned)(fq * 4 * LDC + fr);
      if (MODE == 0 || (MODE == 2 && pn < 16)) {
        bf16_t* cp = (bf16_t*)Cout + base;
#pragma unroll
        for (int ai = 0; ai < 2; ++ai)
#pragma unroll
          for (int m = 0; m < 4; ++m)
#pragma unroll
            for (int j = 0; j < 4; ++j) {
              bf16_t* rp = cp + (ai * HALF + m * 16 + j) * LDC;
#pragma unroll
              for (int bj = 0; bj < 2; ++bj)
#pragma unroll
                for (int n = 0; n < 2; ++n) rp[bj * HALF + n * 16] = f2bf(acc[ai][bj][m][n][j]);
            }
      } else if (MODE == 1) {
        float* cp = (float*)Cout + base;
#pragma unroll
        for (int ai = 0; ai < 2; ++ai)
#pragma unroll
          for (int m = 0; m < 4; ++m)
#pragma unroll
            for (int j = 0; j < 4; ++j) {
              float* rp = cp + (ai * HALF + m * 16 + j) * LDC;
#pragma unroll
              for (int bj = 0; bj < 2; ++bj)
#pragma unroll
                for (int n = 0; n < 2; ++n) rp[bj * HALF + n * 16] = acc[ai][bj][m][n][j];
            }
      } else {
        if (wc == 0) {
          float* gp = GT + (long)(brow + wr * 64) * 32 + (unsigned)(fq * 4 * 32 + fr);
#pragma unroll
          for (int ai = 0; ai < 2; ++ai)
#pragma unroll
            for (int m = 0; m < 4; ++m)
#pragma unroll
              for (int j = 0; j < 4; ++j)
#pragma unroll
                for (int n = 0; n < 2; ++n) gp[(ai * HALF + m * 16 + j) * 32 + n * 16] = acc[ai][0][m][n][j];
        }
      }
    }
    __syncthreads();
  }
#undef SA
#undef SB
#undef STAGE
#undef LDA
#undef LDB
#undef MMA
}

__device__ __forceinline__ void gates_phase(const int wv, const bf16_t* __restrict__ A, const bf16_t* __restrict__ Wg, float* __restrict__ GT) {
  const int lane = llane();
  const int fr = lane & 15, fq = lane >> 4;
  for (int mt = wv * (int)gridDim.x + (int)blockIdx.x; mt < T_TOK / 16; mt += 8 * (int)gridDim.x) {
    const bf16_t* ap = A + (long)(mt * 16 + fr) * 1024 + fq * 8;
    const bf16_t* b0p = Wg + (long)fr * 1024 + fq * 8;
    const bf16_t* b1p = Wg + (long)(16 + fr) * 1024 + fq * 8;
    f32x4 acc0 = {0.f, 0.f, 0.f, 0.f}, acc1 = {0.f, 0.f, 0.f, 0.f};
#pragma unroll 8
    for (int k0 = 0; k0 < 1024; k0 += 32) {
      const bf16x8 a = *reinterpret_cast<const bf16x8*>(ap + k0);
      const bf16x8 b0 = *reinterpret_cast<const bf16x8*>(b0p + k0);
      const bf16x8 b1 = *reinterpret_cast<const bf16x8*>(b1p + k0);
      acc0 = __builtin_amdgcn_mfma_f32_16x16x32_bf16(a, b0, acc0, 0, 0, 0);
      acc1 = __builtin_amdgcn_mfma_f32_16x16x32_bf16(a, b1, acc1, 0, 0, 0);
    }
#pragma unroll
    for (int j = 0; j < 4; ++j) {
      GT[(long)(mt * 16 + fq * 4 + j) * 32 + fr] = acc0[j];
      GT[(long)(mt * 16 + fq * 4 + j) * 32 + 16 + fr] = acc1[j];
    }
  }
}

__device__ __forceinline__ void post_inproj0(const int wv, const Params& p, const int zq, const bf16_t* __restrict__ P0, bf16_t* __restrict__ QA, bf16_t* __restrict__ KA,
                                             bf16_t* __restrict__ VA, float* __restrict__ VV, bf16_t* __restrict__ X0) {
  const int tidx = ltid(wv);
  const int wid = wv, lane = tidx & 63;
  const float* qn = p.in[zq + 21]; const float* kn = p.in[zq + 22]; const float* cw = p.in[zq + 23]; const float* cb = p.in[zq + 24];
  float* outK = p.out + O_K; float* outV = p.out + O_V;
  for (int i = blockIdx.x * 512 + tidx; i < 2 * 512 * 256 / 4; i += gridDim.x * 512) {
    int e = i * 4; int b = e / (512 * 256), rem = e % (512 * 256);
    float4 kk = *(const float4*)(p.in[zq + 2] + e); float4 vv = *(const float4*)(p.in[zq + 3] + e);
    long d = (long)(8192 + b * 2560 + 2048) * 256 + rem;
    u32x2 wk = {cvtpk(kk.x, kk.y), cvtpk(kk.z, kk.w)}; u32x2 wv = {cvtpk(vv.x, vv.y), cvtpk(vv.z, vv.w)};
    *(u32x2*)(KA + d) = wk; *(u32x2*)(VA + d) = wv;
  }
  const int fi = lane & 31;
  const float inv = exp2f(-(float)fi * (13.287712379549449f / 32.f));
  for (int row = blockIdx.x * 8 + wid; row < T_TOK; row += gridDim.x * 8) {
    const bool samp = row >= TPR;
    const int L = samp ? 2048 : 256;
    const int tl = samp ? (row - TPR) % 2048 : row % 256;
    const long krow = samp ? (long)(8192 + ((row - TPR) / 2048) * 2560 + tl) : (long)row;
    const bf16_t* base = P0 + (long)row * 2560;
    float cs = 1.f, sn = 0.f;
    if (samp) { float pos = (lane < 32) ? (float)(tl / 64) : (float)(tl % 64); float ang = pos * inv; cs = cosf(ang); sn = sinf(ang); }
#pragma unroll
    for (int hh = 0; hh < 6; ++hh) {
      float x1 = bf2f(base[hh * 128 + lane]), x2 = bf2f(base[hh * 128 + 64 + lane]);
      float ss = wave_sum(x1 * x1 + x2 * x2);
      float rs = rsqrtf(ss * (1.f / 128.f) + 1e-6f);
      const float* gw = hh < 4 ? qn : kn;
      float y1 = x1 * rs * gw[lane], y2 = x2 * rs * gw[64 + lane];
      if (hh >= 4 && !samp) { outK[(long)row * 256 + (hh - 4) * 128 + lane] = y1; outK[(long)row * 256 + (hh - 4) * 128 + 64 + lane] = y2; }
      float o1 = y1 * cs - y2 * sn, o2 = y1 * sn + y2 * cs;
      if (hh < 4) { QA[(long)row * 512 + hh * 128 + lane] = f2bf(o1); QA[(long)row * 512 + hh * 128 + 64 + lane] = f2bf(o2); }
      else { KA[krow * 256 + (hh - 4) * 128 + lane] = f2bf(o1); KA[krow * 256 + (hh - 4) * 128 + 64 + lane] = f2bf(o2); }
    }
    {
      u32x2 w = *(const u32x2*)(base + 768 + lane * 4);
      *(u32x2*)(VA + krow * 256 + lane * 4) = w;
      if (!samp) { float4 f = make_float4(bflo(w[0]), bfhi(w[0]), bflo(w[1]), bfhi(w[1])); *(float4*)(outV + (long)row * 256 + lane * 4) = f; }
    }
    {
      const int c8 = lane * 8;
      float uc[3][8];
#pragma unroll
      for (int g = 0; g < 3; ++g) {
        const int col = g * 512 + c8;
        float um[8], u0[8], up[8];
        u32x4 z4 = {0u, 0u, 0u, 0u};
        u32x4 wm = (tl > 0) ? *(const u32x4*)(base - 2560 + 1024 + col) : z4;
        u32x4 w0 = *(const u32x4*)(base + 1024 + col);
        u32x4 wp = (tl < L - 1) ? *(const u32x4*)(base + 2560 + 1024 + col) : z4;
        unpack8(wm, um); unpack8(w0, u0); unpack8(wp, up);
#pragma unroll
        for (int e = 0; e < 8; ++e)
          uc[g][e] = cw[col + e] * um[e] + cw[1536 + col + e] * u0[e] + cw[3072 + col + e] * up[e] + cb[col + e];
      }
      float vvv[8];
#pragma unroll
      for (int e = 0; e < 8; ++e) vvv[e] = uc[2][e] * uc[1][e];
      *(float4*)(VV + (long)row * 512 + c8) = make_float4(vvv[0], vvv[1], vvv[2], vvv[3]);
      *(float4*)(VV + (long)row * 512 + c8 + 4) = make_float4(vvv[4], vvv[5], vvv[6], vvv[7]);
      *(u32x4*)(X0 + (long)row * 512 + c8) = pack8(uc[0]);
    }
  }
}

constexpr int AD = 128, ANW = 8, QBLK = 32, KVBLK = 64;
constexpr float ASCALE = 0.088388347648318440f;
constexpr float ATHR = 8.f;
constexpr int LDQ = 512, LDK = 256, LDO = 1024;
constexpr size_t SHM_V = KVBLK * AD * 2, SHM_K = KVBLK * AD * 2;
#define KSWZ(row, colB) ((row) * 256 + ((colB) ^ (((row) & 7) << 4)))
#define SBAR() __builtin_amdgcn_sched_barrier(0)

__device__ __forceinline__ void partialSM(f32x16& p0, f32x16& p1, float& m_reg, float& mn, float& alpha) {
  constexpr float C = ASCALE * 1.4426950408889634f;
  float pmax = p0[0];
#pragma unroll
  for (int r = 1; r < 16; ++r) pmax = fmaxf(pmax, p0[r]);
#pragma unroll
  for (int r = 0; r < 16; ++r) pmax = fmaxf(pmax, p1[r]);
  { auto rr = __builtin_amdgcn_permlane32_swap(__float_as_uint(pmax), __float_as_uint(pmax), false, false);
    pmax = fmaxf(__uint_as_float(rr[0]), __uint_as_float(rr[1])); }
  if (__builtin_expect(__all(pmax - m_reg <= ATHR / ASCALE), 1)) { mn = m_reg; alpha = 1.f; }
  else { mn = fmaxf(m_reg, pmax); alpha = __builtin_amdgcn_exp2f((m_reg - mn) * C); m_reg = mn; }
  float mnC = -mn * C;
#pragma unroll
  for (int r = 0; r < 16; ++r) p0[r] = fmaf(p0[r], C, mnC);
#pragma unroll
  for (int r = 0; r < 16; ++r) p1[r] = fmaf(p1[r], C, mnC);
#pragma unroll
  for (int r = 0; r < 16; ++r) p0[r] = __builtin_amdgcn_exp2f(p0[r]);
}
__device__ __forceinline__ void finishSM(f32x16& p0, f32x16& p1, float alpha, float& l_reg, bf16x8& pa0, bf16x8& pa1, bf16x8& pa2, bf16x8& pa3) {
#pragma unroll
  for (int r = 0; r < 16; ++r) p1[r] = __builtin_amdgcn_exp2f(p1[r]);
  float ps = 0;
#pragma unroll
  for (int r = 0; r < 16; ++r) ps += p0[r];
#pragma unroll
  for (int r = 0; r < 16; ++r) ps += p1[r];
  { auto rr = __builtin_amdgcn_permlane32_swap(__float_as_uint(ps), __float_as_uint(ps), false, false);
    ps = __uint_as_float(rr[0]) + __uint_as_float(rr[1]); }
  l_reg = l_reg * alpha + ps;
#define PK4(P, BASE, OUT) do { unsigned a0 = cvtpk(P[BASE + 0], P[BASE + 1]), a1 = cvtpk(P[BASE + 2], P[BASE + 3]);   \
    unsigned b0 = cvtpk(P[BASE + 4], P[BASE + 5]), b1 = cvtpk(P[BASE + 6], P[BASE + 7]);                              \
    auto r0 = __builtin_amdgcn_permlane32_swap(a0, b0, false, false); auto r1 = __builtin_amdgcn_permlane32_swap(a1, b1, false, false); \
    u32x4 w = {r0[0], r1[0], r0[1], r1[1]}; OUT = *reinterpret_cast<bf16x8*>(&w); } while (0)
  PK4(p0, 0, pa0); PK4(p0, 8, pa1); PK4(p1, 0, pa2); PK4(p1, 8, pa3);
#undef PK4
}
__device__ __forceinline__ void qkt(f32x16& p0, f32x16& p1, const bf16_t* Ks, const bf16x8* qr, int r32, int hi) {
  p0 = f32x16{}; p1 = f32x16{};
#pragma unroll
  for (int d0 = 0; d0 < 8; ++d0) { int cb = (d0 * 16 + hi * 8) * 2;
    bf16x8 b0 = *reinterpret_cast<const bf16x8*>((const char*)Ks + KSWZ(r32, cb));
    bf16x8 b1 = *reinterpret_cast<const bf16x8*>((const char*)Ks + KSWZ(32 + r32, cb));
    p0 = __builtin_amdgcn_mfma_f32_32x32x16_bf16(b0, qr[d0], p0, 0, 0, 0);
    p1 = __builtin_amdgcn_mfma_f32_32x32x16_bf16(b1, qr[d0], p1, 0, 0, 0); }
}
__device__ __forceinline__ int v_st(int k, int c) { const int kk = (k & ~0xC) | ((k & 4) << 1) | ((k & 8) >> 1); return ((kk >> 3) * 4 + (c >> 5)) * 512 + ((kk & 7) * 32 + (c & 31)) * 2; }
__device__ __forceinline__ int v_rd_base(int lane) { return ((lane & 3) << 3) | (((lane >> 2) & 3) << 6) | (((lane >> 4) & 1) << 5) | (((lane >> 5) & 1) << 8); }
constexpr int v_rd_off(int d0, int ks, int half) { return d0 * 512 + ks * 4096 + half * 2048; }
template <int OFF> __device__ __forceinline__ s16x4 tr_read(int vb) {
  s16x4 r; asm volatile("ds_read_b64_tr_b16 %0, %1 offset:%2" : "=&v"(r) : "v"(vb), "i"(OFF) : "memory"); return r;
}
template <int D0> __device__ __forceinline__ void pv_one(f32x16& od, int vb, bf16x8 pa0, bf16x8 pa1, bf16x8 pa2, bf16x8 pa3) {
  const s16x4 l0 = tr_read<v_rd_off(D0, 0, 0)>(vb), h0 = tr_read<v_rd_off(D0, 0, 1)>(vb), l1 = tr_read<v_rd_off(D0, 1, 0)>(vb), h1 = tr_read<v_rd_off(D0, 1, 1)>(vb);
  const s16x4 l2 = tr_read<v_rd_off(D0, 2, 0)>(vb), h2 = tr_read<v_rd_off(D0, 2, 1)>(vb), l3 = tr_read<v_rd_off(D0, 3, 0)>(vb), h3 = tr_read<v_rd_off(D0, 3, 1)>(vb);
  asm volatile("s_waitcnt lgkmcnt(0)" ::: "memory"); SBAR();
#define PK(L, H) (bf16x8){L[0], L[1], L[2], L[3], H[0], H[1], H[2], H[3]}
  od = __builtin_amdgcn_mfma_f32_32x32x16_bf16(pa0, PK(l0, h0), od, 0, 0, 0);
  od = __builtin_amdgcn_mfma_f32_32x32x16_bf16(pa1, PK(l1, h1), od, 0, 0, 0);
  od = __builtin_amdgcn_mfma_f32_32x32x16_bf16(pa2, PK(l2, h2), od, 0, 0, 0);
  od = __builtin_amdgcn_mfma_f32_32x32x16_bf16(pa3, PK(l3, h3), od, 0, 0, 0);
#undef PK
}
__device__ __forceinline__ void pv_d0(f32x16* o, int vb, bf16x8 pa0, bf16x8 pa1, bf16x8 pa2, bf16x8 pa3) {
  pv_one<0>(o[0], vb, pa0, pa1, pa2, pa3); pv_one<1>(o[1], vb, pa0, pa1, pa2, pa3); pv_one<2>(o[2], vb, pa0, pa1, pa2, pa3); pv_one<3>(o[3], vb, pa0, pa1, pa2, pa3);
}

__device__ __forceinline__ void attn_dense_body(const int wv, const bf16_t* __restrict__ Qb, const bf16_t* __restrict__ Kh, const bf16_t* __restrict__ Vh,
                                                bf16_t* __restrict__ Ob, int seq, char* lds) {
  const int tidx = ltid(wv);
  const int tid = tidx, wid = wv, lane = tid & 63, r32 = lane & 31, hi = lane >> 5;
  bf16_t* V_lds = (bf16_t*)lds; bf16_t* K_lds = (bf16_t*)(lds + 2 * SHM_V);
  float* ws = (float*)(lds + 2 * SHM_V + 2 * SHM_K) + wid * 64; float* li_l = ws; float* al_l = ws + 32;
  float m_reg = -1e30f, l_reg = 0; f32x16 o[4] = {}; bf16x8 qr[8];
  const bf16_t* Qw = Qb + (long)(wid * QBLK + r32) * LDQ + hi * 8;
#pragma unroll
  for (int d0 = 0; d0 < 8; ++d0) qr[d0] = *reinterpret_cast<const bf16x8*>(Qw + d0 * 16);
  const int sr = tid >> 4, sc = (tid & 15) * 8, vst0 = v_st(sr, sc), vst1 = v_st(32 + sr, sc);
  const int vb0 = (int)(uintptr_t)V_lds + v_rd_base(lane);
  bf16x8 sA_vs0, sA_vs1, sA_ks0, sA_ks1, sB_vs0, sB_vs1, sB_ks0, sB_ks1;
#define SLOADA(k0) do { sA_vs0 = *(const bf16x8*)(&Vh[(long)((k0) + sr) * LDK + sc]); sA_vs1 = *(const bf16x8*)(&Vh[(long)((k0) + 32 + sr) * LDK + sc]); \
    sA_ks0 = *(const bf16x8*)(&Kh[(long)((k0) + sr) * LDK + sc]); sA_ks1 = *(const bf16x8*)(&Kh[(long)((k0) + 32 + sr) * LDK + sc]); } while (0)
#define SLOADB(k0) do { sB_vs0 = *(const bf16x8*)(&Vh[(long)((k0) + sr) * LDK + sc]); sB_vs1 = *(const bf16x8*)(&Vh[(long)((k0) + 32 + sr) * LDK + sc]); \
    sB_ks0 = *(const bf16x8*)(&Kh[(long)((k0) + sr) * LDK + sc]); sB_ks1 = *(const bf16x8*)(&Kh[(long)((k0) + 32 + sr) * LDK + sc]); } while (0)
#define SWRITEA(b) do { *(bf16x8*)((char*)V_lds + (b) * SHM_V + vst0) = sA_vs0; *(bf16x8*)((char*)V_lds + (b) * SHM_V + vst1) = sA_vs1; int kc = sc * 2; \
    *(bf16x8*)((char*)K_lds + (b) * SHM_K + KSWZ(sr, kc)) = sA_ks0; *(bf16x8*)((char*)K_lds + (b) * SHM_K + KSWZ(32 + sr, kc)) = sA_ks1; } while (0)
#define SWRITEB(b) do { *(bf16x8*)((char*)V_lds + (b) * SHM_V + vst0) = sB_vs0; *(bf16x8*)((char*)V_lds + (b) * SHM_V + vst1) = sB_vs1; int kc = sc * 2; \
    *(bf16x8*)((char*)K_lds + (b) * SHM_K + KSWZ(sr, kc)) = sB_ks0; *(bf16x8*)((char*)K_lds + (b) * SHM_K + KSWZ(32 + sr, kc)) = sB_ks1; } while (0)
#define SWAIT() asm volatile("s_waitcnt vmcnt(4)" ::: "memory")
#define RESC(a) do { if (__any((a) < 1.f)) { if (hi == 0) al_l[r32] = (a); asm volatile("s_waitcnt lgkmcnt(0)" ::: "memory"); \
    _Pragma("unroll") for (int d = 0; d < 4; ++d) _Pragma("unroll") for (int r = 0; r < 16; ++r) o[d][r] *= al_l[crow(r, hi)]; } } while (0)
  f32x16 pA0, pA1, pB0, pB1; float mnA, mnB, alA, alB; bf16x8 pa0, pa1, pa2, pa3; const int NT = seq / KVBLK;
  SLOADA(0); asm volatile("s_waitcnt vmcnt(0)" ::: "memory"); SWRITEA(0); __syncthreads();
  qkt(pA0, pA1, K_lds, qr, r32, hi); partialSM(pA0, pA1, m_reg, mnA, alA);
  SLOADB(KVBLK); if (2 < NT) SLOADA(2 * KVBLK);
  SWAIT(); SWRITEB(1); __syncthreads();
  for (int j = 1; j + 1 < NT; j += 2) {
    SBAR(); qkt(pB0, pB1, (bf16_t*)((char*)K_lds + SHM_K), qr, r32, hi);
    finishSM(pA0, pA1, alA, l_reg, pa0, pa1, pa2, pa3); SBAR();
    SLOADB((j + 2) * KVBLK); SBAR();
    pv_d0(o, vb0, pa0, pa1, pa2, pa3); partialSM(pB0, pB1, m_reg, mnB, alB);
    __syncthreads(); SWAIT(); SWRITEA(0);
    RESC(alB); __syncthreads();
    SBAR(); qkt(pA0, pA1, K_lds, qr, r32, hi);
    finishSM(pB0, pB1, alB, l_reg, pa0, pa1, pa2, pa3); SBAR();
    if (j + 3 < NT) SLOADA((j + 3) * KVBLK); SBAR();
    pv_d0(o, vb0 + (int)SHM_V, pa0, pa1, pa2, pa3); partialSM(pA0, pA1, m_reg, mnA, alA);
    __syncthreads(); SWAIT(); SWRITEB(1);
    RESC(alA); __syncthreads();
  }
  SBAR(); qkt(pB0, pB1, (bf16_t*)((char*)K_lds + SHM_K), qr, r32, hi);
  finishSM(pA0, pA1, alA, l_reg, pa0, pa1, pa2, pa3); SBAR();
  pv_d0(o, vb0, pa0, pa1, pa2, pa3); partialSM(pB0, pB1, m_reg, mnB, alB);
  __syncthreads(); RESC(alB);
  finishSM(pB0, pB1, alB, l_reg, pa0, pa1, pa2, pa3); SBAR();
  pv_d0(o, vb0 + (int)SHM_V, pa0, pa1, pa2, pa3);
  if (hi == 0) li_l[r32] = l_reg; asm volatile("s_waitcnt lgkmcnt(0)" ::: "memory");
  float rli[16];
#pragma unroll
  for (int r = 0; r < 16; ++r) rli[r] = __builtin_amdgcn_rcpf(li_l[crow(r, hi)]);
  bf16_t* Ow = Ob + (long)(wid * QBLK) * LDO;
#pragma unroll
  for (int r = 0; r < 16; ++r) { int orow = crow(r, hi);
#pragma unroll
    for (int d0 = 0; d0 < 4; ++d0) Ow[(long)orow * LDO + d0 * 32 + r32] = f2bf(o[d0][r] * rli[r]); }
#undef SLOADA
#undef SLOADB
#undef SWRITEA
#undef SWRITEB
#undef SWAIT
#undef RESC
}

__device__ __forceinline__ void hyena_item(const float* __restrict__ Fu, const float* __restrict__ Vu, const bf16_t* __restrict__ Xu,
                                           bf16_t* __restrict__ Au, int L, int t0, unsigned ln) {
  float y[16], ring[16];
#pragma unroll
  for (int i = 0; i < 16; ++i) { y[i] = 0.f; const float* fr = Fu + (long)(t0 + i + L - 1) * 512; ring[i] = fr[ln]; }
  const float* fp = Fu + (long)(t0 + L - 2) * 512;
  float va[16], fa[16], vb[16], fb[16];
#define HY_LOAD(V, Fq, S) _Pragma("unroll") for (int j = 0; j < 16; ++j) { const float* vr_ = Vu + (long)((S) + j) * 512; const float* fr_ = fp - (long)((S) + j) * 512; V[j] = vr_[ln]; Fq[j] = fr_[ln]; }
#define HY_STEP(V, Fq) _Pragma("unroll") for (int j = 0; j < 16; ++j) { const float vs = V[j]; \
    _Pragma("unroll") for (int i = 0; i < 16; ++i) y[i] += ring[(i - j) & 15] * vs; ring[(15 - j) & 15] = Fq[j]; }
  HY_LOAD(va, fa, 0)
  for (int s0 = 0; s0 < L; s0 += 32) {
    HY_LOAD(vb, fb, s0 + 16)
    HY_STEP(va, fa)
    if (s0 + 32 < L) { HY_LOAD(va, fa, s0 + 32) }
    HY_STEP(vb, fb)
  }
#undef HY_LOAD
#undef HY_STEP
#pragma unroll
  for (int i = 0; i < 16; ++i) {
    const bf16_t* xr = Xu + (long)(t0 + i) * 512; bf16_t* ar = Au + (long)(t0 + i) * 1024;
    ar[ln] = f2bf(y[i] * bf2f(xr[ln]));
  }
}

__device__ __forceinline__ void mix0_phase(const int wv, const Params& p, const int zq, const bf16_t* QA, const bf16_t* KA, const bf16_t* VA, const float* VV,
                                           const bf16_t* X0, const float* F256, const float* F2048, bf16_t* AO) {
  extern __shared__ __attribute__((aligned(16))) char shm_raw[];
#ifndef NO_ATTN
  for (int it = blockIdx.x; it < 192; it += gridDim.x) {
    long rowb, krow; int h, seqk;
    if (it < 64) { const int qb = it % 8, b = it / 32; h = (it / 8) % 4; rowb = 8192 + (long)b * 2048 + qb * 256; krow = 8192 + (long)b * 2560; seqk = 2560; }
    else { const int j = it - 64; const int b = j / 4; h = j % 4; rowb = (long)b * 256; krow = rowb; seqk = 256; }
    __syncthreads();
    attn_dense_body(wv, QA + rowb * 512 + h * 128, KA + krow * 256 + (h >> 1) * 128, VA + krow * 256 + (h >> 1) * 128, AO + rowb * 1024 + h * 128, seqk, shm_raw);
  }
#endif
#ifndef NO_HYENA
  const int lane = llane(); const int wid = wv;
  {
    unsigned* qctr = (unsigned*)(p.ws + WS_END) + 768;
    volatile int* sidx = (volatile int*)(shm_raw + 120000);
    for (;;) {
      __syncthreads();
      if (ltid(wv) == 0) *sidx = (int)__hip_atomic_fetch_add(qctr, 1u, __ATOMIC_RELAXED, __HIP_MEMORY_SCOPE_AGENT);
      __syncthreads();
      const int it = __builtin_amdgcn_readfirstlane(*sidx);
      if (it >= 768) break;
      if (it < 256) {
        const int b = it / 128, cgp = (it / 16) % 8, tg = it % 16;
        { const long rb = 8192 + (long)b * 2048; hyena_item(F2048 + cgp * 64, VV + rb * 512 + cgp * 64, X0 + rb * 512 + cgp * 64, AO + rb * 1024 + 512 + cgp * 64, 2048, tg * 128 + wid * 16, (unsigned)lane); }
      } else {
        const int jj = it - 256; const int b = jj / 16, cgp = (jj / 2) % 8, tg = jj % 2;
        { const long rb = (long)b * 256; hyena_item(F256 + cgp * 64, VV + rb * 512 + cgp * 64, X0 + rb * 512 + cgp * 64, AO + rb * 1024 + 512 + cgp * 64, 256, tg * 128 + wid * 16, (unsigned)lane); }
      }
    }
  }
#endif
  __syncthreads();
}

__device__ __forceinline__ float erf_as(float x) {
  const float ax = fabsf(x);
  const float t = __builtin_amdgcn_rcpf(fmaf(0.3275911f, ax, 1.f));
  float p = fmaf(1.061405429f, t, -1.453152027f);
  p = fmaf(p, t, 1.421413741f); p = fmaf(p, t, -0.284496736f); p = fmaf(p, t, 0.254829592f);
  const float r = 1.f - p * t * __expf(-ax * ax);
  return copysignf(r, x);
}
__device__ __forceinline__ float gelu_f(float x) { return 0.5f * x * (1.f + erf_as(x * 0.70710678118654752f)); }
__device__ __forceinline__ void ffn_act_phase(const int wv, const bf16_t* __restrict__ P, const float* __restrict__ cw, const float* __restrict__ cb, bf16_t* __restrict__ G) {
  const int tidx = ltid(wv);
  const int tid = tidx;
  if (tid >= 352) return;
  const int c8 = tid * 8;
  float w1[3][8], w2[3][8], b1[8], b2[8];
#pragma unroll
  for (int e = 0; e < 8; ++e) {
#pragma unroll
    for (int k = 0; k < 3; ++k) { w1[k][e] = cw[k * 5632 + c8 + e]; w2[k][e] = cw[k * 5632 + 2816 + c8 + e]; }
    b1[e] = cb[c8 + e]; b2[e] = cb[2816 + c8 + e];
  }
  for (int item = blockIdx.x; item < T_TOK / 16; item += gridDim.x) {
    const int r0 = item * 16;
    const int L = r0 < TPR ? 256 : 2048;
    const int tl0 = r0 < TPR ? r0 % 256 : (r0 - TPR) % 2048;
    float am[8], a0[8], ap[8], gm[8], g0[8], gp[8];
    const u32x4 z4 = {0u, 0u, 0u, 0u};
    {
      const bf16_t* b = P + (long)r0 * 5632 + c8;
      u32x4 x = (tl0 > 0) ? *(const u32x4*)(b - 5632) : z4; unpack8(x, am);
      x = (tl0 > 0) ? *(const u32x4*)(b - 5632 + 2816) : z4; unpack8(x, gm);
      x = *(const u32x4*)(b); unpack8(x, a0);
      x = *(const u32x4*)(b + 2816); unpack8(x, g0);
    }
    for (int r = 0; r < 16; ++r) {
      const bf16_t* b = P + (long)(r0 + r) * 5632 + c8;
      const bool vn = (tl0 + r) < L - 1;
      u32x4 x = vn ? *(const u32x4*)(b + 5632) : z4; unpack8(x, ap);
      x = vn ? *(const u32x4*)(b + 5632 + 2816) : z4; unpack8(x, gp);
      float o[8];
#pragma unroll
      for (int e = 0; e < 8; ++e) {
        float h1 = w1[0][e] * am[e] + w1[1][e] * a0[e] + w1[2][e] * ap[e] + b1[e];
        float h2 = w2[0][e] * gm[e] + w2[1][e] * g0[e] + w2[2][e] * gp[e] + b2[e];
        o[e] = gelu_f(h1) * h2;
        am[e] = a0[e]; a0[e] = ap[e]; gm[e] = g0[e]; g0[e] = gp[e];
      }
      *(u32x4*)(G + (long)(r0 + r) * 2816 + c8) = pack8(o);
    }
  }
}

template <int K>
__device__ __forceinline__ f32x16 mma_nt(const bf16_t* A, int lda, const bf16_t* B, int ldb, f32x16 acc, int r32, int hi) {
  bf16x8 a[K / 16], b[K / 16];
#pragma unroll
  for (int k0 = 0; k0 < K / 16; ++k0) {
    a[k0] = *reinterpret_cast<const bf16x8*>(A + r32 * lda + k0 * 16 + 8 * hi);
    b[k0] = *reinterpret_cast<const bf16x8*>(B + r32 * ldb + k0 * 16 + 8 * hi);
  }
#pragma unroll
  for (int k0 = 0; k0 < K / 16; ++k0) acc = __builtin_amdgcn_mfma_f32_32x32x16_bf16(a[k0], b[k0], acc, 0, 0, 0);
  return acc;
}

__device__ __forceinline__ void mlstm_phase(const int wv, const Params& p, const int zq, const bf16_t* __restrict__ P1, const float* __restrict__ GT,
                                            bf16_t* __restrict__ HF, bf16_t* __restrict__ HB,
                                            bf16_t* DC, float* DN, float* SC, const int pass) {
  const int tidx = ltid(wv);
  extern __shared__ __attribute__((aligned(16))) char shm_raw[];
  bf16_t* Qs = (bf16_t*)shm_raw;
  bf16_t* Ks = Qs + 64 * 136;
  bf16_t* KwT = Ks + 64 * 136;
  bf16_t* VsT = KwT + 128 * 72;
  bf16_t* Wb = VsT + 128 * 72;
  bf16_t* Cb = Wb + 64 * 72;
  float* gbuf = (float*)(Cb + 128 * 136);
  float* sclv = gbuf + 400; float* wintv = sclv + 64; float* nvec = wintv + 64;
  float* cwl = nvec + 128;
  const int tid = tidx, wid = wv, lane = tid & 63, r32 = lane & 31, hi = lane >> 5;
  const float* cw = p.in[zq + 35]; const float* cbias = p.in[zq + 36]; const float* bg = p.in[zq + 34];
  const int nitems = pass == 0 ? 1536 : 1024;
  for (int it = blockIdx.x; it < nitems; it += gridDim.x) {
    int mode, seq, h, dir, c0, c1, su = 0;
    if (pass == 0 && it < 512) { mode = 0; seq = it / 16; h = (it / 2) % 8; dir = it % 2; c0 = 0; c1 = 4; }
    else { su = pass == 0 ? it - 512 : it; const int sidx = su >> 5; mode = pass == 0 ? 1 : 2;
           seq = 32 + sidx / 16; h = (sidx / 2) % 8; dir = sidx % 2; c0 = su & 31; c1 = c0 + 1; }
    const bool do_out = mode != 1;
    const int L = seq < 32 ? 256 : 2048;
    const long rowbase = seq < 32 ? (long)seq * 256 : 8192 + (long)(seq - 32) * 2048;
    __syncthreads();
    f32x16 cacc[2]; float m = (mode == 1) ? -1e30f : 0.f;
    const int vb2 = wid >> 1;
#pragma unroll
    for (int i = 0; i < 2; ++i)
#pragma unroll
      for (int r = 0; r < 16; ++r) cacc[i][r] = 0.f;
    if (mode == 2) {
#pragma unroll
      for (int i = 0; i < 4; ++i) { const int id = tid + 512 * i, row = id >> 4, ck = id & 15;
        *(u32x4*)(Cb + row * 136 + ck * 8) = *(const u32x4*)(DC + (long)su * 16384 + row * 128 + ck * 8); }
      if (tid < 128) nvec[tid] = DN[su * 128 + tid];
      m = SC[su * 4 + 2];
    } else {
#pragma unroll
      for (int i = 0; i < 2; ++i) { const int kb = (wid & 1) * 2 + i;
#pragma unroll
        for (int r = 0; r < 16; ++r) Cb[(vb2 * 32 + crow(r, hi)) * 136 + kb * 32 + r32] = 0; }
      if (tid < 128) nvec[tid] = 0.f;
    }
    if (tid < 256) {
      const int col = (tid < 128) ? (h * 128 + tid) : (1024 + h * 128 + (tid - 128));
      cwl[tid] = cw[col]; cwl[256 + tid] = cw[2048 + col]; cwl[512 + tid] = cw[4096 + col]; cwl[768 + tid] = cbias[col];
    }
    const float bgi = bg[dir * 8 + h], bgf = bg[16 + dir * 8 + h];
    __syncthreads();
    u32x4 rq[2][3], rk[2][3], rv[2]; float g_i = 0.f, g_f = 0.f;
#define ML_LOADRAW(chn) do { \
      const int tcr_ = (chn) * 64 + lane; const int posr_ = dir ? (L - 1 - tcr_) : tcr_; \
      const bf16_t* rp_ = P1 + (rowbase + posr_) * 4096 + h * 128 + wv * 16; \
      const bool hm_ = posr_ > 0, hp_ = posr_ < L - 1; const u32x4 z4_ = {0u, 0u, 0u, 0u}; \
      _Pragma("unroll") for (int hf = 0; hf < 2; ++hf) { \
        rq[hf][0] = hm_ ? *(const u32x4*)(rp_ - 4096 + hf * 8) : z4_; rq[hf][1] = *(const u32x4*)(rp_ + hf * 8); \
        rq[hf][2] = hp_ ? *(const u32x4*)(rp_ + 4096 + hf * 8) : z4_; \
        rk[hf][0] = hm_ ? *(const u32x4*)(rp_ - 4096 + 1024 + hf * 8) : z4_; rk[hf][1] = *(const u32x4*)(rp_ + 1024 + hf * 8); \
        rk[hf][2] = hp_ ? *(const u32x4*)(rp_ + 4096 + 1024 + hf * 8) : z4_; \
        rv[hf] = *(const u32x4*)(rp_ + 2048 + hf * 8); } \
      if (wid == 7) { const float* gr_ = GT + (rowbase + posr_) * 32; g_i = gr_[dir * 8 + h]; g_f = gr_[16 + dir * 8 + h]; } \
    } while (0)
#define ML_GATES(setp, mval) do { float* av_ = gbuf + (setp) * 200; float* Mv_ = av_ + 64; float* bv_ = Mv_ + 64; float* scal_ = bv_ + 64; \
      const float ic_ = g_i + bgi; const float fp_ = g_f + bgf; \
      const float lf_ = fminf(fp_, 0.f) - __logf(1.f + __expf(-fabsf(fp_))); \
      float bc_ = lf_; \
      _Pragma("unroll") for (int off = 1; off < 64; off <<= 1) { float t_ = __shfl_up(bc_, off); if (lane >= off) bc_ += t_; } \
      const float a_ = ic_ - bc_; float pm_ = a_; \
      _Pragma("unroll") for (int off = 1; off < 64; off <<= 1) { float t_ = __shfl_up(pm_, off); if (lane >= off) pm_ = fmaxf(pm_, t_); } \
      const float M_ = fmaxf((mval), pm_); \
      av_[lane] = a_; Mv_[lane] = M_; bv_[lane] = bc_; if (lane == 63) { scal_[0] = M_; scal_[1] = bc_; } } while (0)
    float sv_M = 0.f, sv_b = 0.f;
    ML_LOADRAW(c0);
    if (wid == 7) ML_GATES(c0 & 1, m);
    for (int ch = c0; ch < c1; ++ch) {
      float* av = gbuf + (ch & 1) * 200; float* Mv = av + 64; float* bv = Mv + 64; float* scal = bv + 64;
      float kf[16];
      {
        const int r = lane, c16 = wv * 16;
#pragma unroll
        for (int hf = 0; hf < 2; ++hf) {
          float um[8], u0[8], up[8], qf[8];
          if (do_out) { unpack8(rq[hf][0], um); unpack8(rq[hf][1], u0); unpack8(rq[hf][2], up);
#pragma unroll
            for (int e = 0; e < 8; ++e) { const int c = c16 + hf * 8 + e;
              qf[e] = silu_f(cwl[c] * um[e] + cwl[256 + c] * u0[e] + cwl[512 + c] * up[e] + cwl[768 + c]); }
            *(u32x4*)(Qs + r * 136 + c16 + hf * 8) = pack8(qf); }
          { unpack8(rk[hf][0], um); unpack8(rk[hf][1], u0); unpack8(rk[hf][2], up);
#pragma unroll
            for (int e = 0; e < 8; ++e) { const int c = 128 + c16 + hf * 8 + e;
              qf[e] = 0.088388347648318440f * silu_f(cwl[c] * um[e] + cwl[256 + c] * u0[e] + cwl[512 + c] * up[e] + cwl[768 + c]);
              kf[hf * 8 + e] = qf[e]; }
            *(u32x4*)(Ks + r * 136 + c16 + hf * 8) = pack8(qf); }
          { const u32x4 wv4 = rv[hf];
            bf16_t* vd = VsT + (c16 + hf * 8) * 72 + r;
            vd[0 * 72] = (bf16_t)(wv4[0] & 0xffff); vd[1 * 72] = (bf16_t)(wv4[0] >> 16);
            vd[2 * 72] = (bf16_t)(wv4[1] & 0xffff); vd[3 * 72] = (bf16_t)(wv4[1] >> 16);
            vd[4 * 72] = (bf16_t)(wv4[2] & 0xffff); vd[5 * 72] = (bf16_t)(wv4[2] >> 16);
            vd[6 * 72] = (bf16_t)(wv4[3] & 0xffff); vd[7 * 72] = (bf16_t)(wv4[3] >> 16); }
        }
      }
      if (ch + 1 < c1) ML_LOADRAW(ch + 1);
      __syncthreads();
      const float M63 = scal[0], b63 = scal[1];
      sv_M = M63; sv_b = b63;
      const float m_new = b63 + M63;
      const float w_state = __expf(m - M63);
      {
        const float wt = __expf(av[lane] - M63);
        bf16_t* kd = KwT + (wv * 16) * 72 + lane;
#pragma unroll
        for (int e = 0; e < 16; ++e) kd[e * 72] = f2bf(kf[e] * wt);
      }
      __syncthreads();
      if (wid == 7 && ch + 1 < c1) ML_GATES((ch + 1) & 1, m_new);
      const int tb = wid & 1, vb = wid >> 1;
      if (do_out && wid < 4) {
        const int sb = wid >> 1;
        f32x16 s = {};
        if (sb <= tb) { s = mma_nt<64>(Qs + tb * 32 * 136, 136, Ks + sb * 32 * 136, 136, s, r32, hi); s = mma_nt<64>(Qs + tb * 32 * 136 + 64, 136, Ks + sb * 32 * 136 + 64, 136, s, r32, hi); }
        const int sc = sb * 32 + r32; const float as = av[sc];
#pragma unroll
        for (int r = 0; r < 16; ++r) {
          const int t = tb * 32 + crow(r, hi);
          float w = (sc <= t) ? s[r] * __expf(as - Mv[t]) : 0.f;
          Wb[t * 72 + sc] = f2bf(w);
        }
      }
      f32x16 inter = {};
      if (do_out) inter = mma_nt<64>(Qs + tb * 32 * 136, 136, Cb + vb * 32 * 136, 136, inter, r32, hi); if (do_out) inter = mma_nt<64>(Qs + tb * 32 * 136 + 64, 136, Cb + vb * 32 * 136 + 64, 136, inter, r32, hi);
      __syncthreads();
      if (do_out) {
        const int t = tid >> 3, part = tid & 7;
        float wsum[8]; unpack8(*(const u32x4*)(Wb + t * 72 + part * 8), wsum);
        float dw = 0.f;
#pragma unroll
        for (int e = 0; e < 8; ++e) dw += wsum[e];
        float q0[8], q1[8]; unpack8(*(const u32x4*)(Qs + t * 136 + part * 16), q0); unpack8(*(const u32x4*)(Qs + t * 136 + part * 16 + 8), q1);
        float dq = 0.f;
#pragma unroll
        for (int e = 0; e < 8; ++e) dq += q0[e] * nvec[part * 16 + e] + q1[e] * nvec[part * 16 + 8 + e];
        dw += __shfl_xor(dw, 1); dw += __shfl_xor(dw, 2); dw += __shfl_xor(dw, 4);
        dq += __shfl_xor(dq, 1); dq += __shfl_xor(dq, 2); dq += __shfl_xor(dq, 4);
        if (part == 0) {
          const float Mt = Mv[t];
          const float wint = __expf(m - Mt);
          const float den = wint * dq + dw;
          const float mt = bv[t] + Mt;
          sclv[t] = 1.f / fmaxf(fabsf(den), __expf(-mt));
          wintv[t] = wint;
        }
      }
      __syncthreads();
      if (do_out) {
        f32x16 num;
#pragma unroll
        for (int r = 0; r < 16; ++r) num[r] = inter[r] * wintv[tb * 32 + crow(r, hi)];
        num = mma_nt<64>(Wb + tb * 32 * 72, 72, VsT + vb * 32 * 72, 72, num, r32, hi);
        bf16_t* Hout = dir ? HB : HF;
#pragma unroll
        for (int r = 0; r < 16; ++r) {
          const int t = tb * 32 + crow(r, hi);
          const int tc = ch * 64 + t; const int pos = dir ? (L - 1 - tc) : tc;
          Hout[(rowbase + pos) * 1024 + h * 128 + vb * 32 + r32] = f2bf(num[r] * sclv[t]);
        }
      }
#pragma unroll
      for (int i = 0; i < 2; ++i) {
        const int kb = (wid & 1) * 2 + i;
#pragma unroll
        for (int r = 0; r < 16; ++r) cacc[i][r] *= w_state;
        cacc[i] = mma_nt<64>(VsT + vb2 * 32 * 72, 72, KwT + kb * 32 * 72, 72, cacc[i], r32, hi);
#pragma unroll
        for (int r = 0; r < 16; ++r) Cb[(vb2 * 32 + crow(r, hi)) * 136 + kb * 32 + r32] = f2bf(cacc[i][r]);
      }
      if (tid < 128) {
        float s = 0.f;
#pragma unroll
        for (int q = 0; q < 8; ++q) { float f[8]; unpack8(*(const u32x4*)(KwT + tid * 72 + q * 8), f);
#pragma unroll
          for (int e = 0; e < 8; ++e) s += f[e]; }
        nvec[tid] = w_state * nvec[tid] + s;
      }
      m = m_new;
      __syncthreads();
    }
    if (mode == 0) {
      float* Co = p.out + O_C + (long)((seq * 2 + dir) * 8 + h) * 16384;
#pragma unroll
      for (int i = 0; i < 2; ++i) { const int kb = (wid & 1) * 2 + i;
#pragma unroll
        for (int r = 0; r < 16; ++r) Co[(vb2 * 32 + crow(r, hi)) * 128 + kb * 32 + r32] = cacc[i][r]; }
      if (tid < 128) p.out[O_N + ((seq * 2 + dir) * 8 + h) * 128 + tid] = nvec[tid];
      if (tid == 0) p.out[O_M + (seq * 2 + dir) * 8 + h] = m;
    } else if (mode == 1) {
#pragma unroll
      for (int i = 0; i < 4; ++i) { const int id = tid + 512 * i, row = id >> 4, ck = id & 15;
        *(u32x4*)(DC + (long)su * 16384 + row * 128 + ck * 8) = *(const u32x4*)(Cb + row * 136 + ck * 8); }
      if (tid < 128) DN[su * 128 + tid] = nvec[tid];
      if (tid == 0) { SC[su * 4] = sv_M; SC[su * 4 + 1] = sv_b; }
    }
  }
  __syncthreads();
}

__device__ __forceinline__ void mlstm_scan(const int wv, const Params& p, const int zq, bf16_t* DC, float* DN, float* SC) {
  const int tidx = ltid(wv);
  for (int g = blockIdx.x * 512 + tidx; g < 32 * 4096; g += gridDim.x * 512) {
    const int sidx = g >> 12, e4 = (g & 4095) * 4;
    const int b = sidx >> 4, h = (sidx >> 1) & 7, dir = sidx & 1;
    const float4 c0 = *(const float4*)(p.in[zq + 4] + (long)((b * 2 + dir) * 8 + h) * 16384 + e4);
    float C0 = c0.x, C1 = c0.y, C2 = c0.z, C3 = c0.w;
    float m = p.in[zq + 6][(b * 2 + dir) * 8 + h];
#pragma unroll 4
    for (int c = 0; c < 32; ++c) {
      const int u = sidx * 32 + c;
      const float amax = SC[u * 4], b63 = SC[u * 4 + 1];
      const float Mc = fmaxf(m, amax);
      const float ws = __expf(m - Mc), wd = __expf(amax - Mc);
      u32x2* dp = (u32x2*)(DC + (long)u * 16384 + e4);
      const u32x2 d = *dp;
      u32x2 o = {cvtpk(C0, C1), cvtpk(C2, C3)};
      *dp = o;
      C0 = ws * C0 + wd * bflo(d[0]); C1 = ws * C1 + wd * bfhi(d[0]); C2 = ws * C2 + wd * bflo(d[1]); C3 = ws * C3 + wd * bfhi(d[1]);
      m = b63 + Mc;
    }
  }
  for (int g = blockIdx.x * 512 + tidx; g < 32 * 128; g += gridDim.x * 512) {
    const int sidx = g >> 7, k = g & 127;
    const int b = sidx >> 4, h = (sidx >> 1) & 7, dir = sidx & 1;
    float n = p.in[zq + 5][((b * 2 + dir) * 8 + h) * 128 + k];
    float m = p.in[zq + 6][(b * 2 + dir) * 8 + h];
    for (int c = 0; c < 32; ++c) {
      const int u = sidx * 32 + c;
      const float amax = SC[u * 4], b63 = SC[u * 4 + 1];
      const float Mc = fmaxf(m, amax);
      const float ws = __expf(m - Mc), wd = __expf(amax - Mc);
      const float dn = DN[u * 128 + k];
      DN[u * 128 + k] = n;
      if (k == 0) SC[u * 4 + 2] = m;
      n = ws * n + wd * dn;
      m = b63 + Mc;
    }
  }
}

#undef ML_LOADRAW
#undef ML_GATES
__device__ __forceinline__ void mlstm_post(const int wv, const Params& p, const int zq, const bf16_t* __restrict__ HF, const bf16_t* __restrict__ HB,
                                           const bf16_t* __restrict__ P1, bf16_t* __restrict__ A) {
  const int tidx = ltid(wv);
  const int wid = wv, lane = tidx & 63;
  const float* hn = p.in[zq + 37];
  for (int row = blockIdx.x * 8 + wid; row < T_TOK; row += gridDim.x * 8) {
    float hv[16], t0[8], t1[8];
    unpack8(*(const u32x4*)(HF + (long)row * 1024 + lane * 16), hv); unpack8(*(const u32x4*)(HF + (long)row * 1024 + lane * 16 + 8), hv + 8);
    unpack8(*(const u32x4*)(HB + (long)row * 1024 + lane * 16), t0); unpack8(*(const u32x4*)(HB + (long)row * 1024 + lane * 16 + 8), t1);
    float ss = 0.f;
#pragma unroll
    for (int e = 0; e < 8; ++e) { hv[e] += t0[e]; hv[8 + e] += t1[e]; }
#pragma unroll
    for (int e = 0; e < 16; ++e) ss += hv[e] * hv[e];
    ss += __shfl_xor(ss, 1); ss += __shfl_xor(ss, 2); ss += __shfl_xor(ss, 4);
    const float rs = rsqrtf(ss * (1.f / 128.f) + 1e-6f);
    float ov[16];
    unpack8(*(const u32x4*)(P1 + (long)row * 4096 + 3072 + lane * 16), ov); unpack8(*(const u32x4*)(P1 + (long)row * 4096 + 3072 + lane * 16 + 8), ov + 8);
    float y[16];
#pragma unroll
    for (int e = 0; e < 16; ++e) y[e] = hv[e] * rs * hn[lane * 16 + e] * (1.f / (1.f + __expf(-ov[e])));
    *(u32x4*)(A + (long)row * 1024 + lane * 16) = pack8(y);
    *(u32x4*)(A + (long)row * 1024 + lane * 16 + 8) = pack8(y + 8);
  }
}

__device__ __forceinline__ void gsync(const int wv, unsigned* bar, const unsigned k) {
  const int tidx = ltid(wv);
  asm volatile("s_waitcnt vmcnt(0)" ::: "memory");
  __syncthreads();
  if (tidx == 0) {
    __builtin_amdgcn_fence(__ATOMIC_RELEASE, "agent");
    asm volatile("s_waitcnt vmcnt(0)" ::: "memory");
    const unsigned g = blockIdx.x & 7u;
    const unsigned ng = (gridDim.x + 7u - g) >> 3;
    const unsigned ngroups = gridDim.x < 8u ? gridDim.x : 8u;
    const unsigned old = __hip_atomic_fetch_add(bar + g * 32, 1u, __ATOMIC_RELAXED, __HIP_MEMORY_SCOPE_AGENT);
    if (old + 1u == k * ng) {
      const unsigned o2 = __hip_atomic_fetch_add(bar + 256, 1u, __ATOMIC_RELAXED, __HIP_MEMORY_SCOPE_AGENT);
      if (o2 + 1u == k * ngroups) {
#pragma unroll
        for (int q = 0; q < 8; ++q) __hip_atomic_store(bar + 512 + q * 32, k, __ATOMIC_RELAXED, __HIP_MEMORY_SCOPE_AGENT);
      }
    }
    while (__hip_atomic_load(bar + 512 + g * 32, __ATOMIC_RELAXED, __HIP_MEMORY_SCOPE_AGENT) < k) __builtin_amdgcn_s_sleep(4);
    __builtin_amdgcn_fence(__ATOMIC_ACQUIRE, "agent");
    asm volatile("s_waitcnt vmcnt(0)" ::: "memory");
  }
  __syncthreads();
}

__global__ void __launch_bounds__(512) mega(Params p, int ph_lo, int ph_hi) {
  const int wv = __builtin_amdgcn_readfirstlane(threadIdx.x >> 6);
  if (ph_hi < 0) { cg::this_grid().sync(); }
  unsigned* bar = (unsigned*)(p.ws + WS_END);
  char* ws = p.ws;
  bf16_t* Wt_in0 = (bf16_t*)(ws + OFF_WIN0); bf16_t* Wt_out0 = (bf16_t*)(ws + OFF_WOUT0);
  bf16_t* Wt_up0 = (bf16_t*)(ws + OFF_WUP0); bf16_t* Wt_up1 = (bf16_t*)(ws + OFF_WUP1);
  bf16_t* Wt_dn0 = (bf16_t*)(ws + OFF_WDN0); bf16_t* Wt_dn1 = (bf16_t*)(ws + OFF_WDN1);
  bf16_t* Wt_in1 = (bf16_t*)(ws + OFF_WIN1); bf16_t* Wt_out1 = (bf16_t*)(ws + OFF_WOUT1);
  float* modv = (float*)(ws + OFF_MOD);
  char* Pr = ws + OFF_P; char* Gr = ws + OFF_G;
  bf16_t* Pb = (bf16_t*)Pr; bf16_t* R = (bf16_t*)Pr;
  bf16_t* QA = (bf16_t*)(Pr + P_QA); bf16_t* KA = (bf16_t*)(Pr + P_KA); bf16_t* VA = (bf16_t*)(Pr + P_VA); bf16_t* X0 = (bf16_t*)(Pr + P_X0);
  float* GT = (float*)(Pr + P_GT); bf16_t* A2 = (bf16_t*)(Pr + P_A2);
  bf16_t* A = (bf16_t*)Gr; bf16_t* Gb = (bf16_t*)Gr; float* VV = (float*)(Gr + G_VV);
  bf16_t* HF = (bf16_t*)Gr; bf16_t* HB = (bf16_t*)(Gr + G_HB);
  bf16_t* DCb = (bf16_t*)(Pr + P_A2); float* DNb = (float*)(Gr + 50331648); float* SCb = DNb + 1024 * 128;
  float* X = p.out;
  float* F256 = p.out + O_C + 512; float* F2048 = p.out + O_C + 512 * 512 + 512;
  const float* mod0 = modv; const float* mod1 = modv + 3 * 6144;
  unsigned bk = 0;
#define PH(i, ...) if (ph_lo <= (i) && (i) < ph_hi) { const int zq = opq(); __VA_ARGS__; if ((i) + 1 < ph_hi) gsync(wv, bar, ++bk); }
  PH(0, {
    conv_w(wv, p.in[zq + 19], Wt_in0, 1024, 2560, 2560);
    conv_w(wv, p.in[zq + 20], Wt_out0, 1024, 1024, 1024);
    mod_phase(wv, p, zq, modv);
    filt_phase(wv, p, zq, F256, F2048);
  })
  PH(1, (row_phase<true, false, true>(wv, p, zq, nullptr, nullptr, mod0, 0, nullptr, p.in[zq + 11], mod0, 0, A)))
  PH(2, (gemm_phase<0, 2560>(wv, A, Wt_in0, 2560, 1024, Pb, nullptr)))
  PH(3, post_inproj0(wv, p, zq, Pb, QA, KA, VA, VV, X0))
  PH(4, mix0_phase(wv, p, zq, QA, KA, VA, VV, X0, F256, F2048, A))
  PH(5, { gemm_phase<0, 1024>(wv, A, Wt_out0, 1024, 1024, R, nullptr);
    conv_w(wv, p.in[zq + 15], Wt_up0, 1024, 5632, 5632, gridDim.x > 192 ? 192 : 0); })
  PH(6, (row_phase<true, true, true>(wv, p, zq, R, p.in[zq + 12], mod0, 2, X, p.in[zq + 13], mod0, 3, A)))
  PH(7, { gemm_phase<0, 5632>(wv, A, Wt_up0, 5632, 1024, Pb, nullptr);
    const int ib = (int)(1056u % gridDim.x);
    conv_w(wv, p.in[zq + 18], Wt_dn0, 2816, 1024, 1024, ib);
    conv_w(wv, p.in[zq + 33], Wt_in1, 1024, 4128, 4352, ib); })
  PH(8, ffn_act_phase(wv, Pb, p.in[zq + 16], p.in[zq + 17], Gb))
  PH(9, (gemm_phase<0, 1024>(wv, Gb, Wt_dn0, 1024, 2816, R, nullptr)))
  PH(10, (row_phase<false, true, true>(wv, p, zq, R, p.in[zq + 14], mod0, 5, X, p.in[zq + 11] + 1024, mod1, 0, A)))
  PH(11, { gemm_phase<0, 4096>(wv, A, Wt_in1, 4096, 1024, Pb, nullptr); gates_phase(wv, A, Wt_in1 + (long)4096 * 1024, GT); })
  PH(12, {
    mlstm_phase(wv, p, zq, Pb, GT, HF, HB, DCb, DNb, SCb, 0);
    conv_w(wv, p.in[zq + 15] + (long)1024 * 5632, Wt_up1, 1024, 5632, 5632);
    conv_w(wv, p.in[zq + 18] + (long)2816 * 1024, Wt_dn1, 2816, 1024, 1024);
    conv_w(wv, p.in[zq + 38], Wt_out1, 1024, 1024, 1024);
  })
  PH(13, mlstm_scan(wv, p, zq, DCb, DNb, SCb))
  PH(21, mlstm_phase(wv, p, zq, Pb, GT, HF, HB, DCb, DNb, SCb, 1))
  PH(14, mlstm_post(wv, p, zq, HF, HB, Pb, A2))
  PH(15, (gemm_phase<0, 1024>(wv, A2, Wt_out1, 1024, 1024, R, nullptr)))
  PH(16, (row_phase<false, true, true>(wv, p, zq, R, p.in[zq + 12] + 1024, mod1, 2, X, p.in[zq + 13] + 1024, mod1, 3, A)))
  PH(17, (gemm_phase<0, 5632>(wv, A, Wt_up1, 5632, 1024, Pb, nullptr)))
  PH(18, ffn_act_phase(wv, Pb, p.in[zq + 16] + 3 * 5632, p.in[zq + 17] + 5632, Gb))
  PH(19, (gemm_phase<0, 1024>(wv, Gb, Wt_dn1, 1024, 2816, R, nullptr)))
  PH(39, (row_phase<false, true, false>(wv, p, zq, R, p.in[zq + 14] + 1024, mod1, 5, X, nullptr, mod1, 0, nullptr)))
#undef PH
}

extern "C" void kernel_launch(void* const* d_in, const int* in_sizes, int n_in, void* d_out, int out_size, void* d_ws, size_t ws_size,
                              hipStream_t stream) {
  static int grid_blocks = 0;
  if (!grid_blocks) {
    if (ws_size < WS_END + 4096) fprintf(stderr, "kernel_launch: workspace too small: %zu < %zu\n", ws_size, (size_t)WS_END);
    hipFuncSetAttribute((const void*)mega, hipFuncAttributeMaxDynamicSharedMemorySize, LDS_BYTES);
    int dev = 0, cus = 0, per = 0;
    hipGetDevice(&dev);
    hipDeviceGetAttribute(&cus, hipDeviceAttributeMultiprocessorCount, dev);
    hipOccupancyMaxActiveBlocksPerMultiprocessor(&per, mega, 512, LDS_BYTES);
    if (per < 1) { fprintf(stderr, "kernel_launch: occupancy query returned %d\n", per); per = 1; }
    grid_blocks = cus;
  }
  Params p{};
  for (int i = 0; i < 39; ++i) p.in[i] = (const float*)d_in[i];
  p.out = (float*)d_out; p.ws = (char*)d_ws;
  int lo = 0, hi = NPH;
  (void)hipMemsetAsync((char*)d_ws + WS_END, 0, 4096, stream);
  void* args[] = {&p, &lo, &hi};
  hipError_t e = hipLaunchCooperativeKernel((void*)mega, dim3(grid_blocks), dim3(512), args, LDS_BYTES, stream);
  if (e != hipSuccess) fprintf(stderr, "cooperative launch failed: %s (grid %d)\n", hipGetErrorString(e), grid_blocks);
}
```

```cpp
#include <hip/hip_runtime.h>
#include <hip/hip_cooperative_groups.h>
#include <cstdio>
#include <cstdint>
namespace cg = cooperative_groups;

typedef unsigned short bf16_t;
typedef short bf16x8 __attribute__((ext_vector_type(8)));
typedef short s16x4 __attribute__((ext_vector_type(4)));
typedef float f32x4 __attribute__((ext_vector_type(4)));
typedef float f32x8 __attribute__((ext_vector_type(8)));
typedef float f32x16 __attribute__((ext_vector_type(16)));
typedef unsigned u32x4 __attribute__((ext_vector_type(4)));
typedef unsigned u32x2 __attribute__((ext_vector_type(2)));

constexpr int T_TOK = 12288, TPR = 8192;
constexpr int LDS_BYTES = 131072;
constexpr int NPH = 40;

constexpr size_t OFF_WIN0 = 0, OFF_WOUT0 = 5242880, OFF_WUP0 = 7340032, OFF_WUP1 = 18874368, OFF_WDN0 = 30408704,
                 OFF_WDN1 = 36175872, OFF_WIN1 = 41943040, OFF_WOUT1 = 50855936, OFF_MOD = 52953088, OFF_P = 53100544,
                 OFF_G = 191512576, WS_END = 260718592;
constexpr size_t P_QA = 62914560, P_KA = 75497472, P_VA = 82313216, P_X0 = 89128960;
constexpr size_t P_GT = 100663296, P_A2 = 102236160;
constexpr size_t G_VV = 25165824, G_HB = 25165824;
constexpr size_t O_K = 12582912, O_V = 14680064, O_C = 16777216, O_N = 25165824, O_M = 25231360;

struct Params { const float* in[39]; float* out; char* ws; };

typedef __bf16 nbf16x2 __attribute__((ext_vector_type(2)));
typedef float nf32x2 __attribute__((ext_vector_type(2)));
__device__ __forceinline__ unsigned cvtpk(float lo, float hi) {
  nf32x2 v = {lo, hi};
  nbf16x2 b = __builtin_convertvector(v, nbf16x2);
  return __builtin_bit_cast(unsigned, b);
}
__device__ __forceinline__ bf16_t f2bf(float f) { return (bf16_t)(cvtpk(f, 0.f) & 0xffffu); }
__device__ __forceinline__ float bf2f(bf16_t h) { return __uint_as_float(((unsigned)h) << 16); }
__device__ __forceinline__ float bflo(unsigned w) { return __uint_as_float(w << 16); }
__device__ __forceinline__ float bfhi(unsigned w) { return __uint_as_float(w & 0xffff0000u); }
__device__ __forceinline__ float wave_sum(float v) {
#pragma unroll
  for (int o = 32; o > 0; o >>= 1) v += __shfl_xor(v, o);
  return v;
}
__device__ __forceinline__ int llane() { int l; asm volatile("v_mbcnt_lo_u32_b32 %0, -1, 0\n\tv_mbcnt_hi_u32_b32 %0, -1, %0" : "=v"(l)); return l; }
__device__ __forceinline__ int ltid(int wv) { return (wv << 6) | llane(); }
__device__ __forceinline__ int opq() { int z; asm volatile("s_mov_b32 %0, 0" : "=s"(z)); return z; }
__device__ __forceinline__ float silu_f(float x) { return x * __builtin_amdgcn_rcpf(1.f + __expf(-x)); }
__device__ __forceinline__ int crow(int r, int hi) { return (r & 3) + 8 * (r >> 2) + 4 * hi; }
__device__ __forceinline__ void unpack8(u32x4 w, float* f) {
  f[0] = bflo(w[0]); f[1] = bfhi(w[0]); f[2] = bflo(w[1]); f[3] = bfhi(w[1]);
  f[4] = bflo(w[2]); f[5] = bfhi(w[2]); f[6] = bflo(w[3]); f[7] = bfhi(w[3]);
}
__device__ __forceinline__ u32x4 pack8(const float* f) {
  u32x4 w = {cvtpk(f[0], f[1]), cvtpk(f[2], f[3]), cvtpk(f[4], f[5]), cvtpk(f[6], f[7])}; return w;
}

__device__ __forceinline__ void conv_w(const int wv, const float* __restrict__ W, bf16_t* __restrict__ Wt, int K, int N, int NP, int b0 = 0) {
  const int tidx = ltid(wv);
  extern __shared__ __attribute__((aligned(16))) char shm_raw[];
  float* tl = (float*)shm_raw;
  const int tid = tidx;
  const int ntn = NP / 64, ntiles = (K / 64) * ntn;
  if ((int)blockIdx.x < b0) return;
  for (int tile = (int)blockIdx.x - b0; tile < ntiles; tile += (int)gridDim.x - b0) {
    const int k0 = (tile / ntn) * 64, n0 = (tile % ntn) * 64;
    __syncthreads();
#pragma unroll
    for (int i = 0; i < 2; ++i) {
      int kr = (tid >> 4) + 32 * i, nc = (tid & 15) * 4;
      float4 v = make_float4(0.f, 0.f, 0.f, 0.f);
      if (n0 + nc < N) v = *(const float4*)(W + (long)(k0 + kr) * N + n0 + nc);
      float* d = tl + kr * 65 + nc; d[0] = v.x; d[1] = v.y; d[2] = v.z; d[3] = v.w;
    }
    __syncthreads();
    {
      int n = tid >> 3, kg = (tid & 7) * 8;
      u32x4 w;
      w[0] = cvtpk(tl[(kg + 0) * 65 + n], tl[(kg + 1) * 65 + n]);
      w[1] = cvtpk(tl[(kg + 2) * 65 + n], tl[(kg + 3) * 65 + n]);
      w[2] = cvtpk(tl[(kg + 4) * 65 + n], tl[(kg + 5) * 65 + n]);
      w[3] = cvtpk(tl[(kg + 6) * 65 + n], tl[(kg + 7) * 65 + n]);
      *(u32x4*)(Wt + (long)(n0 + n) * K + k0 + kg) = w;
    }
  }
  __syncthreads();
}

__device__ __forceinline__ void mod_phase(const int wv, const Params& p, const int zq, float* modv) {
  const int tidx = ltid(wv);
  extern __shared__ __attribute__((aligned(16))) char shm_raw[];
  float* red = (float*)shm_raw;
  const int tid = tidx;
  const float* cvec = p.in[zq + 7]; const float* cctx = p.in[zq + 8]; const float* bmod = p.in[zq + 10];
  for (int item = blockIdx.x; item < 192; item += gridDim.x) {
    const int l = item / 96, cb = (item % 96) * 64;
    const float* W = p.in[zq + 9] + (long)l * 1024 * 6144;
    const int cl = tid & 15, kg = tid >> 4;
    float a0[4] = {0, 0, 0, 0}, a1[4] = {0, 0, 0, 0}, a2[4] = {0, 0, 0, 0};
#pragma unroll 8
    for (int i = 0; i < 32; ++i) {
      int k = kg + 32 * i;
      float4 w = *(const float4*)(W + (long)k * 6144 + cb + cl * 4);
      float s0 = silu_f(cctx[k]), s1 = silu_f(cvec[k]), s2 = silu_f(cvec[1024 + k]);
      a0[0] += s0 * w.x; a0[1] += s0 * w.y; a0[2] += s0 * w.z; a0[3] += s0 * w.w;
      a1[0] += s1 * w.x; a1[1] += s1 * w.y; a1[2] += s1 * w.z; a1[3] += s1 * w.w;
      a2[0] += s2 * w.x; a2[1] += s2 * w.y; a2[2] += s2 * w.z; a2[3] += s2 * w.w;
    }
    __syncthreads();
#pragma unroll
    for (int j = 0; j < 4; ++j) {
      red[kg * 192 + 0 * 64 + cl * 4 + j] = a0[j];
      red[kg * 192 + 1 * 64 + cl * 4 + j] = a1[j];
      red[kg * 192 + 2 * 64 + cl * 4 + j] = a2[j];
    }
    __syncthreads();
    if (tid < 192) {
      float s = 0.f;
#pragma unroll 8
      for (int q = 0; q < 32; ++q) s += red[q * 192 + tid];
      int g = tid / 64, col = cb + (tid % 64);
      modv[(l * 3 + g) * 6144 + col] = s + bmod[l * 6144 + col];
    }
  }
  __syncthreads();
}

__device__ __forceinline__ void filt_phase(const int wv, const Params& p, const int zq, float* F256, float* F2048) {
  const int tidx = ltid(wv);
  extern __shared__ __attribute__((aligned(16))) char shm_raw[];
  float* z = (float*)shm_raw;
  float* h1 = z + 256;
  float* h2 = h1 + 512;
  const int tid = tidx;
  const float *w1 = p.in[zq + 25], *b1 = p.in[zq + 26], *w2 = p.in[zq + 27], *b2 = p.in[zq + 28], *w3 = p.in[zq + 29], *b3 = p.in[zq + 30], *sf = p.in[zq + 31], *skip = p.in[zq + 32];
  const float DMAX = -15.350567286626973f, DMIN = -3.0701134573253946f;
  for (int item = blockIdx.x; item < 288; item += gridDim.x) {
    const int L = item < 32 ? 256 : 2048; const int i0 = item < 32 ? item * 8 : (item - 32) * 8;
    float* F = item < 32 ? F256 : F2048;
    __syncthreads();
    if (tid < 136) {
      const int q = tid / 17, f = tid % 17;
      const float t = (float)(i0 + q) / (float)(L - 1);
      float v;
      if (f == 0) v = t;
      else if (f <= 8) v = cosf(6.283185307179586f * t * (float)f);
      else v = sinf(6.283185307179586f * t * (float)(f - 8));
      z[q * 32 + f] = v;
    }
    __syncthreads();
    { const int q = tid >> 6, u = tid & 63; float a = b1[u];
#pragma unroll 1
      for (int jj = 0; jj < 17; ++jj) a += z[q * 32 + jj] * w1[jj * 64 + u];
      h1[q * 64 + u] = sinf(sf[u] * a); }
    __syncthreads();
    { const int q = tid >> 6, u = tid & 63; float a = b2[u];
#pragma unroll 8
      for (int jj = 0; jj < 64; ++jj) a += h1[q * 64 + jj] * w2[jj * 64 + u];
      h2[q * 64 + u] = sinf(sf[64 + u] * a); }
    __syncthreads();
    {
      const int ch = tid;
      float af[8], ab[8];
#pragma unroll
      for (int q = 0; q < 8; ++q) { af[q] = b3[ch]; ab[q] = b3[512 + ch]; }
#pragma unroll 4
      for (int jj = 0; jj < 64; ++jj) {
        const float wa = w3[jj * 1024 + ch], wb = w3[jj * 1024 + 512 + ch];
#pragma unroll
        for (int q = 0; q < 8; ++q) { const float hh = h2[q * 64 + jj]; af[q] += hh * wa; ab[q] += hh * wb; }
      }
      const float delta = fabsf(DMIN + (DMAX - DMIN) * ((float)ch / 511.f));
#pragma unroll
      for (int q = 0; q < 8; ++q) {
        const int i = i0 + q;
        const float t = (float)i / (float)(L - 1);
        const float win = expf(-t * delta);
        const float sfw = af[q] * win, sbw = ab[q] * win;
        if (i == 0) F[(long)(L - 1) * 512 + ch] = sfw + sbw + skip[ch];
        else { F[(long)(L - 1 + i) * 512 + ch] = sfw; F[(long)(L - 1 - i) * 512 + ch] = sbw; }
      }
    }
  }
  __syncthreads();
}

template <bool FROM_IN, bool HAS_R, bool HAS_A>
__device__ __forceinline__ void row_phase(const int wv, const Params& p, const int zq, const bf16_t* __restrict__ R, const float* __restrict__ postg,
                                          const float* __restrict__ modg, int gate_m, float* X,
                                          const float* __restrict__ preg, const float* __restrict__ mods, int shift_m, bf16_t* __restrict__ A) {
  const int tidx = ltid(wv);
  const int wid = wv, lane = tidx & 63;
  for (int row = blockIdx.x * 8 + wid; row < T_TOK; row += gridDim.x * 8) {
    const int g = row < TPR ? 0 : 1 + (row - TPR) / 2048;
    const float* mg = modg + g * 6144;
    const float* ms = mods + g * 6144;
    const float* xin = FROM_IN ? (row < TPR ? p.in[zq + 0] + (long)row * 1024 : p.in[zq + 1] + (long)(row - TPR) * 1024) : (const float*)X + (long)row * 1024;
    float4 x[4];
#pragma unroll
    for (int j = 0; j < 4; ++j) x[j] = *(const float4*)(xin + j * 256 + lane * 4);
    if (HAS_R) {
      float4 r[4]; float ss = 0.f;
#pragma unroll
      for (int j = 0; j < 4; ++j) { const u32x2 rw = *(const u32x2*)(R + (long)row * 1024 + j * 256 + lane * 4); r[j] = make_float4(bflo(rw[0]), bfhi(rw[0]), bflo(rw[1]), bfhi(rw[1])); ss += r[j].x * r[j].x + r[j].y * r[j].y + r[j].z * r[j].z + r[j].w * r[j].w; }
      ss = wave_sum(ss); const float rs = rsqrtf(ss * (1.f / 1024.f) + 1e-6f);
#pragma unroll
      for (int j = 0; j < 4; ++j) {
        float4 pg = *(const float4*)(postg + j * 256 + lane * 4);
        float4 gt = *(const float4*)(mg + gate_m * 1024 + j * 256 + lane * 4);
        x[j].x += gt.x * (r[j].x * rs * pg.x); x[j].y += gt.y * (r[j].y * rs * pg.y);
        x[j].z += gt.z * (r[j].z * rs * pg.z); x[j].w += gt.w * (r[j].w * rs * pg.w);
        *(float4*)(X + (long)row * 1024 + j * 256 + lane * 4) = x[j];
      }
    }
    if (HAS_A) {
      float ss = 0.f;
#pragma unroll
      for (int j = 0; j < 4; ++j) ss += x[j].x * x[j].x + x[j].y * x[j].y + x[j].z * x[j].z + x[j].w * x[j].w;
      ss = wave_sum(ss); const float rs = rsqrtf(ss * (1.f / 1024.f) + 1e-6f);
#pragma unroll
      for (int j = 0; j < 4; ++j) {
        float4 pg = *(const float4*)(preg + j * 256 + lane * 4);
        float4 sh = *(const float4*)(ms + shift_m * 1024 + j * 256 + lane * 4);
        float4 sc = *(const float4*)(ms + (shift_m + 1) * 1024 + j * 256 + lane * 4);
        float y0 = x[j].x * rs * pg.x * (1.f + sc.x) + sh.x, y1 = x[j].y * rs * pg.y * (1.f + sc.y) + sh.y;
        float y2 = x[j].z * rs * pg.z * (1.f + sc.z) + sh.z, y3 = x[j].w * rs * pg.w * (1.f + sc.w) + sh.w;
        u32x2 w = {cvtpk(y0, y1), cvtpk(y2, y3)};
        *(u32x2*)(A + (long)row * 1024 + j * 256 + lane * 4) = w;
      }
    }
  }
}

constexpr int BM = 256, BK = 64, HALF = 128, WGM = 8, HT = HALF * BK;
__device__ __forceinline__ int lds_byte(int r, int c) {
  int st = (r >> 4) * 2 + (c >> 5), rr = r & 15, cc = c & 31, ob = rr * 64 + cc * 2;
  return st * 1024 + (ob ^ (((ob >> 9) & 1) << 5));
}
__device__ __forceinline__ void stage_rc(int b, int& R, int& C) {
  int st = b / 1024, sb = b % 1024, swz = sb ^ (((sb >> 9) & 1) << 5);
  R = (st >> 1) * 16 + swz / 64; C = (st & 1) * 32 + (swz % 64) / 2;
}

template <int MODE, int LDC>
__device__ __forceinline__ void gemm_phase(const int wv, const bf16_t* __restrict__ A, const bf16_t* __restrict__ Bt, int N, int K,
                                           void* Cout, float* GT) {
  const int tidx = ltid(wv);
  extern __shared__ __attribute__((aligned(16))) char shm_raw[];
  bf16_t* shm = (bf16_t*)shm_raw;
#define SA(b, h) (shm + ((b) * 2 + (h)) * HT)
#define SB(b, h) (shm + (4 + (b) * 2 + (h)) * HT)
#define STAGE(P, BASE, br, kt) do { const bf16_t* _gb = (BASE) + ((long)(br) * K + (long)(kt) * BK); \
    __builtin_amdgcn_global_load_lds((const unsigned*)(_gb + soff0), (unsigned*)((char*)(P) + sl0), 16, 0, 0); \
    __builtin_amdgcn_global_load_lds((const unsigned*)(_gb + soff1), (unsigned*)((char*)(P) + sl0 + 8192), 16, 0, 0); } while (0)
#define LDA(dst, b, h) _Pragma("unroll") for (int m = 0; m < 4; ++m) _Pragma("unroll") for (int k = 0; k < 2; ++k) \
    dst[m][k] = *reinterpret_cast<const bf16x8*>((char*)SA(b, h) + lds_byte(wr * 64 + m * 16 + fr, k * 32 + fq * 8))
#define LDB(dst, b, h) _Pragma("unroll") for (int n = 0; n < 2; ++n) _Pragma("unroll") for (int k = 0; k < 2; ++k) \
    dst[n][k] = *reinterpret_cast<const bf16x8*>((char*)SB(b, h) + lds_byte(wc * 32 + n * 16 + fr, k * 32 + fq * 8))
#define MMA(ai, bj, At, Bt_) do { __builtin_amdgcn_s_setprio(1); \
    _Pragma("unroll") for (int m = 0; m < 4; ++m) _Pragma("unroll") for (int n = 0; n < 2; ++n) _Pragma("unroll") for (int k = 0; k < 2; ++k) \
      acc[ai][bj][m][n] = __builtin_amdgcn_mfma_f32_16x16x32_bf16(At[m][k], Bt_[n][k], acc[ai][bj][m][n], 0, 0, 0); \
    __builtin_amdgcn_s_setprio(0); } while (0)
#define WAIT_V(n) asm volatile("s_waitcnt vmcnt(" #n ")" ::: "memory")
#define WAIT_L(n) asm volatile("s_waitcnt lgkmcnt(" #n ")" ::: "memory")
#define BAR __builtin_amdgcn_s_barrier()
#define SCHED __builtin_amdgcn_sched_barrier(0)
  const int nM = T_TOK / BM, nN = N / BM, nwg = nM * nN;
  const int wid = wv, lane = tidx & 63, wr = wid >> 2, wc = wid & 3, fr = lane & 15, fq = lane >> 4;
  const int nt = K / BK;
  unsigned soff0, soff1; const int sl0 = tidx * 16;
  { int _r, _c; stage_rc(sl0, _r, _c); soff0 = (unsigned)(_r * K + _c); stage_rc(sl0 + 8192, _r, _c); soff1 = (unsigned)(_r * K + _c); }
  for (int tile = blockIdx.x; tile < nwg; tile += gridDim.x) {
    int wgt = tile;
    { const int q = nwg / 8, r = nwg % 8, xcd = wgt % 8, off = wgt / 8;
      wgt = (xcd < r ? xcd * (q + 1) : r * (q + 1) + (xcd - r) * q) + off; }
    const int nig = WGM * nN, gid = wgt / nig, fm = gid * WGM, gsz = min(nM - fm, WGM);
    const int pm = fm + ((wgt % nig) % gsz), pn = (wgt % nig) / gsz, brow = pm * BM, bcol = pn * BM;
    f32x4 acc[2][2][4][2] = {};
    bf16x8 At[4][2], B0[2][2], B1[2][2];
    STAGE(SB(0, 0), Bt, bcol, 0); STAGE(SA(0, 0), A, brow, 0);
    STAGE(SB(0, 1), Bt, bcol + HALF, 0); STAGE(SA(0, 1), A, brow + HALF, 0);
    if (wr == 1) BAR;
    WAIT_V(4); BAR;
    STAGE(SB(1, 0), Bt, bcol, 1); STAGE(SA(1, 0), A, brow, 1); STAGE(SB(1, 1), Bt, bcol + HALF, 1);
    WAIT_V(6); BAR;
    for (int t = 0; t < nt - 2; t += 2) {
      LDB(B0, 0, 0); SCHED; LDA(At, 0, 0); STAGE(SA(1, 1), A, brow + HALF, t + 1);
      WAIT_L(8); BAR; WAIT_L(0); MMA(0, 0, At, B0); BAR; SCHED;
      LDB(B1, 0, 1); STAGE(SB(0, 0), Bt, bcol, t + 2);
      BAR; WAIT_L(0); MMA(0, 1, At, B1); BAR;
      LDA(At, 0, 1); STAGE(SA(0, 0), A, brow, t + 2);
      BAR; WAIT_L(0); MMA(1, 0, At, B0); BAR; SCHED;
      STAGE(SB(0, 1), Bt, bcol + HALF, t + 2);
      WAIT_V(6); BAR; MMA(1, 1, At, B1); BAR;
      LDB(B0, 1, 0); SCHED; LDA(At, 1, 0); STAGE(SA(0, 1), A, brow + HALF, t + 2);
      WAIT_L(8); BAR; WAIT_L(0); MMA(0, 0, At, B0); BAR; SCHED;
      LDB(B1, 1, 1); STAGE(SB(1, 0), Bt, bcol, t + 3);
      BAR; WAIT_L(0); MMA(0, 1, At, B1); BAR;
      LDA(At, 1, 1); STAGE(SA(1, 0), A, brow, t + 3);
      BAR; WAIT_L(0); MMA(1, 0, At, B0); BAR; SCHED;
      STAGE(SB(1, 1), Bt, bcol + HALF, t + 3);
      WAIT_V(6); BAR; MMA(1, 1, At, B1); BAR;
    }
    { LDB(B0, 0, 0); LDA(At, 0, 0); STAGE(SA(1, 1), A, brow + HALF, nt - 1);
      BAR; WAIT_L(0); MMA(0, 0, At, B0); BAR;
      LDB(B1, 0, 1); BAR; WAIT_L(0); MMA(0, 1, At, B1); BAR;
      LDA(At, 0, 1); WAIT_V(4); BAR; WAIT_L(0); MMA(1, 0, At, B0); MMA(1, 1, At, B1); BAR; }
    { LDB(B0, 1, 0); LDA(At, 1, 0); WAIT_V(2); BAR; WAIT_L(0); MMA(0, 0, At, B0); BAR;
      LDB(B1, 1, 1); WAIT_V(0); BAR; WAIT_L(0); MMA(0, 1, At, B1); BAR;
      LDA(At, 1, 1); BAR; WAIT_L(0); MMA(1, 0, At, B0); MMA(1, 1, At, B1); BAR; }
    if (wr == 0) BAR;
    {
      const int le = llane();
      const int fr = le & 15, fq = le >> 4;
      const long base = (long)(brow + wr * 64) * LDC + bcol + wc * 32 + (unsigned)(fq * 4 * LDC + fr);
      if (MODE == 0 || (MODE == 2 && pn < 16)) {
        bf16_t* cp = (bf16_t*)Cout + base;
#pragma unroll
        for (int ai = 0; ai < 2; ++ai)
#pragma unroll
          for (int m = 0; m < 4; ++m)
#pragma unroll
            for (int j = 0; j < 4; ++j) {
              bf16_t* rp = cp + (ai * HALF + m * 16 + j) * LDC;
#pragma unroll
              for (int bj = 0; bj < 2; ++bj)
#pragma unroll
                for (int n = 0; n < 2; ++n) rp[bj * HALF + n * 16] = f2bf(acc[ai][bj][m][n][j]);
            }
      } else if (MODE == 1) {
        float* cp = (float*)Cout + base;
#pragma unroll
        for (int ai = 0; ai < 2; ++ai)
#pragma unroll
          for (int m = 0; m < 4; ++m)
#pragma unroll
            for (int j = 0; j < 4; ++j) {
              float* rp = cp + (ai * HALF + m * 16 + j) * LDC;
#pragma unroll
              for (int bj = 0; bj < 2; ++bj)
#pragma unroll
                for (int n = 0; n < 2; ++n) rp[bj * HALF + n * 16] = acc[ai][bj][m][n][j];
            }
      } else {
        if (wc == 0) {
          float* gp = GT + (long)(brow + wr * 64) * 32 + (unsigned)(fq * 4 * 32 + fr);
#pragma unroll
          for (int ai = 0; ai < 2; ++ai)
#pragma unroll
            for (int m = 0; m < 4; ++m)
#pragma unroll
              for (int j = 0; j < 4; ++j)
#pragma unroll
                for (int n = 0; n < 2; ++n) gp[(ai * HALF + m * 16 + j) * 32 + n * 16] = acc[ai][0][m][n][j];
        }
      }
    }
    __syncthreads();
  }
#undef SA
#undef SB
#undef STAGE
#undef LDA
#undef LDB
#undef MMA
}

__device__ __forceinline__ void gates_phase(const int wv, const bf16_t* __restrict__ A, const bf16_t* __restrict__ Wg, float* __restrict__ GT) {
  const int lane = llane();
  const int fr = lane & 15, fq = lane >> 4;
  for (int mt = wv * (int)gridDim.x + (int)blockIdx.x; mt < T_TOK / 16; mt += 8 * (int)gridDim.x) {
    const bf16_t* ap = A + (long)(mt * 16 + fr) * 1024 + fq * 8;
    const bf16_t* b0p = Wg + (long)fr * 1024 + fq * 8;
    const bf16_t* b1p = Wg + (long)(16 + fr) * 1024 + fq * 8;
    f32x4 acc0 = {0.f, 0.f, 0.f, 0.f}, acc1 = {0.f, 0.f, 0.f, 0.f};
#pragma unroll 8
    for (int k0 = 0; k0 < 1024; k0 += 32) {
      const bf16x8 a = *reinterpret_cast<const bf16x8*>(ap + k0);
      const bf16x8 b0 = *reinterpret_cast<const bf16x8*>(b0p + k0);
      const bf16x8 b1 = *reinterpret_cast<const bf16x8*>(b1p + k0);
      acc0 = __builtin_amdgcn_mfma_f32_16x16x32_bf16(a, b0, acc0, 0, 0, 0);
      acc1 = __builtin_amdgcn_mfma_f32_16x16x32_bf16(a, b1, acc1, 0, 0, 0);
    }
#pragma unroll
    for (int j = 0; j < 4; ++j) {
      GT[(long)(mt * 16 + fq * 4 + j) * 32 + fr] = acc0[j];
      GT[(long)(mt * 16 + fq * 4 + j) * 32 + 16 + fr] = acc1[j];
    }
  }
}

__device__ __forceinline__ void post_inproj0(const int wv, const Params& p, const int zq, const bf16_t* __restrict__ P0, bf16_t* __restrict__ QA, bf16_t* __restrict__ KA,
                                             bf16_t* __restrict__ VA, float* __restrict__ VV, bf16_t* __restrict__ X0) {
  const int tidx = ltid(wv);
  const int wid = wv, lane = tidx & 63;
  const float* qn = p.in[zq + 21]; const float* kn = p.in[zq + 22]; const float* cw = p.in[zq + 23]; const float* cb = p.in[zq + 24];
  float* outK = p.out + O_K; float* outV = p.out + O_V;
  for (int i = blockIdx.x * 512 + tidx; i < 2 * 512 * 256 / 4; i += gridDim.x * 512) {
    int e = i * 4; int b = e / (512 * 256), rem = e % (512 * 256);
    float4 kk = *(const float4*)(p.in[zq + 2] + e); float4 vv = *(const float4*)(p.in[zq + 3] + e);
    long d = (long)(8192 + b * 2560 + 2048) * 256 + rem;
    u32x2 wk = {cvtpk(kk.x, kk.y), cvtpk(kk.z, kk.w)}; u32x2 wv = {cvtpk(vv.x, vv.y), cvtpk(vv.z, vv.w)};
    *(u32x2*)(KA + d) = wk; *(u32x2*)(VA + d) = wv;
  }
  const int fi = lane & 31;
  const float inv = exp2f(-(float)fi * (13.287712379549449f / 32.f));
  for (int row = blockIdx.x * 8 + wid; row < T_TOK; row += gridDim.x * 8) {
    const bool samp = row >= TPR;
    const int L = samp ? 2048 : 256;
    const int tl = samp ? (row - TPR) % 2048 : row % 256;
    const long krow = samp ? (long)(8192 + ((row - TPR) / 2048) * 2560 + tl) : (long)row;
    const bf16_t* base = P0 + (long)row * 2560;
    float cs = 1.f, sn = 0.f;
    if (samp) { float pos = (lane < 32) ? (float)(tl / 64) : (float)(tl % 64); float ang = pos * inv; cs = cosf(ang); sn = sinf(ang); }
#pragma unroll
    for (int hh = 0; hh < 6; ++hh) {
      float x1 = bf2f(base[hh * 128 + lane]), x2 = bf2f(base[hh * 128 + 64 + lane]);
      float ss = wave_sum(x1 * x1 + x2 * x2);
      float rs = rsqrtf(ss * (1.f / 128.f) + 1e-6f);
      const float* gw = hh < 4 ? qn : kn;
      float y1 = x1 * rs * gw[lane], y2 = x2 * rs * gw[64 + lane];
      if (hh >= 4 && !samp) { outK[(long)row * 256 + (hh - 4) * 128 + lane] = y1; outK[(long)row * 256 + (hh - 4) * 128 + 64 + lane] = y2; }
      float o1 = y1 * cs - y2 * sn, o2 = y1 * sn + y2 * cs;
      if (hh < 4) { QA[(long)row * 512 + hh * 128 + lane] = f2bf(o1); QA[(long)row * 512 + hh * 128 + 64 + lane] = f2bf(o2); }
      else { KA[krow * 256 + (hh - 4) * 128 + lane] = f2bf(o1); KA[krow * 256 + (hh - 4) * 128 + 64 + lane] = f2bf(o2); }
    }
    {
      u32x2 w = *(const u32x2*)(base + 768 + lane * 4);
      *(u32x2*)(VA + krow * 256 + lane * 4) = w;
      if (!samp) { float4 f = make_float4(bflo(w[0]), bfhi(w[0]), bflo(w[1]), bfhi(w[1])); *(float4*)(outV + (long)row * 256 + lane * 4) = f; }
    }
    {
      const int c8 = lane * 8;
      float uc[3][8];
#pragma unroll
      for (int g = 0; g < 3; ++g) {
        const int col = g * 512 + c8;
        float um[8], u0[8], up[8];
        u32x4 z4 = {0u, 0u, 0u, 0u};
        u32x4 wm = (tl > 0) ? *(const u32x4*)(base - 2560 + 1024 + col) : z4;
        u32x4 w0 = *(const u32x4*)(base + 1024 + col);
        u32x4 wp = (tl < L - 1) ? *(const u32x4*)(base + 2560 + 1024 + col) : z4;
        unpack8(wm, um); unpack8(w0, u0); unpack8(wp, up);
#pragma unroll
        for (int e = 0; e < 8; ++e)
          uc[g][e] = cw[col + e] * um[e] + cw[1536 + col + e] * u0[e] + cw[3072 + col + e] * up[e] + cb[col + e];
      }
      float vvv[8];
#pragma unroll
      for (int e = 0; e < 8; ++e) vvv[e] = uc[2][e] * uc[1][e];
      *(float4*)(VV + (long)row * 512 + c8) = make_float4(vvv[0], vvv[1], vvv[2], vvv[3]);
      *(float4*)(VV + (long)row * 512 + c8 + 4) = make_float4(vvv[4], vvv[5], vvv[6], vvv[7]);
      *(u32x4*)(X0 + (long)row * 512 + c8) = pack8(uc[0]);
    }
  }
}

constexpr int AD = 128, ANW = 8, QBLK = 32, KVBLK = 64;
constexpr float ASCALE = 0.088388347648318440f;
constexpr float ATHR = 8.f;
constexpr int LDQ = 512, LDK = 256, LDO = 1024;
constexpr size_t SHM_V = KVBLK * AD * 2, SHM_K = KVBLK * AD * 2;
#define KSWZ(row, colB) ((row) * 256 + ((colB) ^ (((row) & 7) << 4)))
#define SBAR() __builtin_amdgcn_sched_barrier(0)

__device__ __forceinline__ void partialSM(f32x16& p0, f32x16& p1, float& m_reg, float& mn, float& alpha) {
  constexpr float C = ASCALE * 1.4426950408889634f;
  float pmax = p0[0];
#pragma unroll
  for (int r = 1; r < 16; ++r) pmax = fmaxf(pmax, p0[r]);
#pragma unroll
  for (int r = 0; r < 16; ++r) pmax = fmaxf(pmax, p1[r]);
  { auto rr = __builtin_amdgcn_permlane32_swap(__float_as_uint(pmax), __float_as_uint(pmax), false, false);
    pmax = fmaxf(__uint_as_float(rr[0]), __uint_as_float(rr[1])); }
  if (__builtin_expect(__all(pmax - m_reg <= ATHR / ASCALE), 1)) { mn = m_reg; alpha = 1.f; }
  else { mn = fmaxf(m_reg, pmax); alpha = __builtin_amdgcn_exp2f((m_reg - mn) * C); m_reg = mn; }
  float mnC = -mn * C;
#pragma unroll
  for (int r = 0; r < 16; ++r) p0[r] = fmaf(p0[r], C, mnC);
#pragma unroll
  for (int r = 0; r < 16; ++r) p1[r] = fmaf(p1[r], C, mnC);
#pragma unroll
  for (int r = 0; r < 16; ++r) p0[r] = __builtin_amdgcn_exp2f(p0[r]);
}
__device__ __forceinline__ void finishSM(f32x16& p0, f32x16& p1, float alpha, float& l_reg, bf16x8& pa0, bf16x8& pa1, bf16x8& pa2, bf16x8& pa3) {
#pragma unroll
  for (int r = 0; r < 16; ++r) p1[r] = __builtin_amdgcn_exp2f(p1[r]);
  float ps = 0;
#pragma unroll
  for (int r = 0; r < 16; ++r) ps += p0[r];
#pragma unroll
  for (int r = 0; r < 16; ++r) ps += p1[r];
  { auto rr = __builtin_amdgcn_permlane32_swap(__float_as_uint(ps), __float_as_uint(ps), false, false);
    ps = __uint_as_float(rr[0]) + __uint_as_float(rr[1]); }
  l_reg = l_reg * alpha + ps;
#define PK4(P, BASE, OUT) do { unsigned a0 = cvtpk(P[BASE + 0], P[BASE + 1]), a1 = cvtpk(P[BASE + 2], P[BASE + 3]);   \
    unsigned b0 = cvtpk(P[BASE + 4], P[BASE + 5]), b1 = cvtpk(P[BASE + 6], P[BASE + 7]);                              \
    auto r0 = __builtin_amdgcn_permlane32_swap(a0, b0, false, false); auto r1 = __builtin_amdgcn_permlane32_swap(a1, b1, false, false); \
    u32x4 w = {r0[0], r1[0], r0[1], r1[1]}; OUT = *reinterpret_cast<bf16x8*>(&w); } while (0)
  PK4(p0, 0, pa0); PK4(p0, 8, pa1); PK4(p1, 0, pa2); PK4(p1, 8, pa3);
#undef PK4
}
__device__ __forceinline__ void qkt(f32x16& p0, f32x16& p1, const bf16_t* Ks, const bf16x8* qr, int r32, int hi) {
  p0 = f32x16{}; p1 = f32x16{};
#pragma unroll
  for (int d0 = 0; d0 < 8; ++d0) { int cb = (d0 * 16 + hi * 8) * 2;
    bf16x8 b0 = *reinterpret_cast<const bf16x8*>((const char*)Ks + KSWZ(r32, cb));
    bf16x8 b1 = *reinterpret_cast<const bf16x8*>((const char*)Ks + KSWZ(32 + r32, cb));
    p0 = __builtin_amdgcn_mfma_f32_32x32x16_bf16(b0, qr[d0], p0, 0, 0, 0);
    p1 = __builtin_amdgcn_mfma_f32_32x32x16_bf16(b1, qr[d0], p1, 0, 0, 0); }
}
__device__ __forceinline__ int v_st(int k, int c) { const int kk = (k & ~0xC) | ((k & 4) << 1) | ((k & 8) >> 1); return ((kk >> 3) * 4 + (c >> 5)) * 512 + ((kk & 7) * 32 + (c & 31)) * 2; }
__device__ __forceinline__ int v_rd_base(int lane) { return ((lane & 3) << 3) | (((lane >> 2) & 3) << 6) | (((lane >> 4) & 1) << 5) | (((lane >> 5) & 1) << 8); }
constexpr int v_rd_off(int d0, int ks, int half) { return d0 * 512 + ks * 4096 + half * 2048; }
template <int OFF> __device__ __forceinline__ s16x4 tr_read(int vb) {
  s16x4 r; asm volatile("ds_read_b64_tr_b16 %0, %1 offset:%2" : "=&v"(r) : "v"(vb), "i"(OFF) : "memory"); return r;
}
template <int D0> __device__ __forceinline__ void pv_one(f32x16& od, int vb, bf16x8 pa0, bf16x8 pa1, bf16x8 pa2, bf16x8 pa3) {
  const s16x4 l0 = tr_read<v_rd_off(D0, 0, 0)>(vb), h0 = tr_read<v_rd_off(D0, 0, 1)>(vb), l1 = tr_read<v_rd_off(D0, 1, 0)>(vb), h1 = tr_read<v_rd_off(D0, 1, 1)>(vb);
  const s16x4 l2 = tr_read<v_rd_off(D0, 2, 0)>(vb), h2 = tr_read<v_rd_off(D0, 2, 1)>(vb), l3 = tr_read<v_rd_off(D0, 3, 0)>(vb), h3 = tr_read<v_rd_off(D0, 3, 1)>(vb);
  asm volatile("s_waitcnt lgkmcnt(0)" ::: "memory"); SBAR();
#define PK(L, H) (bf16x8){L[0], L[1], L[2], L[3], H[0], H[1], H[2], H[3]}
  od = __builtin_amdgcn_mfma_f32_32x32x16_bf16(pa0, PK(l0, h0), od, 0, 0, 0);
  od = __builtin_amdgcn_mfma_f32_32x32x16_bf16(pa1, PK(l1, h1), od, 0, 0, 0);
  od = __builtin_amdgcn_mfma_f32_32x32x16_bf16(pa2, PK(l2, h2), od, 0, 0, 0);
  od = __builtin_amdgcn_mfma_f32_32x32x16_bf16(pa3, PK(l3, h3), od, 0, 0, 0);
#undef PK
}
__device__ __forceinline__ void pv_d0(f32x16* o, int vb, bf16x8 pa0, bf16x8 pa1, bf16x8 pa2, bf16x8 pa3) {
  pv_one<0>(o[0], vb, pa0, pa1, pa2, pa3); pv_one<1>(o[1], vb, pa0, pa1, pa2, pa3); pv_one<2>(o[2], vb, pa0, pa1, pa2, pa3); pv_one<3>(o[3], vb, pa0, pa1, pa2, pa3);
}

__device__ __forceinline__ void attn_dense_body(const int wv, const bf16_t* __restrict__ Qb, const bf16_t* __restrict__ Kh, const bf16_t* __restrict__ Vh,
                                                bf16_t* __restrict__ Ob, int seq, char* lds) {
  const int tidx = ltid(wv);
  const int tid = tidx, wid = wv, lane = tid & 63, r32 = lane & 31, hi = lane >> 5;
  bf16_t* V_lds = (bf16_t*)lds; bf16_t* K_lds = (bf16_t*)(lds + 2 * SHM_V);
  float* ws = (float*)(lds + 2 * SHM_V + 2 * SHM_K) + wid * 64; float* li_l = ws; float* al_l = ws + 32;
  float m_reg = -1e30f, l_reg = 0; f32x16 o[4] = {}; bf16x8 qr[8];
  const bf16_t* Qw = Qb + (long)(wid * QBLK + r32) * LDQ + hi * 8;
#pragma unroll
  for (int d0 = 0; d0 < 8; ++d0) qr[d0] = *reinterpret_cast<const bf16x8*>(Qw + d0 * 16);
  const int sr = tid >> 4, sc = (tid & 15) * 8, vst0 = v_st(sr, sc), vst1 = v_st(32 + sr, sc);
  const int vb0 = (int)(uintptr_t)V_lds + v_rd_base(lane);
  bf16x8 sA_vs0, sA_vs1, sA_ks0, sA_ks1, sB_vs0, sB_vs1, sB_ks0, sB_ks1;
#define SLOADA(k0) do { sA_vs0 = *(const bf16x8*)(&Vh[(long)((k0) + sr) * LDK + sc]); sA_vs1 = *(const bf16x8*)(&Vh[(long)((k0) + 32 + sr) * LDK + sc]); \
    sA_ks0 = *(const bf16x8*)(&Kh[(long)((k0) + sr) * LDK + sc]); sA_ks1 = *(const bf16x8*)(&Kh[(long)((k0) + 32 + sr) * LDK + sc]); } while (0)
#define SLOADB(k0) do { sB_vs0 = *(const bf16x8*)(&Vh[(long)((k0) + sr) * LDK + sc]); sB_vs1 = *(const bf16x8*)(&Vh[(long)((k0) + 32 + sr) * LDK + sc]); \
    sB_ks0 = *(const bf16x8*)(&Kh[(long)((k0) + sr) * LDK + sc]); sB_ks1 = *(const bf16x8*)(&Kh[(long)((k0) + 32 + sr) * LDK + sc]); } while (0)
#define SWRITEA(b) do { *(bf16x8*)((char*)V_lds + (b) * SHM_V + vst0) = sA_vs0; *(bf16x8*)((char*)V_lds + (b) * SHM_V + vst1) = sA_vs1; int kc = sc * 2; \
    *(bf16x8*)((char*)K_lds + (b) * SHM_K + KSWZ(sr, kc)) = sA_ks0; *(bf16x8*)((char*)K_lds + (b) * SHM_K + KSWZ(32 + sr, kc)) = sA_ks1; } while (0)
#define SWRITEB(b) do { *(bf16x8*)((char*)V_lds + (b) * SHM_V + vst0) = sB_vs0; *(bf16x8*)((char*)V_lds + (b) * SHM_V + vst1) = sB_vs1; int kc = sc * 2; \
    *(bf16x8*)((char*)K_lds + (b) * SHM_K + KSWZ(sr, kc)) = sB_ks0; *(bf16x8*)((char*)K_lds + (b) * SHM_K + KSWZ(32 + sr, kc)) = sB_ks1; } while (0)
#define SWAIT() asm volatile("s_waitcnt vmcnt(4)" ::: "memory")
#define RESC(a) do { if (__any((a) < 1.f)) { if (hi == 0) al_l[r32] = (a); asm volatile("s_waitcnt lgkmcnt(0)" ::: "memory"); \
    _Pragma("unroll") for (int d = 0; d < 4; ++d) _Pragma("unroll") for (int r = 0; r < 16; ++r) o[d][r] *= al_l[crow(r, hi)]; } } while (0)
  f32x16 pA0, pA1, pB0, pB1; float mnA, mnB, alA, alB; bf16x8 pa0, pa1, pa2, pa3; const int NT = seq / KVBLK;
  SLOADA(0); asm volatile("s_waitcnt vmcnt(0)" ::: "memory"); SWRITEA(0); __syncthreads();
  qkt(pA0, pA1, K_lds, qr, r32, hi); partialSM(pA0, pA1, m_reg, mnA, alA);
  SLOADB(KVBLK); if (2 < NT) SLOADA(2 * KVBLK);
  SWAIT(); SWRITEB(1); __syncthreads();
  for (int j = 1; j + 1 < NT; j += 2) {
    SBAR(); qkt(pB0, pB1, (bf16_t*)((char*)K_lds + SHM_K), qr, r32, hi);
    finishSM(pA0, pA1, alA, l_reg, pa0, pa1, pa2, pa3); SBAR();
    SLOADB((j + 2) * KVBLK); SBAR();
    pv_d0(o, vb0, pa0, pa1, pa2, pa3); partialSM(pB0, pB1, m_reg, mnB, alB);
    __syncthreads(); SWAIT(); SWRITEA(0);
    RESC(alB); __syncthreads();
    SBAR(); qkt(pA0, pA1, K_lds, qr, r32, hi);
    finishSM(pB0, pB1, alB, l_reg, pa0, pa1, pa2, pa3); SBAR();
    if (j + 3 < NT) SLOADA((j + 3) * KVBLK); SBAR();
    pv_d0(o, vb0 + (int)SHM_V, pa0, pa1, pa2, pa3); partialSM(pA0, pA1, m_reg, mnA, alA);
    __syncthreads(); SWAIT(); SWRITEB(1);
    RESC(alA); __syncthreads();
  }
  SBAR(); qkt(pB0, pB1, (bf16_t*)((char*)K_lds + SHM_K), qr, r32, hi);
  finishSM(pA0, pA1, alA, l_reg, pa0, pa1, pa2, pa3); SBAR();
  pv_d0(o, vb0, pa0, pa1, pa2, pa3); partialSM(pB0, pB1, m_reg, mnB, alB);
  __syncthreads(); RESC(alB);
  finishSM(pB0, pB1, alB, l_reg, pa0, pa1, pa2, pa3); SBAR();
  pv_d0(o, vb0 + (int)SHM_V, pa0, pa1, pa2, pa3);
  if (hi == 0) li_l[r32] = l_reg; asm volatile("s_waitcnt lgkmcnt(0)" ::: "memory");
  float rli[16];
#pragma unroll
  for (int r = 0; r < 16; ++r) rli[r] = __builtin_amdgcn_rcpf(li_l[crow(r, hi)]);
  bf16_t* Ow = Ob + (long)(wid * QBLK) * LDO;
#pragma unroll
  for (int r = 0; r < 16; ++r) { int orow = crow(r, hi);
#pragma unroll
    for (int d0 = 0; d0 < 4; ++d0) Ow[(long)orow * LDO + d0 * 32 + r32] = f2bf(o[d0][r] * rli[r]); }
#undef SLOADA
#undef SLOADB
#undef SWRITEA
#undef SWRITEB
#undef SWAIT
#undef RESC
}

__device__ __forceinline__ void hyena_item(const float* __restrict__ Fu, const float* __restrict__ Vu, const bf16_t* __restrict__ Xu,
                                           bf16_t* __restrict__ Au, int L, int t0, unsigned ln) {
  float y[16], ring[16];
#pragma unroll
  for (int i = 0; i < 16; ++i) { y[i] = 0.f; const float* fr = Fu + (long)(t0 + i + L - 1) * 512; ring[i] = fr[ln]; }
  const float* fp = Fu + (long)(t0 + L - 2) * 512;
  float va[16], fa[16], vb[16], fb[16];
#define HY_LOAD(V, Fq, S) _Pragma("unroll") for (int j = 0; j < 16; ++j) { const float* vr_ = Vu + (long)((S) + j) * 512; const float* fr_ = fp - (long)((S) + j) * 512; V[j] = vr_[ln]; Fq[j] = fr_[ln]; }
#define HY_STEP(V, Fq) _Pragma("unroll") for (int j = 0; j < 16; ++j) { const float vs = V[j]; \
    _Pragma("unroll") for (int i = 0; i < 16; ++i) y[i] += ring[(i - j) & 15] * vs; ring[(15 - j) & 15] = Fq[j]; }
  HY_LOAD(va, fa, 0)
  for (int s0 = 0; s0 < L; s0 += 32) {
    HY_LOAD(vb, fb, s0 + 16)
    HY_STEP(va, fa)
    if (s0 + 32 < L) { HY_LOAD(va, fa, s0 + 32) }
    HY_STEP(vb, fb)
  }
#undef HY_LOAD
#undef HY_STEP
#pragma unroll
  for (int i = 0; i < 16; ++i) {
    const bf16_t* xr = Xu + (long)(t0 + i) * 512; bf16_t* ar = Au + (long)(t0 + i) * 1024;
    ar[ln] = f2bf(y[i] * bf2f(xr[ln]));
  }
}

__device__ __forceinline__ void mix0_phase(const int wv, const Params& p, const int zq, const bf16_t* QA, const bf16_t* KA, const bf16_t* VA, const float* VV,
                                           const bf16_t* X0, const float* F256, const float* F2048, bf16_t* AO) {
  extern __shared__ __attribute__((aligned(16))) char shm_raw[];
#ifndef NO_ATTN
  for (int it = blockIdx.x; it < 192; it += gridDim.x) {
    long rowb, krow; int h, seqk;
    if (it < 64) { const int qb = it % 8, b = it / 32; h = (it / 8) % 4; rowb = 8192 + (long)b * 2048 + qb * 256; krow = 8192 + (long)b * 2560; seqk = 2560; }
    else { const int j = it - 64; const int b = j / 4; h = j % 4; rowb = (long)b * 256; krow = rowb; seqk = 256; }
    __syncthreads();
    attn_dense_body(wv, QA + rowb * 512 + h * 128, KA + krow * 256 + (h >> 1) * 128, VA + krow * 256 + (h >> 1) * 128, AO + rowb * 1024 + h * 128, seqk, shm_raw);
  }
#endif
#ifndef NO_HYENA
  const int lane = llane(); const int wid = wv;
  {
    unsigned* qctr = (unsigned*)(p.ws + WS_END) + 768;
    volatile int* sidx = (volatile int*)(shm_raw + 120000);
    for (;;) {
      __syncthreads();
      if (ltid(wv) == 0) *sidx = (int)__hip_atomic_fetch_add(qctr, 1u, __ATOMIC_RELAXED, __HIP_MEMORY_SCOPE_AGENT);
      __syncthreads();
      const int it = __builtin_amdgcn_readfirstlane(*sidx);
      if (it >= 768) break;
      if (it < 256) {
        const int b = it / 128, cgp = (it / 16) % 8, tg = it % 16;
        { const long rb = 8192 + (long)b * 2048; hyena_item(F2048 + cgp * 64, VV + rb * 512 + cgp * 64, X0 + rb * 512 + cgp * 64, AO + rb * 1024 + 512 + cgp * 64, 2048, tg * 128 + wid * 16, (unsigned)lane); }
      } else {
        const int jj = it - 256; const int b = jj / 16, cgp = (jj / 2) % 8, tg = jj % 2;
        { const long rb = (long)b * 256; hyena_item(F256 + cgp * 64, VV + rb * 512 + cgp * 64, X0 + rb * 512 + cgp * 64, AO + rb * 1024 + 512 + cgp * 64, 256, tg * 128 + wid * 16, (unsigned)lane); }
      }
    }
  }
#endif
  __syncthreads();
}

__device__ __forceinline__ float erf_as(float x) {
  const float ax = fabsf(x);
  const float t = __builtin_amdgcn_rcpf(fmaf(0.3275911f, ax, 1.f));
  float p = fmaf(1.061405429f, t, -1.453152027f);
  p = fmaf(p, t, 1.421413741f); p = fmaf(p, t, -0.284496736f); p = fmaf(p, t, 0.254829592f);
  const float r = 1.f - p * t * __expf(-ax * ax);
  return copysignf(r, x);
}
__device__ __forceinline__ float gelu_f(float x) { return 0.5f * x * (1.f + erf_as(x * 0.70710678118654752f)); }
__device__ __forceinline__ void ffn_act_phase(const int wv, const bf16_t* __restrict__ P, const float* __restrict__ cw, const float* __restrict__ cb, bf16_t* __restrict__ G) {
  const int tidx = ltid(wv);
  const int tid = tidx;
  if (tid >= 352) return;
  const int c8 = tid * 8;
  float w1[3][8], w2[3][8], b1[8], b2[8];
#pragma unroll
  for (int e = 0; e < 8; ++e) {
#pragma unroll
    for (int k = 0; k < 3; ++k) { w1[k][e] = cw[k * 5632 + c8 + e]; w2[k][e] = cw[k * 5632 + 2816 + c8 + e]; }
    b1[e] = cb[c8 + e]; b2[e] = cb[2816 + c8 + e];
  }
  for (int item = blockIdx.x; item < T_TOK / 16; item += gridDim.x) {
    const int r0 = item * 16;
    const int L = r0 < TPR ? 256 : 2048;
    const int tl0 = r0 < TPR ? r0 % 256 : (r0 - TPR) % 2048;
    float am[8], a0[8], ap[8], gm[8], g0[8], gp[8];
    const u32x4 z4 = {0u, 0u, 0u, 0u};
    {
      const bf16_t* b = P + (long)r0 * 5632 + c8;
      u32x4 x = (tl0 > 0) ? *(const u32x4*)(b - 5632) : z4; unpack8(x, am);
      x = (tl0 > 0) ? *(const u32x4*)(b - 5632 + 2816) : z4; unpack8(x, gm);
      x = *(const u32x4*)(b); unpack8(x, a0);
      x = *(const u32x4*)(b + 2816); unpack8(x, g0);
    }
    for (int r = 0; r < 16; ++r) {
      const bf16_t* b = P + (long)(r0 + r) * 5632 + c8;
      const bool vn = (tl0 + r) < L - 1;
      u32x4 x = vn ? *(const u32x4*)(b + 5632) : z4; unpack8(x, ap);
      x = vn ? *(const u32x4*)(b + 5632 + 2816) : z4; unpack8(x, gp);
      float o[8];
#pragma unroll
      for (int e = 0; e < 8; ++e) {
        float h1 = w1[0][e] * am[e] + w1[1][e] * a0[e] + w1[2][e] * ap[e] + b1[e];
        float h2 = w2[0][e] * gm[e] + w2[1][e] * g0[e] + w2[2][e] * gp[e] + b2[e];
        o[e] = gelu_f(h1) * h2;
        am[e] = a0[e]; a0[e] = ap[e]; gm[e] = g0[e]; g0[e] = gp[e];
      }
      *(u32x4*)(G + (long)(r0 + r) * 2816 + c8) = pack8(o);
    }
  }
}

template <int K>
__device__ __forceinline__ f32x16 mma_nt(const bf16_t* A, int lda, const bf16_t* B, int ldb, f32x16 acc, int r32, int hi) {
  bf16x8 a[K / 16], b[K / 16];
#pragma unroll
  for (int k0 = 0; k0 < K / 16; ++k0) {
    a[k0] = *reinterpret_cast<const bf16x8*>(A + r32 * lda + k0 * 16 + 8 * hi);
    b[k0] = *reinterpret_cast<const bf16x8*>(B + r32 * ldb + k0 * 16 + 8 * hi);
  }
#pragma unroll
  for (int k0 = 0; k0 < K / 16; ++k0) acc = __builtin_amdgcn_mfma_f32_32x32x16_bf16(a[k0], b[k0], acc, 0, 0, 0);
  return acc;
}

__device__ __forceinline__ void mlstm_phase(const int wv, const Params& p, const int zq, const bf16_t* __restrict__ P1, const float* __restrict__ GT,
                                            bf16_t* __restrict__ HF, bf16_t* __restrict__ HB,
                                            bf16_t* DC, float* DN, float* SC, const int pass) {
  const int tidx = ltid(wv);
  extern __shared__ __attribute__((aligned(16))) char shm_raw[];
  bf16_t* Qs = (bf16_t*)shm_raw;
  bf16_t* Ks = Qs + 64 * 136;
  bf16_t* KwT = Ks + 64 * 136;
  bf16_t* VsT = KwT + 128 * 72;
  bf16_t* Wb = VsT + 128 * 72;
  bf16_t* Cb = Wb + 64 * 72;
  float* gbuf = (float*)(Cb + 128 * 136);
  float* sclv = gbuf + 400; float* wintv = sclv + 64; float* nvec = wintv + 64;
  float* cwl = nvec + 128;
  const int tid = tidx, wid = wv, lane = tid & 63, r32 = lane & 31, hi = lane >> 5;
  const float* cw = p.in[zq + 35]; const float* cbias = p.in[zq + 36]; const float* bg = p.in[zq + 34];
  const int nitems = pass == 0 ? 1536 : 1024;
  for (int it = blockIdx.x; it < nitems; it += gridDim.x) {
    int mode, seq, h, dir, c0, c1, su = 0;
    if (pass == 0 && it < 512) { mode = 0; seq = it / 16; h = (it / 2) % 8; dir = it % 2; c0 = 0; c1 = 4; }
    else { su = pass == 0 ? it - 512 : it; const int sidx = su >> 5; mode = pass == 0 ? 1 : 2;
           seq = 32 + sidx / 16; h = (sidx / 2) % 8; dir = sidx % 2; c0 = su & 31; c1 = c0 + 1; }
    const bool do_out = mode != 1;
    const int L = seq < 32 ? 256 : 2048;
    const long rowbase = seq < 32 ? (long)seq * 256 : 8192 + (long)(seq - 32) * 2048;
    __syncthreads();
    f32x16 cacc[2]; float m = (mode == 1) ? -1e30f : 0.f;
    const int vb2 = wid >> 1;
#pragma unroll
    for (int i = 0; i < 2; ++i)
#pragma unroll
      for (int r = 0; r < 16; ++r) cacc[i][r] = 0.f;
    if (mode == 2) {
#pragma unroll
      for (int i = 0; i < 4; ++i) { const int id = tid + 512 * i, row = id >> 4, ck = id & 15;
        *(u32x4*)(Cb + row * 136 + ck * 8) = *(const u32x4*)(DC + (long)su * 16384 + row * 128 + ck * 8); }
      if (tid < 128) nvec[tid] = DN[su * 128 + tid];
      m = SC[su * 4 + 2];
    } else {
#pragma unroll
      for (int i = 0; i < 2; ++i) { const int kb = (wid & 1) * 2 + i;
#pragma unroll
        for (int r = 0; r < 16; ++r) Cb[(vb2 * 32 + crow(r, hi)) * 136 + kb * 32 + r32] = 0; }
      if (tid < 128) nvec[tid] = 0.f;
    }
    if (tid < 256) {
      const int col = (tid < 128) ? (h * 128 + tid) : (1024 + h * 128 + (tid - 128));
      cwl[tid] = cw[col]; cwl[256 + tid] = cw[2048 + col]; cwl[512 + tid] = cw[4096 + col]; cwl[768 + tid] = cbias[col];
    }
    const float bgi = bg[dir * 8 + h], bgf = bg[16 + dir * 8 + h];
    __syncthreads();
    u32x4 rq[2][3], rk[2][3], rv[2]; float g_i = 0.f, g_f = 0.f;
#define ML_LOADRAW(chn) do { \
      const int tcr_ = (chn) * 64 + lane; const int posr_ = dir ? (L - 1 - tcr_) : tcr_; \
      const bf16_t* rp_ = P1 + (rowbase + posr_) * 4096 + h * 128 + wv * 16; \
      const bool hm_ = posr_ > 0, hp_ = posr_ < L - 1; const u32x4 z4_ = {0u, 0u, 0u, 0u}; \
      _Pragma("unroll") for (int hf = 0; hf < 2; ++hf) { \
        rq[hf][0] = hm_ ? *(const u32x4*)(rp_ - 4096 + hf * 8) : z4_; rq[hf][1] = *(const u32x4*)(rp_ + hf * 8); \
        rq[hf][2] = hp_ ? *(const u32x4*)(rp_ + 4096 + hf * 8) : z4_; \
        rk[hf][0] = hm_ ? *(const u32x4*)(rp_ - 4096 + 1024 + hf * 8) : z4_; rk[hf][1] = *(const u32x4*)(rp_ + 1024 + hf * 8); \
        rk[hf][2] = hp_ ? *(const u32x4*)(rp_ + 4096 + 1024 + hf * 8) : z4_; \
        rv[hf] = *(const u32x4*)(rp_ + 2048 + hf * 8); } \
      if (wid == 7) { const float* gr_ = GT + (rowbase + posr_) * 32; g_i = gr_[dir * 8 + h]; g_f = gr_[16 + dir * 8 + h]; } \
    } while (0)
#define ML_GATES(setp, mval) do { float* av_ = gbuf + (setp) * 200; float* Mv_ = av_ + 64; float* bv_ = Mv_ + 64; float* scal_ = bv_ + 64; \
      const float ic_ = g_i + bgi; const float fp_ = g_f + bgf; \
      const float lf_ = fminf(fp_, 0.f) - __logf(1.f + __expf(-fabsf(fp_))); \
      float bc_ = lf_; \
      _Pragma("unroll") for (int off = 1; off < 64; off <<= 1) { float t_ = __shfl_up(bc_, off); if (lane >= off) bc_ += t_; } \
      const float a_ = ic_ - bc_; float pm_ = a_; \
      _Pragma("unroll") for (int off = 1; off < 64; off <<= 1) { float t_ = __shfl_up(pm_, off); if (lane >= off) pm_ = fmaxf(pm_, t_); } \
      const float M_ = fmaxf((mval), pm_); \
      av_[lane] = a_; Mv_[lane] = M_; bv_[lane] = bc_; if (lane == 63) { scal_[0] = M_; scal_[1] = bc_; } } while (0)
    float sv_M = 0.f, sv_b = 0.f;
    ML_LOADRAW(c0);
    if (wid == 7) ML_GATES(c0 & 1, m);
    for (int ch = c0; ch < c1; ++ch) {
      float* av = gbuf + (ch & 1) * 200; float* Mv = av + 64; float* bv = Mv + 64; float* scal = bv + 64;
      float kf[16];
      {
        const int r = lane, c16 = wv * 16;
#pragma unroll
        for (int hf = 0; hf < 2; ++hf) {
          float um[8], u0[8], up[8], qf[8];
          if (do_out) { unpack8(rq[hf][0], um); unpack8(rq[hf][1], u0); unpack8(rq[hf][2], up);
#pragma unroll
            for (int e = 0; e < 8; ++e) { const int c = c16 + hf * 8 + e;
              qf[e] = silu_f(cwl[c] * um[e] + cwl[256 + c] * u0[e] + cwl[512 + c] * up[e] + cwl[768 + c]); }
            *(u32x4*)(Qs + r * 136 + c16 + hf * 8) = pack8(qf); }
          { unpack8(rk[hf][0], um); unpack8(rk[hf][1], u0); unpack8(rk[hf][2], up);
#pragma unroll
            for (int e = 0; e < 8; ++e) { const int c = 128 + c16 + hf * 8 + e;
              qf[e] = 0.088388347648318440f * silu_f(cwl[c] * um[e] + cwl[256 + c] * u0[e] + cwl[512 + c] * up[e] + cwl[768 + c]);
              kf[hf * 8 + e] = qf[e]; }
            *(u32x4*)(Ks + r * 136 + c16 + hf * 8) = pack8(qf); }
          { const u32x4 wv4 = rv[hf];
            bf16_t* vd = VsT + (c16 + hf * 8) * 72 + r;
            vd[0 * 72] = (bf16_t)(wv4[0] & 0xffff); vd[1 * 72] = (bf16_t)(wv4[0] >> 16);
            vd[2 * 72] = (bf16_t)(wv4[1] & 0xffff); vd[3 * 72] = (bf16_t)(wv4[1] >> 16);
            vd[4 * 72] = (bf16_t)(wv4[2] & 0xffff); vd[5 * 72] = (bf16_t)(wv4[2] >> 16);
            vd[6 * 72] = (bf16_t)(wv4[3] & 0xffff); vd[7 * 72] = (bf16_t)(wv4[3] >> 16); }
        }
      }
      if (ch + 1 < c1) ML_LOADRAW(ch + 1);
      __syncthreads();
      const float M63 = scal[0], b63 = scal[1];
      sv_M = M63; sv_b = b63;
      const float m_new = b63 + M63;
      const float w_state = __expf(m - M63);
      {
        const float wt = __expf(av[lane] - M63);
        bf16_t* kd = KwT + (wv * 16) * 72 + lane;
#pragma unroll
        for (int e = 0; e < 16; ++e) kd[e * 72] = f2bf(kf[e] * wt);
      }
      __syncthreads();
      if (wid == 7 && ch + 1 < c1) ML_GATES((ch + 1) & 1, m_new);
      const int tb = wid & 1, vb = wid >> 1;
      if (do_out && wid < 4) {
        const int sb = wid >> 1;
        f32x16 s = {};
        if (sb <= tb) { s = mma_nt<64>(Qs + tb * 32 * 136, 136, Ks + sb * 32 * 136, 136, s, r32, hi); s = mma_nt<64>(Qs + tb * 32 * 136 + 64, 136, Ks + sb * 32 * 136 + 64, 136, s, r32, hi); }
        const int sc = sb * 32 + r32; const float as = av[sc];
#pragma unroll
        for (int r = 0; r < 16; ++r) {
          const int t = tb * 32 + crow(r, hi);
          float w = (sc <= t) ? s[r] * __expf(as - Mv[t]) : 0.f;
          Wb[t * 72 + sc] = f2bf(w);
        }
      }
      f32x16 inter = {};
      if (do_out) inter = mma_nt<64>(Qs + tb * 32 * 136, 136, Cb + vb * 32 * 136, 136, inter, r32, hi); if (do_out) inter = mma_nt<64>(Qs + tb * 32 * 136 + 64, 136, Cb + vb * 32 * 136 + 64, 136, inter, r32, hi);
      __syncthreads();
      if (do_out) {
        const int t = tid >> 3, part = tid & 7;
        float wsum[8]; unpack8(*(const u32x4*)(Wb + t * 72 + part * 8), wsum);
        float dw = 0.f;
#pragma unroll
        for (int e = 0; e < 8; ++e) dw += wsum[e];
        float q0[8], q1[8]; unpack8(*(const u32x4*)(Qs + t * 136 + part * 16), q0); unpack8(*(const u32x4*)(Qs + t * 136 + part * 16 + 8), q1);
        float dq = 0.f;
#pragma unroll
        for (int e = 0; e < 8; ++e) dq += q0[e] * nvec[part * 16 + e] + q1[e] * nvec[part * 16 + 8 + e];
        dw += __shfl_xor(dw, 1); dw += __shfl_xor(dw, 2); dw += __shfl_xor(dw, 4);
        dq += __shfl_xor(dq, 1); dq += __shfl_xor(dq, 2); dq += __shfl_xor(dq, 4);
        if (part == 0) {
          const float Mt = Mv[t];
          const float wint = __expf(m - Mt);
          const float den = wint * dq + dw;
          const float mt = bv[t] + Mt;
          sclv[t] = 1.f / fmaxf(fabsf(den), __expf(-mt));
          wintv[t] = wint;
        }
      }
      __syncthreads();
      if (do_out) {
        f32x16 num;
#pragma unroll
        for (int r = 0; r < 16; ++r) num[r] = inter[r] * wintv[tb * 32 + crow(r, hi)];
        num = mma_nt<64>(Wb + tb * 32 * 72, 72, VsT + vb * 32 * 72, 72, num, r32, hi);
        bf16_t* Hout = dir ? HB : HF;
#pragma unroll
        for (int r = 0; r < 16; ++r) {
          const int t = tb * 32 + crow(r, hi);
          const int tc = ch * 64 + t; const int pos = dir ? (L - 1 - tc) : tc;
          Hout[(rowbase + pos) * 1024 + h * 128 + vb * 32 + r32] = f2bf(num[r] * sclv[t]);
        }
      }
#pragma unroll
      for (int i = 0; i < 2; ++i) {
        const int kb = (wid & 1) * 2 + i;
#pragma unroll
        for (int r = 0; r < 16; ++r) cacc[i][r] *= w_state;
        cacc[i] = mma_nt<64>(VsT + vb2 * 32 * 72, 72, KwT + kb * 32 * 72, 72, cacc[i], r32, hi);
#pragma unroll
        for (int r = 0; r < 16; ++r) Cb[(vb2 * 32 + crow(r, hi)) * 136 + kb * 32 + r32] = f2bf(cacc[i][r]);
      }
      if (tid < 128) {
        float s = 0.f;
#pragma unroll
        for (int q = 0; q < 8; ++q) { float f[8]; unpack8(*(const u32x4*)(KwT + tid * 72 + q * 8), f);
#pragma unroll
          for (int e = 0; e < 8; ++e) s += f[e]; }
        nvec[tid] = w_state * nvec[tid] + s;
      }
      m = m_new;
      __syncthreads();
    }
    if (mode == 0) {
      float* Co = p.out + O_C + (long)((seq * 2 + dir) * 8 + h) * 16384;
#pragma unroll
      for (int i = 0; i < 2; ++i) { const int kb = (wid & 1) * 2 + i;
#pragma unroll
        for (int r = 0; r < 16; ++r) Co[(vb2 * 32 + crow(r, hi)) * 128 + kb * 32 + r32] = cacc[i][r]; }
      if (tid < 128) p.out[O_N + ((seq * 2 + dir) * 8 + h) * 128 + tid] = nvec[tid];
      if (tid == 0) p.out[O_M + (seq * 2 + dir) * 8 + h] = m;
    } else if (mode == 1) {
#pragma unroll
      for (int i = 0; i < 4; ++i) { const int id = tid + 512 * i, row = id >> 4, ck = id & 15;
        *(u32x4*)(DC + (long)su * 16384 + row * 128 + ck * 8) = *(const u32x4*)(Cb + row * 136 + ck * 8); }
      if (tid < 128) DN[su * 128 + tid] = nvec[tid];
      if (tid == 0) { SC[su * 4] = sv_M; SC[su * 4 + 1] = sv_b; }
    }
  }
  __syncthreads();
}

__device__ __forceinline__ void mlstm_scan(const int wv, const Params& p, const int zq, bf16_t* DC, float* DN, float* SC) {
  const int tidx = ltid(wv);
  for (int g = blockIdx.x * 512 + tidx; g < 32 * 4096; g += gridDim.x * 512) {
    const int sidx = g >> 12, e4 = (g & 4095) * 4;
    const int b = sidx >> 4, h = (sidx >> 1) & 7, dir = sidx & 1;
    const float4 c0 = *(const float4*)(p.in[zq + 4] + (long)((b * 2 + dir) * 8 + h) * 16384 + e4);
    float C0 = c0.x, C1 = c0.y, C2 = c0.z, C3 = c0.w;
    float m = p.in[zq + 6][(b * 2 + dir) * 8 + h];
#pragma unroll 4
    for (int c = 0; c < 32; ++c) {
      const int u = sidx * 32 + c;
      const float amax = SC[u * 4], b63 = SC[u * 4 + 1];
      const float Mc = fmaxf(m, amax);
      const float ws = __expf(m - Mc), wd = __expf(amax - Mc);
      u32x2* dp = (u32x2*)(DC + (long)u * 16384 + e4);
      const u32x2 d = *dp;
      u32x2 o = {cvtpk(C0, C1), cvtpk(C2, C3)};
      *dp = o;
      C0 = ws * C0 + wd * bflo(d[0]); C1 = ws * C1 + wd * bfhi(d[0]); C2 = ws * C2 + wd * bflo(d[1]); C3 = ws * C3 + wd * bfhi(d[1]);
      m = b63 + Mc;
    }
  }
  for (int g = blockIdx.x * 512 + tidx; g < 32 * 128; g += gridDim.x * 512) {
    const int sidx = g >> 7, k = g & 127;
    const int b = sidx >> 4, h = (sidx >> 1) & 7, dir = sidx & 1;
    float n = p.in[zq + 5][((b * 2 + dir) * 8 + h) * 128 + k];
    float m = p.in[zq + 6][(b * 2 + dir) * 8 + h];
    for (int c = 0; c < 32; ++c) {
      const int u = sidx * 32 + c;
      const float amax = SC[u * 4], b63 = SC[u * 4 + 1];
      const float Mc = fmaxf(m, amax);
      const float ws = __expf(m - Mc), wd = __expf(amax - Mc);
      const float dn = DN[u * 128 + k];
      DN[u * 128 + k] = n;
      if (k == 0) SC[u * 4 + 2] = m;
      n = ws * n + wd * dn;
      m = b63 + Mc;
    }
  }
}

#undef ML_LOADRAW
#undef ML_GATES
__device__ __forceinline__ void mlstm_post(const int wv, const Params& p, const int zq, const bf16_t* __restrict__ HF, const bf16_t* __restrict__ HB,
                                           const bf16_t* __restrict__ P1, bf16_t* __restrict__ A) {
  const int tidx = ltid(wv);
  const int wid = wv, lane = tidx & 63;
  const float* hn = p.in[zq + 37];
  for (int row = blockIdx.x * 8 + wid; row < T_TOK; row += gridDim.x * 8) {
    float hv[16], t0[8], t1[8];
    unpack8(*(const u32x4*)(HF + (long)row * 1024 + lane * 16), hv); unpack8(*(const u32x4*)(HF + (long)row * 1024 + lane * 16 + 8), hv + 8);
    unpack8(*(const u32x4*)(HB + (long)row * 1024 + lane * 16), t0); unpack8(*(const u32x4*)(HB + (long)row * 1024 + lane * 16 + 8), t1);
    float ss = 0.f;
#pragma unroll
    for (int e = 0; e < 8; ++e) { hv[e] += t0[e]; hv[8 + e] += t1[e]; }
#pragma unroll
    for (int e = 0; e < 16; ++e) ss += hv[e] * hv[e];
    ss += __shfl_xor(ss, 1); ss += __shfl_xor(ss, 2); ss += __shfl_xor(ss, 4);
    const float rs = rsqrtf(ss * (1.f / 128.f) + 1e-6f);
    float ov[16];
    unpack8(*(const u32x4*)(P1 + (long)row * 4096 + 3072 + lane * 16), ov); unpack8(*(const u32x4*)(P1 + (long)row * 4096 + 3072 + lane * 16 + 8), ov + 8);
    float y[16];
#pragma unroll
    for (int e = 0; e < 16; ++e) y[e] = hv[e] * rs * hn[lane * 16 + e] * (1.f / (1.f + __expf(-ov[e])));
    *(u32x4*)(A + (long)row * 1024 + lane * 16) = pack8(y);
    *(u32x4*)(A + (long)row * 1024 + lane * 16 + 8) = pack8(y + 8);
  }
}

__device__ __forceinline__ void gsync(const int wv, unsigned* bar, const unsigned k) {
  const int tidx = ltid(wv);
  asm volatile("s_waitcnt vmcnt(0)" ::: "memory");
  __syncthreads();
  if (tidx == 0) {
    __builtin_amdgcn_fence(__ATOMIC_RELEASE, "agent");
    asm volatile("s_waitcnt vmcnt(0)" ::: "memory");
    const unsigned g = blockIdx.x & 7u;
    const unsigned ng = (gridDim.x + 7u - g) >> 3;
    const unsigned ngroups = gridDim.x < 8u ? gridDim.x : 8u;
    const unsigned old = __hip_atomic_fetch_add(bar + g * 32, 1u, __ATOMIC_RELAXED, __HIP_MEMORY_SCOPE_AGENT);
    if (old + 1u == k * ng) {
      const unsigned o2 = __hip_atomic_fetch_add(bar + 256, 1u, __ATOMIC_RELAXED, __HIP_MEMORY_SCOPE_AGENT);
      if (o2 + 1u == k * ngroups) {
#pragma unroll
        for (int q = 0; q < 8; ++q) __hip_atomic_store(bar + 512 + q * 32, k, __ATOMIC_RELAXED, __HIP_MEMORY_SCOPE_AGENT);
      }
    }
    while (__hip_atomic_load(bar + 512 + g * 32, __ATOMIC_RELAXED, __HIP_MEMORY_SCOPE_AGENT) < k) __builtin_amdgcn_s_sleep(4);
    __builtin_amdgcn_fence(__ATOMIC_ACQUIRE, "agent");
    asm volatile("s_waitcnt vmcnt(0)" ::: "memory");
  }
  __syncthreads();
}

__global__ void __launch_bounds__(512) mega(Params p, int ph_lo, int ph_hi) {
  const int wv = __builtin_amdgcn_readfirstlane(threadIdx.x >> 6);
  if (ph_hi < 0) { cg::this_grid().sync(); }
  unsigned* bar = (unsigned*)(p.ws + WS_END);
  char* ws = p.ws;
  bf16_t* Wt_in0 = (bf16_t*)(ws + OFF_WIN0); bf16_t* Wt_out0 = (bf16_t*)(ws + OFF_WOUT0);
  bf16_t* Wt_up0 = (bf16_t*)(ws + OFF_WUP0); bf16_t* Wt_up1 = (bf16_t*)(ws + OFF_WUP1);
  bf16_t* Wt_dn0 = (bf16_t*)(ws + OFF_WDN0); bf16_t* Wt_dn1 = (bf16_t*)(ws + OFF_WDN1);
  bf16_t* Wt_in1 = (bf16_t*)(ws + OFF_WIN1); bf16_t* Wt_out1 = (bf16_t*)(ws + OFF_WOUT1);
  float* modv = (float*)(ws + OFF_MOD);
  char* Pr = ws + OFF_P; char* Gr = ws + OFF_G;
  bf16_t* Pb = (bf16_t*)Pr; bf16_t* R = (bf16_t*)Pr;
  bf16_t* QA = (bf16_t*)(Pr + P_QA); bf16_t* KA = (bf16_t*)(Pr + P_KA); bf16_t* VA = (bf16_t*)(Pr + P_VA); bf16_t* X0 = (bf16_t*)(Pr + P_X0);
  float* GT = (float*)(Pr + P_GT); bf16_t* A2 = (bf16_t*)(Pr + P_A2);
  bf16_t* A = (bf16_t*)Gr; bf16_t* Gb = (bf16_t*)Gr; float* VV = (float*)(Gr + G_VV);
  bf16_t* HF = (bf16_t*)Gr; bf16_t* HB = (bf16_t*)(Gr + G_HB);
  bf16_t* DCb = (bf16_t*)(Pr + P_A2); float* DNb = (float*)(Gr + 50331648); float* SCb = DNb + 1024 * 128;
  float* X = p.out;
  float* F256 = p.out + O_C + 512; float* F2048 = p.out + O_C + 512 * 512 + 512;
  const float* mod0 = modv; const float* mod1 = modv + 3 * 6144;
  unsigned bk = 0;
#define PH(i, ...) if (ph_lo <= (i) && (i) < ph_hi) { const int zq = opq(); __VA_ARGS__; if ((i) + 1 < ph_hi) gsync(wv, bar, ++bk); }
  PH(0, {
    conv_w(wv, p.in[zq + 19], Wt_in0, 1024, 2560, 2560);
    conv_w(wv, p.in[zq + 20], Wt_out0, 1024, 1024, 1024);
    mod_phase(wv, p, zq, modv);
    filt_phase(wv, p, zq, F256, F2048);
  })
  PH(1, (row_phase<true, false, true>(wv, p, zq, nullptr, nullptr, mod0, 0, nullptr, p.in[zq + 11], mod0, 0, A)))
  PH(2, (gemm_phase<0, 2560>(wv, A, Wt_in0, 2560, 1024, Pb, nullptr)))
  PH(3, post_inproj0(wv, p, zq, Pb, QA, KA, VA, VV, X0))
  PH(4, mix0_phase(wv, p, zq, QA, KA, VA, VV, X0, F256, F2048, A))
  PH(5, { gemm_phase<0, 1024>(wv, A, Wt_out0, 1024, 1024, R, nullptr);
    conv_w(wv, p.in[zq + 15], Wt_up0, 1024, 5632, 5632, gridDim.x > 192 ? 192 : 0); })
  PH(6, (row_phase<true, true, true>(wv, p, zq, R, p.in[zq + 12], mod0, 2, X, p.in[zq + 13], mod0, 3, A)))
  PH(7, { gemm_phase<0, 5632>(wv, A, Wt_up0, 5632, 1024, Pb, nullptr);
    const int ib = (int)(1056u % gridDim.x);
    conv_w(wv, p.in[zq + 18], Wt_dn0, 2816, 1024, 1024, ib);
    conv_w(wv, p.in[zq + 33], Wt_in1, 1024, 4128, 4352, ib); })
  PH(8, ffn_act_phase(wv, Pb, p.in[zq + 16], p.in[zq + 17], Gb))
  PH(9, { gemm_phase<0, 1024>(wv, Gb, Wt_dn0, 1024, 2816, R, nullptr);
    const int ib = gridDim.x > 192 ? 192 : 0;
    conv_w(wv, p.in[zq + 15] + (long)1024 * 5632, Wt_up1, 1024, 5632, 5632, ib);
    conv_w(wv, p.in[zq + 18] + (long)2816 * 1024, Wt_dn1, 2816, 1024, 1024, ib);
    conv_w(wv, p.in[zq + 38], Wt_out1, 1024, 1024, 1024, ib); })
  PH(10, (row_phase<false, true, true>(wv, p, zq, R, p.in[zq + 14], mod0, 5, X, p.in[zq + 11] + 1024, mod1, 0, A)))
  PH(11, { gemm_phase<0, 4096>(wv, A, Wt_in1, 4096, 1024, Pb, nullptr); gates_phase(wv, A, Wt_in1 + (long)4096 * 1024, GT); })
  PH(12, {
    mlstm_phase(wv, p, zq, Pb, GT, HF, HB, DCb, DNb, SCb, 0);
  })
  PH(13, mlstm_scan(wv, p, zq, DCb, DNb, SCb))
  PH(21, mlstm_phase(wv, p, zq, Pb, GT, HF, HB, DCb, DNb, SCb, 1))
  PH(14, mlstm_post(wv, p, zq, HF, HB, Pb, A2))
  PH(15, (gemm_phase<0, 1024>(wv, A2, Wt_out1, 1024, 1024, R, nullptr)))
  PH(16, (row_phase<false, true, true>(wv, p, zq, R, p.in[zq + 12] + 1024, mod1, 2, X, p.in[zq + 13] + 1024, mod1, 3, A)))
  PH(17, (gemm_phase<0, 5632>(wv, A, Wt_up1, 5632, 1024, Pb, nullptr)))
  PH(18, ffn_act_phase(wv, Pb, p.in[zq + 16] + 3 * 5632, p.in[zq + 17] + 5632, Gb))
  PH(19, (gemm_phase<0, 1024>(wv, Gb, Wt_dn1, 1024, 2816, R, nullptr)))
  PH(39, (row_phase<false, true, false>(wv, p, zq, R, p.in[zq + 14] + 1024, mod1, 5, X, nullptr, mod1, 0, nullptr)))
#undef PH
}

extern "C" void kernel_launch(void* const* d_in, const int* in_sizes, int n_in, void* d_out, int out_size, void* d_ws, size_t ws_size,
                              hipStream_t stream) {
  static int grid_blocks = 0;
  if (!grid_blocks) {
    if (ws_size < WS_END + 4096) fprintf(stderr, "kernel_launch: workspace too small: %zu < %zu\n", ws_size, (size_t)WS_END);
    hipFuncSetAttribute((const void*)mega, hipFuncAttributeMaxDynamicSharedMemorySize, LDS_BYTES);
    int dev = 0, cus = 0, per = 0;
    hipGetDevice(&dev);
    hipDeviceGetAttribute(&cus, hipDeviceAttributeMultiprocessorCount, dev);
    hipOccupancyMaxActiveBlocksPerMultiprocessor(&per, mega, 512, LDS_BYTES);
    if (per < 1) { fprintf(stderr, "kernel_launch: occupancy query returned %d\n", per); per = 1; }
    grid_blocks = cus;
  }
  Params p{};
  for (int i = 0; i < 39; ++i) p.in[i] = (const float*)d_in[i];
  p.out = (float*)d_out; p.ws = (char*)d_ws;
  int lo = 0, hi = NPH;
  (void)hipMemsetAsync((char*)d_ws + WS_END, 0, 4096, stream);
  void* args[] = {&p, &lo, &hi};
  hipError_t e = hipLaunchCooperativeKernel((void*)mega, dim3(grid_blocks), dim3(512), args, LDS_BYTES, stream);
  if (e != hipSuccess) fprintf(stderr, "cooperative launch failed: %s (grid %d)\n", hipGetErrorString(e), grid_blocks);
}
```

```cpp
#include <hip/hip_runtime.h>
#include <hip/hip_cooperative_groups.h>
#include <cstdio>
#include <cstdint>
namespace cg = cooperative_groups;

typedef unsigned short bf16_t;
typedef short bf16x8 __attribute__((ext_vector_type(8)));
typedef short s16x4 __attribute__((ext_vector_type(4)));
typedef float f32x4 __attribute__((ext_vector_type(4)));
typedef float f32x8 __attribute__((ext_vector_type(8)));
typedef float f32x16 __attribute__((ext_vector_type(16)));
typedef unsigned u32x4 __attribute__((ext_vector_type(4)));
typedef unsigned u32x2 __attribute__((ext_vector_type(2)));

constexpr int T_TOK = 12288, TPR = 8192;
constexpr int LDS_BYTES = 131072;
constexpr int NPH = 40;

constexpr size_t OFF_WIN0 = 0, OFF_WOUT0 = 5242880, OFF_WUP0 = 7340032, OFF_WUP1 = 18874368, OFF_WDN0 = 30408704,
                 OFF_WDN1 = 36175872, OFF_WIN1 = 41943040, OFF_WOUT1 = 50855936, OFF_MOD = 52953088, OFF_P = 53100544,
                 OFF_G = 191512576, WS_END = 260718592;
constexpr size_t P_QA = 62914560, P_KA = 75497472, P_VA = 82313216, P_X0 = 89128960;
constexpr size_t P_GT = 100663296, P_A2 = 102236160;
constexpr size_t G_VV = 25165824, G_HB = 25165824;
constexpr size_t O_K = 12582912, O_V = 14680064, O_C = 16777216, O_N = 25165824, O_M = 25231360;

struct Params { const float* in[39]; float* out; char* ws; };

typedef __bf16 nbf16x2 __attribute__((ext_vector_type(2)));
typedef float nf32x2 __attribute__((ext_vector_type(2)));
__device__ __forceinline__ unsigned cvtpk(float lo, float hi) {
  nf32x2 v = {lo, hi};
  nbf16x2 b = __builtin_convertvector(v, nbf16x2);
  return __builtin_bit_cast(unsigned, b);
}
__device__ __forceinline__ bf16_t f2bf(float f) { return (bf16_t)(cvtpk(f, 0.f) & 0xffffu); }
__device__ __forceinline__ float bf2f(bf16_t h) { return __uint_as_float(((unsigned)h) << 16); }
__device__ __forceinline__ float bflo(unsigned w) { return __uint_as_float(w << 16); }
__device__ __forceinline__ float bfhi(unsigned w) { return __uint_as_float(w & 0xffff0000u); }
__device__ __forceinline__ float wave_sum(float v) {
#pragma unroll
  for (int o = 32; o > 0; o >>= 1) v += __shfl_xor(v, o);
  return v;
}
__device__ __forceinline__ int llane() { int l; asm volatile("v_mbcnt_lo_u32_b32 %0, -1, 0\n\tv_mbcnt_hi_u32_b32 %0, -1, %0" : "=v"(l)); return l; }
__device__ __forceinline__ int ltid(int wv) { return (wv << 6) | llane(); }
__device__ __forceinline__ int opq() { int z; asm volatile("s_mov_b32 %0, 0" : "=s"(z)); return z; }
__device__ __forceinline__ float silu_f(float x) { return x * __builtin_amdgcn_rcpf(1.f + __expf(-x)); }
__device__ __forceinline__ int crow(int r, int hi) { return (r & 3) + 8 * (r >> 2) + 4 * hi; }
__device__ __forceinline__ void unpack8(u32x4 w, float* f) {
  f[0] = bflo(w[0]); f[1] = bfhi(w[0]); f[2] = bflo(w[1]); f[3] = bfhi(w[1]);
  f[4] = bflo(w[2]); f[5] = bfhi(w[2]); f[6] = bflo(w[3]); f[7] = bfhi(w[3]);
}
__device__ __forceinline__ u32x4 pack8(const float* f) {
  u32x4 w = {cvtpk(f[0], f[1]), cvtpk(f[2], f[3]), cvtpk(f[4], f[5]), cvtpk(f[6], f[7])}; return w;
}

__device__ __forceinline__ void conv_w(const int wv, const float* __restrict__ W, bf16_t* __restrict__ Wt, int K, int N, int NP, int b0 = 0) {
  const int tidx = ltid(wv);
  extern __shared__ __attribute__((aligned(16))) char shm_raw[];
  float* tl = (float*)shm_raw;
  const int tid = tidx;
  const int ntn = NP / 64, ntiles = (K / 64) * ntn;
  if ((int)blockIdx.x < b0) return;
  for (int tile = (int)blockIdx.x - b0; tile < ntiles; tile += (int)gridDim.x - b0) {
    const int k0 = (tile / ntn) * 64, n0 = (tile % ntn) * 64;
    __syncthreads();
#pragma unroll
    for (int i = 0; i < 2; ++i) {
      int kr = (tid >> 4) + 32 * i, nc = (tid & 15) * 4;
      float4 v = make_float4(0.f, 0.f, 0.f, 0.f);
      if (n0 + nc < N) v = *(const float4*)(W + (long)(k0 + kr) * N + n0 + nc);
      float* d = tl + kr * 65 + nc; d[0] = v.x; d[1] = v.y; d[2] = v.z; d[3] = v.w;
    }
    __syncthreads();
    {
      int n = tid >> 3, kg = (tid & 7) * 8;
      u32x4 w;
      w[0] = cvtpk(tl[(kg + 0) * 65 + n], tl[(kg + 1) * 65 + n]);
      w[1] = cvtpk(tl[(kg + 2) * 65 + n], tl[(kg + 3) * 65 + n]);
      w[2] = cvtpk(tl[(kg + 4) * 65 + n], tl[(kg + 5) * 65 + n]);
      w[3] = cvtpk(tl[(kg + 6) * 65 + n], tl[(kg + 7) * 65 + n]);
      *(u32x4*)(Wt + (long)(n0 + n) * K + k0 + kg) = w;
    }
  }
  __syncthreads();
}

__device__ __forceinline__ void mod_phase(const int wv, const Params& p, const int zq, float* modv) {
  const int tidx = ltid(wv);
  extern __shared__ __attribute__((aligned(16))) char shm_raw[];
  float* red = (float*)shm_raw;
  const int tid = tidx;
  const float* cvec = p.in[zq + 7]; const float* cctx = p.in[zq + 8]; const float* bmod = p.in[zq + 10];
  for (int item = blockIdx.x; item < 192; item += gridDim.x) {
    const int l = item / 96, cb = (item % 96) * 64;
    const float* W = p.in[zq + 9] + (long)l * 1024 * 6144;
    const int cl = tid & 15, kg = tid >> 4;
    float a0[4] = {0, 0, 0, 0}, a1[4] = {0, 0, 0, 0}, a2[4] = {0, 0, 0, 0};
#pragma unroll 8
    for (int i = 0; i < 32; ++i) {
      int k = kg + 32 * i;
      float4 w = *(const float4*)(W + (long)k * 6144 + cb + cl * 4);
      float s0 = silu_f(cctx[k]), s1 = silu_f(cvec[k]), s2 = silu_f(cvec[1024 + k]);
      a0[0] += s0 * w.x; a0[1] += s0 * w.y; a0[2] += s0 * w.z; a0[3] += s0 * w.w;
      a1[0] += s1 * w.x; a1[1] += s1 * w.y; a1[2] += s1 * w.z; a1[3] += s1 * w.w;
      a2[0] += s2 * w.x; a2[1] += s2 * w.y; a2[2] += s2 * w.z; a2[3] += s2 * w.w;
    }
    __syncthreads();
#pragma unroll
    for (int j = 0; j < 4; ++j) {
      red[kg * 192 + 0 * 64 + cl * 4 + j] = a0[j];
      red[kg * 192 + 1 * 64 + cl * 4 + j] = a1[j];
      red[kg * 192 + 2 * 64 + cl * 4 + j] = a2[j];
    }
    __syncthreads();
    if (tid < 192) {
      float s = 0.f;
#pragma unroll 8
      for (int q = 0; q < 32; ++q) s += red[q * 192 + tid];
      int g = tid / 64, col = cb + (tid % 64);
      modv[(l * 3 + g) * 6144 + col] = s + bmod[l * 6144 + col];
    }
  }
  __syncthreads();
}

__device__ __forceinline__ void filt_phase(const int wv, const Params& p, const int zq, float* F256, float* F2048) {
  const int tidx = ltid(wv);
  extern __shared__ __attribute__((aligned(16))) char shm_raw[];
  float* z = (float*)shm_raw;
  float* h1 = z + 256;
  float* h2 = h1 + 512;
  const int tid = tidx;
  const float *w1 = p.in[zq + 25], *b1 = p.in[zq + 26], *w2 = p.in[zq + 27], *b2 = p.in[zq + 28], *w3 = p.in[zq + 29], *b3 = p.in[zq + 30], *sf = p.in[zq + 31], *skip = p.in[zq + 32];
  const float DMAX = -15.350567286626973f, DMIN = -3.0701134573253946f;
  const bool fsp = gridDim.x == 256;
  for (int rnd = 0, item = blockIdx.x; item < 288; ++rnd,
       item = fsp ? ((rnd == 1 && blockIdx.x >= 192 && blockIdx.x < 224) ? 64 + (int)blockIdx.x : 288) : item + (int)gridDim.x) {
    const int L = item < 32 ? 256 : 2048; const int i0 = item < 32 ? item * 8 : (item - 32) * 8;
    float* F = item < 32 ? F256 : F2048;
    __syncthreads();
    if (tid < 136) {
      const int q = tid / 17, f = tid % 17;
      const float t = (float)(i0 + q) / (float)(L - 1);
      float v;
      if (f == 0) v = t;
      else if (f <= 8) v = cosf(6.283185307179586f * t * (float)f);
      else v = sinf(6.283185307179586f * t * (float)(f - 8));
      z[q * 32 + f] = v;
    }
    __syncthreads();
    { const int q = tid >> 6, u = tid & 63; float a = b1[u];
#pragma unroll 1
      for (int jj = 0; jj < 17; ++jj) a += z[q * 32 + jj] * w1[jj * 64 + u];
      h1[q * 64 + u] = sinf(sf[u] * a); }
    __syncthreads();
    { const int q = tid >> 6, u = tid & 63; float a = b2[u];
#pragma unroll 8
      for (int jj = 0; jj < 64; ++jj) a += h1[q * 64 + jj] * w2[jj * 64 + u];
      h2[q * 64 + u] = sinf(sf[64 + u] * a); }
    __syncthreads();
    {
      const int ch = tid;
      float af[8], ab[8];
#pragma unroll
      for (int q = 0; q < 8; ++q) { af[q] = b3[ch]; ab[q] = b3[512 + ch]; }
#pragma unroll 4
      for (int jj = 0; jj < 64; ++jj) {
        const float wa = w3[jj * 1024 + ch], wb = w3[jj * 1024 + 512 + ch];
#pragma unroll
        for (int q = 0; q < 8; ++q) { const float hh = h2[q * 64 + jj]; af[q] += hh * wa; ab[q] += hh * wb; }
      }
      const float delta = fabsf(DMIN + (DMAX - DMIN) * ((float)ch / 511.f));
#pragma unroll
      for (int q = 0; q < 8; ++q) {
        const int i = i0 + q;
        const float t = (float)i / (float)(L - 1);
        const float win = expf(-t * delta);
        const float sfw = af[q] * win, sbw = ab[q] * win;
        if (i == 0) F[(long)(L - 1) * 512 + ch] = sfw + sbw + skip[ch];
        else { F[(long)(L - 1 + i) * 512 + ch] = sfw; F[(long)(L - 1 - i) * 512 + ch] = sbw; }
      }
    }
  }
  __syncthreads();
}

template <bool FROM_IN, bool HAS_R, bool HAS_A>
__device__ __forceinline__ void row_phase(const int wv, const Params& p, const int zq, const bf16_t* __restrict__ R, const float* __restrict__ postg,
                                          const float* __restrict__ modg, int gate_m, float* X,
                                          const float* __restrict__ preg, const float* __restrict__ mods, int shift_m, bf16_t* __restrict__ A) {
  const int tidx = ltid(wv);
  const int wid = wv, lane = tidx & 63;
  for (int row = blockIdx.x * 8 + wid; row < T_TOK; row += gridDim.x * 8) {
    const int g = row < TPR ? 0 : 1 + (row - TPR) / 2048;
    const float* mg = modg + g * 6144;
    const float* ms = mods + g * 6144;
    const float* xin = FROM_IN ? (row < TPR ? p.in[zq + 0] + (long)row * 1024 : p.in[zq + 1] + (long)(row - TPR) * 1024) : (const float*)X + (long)row * 1024;
    float4 x[4];
#pragma unroll
    for (int j = 0; j < 4; ++j) x[j] = *(const float4*)(xin + j * 256 + lane * 4);
    if (HAS_R) {
      float4 r[4]; float ss = 0.f;
#pragma unroll
      for (int j = 0; j < 4; ++j) { const u32x2 rw = *(const u32x2*)(R + (long)row * 1024 + j * 256 + lane * 4); r[j] = make_float4(bflo(rw[0]), bfhi(rw[0]), bflo(rw[1]), bfhi(rw[1])); ss += r[j].x * r[j].x + r[j].y * r[j].y + r[j].z * r[j].z + r[j].w * r[j].w; }
      ss = wave_sum(ss); const float rs = rsqrtf(ss * (1.f / 1024.f) + 1e-6f);
#pragma unroll
      for (int j = 0; j < 4; ++j) {
        float4 pg = *(const float4*)(postg + j * 256 + lane * 4);
        float4 gt = *(const float4*)(mg + gate_m * 1024 + j * 256 + lane * 4);
        x[j].x += gt.x * (r[j].x * rs * pg.x); x[j].y += gt.y * (r[j].y * rs * pg.y);
        x[j].z += gt.z * (r[j].z * rs * pg.z); x[j].w += gt.w * (r[j].w * rs * pg.w);
        *(float4*)(X + (long)row * 1024 + j * 256 + lane * 4) = x[j];
      }
    }
    if (HAS_A) {
      float ss = 0.f;
#pragma unroll
      for (int j = 0; j < 4; ++j) ss += x[j].x * x[j].x + x[j].y * x[j].y + x[j].z * x[j].z + x[j].w * x[j].w;
      ss = wave_sum(ss); const float rs = rsqrtf(ss * (1.f / 1024.f) + 1e-6f);
#pragma unroll
      for (int j = 0; j < 4; ++j) {
        float4 pg = *(const float4*)(preg + j * 256 + lane * 4);
        float4 sh = *(const float4*)(ms + shift_m * 1024 + j * 256 + lane * 4);
        float4 sc = *(const float4*)(ms + (shift_m + 1) * 1024 + j * 256 + lane * 4);
        float y0 = x[j].x * rs * pg.x * (1.f + sc.x) + sh.x, y1 = x[j].y * rs * pg.y * (1.f + sc.y) + sh.y;
        float y2 = x[j].z * rs * pg.z * (1.f + sc.z) + sh.z, y3 = x[j].w * rs * pg.w * (1.f + sc.w) + sh.w;
        u32x2 w = {cvtpk(y0, y1), cvtpk(y2, y3)};
        *(u32x2*)(A + (long)row * 1024 + j * 256 + lane * 4) = w;
      }
    }
  }
}

constexpr int BM = 256, BK = 64, HALF = 128, WGM = 8, HT = HALF * BK;
__device__ __forceinline__ int lds_byte(int r, int c) {
  int st = (r >> 4) * 2 + (c >> 5), rr = r & 15, cc = c & 31, ob = rr * 64 + cc * 2;
  return st * 1024 + (ob ^ (((ob >> 9) & 1) << 5));
}
__device__ __forceinline__ void stage_rc(int b, int& R, int& C) {
  int st = b / 1024, sb = b % 1024, swz = sb ^ (((sb >> 9) & 1) << 5);
  R = (st >> 1) * 16 + swz / 64; C = (st & 1) * 32 + (swz % 64) / 2;
}

template <int MODE, int LDC>
__device__ __forceinline__ void gemm_phase(const int wv, const bf16_t* __restrict__ A, const bf16_t* __restrict__ Bt, int N, int K,
                                           void* Cout, float* GT) {
  const int tidx = ltid(wv);
  extern __shared__ __attribute__((aligned(16))) char shm_raw[];
  bf16_t* shm = (bf16_t*)shm_raw;
#define SA(b, h) (shm + ((b) * 2 + (h)) * HT)
#define SB(b, h) (shm + (4 + (b) * 2 + (h)) * HT)
#define STAGE(P, BASE, br, kt) do { const bf16_t* _gb = (BASE) + ((long)(br) * K + (long)(kt) * BK); \
    __builtin_amdgcn_global_load_lds((const unsigned*)(_gb + soff0), (unsigned*)((char*)(P) + sl0), 16, 0, 0); \
    __builtin_amdgcn_global_load_lds((const unsigned*)(_gb + soff1), (unsigned*)((char*)(P) + sl0 + 8192), 16, 0, 0); } while (0)
#define LDA(dst, b, h) _Pragma("unroll") for (int m = 0; m < 4; ++m) _Pragma("unroll") for (int k = 0; k < 2; ++k) \
    dst[m][k] = *reinterpret_cast<const bf16x8*>((char*)SA(b, h) + lds_byte(wr * 64 + m * 16 + fr, k * 32 + fq * 8))
#define LDB(dst, b, h) _Pragma("unroll") for (int n = 0; n < 2; ++n) _Pragma("unroll") for (int k = 0; k < 2; ++k) \
    dst[n][k] = *reinterpret_cast<const bf16x8*>((char*)SB(b, h) + lds_byte(wc * 32 + n * 16 + fr, k * 32 + fq * 8))
#define MMA(ai, bj, At, Bt_) do { __builtin_amdgcn_s_setprio(1); \
    _Pragma("unroll") for (int m = 0; m < 4; ++m) _Pragma("unroll") for (int n = 0; n < 2; ++n) _Pragma("unroll") for (int k = 0; k < 2; ++k) \
      acc[ai][bj][m][n] = __builtin_amdgcn_mfma_f32_16x16x32_bf16(At[m][k], Bt_[n][k], acc[ai][bj][m][n], 0, 0, 0); \
    __builtin_amdgcn_s_setprio(0); } while (0)
#define WAIT_V(n) asm volatile("s_waitcnt vmcnt(" #n ")" ::: "memory")
#define WAIT_L(n) asm volatile("s_waitcnt lgkmcnt(" #n ")" ::: "memory")
#define BAR __builtin_amdgcn_s_barrier()
#define SCHED __builtin_amdgcn_sched_barrier(0)
  const int nM = T_TOK / BM, nN = N / BM, nwg = nM * nN;
  const int wid = wv, lane = tidx & 63, wr = wid >> 2, wc = wid & 3, fr = lane & 15, fq = lane >> 4;
  const int nt = K / BK;
  unsigned soff0, soff1; const int sl0 = tidx * 16;
  { int _r, _c; stage_rc(sl0, _r, _c); soff0 = (unsigned)(_r * K + _c); stage_rc(sl0 + 8192, _r, _c); soff1 = (unsigned)(_r * K + _c); }
  for (int tile = blockIdx.x; tile < nwg; tile += gridDim.x) {
    int wgt = tile;
    { const int q = nwg / 8, r = nwg % 8, xcd = wgt % 8, off = wgt / 8;
      wgt = (xcd < r ? xcd * (q + 1) : r * (q + 1) + (xcd - r) * q) + off; }
    const int nig = WGM * nN, gid = wgt / nig, fm = gid * WGM, gsz = min(nM - fm, WGM);
    const int pm = fm + ((wgt % nig) % gsz), pn = (wgt % nig) / gsz, brow = pm * BM, bcol = pn * BM;
    f32x4 acc[2][2][4][2] = {};
    bf16x8 At[4][2], B0[2][2], B1[2][2];
    STAGE(SB(0, 0), Bt, bcol, 0); STAGE(SA(0, 0), A, brow, 0);
    STAGE(SB(0, 1), Bt, bcol + HALF, 0); STAGE(SA(0, 1), A, brow + HALF, 0);
    if (wr == 1) BAR;
    WAIT_V(4); BAR;
    STAGE(SB(1, 0), Bt, bcol, 1); STAGE(SA(1, 0), A, brow, 1); STAGE(SB(1, 1), Bt, bcol + HALF, 1);
    WAIT_V(6); BAR;
    for (int t = 0; t < nt - 2; t += 2) {
      LDB(B0, 0, 0); SCHED; LDA(At, 0, 0); STAGE(SA(1, 1), A, brow + HALF, t + 1);
      WAIT_L(8); BAR; WAIT_L(0); MMA(0, 0, At, B0); BAR; SCHED;
      LDB(B1, 0, 1); STAGE(SB(0, 0), Bt, bcol, t + 2);
      BAR; WAIT_L(0); MMA(0, 1, At, B1); BAR;
      LDA(At, 0, 1); STAGE(SA(0, 0), A, brow, t + 2);
      BAR; WAIT_L(0); MMA(1, 0, At, B0); BAR; SCHED;
      STAGE(SB(0, 1), Bt, bcol + HALF, t + 2);
      WAIT_V(6); BAR; MMA(1, 1, At, B1); BAR;
      LDB(B0, 1, 0); SCHED; LDA(At, 1, 0); STAGE(SA(0, 1), A, brow + HALF, t + 2);
      WAIT_L(8); BAR; WAIT_L(0); MMA(0, 0, At, B0); BAR; SCHED;
      LDB(B1, 1, 1); STAGE(SB(1, 0), Bt, bcol, t + 3);
      BAR; WAIT_L(0); MMA(0, 1, At, B1); BAR;
      LDA(At, 1, 1); STAGE(SA(1, 0), A, brow, t + 3);
      BAR; WAIT_L(0); MMA(1, 0, At, B0); BAR; SCHED;
      STAGE(SB(1, 1), Bt, bcol + HALF, t + 3);
      WAIT_V(6); BAR; MMA(1, 1, At, B1); BAR;
    }
    { LDB(B0, 0, 0); LDA(At, 0, 0); STAGE(SA(1, 1), A, brow + HALF, nt - 1);
      BAR; WAIT_L(0); MMA(0, 0, At, B0); BAR;
      LDB(B1, 0, 1); BAR; WAIT_L(0); MMA(0, 1, At, B1); BAR;
      LDA(At, 0, 1); WAIT_V(4); BAR; WAIT_L(0); MMA(1, 0, At, B0); MMA(1, 1, At, B1); BAR; }
    { LDB(B0, 1, 0); LDA(At, 1, 0); WAIT_V(2); BAR; WAIT_L(0); MMA(0, 0, At, B0); BAR;
      LDB(B1, 1, 1); WAIT_V(0); BAR; WAIT_L(0); MMA(0, 1, At, B1); BAR;
      LDA(At, 1, 1); BAR; WAIT_L(0); MMA(1, 0, At, B0); MMA(1, 1, At, B1); BAR; }
    if (wr == 0) BAR;
    {
      const int le = llane();
      const int fr = le & 15, fq = le >> 4;
      const long base = (long)(brow + wr * 64) * LDC + bcol + wc * 32 + (unsigned)(fq * 4 * LDC + fr);
      if (MODE == 0 || (MODE == 2 && pn < 16)) {
        bf16_t* cp = (bf16_t*)Cout + base;
#pragma unroll
        for (int ai = 0; ai < 2; ++ai)
#pragma unroll
          for (int m = 0; m < 4; ++m)
#pragma unroll
            for (int j = 0; j < 4; ++j) {
              bf16_t* rp = cp + (ai * HALF + m * 16 + j) * LDC;
#pragma unroll
              for (int bj = 0; bj < 2; ++bj)
#pragma unroll
                for (int n = 0; n < 2; ++n) rp[bj * HALF + n * 16] = f2bf(acc[ai][bj][m][n][j]);
            }
      } else if (MODE == 1) {
        float* cp = (float*)Cout + base;
#pragma unroll
        for (int ai = 0; ai < 2; ++ai)
#pragma unroll
          for (int m = 0; m < 4; ++m)
#pragma unroll
            for (int j = 0; j < 4; ++j) {
              float* rp = cp + (ai * HALF + m * 16 + j) * LDC;
#pragma unroll
              for (int bj = 0; bj < 2; ++bj)
#pragma unroll
                for (int n = 0; n < 2; ++n) rp[bj * HALF + n * 16] = acc[ai][bj][m][n][j];
            }
      } else {
        if (wc == 0) {
          float* gp = GT + (long)(brow + wr * 64) * 32 + (unsigned)(fq * 4 * 32 + fr);
#pragma unroll
          for (int ai = 0; ai < 2; ++ai)
#pragma unroll
            for (int m = 0; m < 4; ++m)
#pragma unroll
              for (int j = 0; j < 4; ++j)
#pragma unroll
                for (int n = 0; n < 2; ++n) gp[(ai * HALF + m * 16 + j) * 32 + n * 16] = acc[ai][0][m][n][j];
        }
      }
    }
    __syncthreads();
  }
#undef SA
#undef SB
#undef STAGE
#undef LDA
#undef LDB
#undef MMA
}

__device__ __forceinline__ void gates_phase(const int wv, const bf16_t* __restrict__ A, const bf16_t* __restrict__ Wg, float* __restrict__ GT) {
  const int lane = llane();
  const int fr = lane & 15, fq = lane >> 4;
  for (int mt = wv * (int)gridDim.x + (int)blockIdx.x; mt < T_TOK / 16; mt += 8 * (int)gridDim.x) {
    const bf16_t* ap = A + (long)(mt * 16 + fr) * 1024 + fq * 8;
    const bf16_t* b0p = Wg + (long)fr * 1024 + fq * 8;
    const bf16_t* b1p = Wg + (long)(16 + fr) * 1024 + fq * 8;
    f32x4 acc0 = {0.f, 0.f, 0.f, 0.f}, acc1 = {0.f, 0.f, 0.f, 0.f};
#pragma unroll 8
    for (int k0 = 0; k0 < 1024; k0 += 32) {
      const bf16x8 a = *reinterpret_cast<const bf16x8*>(ap + k0);
      const bf16x8 b0 = *reinterpret_cast<const bf16x8*>(b0p + k0);
      const bf16x8 b1 = *reinterpret_cast<const bf16x8*>(b1p + k0);
      acc0 = __builtin_amdgcn_mfma_f32_16x16x32_bf16(a, b0, acc0, 0, 0, 0);
      acc1 = __builtin_amdgcn_mfma_f32_16x16x32_bf16(a, b1, acc1, 0, 0, 0);
    }
#pragma unroll
    for (int j = 0; j < 4; ++j) {
      GT[(long)(mt * 16 + fq * 4 + j) * 32 + fr] = acc0[j];
      GT[(long)(mt * 16 + fq * 4 + j) * 32 + 16 + fr] = acc1[j];
    }
  }
}

__device__ __forceinline__ void post_inproj0(const int wv, const Params& p, const int zq, const bf16_t* __restrict__ P0, bf16_t* __restrict__ QA, bf16_t* __restrict__ KA,
                                             bf16_t* __restrict__ VA, float* __restrict__ VV, bf16_t* __restrict__ X0) {
  const int tidx = ltid(wv);
  const int wid = wv, lane = tidx & 63;
  const float* qn = p.in[zq + 21]; const float* kn = p.in[zq + 22]; const float* cw = p.in[zq + 23]; const float* cb = p.in[zq + 24];
  float* outK = p.out + O_K; float* outV = p.out + O_V;
  for (int i = blockIdx.x * 512 + tidx; i < 2 * 512 * 256 / 4; i += gridDim.x * 512) {
    int e = i * 4; int b = e / (512 * 256), rem = e % (512 * 256);
    float4 kk = *(const float4*)(p.in[zq + 2] + e); float4 vv = *(const float4*)(p.in[zq + 3] + e);
    long d = (long)(8192 + b * 2560 + 2048) * 256 + rem;
    u32x2 wk = {cvtpk(kk.x, kk.y), cvtpk(kk.z, kk.w)}; u32x2 wv = {cvtpk(vv.x, vv.y), cvtpk(vv.z, vv.w)};
    *(u32x2*)(KA + d) = wk; *(u32x2*)(VA + d) = wv;
  }
  const int fi = lane & 31;
  const float inv = exp2f(-(float)fi * (13.287712379549449f / 32.f));
  for (int row = blockIdx.x * 8 + wid; row < T_TOK; row += gridDim.x * 8) {
    const bool samp = row >= TPR;
    const int L = samp ? 2048 : 256;
    const int tl = samp ? (row - TPR) % 2048 : row % 256;
    const long krow = samp ? (long)(8192 + ((row - TPR) / 2048) * 2560 + tl) : (long)row;
    const bf16_t* base = P0 + (long)row * 2560;
    float cs = 1.f, sn = 0.f;
    if (samp) { float pos = (lane < 32) ? (float)(tl / 64) : (float)(tl % 64); float ang = pos * inv; cs = cosf(ang); sn = sinf(ang); }
#pragma unroll
    for (int hh = 0; hh < 6; ++hh) {
      float x1 = bf2f(base[hh * 128 + lane]), x2 = bf2f(base[hh * 128 + 64 + lane]);
      float ss = wave_sum(x1 * x1 + x2 * x2);
      float rs = rsqrtf(ss * (1.f / 128.f) + 1e-6f);
      const float* gw = hh < 4 ? qn : kn;
      float y1 = x1 * rs * gw[lane], y2 = x2 * rs * gw[64 + lane];
      if (hh >= 4 && !samp) { outK[(long)row * 256 + (hh - 4) * 128 + lane] = y1; outK[(long)row * 256 + (hh - 4) * 128 + 64 + lane] = y2; }
      float o1 = y1 * cs - y2 * sn, o2 = y1 * sn + y2 * cs;
      if (hh < 4) { QA[(long)row * 512 + hh * 128 + lane] = f2bf(o1); QA[(long)row * 512 + hh * 128 + 64 + lane] = f2bf(o2); }
      else { KA[krow * 256 + (hh - 4) * 128 + lane] = f2bf(o1); KA[krow * 256 + (hh - 4) * 128 + 64 + lane] = f2bf(o2); }
    }
    {
      u32x2 w = *(const u32x2*)(base + 768 + lane * 4);
      *(u32x2*)(VA + krow * 256 + lane * 4) = w;
      if (!samp) { float4 f = make_float4(bflo(w[0]), bfhi(w[0]), bflo(w[1]), bfhi(w[1])); *(float4*)(outV + (long)row * 256 + lane * 4) = f; }
    }
    {
      const int c8 = lane * 8;
      float uc[3][8];
#pragma unroll
      for (int g = 0; g < 3; ++g) {
        const int col = g * 512 + c8;
        float um[8], u0[8], up[8];
        u32x4 z4 = {0u, 0u, 0u, 0u};
        u32x4 wm = (tl > 0) ? *(const u32x4*)(base - 2560 + 1024 + col) : z4;
        u32x4 w0 = *(const u32x4*)(base + 1024 + col);
        u32x4 wp = (tl < L - 1) ? *(const u32x4*)(base + 2560 + 1024 + col) : z4;
        unpack8(wm, um); unpack8(w0, u0); unpack8(wp, up);
#pragma unroll
        for (int e = 0; e < 8; ++e)
          uc[g][e] = cw[col + e] * um[e] + cw[1536 + col + e] * u0[e] + cw[3072 + col + e] * up[e] + cb[col + e];
      }
      float vvv[8];
#pragma unroll
      for (int e = 0; e < 8; ++e) vvv[e] = uc[2][e] * uc[1][e];
      *(float4*)(VV + (long)row * 512 + c8) = make_float4(vvv[0], vvv[1], vvv[2], vvv[3]);
      *(float4*)(VV + (long)row * 512 + c8 + 4) = make_float4(vvv[4], vvv[5], vvv[6], vvv[7]);
      *(u32x4*)(X0 + (long)row * 512 + c8) = pack8(uc[0]);
    }
  }
}

constexpr int AD = 128, ANW = 8, QBLK = 32, KVBLK = 64;
constexpr float ASCALE = 0.088388347648318440f;
constexpr float ATHR = 8.f;
constexpr int LDQ = 512, LDK = 256, LDO = 1024;
constexpr size_t SHM_V = KVBLK * AD * 2, SHM_K = KVBLK * AD * 2;
#define KSWZ(row, colB) ((row) * 256 + ((colB) ^ (((row) & 7) << 4)))
#define SBAR() __builtin_amdgcn_sched_barrier(0)

__device__ __forceinline__ void partialSM(f32x16& p0, f32x16& p1, float& m_reg, float& mn, float& alpha) {
  constexpr float C = ASCALE * 1.4426950408889634f;
  float pmax = p0[0];
#pragma unroll
  for (int r = 1; r < 16; ++r) pmax = fmaxf(pmax, p0[r]);
#pragma unroll
  for (int r = 0; r < 16; ++r) pmax = fmaxf(pmax, p1[r]);
  { auto rr = __builtin_amdgcn_permlane32_swap(__float_as_uint(pmax), __float_as_uint(pmax), false, false);
    pmax = fmaxf(__uint_as_float(rr[0]), __uint_as_float(rr[1])); }
  if (__builtin_expect(__all(pmax - m_reg <= ATHR / ASCALE), 1)) { mn = m_reg; alpha = 1.f; }
  else { mn = fmaxf(m_reg, pmax); alpha = __builtin_amdgcn_exp2f((m_reg - mn) * C); m_reg = mn; }
  float mnC = -mn * C;
#pragma unroll
  for (int r = 0; r < 16; ++r) p0[r] = fmaf(p0[r], C, mnC);
#pragma unroll
  for (int r = 0; r < 16; ++r) p1[r] = fmaf(p1[r], C, mnC);
#pragma unroll
  for (int r = 0; r < 16; ++r) p0[r] = __builtin_amdgcn_exp2f(p0[r]);
}
__device__ __forceinline__ void finishSM(f32x16& p0, f32x16& p1, float alpha, float& l_reg, bf16x8& pa0, bf16x8& pa1, bf16x8& pa2, bf16x8& pa3) {
#pragma unroll
  for (int r = 0; r < 16; ++r) p1[r] = __builtin_amdgcn_exp2f(p1[r]);
  float ps = 0;
#pragma unroll
  for (int r = 0; r < 16; ++r) ps += p0[r];
#pragma unroll
  for (int r = 0; r < 16; ++r) ps += p1[r];
  { auto rr = __builtin_amdgcn_permlane32_swap(__float_as_uint(ps), __float_as_uint(ps), false, false);
    ps = __uint_as_float(rr[0]) + __uint_as_float(rr[1]); }
  l_reg = l_reg * alpha + ps;
#define PK4(P, BASE, OUT) do { unsigned a0 = cvtpk(P[BASE + 0], P[BASE + 1]), a1 = cvtpk(P[BASE + 2], P[BASE + 3]);   \
    unsigned b0 = cvtpk(P[BASE + 4], P[BASE + 5]), b1 = cvtpk(P[BASE + 6], P[BASE + 7]);                              \
    auto r0 = __builtin_amdgcn_permlane32_swap(a0, b0, false, false); auto r1 = __builtin_amdgcn_permlane32_swap(a1, b1, false, false); \
    u32x4 w = {r0[0], r1[0], r0[1], r1[1]}; OUT = *reinterpret_cast<bf16x8*>(&w); } while (0)
  PK4(p0, 0, pa0); PK4(p0, 8, pa1); PK4(p1, 0, pa2); PK4(p1, 8, pa3);
#undef PK4
}
__device__ __forceinline__ void qkt(f32x16& p0, f32x16& p1, const bf16_t* Ks, const bf16x8* qr, int r32, int hi) {
  p0 = f32x16{}; p1 = f32x16{};
#pragma unroll
  for (int d0 = 0; d0 < 8; ++d0) { int cb = (d0 * 16 + hi * 8) * 2;
    bf16x8 b0 = *reinterpret_cast<const bf16x8*>((const char*)Ks + KSWZ(r32, cb));
    bf16x8 b1 = *reinterpret_cast<const bf16x8*>((const char*)Ks + KSWZ(32 + r32, cb));
    p0 = __builtin_amdgcn_mfma_f32_32x32x16_bf16(b0, qr[d0], p0, 0, 0, 0);
    p1 = __builtin_amdgcn_mfma_f32_32x32x16_bf16(b1, qr[d0], p1, 0, 0, 0); }
}
__device__ __forceinline__ int v_st(int k, int c) { const int kk = (k & ~0xC) | ((k & 4) << 1) | ((k & 8) >> 1); return ((kk >> 3) * 4 + (c >> 5)) * 512 + ((kk & 7) * 32 + (c & 31)) * 2; }
__device__ __forceinline__ int v_rd_base(int lane) { return ((lane & 3) << 3) | (((lane >> 2) & 3) << 6) | (((lane >> 4) & 1) << 5) | (((lane >> 5) & 1) << 8); }
constexpr int v_rd_off(int d0, int ks, int half) { return d0 * 512 + ks * 4096 + half * 2048; }
template <int OFF> __device__ __forceinline__ s16x4 tr_read(int vb) {
  s16x4 r; asm volatile("ds_read_b64_tr_b16 %0, %1 offset:%2" : "=&v"(r) : "v"(vb), "i"(OFF) : "memory"); return r;
}
template <int D0> __device__ __forceinline__ void pv_one(f32x16& od, int vb, bf16x8 pa0, bf16x8 pa1, bf16x8 pa2, bf16x8 pa3) {
  const s16x4 l0 = tr_read<v_rd_off(D0, 0, 0)>(vb), h0 = tr_read<v_rd_off(D0, 0, 1)>(vb), l1 = tr_read<v_rd_off(D0, 1, 0)>(vb), h1 = tr_read<v_rd_off(D0, 1, 1)>(vb);
  const s16x4 l2 = tr_read<v_rd_off(D0, 2, 0)>(vb), h2 = tr_read<v_rd_off(D0, 2, 1)>(vb), l3 = tr_read<v_rd_off(D0, 3, 0)>(vb), h3 = tr_read<v_rd_off(D0, 3, 1)>(vb);
  asm volatile("s_waitcnt lgkmcnt(0)" ::: "memory"); SBAR();
#define PK(L, H) (bf16x8){L[0], L[1], L[2], L[3], H[0], H[1], H[2], H[3]}
  od = __builtin_amdgcn_mfma_f32_32x32x16_bf16(pa0, PK(l0, h0), od, 0, 0, 0);
  od = __builtin_amdgcn_mfma_f32_32x32x16_bf16(pa1, PK(l1, h1), od, 0, 0, 0);
  od = __builtin_amdgcn_mfma_f32_32x32x16_bf16(pa2, PK(l2, h2), od, 0, 0, 0);
  od = __builtin_amdgcn_mfma_f32_32x32x16_bf16(pa3, PK(l3, h3), od, 0, 0, 0);
#undef PK
}
__device__ __forceinline__ void pv_d0(f32x16* o, int vb, bf16x8 pa0, bf16x8 pa1, bf16x8 pa2, bf16x8 pa3) {
  pv_one<0>(o[0], vb, pa0, pa1, pa2, pa3); pv_one<1>(o[1], vb, pa0, pa1, pa2, pa3); pv_one<2>(o[2], vb, pa0, pa1, pa2, pa3); pv_one<3>(o[3], vb, pa0, pa1, pa2, pa3);
}

__device__ __forceinline__ void attn_dense_body(const int wv, const bf16_t* __restrict__ Qb, const bf16_t* __restrict__ Kh, const bf16_t* __restrict__ Vh,
                                                bf16_t* __restrict__ Ob, int seq, char* lds) {
  const int tidx = ltid(wv);
  const int tid = tidx, wid = wv, lane = tid & 63, r32 = lane & 31, hi = lane >> 5;
  bf16_t* V_lds = (bf16_t*)lds; bf16_t* K_lds = (bf16_t*)(lds + 2 * SHM_V);
  float* ws = (float*)(lds + 2 * SHM_V + 2 * SHM_K) + wid * 64; float* li_l = ws; float* al_l = ws + 32;
  float m_reg = -1e30f, l_reg = 0; f32x16 o[4] = {}; bf16x8 qr[8];
  const bf16_t* Qw = Qb + (long)(wid * QBLK + r32) * LDQ + hi * 8;
#pragma unroll
  for (int d0 = 0; d0 < 8; ++d0) qr[d0] = *reinterpret_cast<const bf16x8*>(Qw + d0 * 16);
  const int sr = tid >> 4, sc = (tid & 15) * 8, vst0 = v_st(sr, sc), vst1 = v_st(32 + sr, sc);
  const int vb0 = (int)(uintptr_t)V_lds + v_rd_base(lane);
  bf16x8 sA_vs0, sA_vs1, sA_ks0, sA_ks1, sB_vs0, sB_vs1, sB_ks0, sB_ks1;
#define SLOADA(k0) do { sA_vs0 = *(const bf16x8*)(&Vh[(long)((k0) + sr) * LDK + sc]); sA_vs1 = *(const bf16x8*)(&Vh[(long)((k0) + 32 + sr) * LDK + sc]); \
    sA_ks0 = *(const bf16x8*)(&Kh[(long)((k0) + sr) * LDK + sc]); sA_ks1 = *(const bf16x8*)(&Kh[(long)((k0) + 32 + sr) * LDK + sc]); } while (0)
#define SLOADB(k0) do { sB_vs0 = *(const bf16x8*)(&Vh[(long)((k0) + sr) * LDK + sc]); sB_vs1 = *(const bf16x8*)(&Vh[(long)((k0) + 32 + sr) * LDK + sc]); \
    sB_ks0 = *(const bf16x8*)(&Kh[(long)((k0) + sr) * LDK + sc]); sB_ks1 = *(const bf16x8*)(&Kh[(long)((k0) + 32 + sr) * LDK + sc]); } while (0)
#define SWRITEA(b) do { *(bf16x8*)((char*)V_lds + (b) * SHM_V + vst0) = sA_vs0; *(bf16x8*)((char*)V_lds + (b) * SHM_V + vst1) = sA_vs1; int kc = sc * 2; \
    *(bf16x8*)((char*)K_lds + (b) * SHM_K + KSWZ(sr, kc)) = sA_ks0; *(bf16x8*)((char*)K_lds + (b) * SHM_K + KSWZ(32 + sr, kc)) = sA_ks1; } while (0)
#define SWRITEB(b) do { *(bf16x8*)((char*)V_lds + (b) * SHM_V + vst0) = sB_vs0; *(bf16x8*)((char*)V_lds + (b) * SHM_V + vst1) = sB_vs1; int kc = sc * 2; \
    *(bf16x8*)((char*)K_lds + (b) * SHM_K + KSWZ(sr, kc)) = sB_ks0; *(bf16x8*)((char*)K_lds + (b) * SHM_K + KSWZ(32 + sr, kc)) = sB_ks1; } while (0)
#define SWAIT() asm volatile("s_waitcnt vmcnt(4)" ::: "memory")
#define RESC(a) do { if (__any((a) < 1.f)) { if (hi == 0) al_l[r32] = (a); asm volatile("s_waitcnt lgkmcnt(0)" ::: "memory"); \
    _Pragma("unroll") for (int d = 0; d < 4; ++d) _Pragma("unroll") for (int r = 0; r < 16; ++r) o[d][r] *= al_l[crow(r, hi)]; } } while (0)
  f32x16 pA0, pA1, pB0, pB1; float mnA, mnB, alA, alB; bf16x8 pa0, pa1, pa2, pa3; const int NT = seq / KVBLK;
  SLOADA(0); asm volatile("s_waitcnt vmcnt(0)" ::: "memory"); SWRITEA(0); __syncthreads();
  qkt(pA0, pA1, K_lds, qr, r32, hi); partialSM(pA0, pA1, m_reg, mnA, alA);
  SLOADB(KVBLK); if (2 < NT) SLOADA(2 * KVBLK);
  SWAIT(); SWRITEB(1); __syncthreads();
  for (int j = 1; j + 1 < NT; j += 2) {
    SBAR(); qkt(pB0, pB1, (bf16_t*)((char*)K_lds + SHM_K), qr, r32, hi);
    finishSM(pA0, pA1, alA, l_reg, pa0, pa1, pa2, pa3); SBAR();
    SLOADB((j + 2) * KVBLK); SBAR();
    pv_d0(o, vb0, pa0, pa1, pa2, pa3); partialSM(pB0, pB1, m_reg, mnB, alB);
    __syncthreads(); SWAIT(); SWRITEA(0);
    RESC(alB); __syncthreads();
    SBAR(); qkt(pA0, pA1, K_lds, qr, r32, hi);
    finishSM(pB0, pB1, alB, l_reg, pa0, pa1, pa2, pa3); SBAR();
    if (j + 3 < NT) SLOADA((j + 3) * KVBLK); SBAR();
    pv_d0(o, vb0 + (int)SHM_V, pa0, pa1, pa2, pa3); partialSM(pA0, pA1, m_reg, mnA, alA);
    __syncthreads(); SWAIT(); SWRITEB(1);
    RESC(alA); __syncthreads();
  }
  SBAR(); qkt(pB0, pB1, (bf16_t*)((char*)K_lds + SHM_K), qr, r32, hi);
  finishSM(pA0, pA1, alA, l_reg, pa0, pa1, pa2, pa3); SBAR();
  pv_d0(o, vb0, pa0, pa1, pa2, pa3); partialSM(pB0, pB1, m_reg, mnB, alB);
  __syncthreads(); RESC(alB);
  finishSM(pB0, pB1, alB, l_reg, pa0, pa1, pa2, pa3); SBAR();
  pv_d0(o, vb0 + (int)SHM_V, pa0, pa1, pa2, pa3);
  if (hi == 0) li_l[r32] = l_reg; asm volatile("s_waitcnt lgkmcnt(0)" ::: "memory");
  float rli[16];
#pragma unroll
  for (int r = 0; r < 16; ++r) rli[r] = __builtin_amdgcn_rcpf(li_l[crow(r, hi)]);
  bf16_t* Ow = Ob + (long)(wid * QBLK) * LDO;
#pragma unroll
  for (int r = 0; r < 16; ++r) { int orow = crow(r, hi);
#pragma unroll
    for (int d0 = 0; d0 < 4; ++d0) Ow[(long)orow * LDO + d0 * 32 + r32] = f2bf(o[d0][r] * rli[r]); }
#undef SLOADA
#undef SLOADB
#undef SWRITEA
#undef SWRITEB
#undef SWAIT
#undef RESC
}

__device__ __forceinline__ void hyena_item(const float* __restrict__ Fu, const float* __restrict__ Vu, const bf16_t* __restrict__ Xu,
                                           bf16_t* __restrict__ Au, int L, int t0, unsigned ln) {
  float y[16], ring[16];
#pragma unroll
  for (int i = 0; i < 16; ++i) { y[i] = 0.f; const float* fr = Fu + (long)(t0 + i + L - 1) * 512; ring[i] = fr[ln]; }
  const float* fp = Fu + (long)(t0 + L - 2) * 512;
  float va[16], fa[16], vb[16], fb[16];
#define HY_LOAD(V, Fq, S) _Pragma("unroll") for (int j = 0; j < 16; ++j) { const float* vr_ = Vu + (long)((S) + j) * 512; const float* fr_ = fp - (long)((S) + j) * 512; V[j] = vr_[ln]; Fq[j] = fr_[ln]; }
#define HY_STEP(V, Fq) _Pragma("unroll") for (int j = 0; j < 16; ++j) { const float vs = V[j]; \
    _Pragma("unroll") for (int i = 0; i < 16; ++i) y[i] += ring[(i - j) & 15] * vs; ring[(15 - j) & 15] = Fq[j]; }
  HY_LOAD(va, fa, 0)
  for (int s0 = 0; s0 < L; s0 += 32) {
    HY_LOAD(vb, fb, s0 + 16)
    HY_STEP(va, fa)
    if (s0 + 32 < L) { HY_LOAD(va, fa, s0 + 32) }
    HY_STEP(vb, fb)
  }
#undef HY_LOAD
#undef HY_STEP
#pragma unroll
  for (int i = 0; i < 16; ++i) {
    const bf16_t* xr = Xu + (long)(t0 + i) * 512; bf16_t* ar = Au + (long)(t0 + i) * 1024;
    ar[ln] = f2bf(y[i] * bf2f(xr[ln]));
  }
}

__device__ __forceinline__ void mix0_phase(const int wv, const Params& p, const int zq, const bf16_t* QA, const bf16_t* KA, const bf16_t* VA, const float* VV,
                                           const bf16_t* X0, const float* F256, const float* F2048, bf16_t* AO) {
  extern __shared__ __attribute__((aligned(16))) char shm_raw[];
#ifndef NO_ATTN
  for (int it = blockIdx.x; it < 192; it += gridDim.x) {
    long rowb, krow; int h, seqk;
    if (it < 64) { const int qb = it % 8, b = it / 32; h = (it / 8) % 4; rowb = 8192 + (long)b * 2048 + qb * 256; krow = 8192 + (long)b * 2560; seqk = 2560; }
    else { const int j = it - 64; const int b = j / 4; h = j % 4; rowb = (long)b * 256; krow = rowb; seqk = 256; }
    __syncthreads();
    attn_dense_body(wv, QA + rowb * 512 + h * 128, KA + krow * 256 + (h >> 1) * 128, VA + krow * 256 + (h >> 1) * 128, AO + rowb * 1024 + h * 128, seqk, shm_raw);
  }
#endif
#ifndef NO_HYENA
  const int lane = llane(); const int wid = wv;
  {
    unsigned* qctr = (unsigned*)(p.ws + WS_END) + 768;
    volatile int* sidx = (volatile int*)(shm_raw + 120000);
    for (;;) {
      __syncthreads();
      if (ltid(wv) == 0) *sidx = (int)__hip_atomic_fetch_add(qctr, 1u, __ATOMIC_RELAXED, __HIP_MEMORY_SCOPE_AGENT);
      __syncthreads();
      const int it = __builtin_amdgcn_readfirstlane(*sidx);
      if (it >= 768) break;
      if (it < 256) {
        const int b = it / 128, cgp = (it / 16) % 8, tg = it % 16;
        { const long rb = 8192 + (long)b * 2048; hyena_item(F2048 + cgp * 64, VV + rb * 512 + cgp * 64, X0 + rb * 512 + cgp * 64, AO + rb * 1024 + 512 + cgp * 64, 2048, tg * 128 + wid * 16, (unsigned)lane); }
      } else {
        const int jj = it - 256; const int b = jj / 16, cgp = (jj / 2) % 8, tg = jj % 2;
        { const long rb = (long)b * 256; hyena_item(F256 + cgp * 64, VV + rb * 512 + cgp * 64, X0 + rb * 512 + cgp * 64, AO + rb * 1024 + 512 + cgp * 64, 256, tg * 128 + wid * 16, (unsigned)lane); }
      }
    }
  }
#endif
  __syncthreads();
}

__device__ __forceinline__ float erf_as(float x) {
  const float ax = fabsf(x);
  const float t = __builtin_amdgcn_rcpf(fmaf(0.3275911f, ax, 1.f));
  float p = fmaf(1.061405429f, t, -1.453152027f);
  p = fmaf(p, t, 1.421413741f); p = fmaf(p, t, -0.284496736f); p = fmaf(p, t, 0.254829592f);
  const float r = 1.f - p * t * __expf(-ax * ax);
  return copysignf(r, x);
}
__device__ __forceinline__ float gelu_f(float x) { return 0.5f * x * (1.f + erf_as(x * 0.70710678118654752f)); }
__device__ __forceinline__ void ffn_act_phase(const int wv, const bf16_t* __restrict__ P, const float* __restrict__ cw, const float* __restrict__ cb, bf16_t* __restrict__ G) {
  const int tidx = ltid(wv);
  const int tid = tidx;
  if (tid >= 352) return;
  const int c8 = tid * 8;
  float w1[3][8], w2[3][8], b1[8], b2[8];
#pragma unroll
  for (int e = 0; e < 8; ++e) {
#pragma unroll
    for (int k = 0; k < 3; ++k) { w1[k][e] = cw[k * 5632 + c8 + e]; w2[k][e] = cw[k * 5632 + 2816 + c8 + e]; }
    b1[e] = cb[c8 + e]; b2[e] = cb[2816 + c8 + e];
  }
  for (int item = blockIdx.x; item < T_TOK / 16; item += gridDim.x) {
    const int r0 = item * 16;
    const int L = r0 < TPR ? 256 : 2048;
    const int tl0 = r0 < TPR ? r0 % 256 : (r0 - TPR) % 2048;
    float am[8], a0[8], ap[8], gm[8], g0[8], gp[8];
    const u32x4 z4 = {0u, 0u, 0u, 0u};
    {
      const bf16_t* b = P + (long)r0 * 5632 + c8;
      u32x4 x = (tl0 > 0) ? *(const u32x4*)(b - 5632) : z4; unpack8(x, am);
      x = (tl0 > 0) ? *(const u32x4*)(b - 5632 + 2816) : z4; unpack8(x, gm);
      x = *(const u32x4*)(b); unpack8(x, a0);
      x = *(const u32x4*)(b + 2816); unpack8(x, g0);
    }
    for (int r = 0; r < 16; ++r) {
      const bf16_t* b = P + (long)(r0 + r) * 5632 + c8;
      const bool vn = (tl0 + r) < L - 1;
      u32x4 x = vn ? *(const u32x4*)(b + 5632) : z4; unpack8(x, ap);
      x = vn ? *(const u32x4*)(b + 5632 + 2816) : z4; unpack8(x, gp);
      float o[8];
#pragma unroll
      for (int e = 0; e < 8; ++e) {
        float h1 = w1[0][e] * am[e] + w1[1][e] * a0[e] + w1[2][e] * ap[e] + b1[e];
        float h2 = w2[0][e] * gm[e] + w2[1][e] * g0[e] + w2[2][e] * gp[e] + b2[e];
        o[e] = gelu_f(h1) * h2;
        am[e] = a0[e]; a0[e] = ap[e]; gm[e] = g0[e]; g0[e] = gp[e];
      }
      *(u32x4*)(G + (long)(r0 + r) * 2816 + c8) = pack8(o);
    }
  }
}

template <int K>
__device__ __forceinline__ f32x16 mma_nt(const bf16_t* A, int lda, const bf16_t* B, int ldb, f32x16 acc, int r32, int hi) {
  bf16x8 a[K / 16], b[K / 16];
#pragma unroll
  for (int k0 = 0; k0 < K / 16; ++k0) {
    a[k0] = *reinterpret_cast<const bf16x8*>(A + r32 * lda + k0 * 16 + 8 * hi);
    b[k0] = *reinterpret_cast<const bf16x8*>(B + r32 * ldb + k0 * 16 + 8 * hi);
  }
#pragma unroll
  for (int k0 = 0; k0 < K / 16; ++k0) acc = __builtin_amdgcn_mfma_f32_32x32x16_bf16(a[k0], b[k0], acc, 0, 0, 0);
  return acc;
}

__device__ __forceinline__ void mlstm_phase(const int wv, const Params& p, const int zq, const bf16_t* __restrict__ P1, const float* __restrict__ GT,
                                            bf16_t* __restrict__ HF, bf16_t* __restrict__ HB,
                                            bf16_t* DC, float* DN, float* SC, const int pass) {
  const int tidx = ltid(wv);
  extern __shared__ __attribute__((aligned(16))) char shm_raw[];
  bf16_t* Qs = (bf16_t*)shm_raw;
  bf16_t* Ks = Qs + 64 * 136;
  bf16_t* KwT = Ks + 64 * 136;
  bf16_t* VsT = KwT + 128 * 72;
  bf16_t* Wb = VsT + 128 * 72;
  bf16_t* Cb = Wb + 64 * 72;
  float* gbuf = (float*)(Cb + 128 * 136);
  float* sclv = gbuf + 400; float* wintv = sclv + 64; float* nvec = wintv + 64;
  float* cwl = nvec + 128;
  const int tid = tidx, wid = wv, lane = tid & 63, r32 = lane & 31, hi = lane >> 5;
  const float* cw = p.in[zq + 35]; const float* cbias = p.in[zq + 36]; const float* bg = p.in[zq + 34];
  const int nitems = pass == 0 ? 1536 : 1024;
  for (int it = blockIdx.x; it < nitems; it += gridDim.x) {
    int mode, seq, h, dir, c0, c1, su = 0;
    if (pass == 0 && it < 512) { mode = 0; seq = it / 16; h = (it / 2) % 8; dir = it % 2; c0 = 0; c1 = 4; }
    else { su = pass == 0 ? it - 512 : it; const int sidx = su >> 5; mode = pass == 0 ? 1 : 2;
           seq = 32 + sidx / 16; h = (sidx / 2) % 8; dir = sidx % 2; c0 = su & 31; c1 = c0 + 1; }
    const bool do_out = mode != 1;
    const int L = seq < 32 ? 256 : 2048;
    const long rowbase = seq < 32 ? (long)seq * 256 : 8192 + (long)(seq - 32) * 2048;
    __syncthreads();
    f32x16 cacc[2]; float m = (mode == 1) ? -1e30f : 0.f;
    const int vb2 = wid >> 1;
#pragma unroll
    for (int i = 0; i < 2; ++i)
#pragma unroll
      for (int r = 0; r < 16; ++r) cacc[i][r] = 0.f;
    if (mode == 2) {
#pragma unroll
      for (int i = 0; i < 4; ++i) { const int id = tid + 512 * i, row = id >> 4, ck = id & 15;
        *(u32x4*)(Cb + row * 136 + ck * 8) = *(const u32x4*)(DC + (long)su * 16384 + row * 128 + ck * 8); }
      if (tid < 128) nvec[tid] = DN[su * 128 + tid];
      m = SC[su * 4 + 2];
    } else {
#pragma unroll
      for (int i = 0; i < 2; ++i) { const int kb = (wid & 1) * 2 + i;
#pragma unroll
        for (int r = 0; r < 16; ++r) Cb[(vb2 * 32 + crow(r, hi)) * 136 + kb * 32 + r32] = 0; }
      if (tid < 128) nvec[tid] = 0.f;
    }
    if (tid < 256) {
      const int col = (tid < 128) ? (h * 128 + tid) : (1024 + h * 128 + (tid - 128));
      cwl[tid] = cw[col]; cwl[256 + tid] = cw[2048 + col]; cwl[512 + tid] = cw[4096 + col]; cwl[768 + tid] = cbias[col];
    }
    const float bgi = bg[dir * 8 + h], bgf = bg[16 + dir * 8 + h];
    __syncthreads();
    u32x4 rq[2][3], rk[2][3], rv[2]; float g_i = 0.f, g_f = 0.f;
#define ML_LOADRAW(chn) do { \
      const int tcr_ = (chn) * 64 + lane; const int posr_ = dir ? (L - 1 - tcr_) : tcr_; \
      const bf16_t* rp_ = P1 + (rowbase + posr_) * 4096 + h * 128 + wv * 16; \
      const bool hm_ = posr_ > 0, hp_ = posr_ < L - 1; const u32x4 z4_ = {0u, 0u, 0u, 0u}; \
      _Pragma("unroll") for (int hf = 0; hf < 2; ++hf) { \
        rq[hf][0] = hm_ ? *(const u32x4*)(rp_ - 4096 + hf * 8) : z4_; rq[hf][1] = *(const u32x4*)(rp_ + hf * 8); \
        rq[hf][2] = hp_ ? *(const u32x4*)(rp_ + 4096 + hf * 8) : z4_; \
        rk[hf][0] = hm_ ? *(const u32x4*)(rp_ - 4096 + 1024 + hf * 8) : z4_; rk[hf][1] = *(const u32x4*)(rp_ + 1024 + hf * 8); \
        rk[hf][2] = hp_ ? *(const u32x4*)(rp_ + 4096 + 1024 + hf * 8) : z4_; \
        rv[hf] = *(const u32x4*)(rp_ + 2048 + hf * 8); } \
      if (wid == 7) { const float* gr_ = GT + (rowbase + posr_) * 32; g_i = gr_[dir * 8 + h]; g_f = gr_[16 + dir * 8 + h]; } \
    } while (0)
#define ML_GATES(setp, mval) do { float* av_ = gbuf + (setp) * 200; float* Mv_ = av_ + 64; float* bv_ = Mv_ + 64; float* scal_ = bv_ + 64; \
      const float ic_ = g_i + bgi; const float fp_ = g_f + bgf; \
      const float lf_ = fminf(fp_, 0.f) - __logf(1.f + __expf(-fabsf(fp_))); \
      float bc_ = lf_; \
      _Pragma("unroll") for (int off = 1; off < 64; off <<= 1) { float t_ = __shfl_up(bc_, off); if (lane >= off) bc_ += t_; } \
      const float a_ = ic_ - bc_; float pm_ = a_; \
      _Pragma("unroll") for (int off = 1; off < 64; off <<= 1) { float t_ = __shfl_up(pm_, off); if (lane >= off) pm_ = fmaxf(pm_, t_); } \
      const float M_ = fmaxf((mval), pm_); \
      av_[lane] = a_; Mv_[lane] = M_; bv_[lane] = bc_; if (lane == 63) { scal_[0] = M_; scal_[1] = bc_; } } while (0)
    float sv_M = 0.f, sv_b = 0.f;
    ML_LOADRAW(c0);
    if (wid == 7) ML_GATES(c0 & 1, m);
    for (int ch = c0; ch < c1; ++ch) {
      float* av = gbuf + (ch & 1) * 200; float* Mv = av + 64; float* bv = Mv + 64; float* scal = bv + 64;
      float kf[16];
      {
        const int r = lane, c16 = wv * 16;
#pragma unroll
        for (int hf = 0; hf < 2; ++hf) {
          float um[8], u0[8], up[8], qf[8];
          if (do_out) { unpack8(rq[hf][0], um); unpack8(rq[hf][1], u0); unpack8(rq[hf][2], up);
#pragma unroll
            for (int e = 0; e < 8; ++e) { const int c = c16 + hf * 8 + e;
              qf[e] = silu_f(cwl[c] * um[e] + cwl[256 + c] * u0[e] + cwl[512 + c] * up[e] + cwl[768 + c]); }
            *(u32x4*)(Qs + r * 136 + c16 + hf * 8) = pack8(qf); }
          { unpack8(rk[hf][0], um); unpack8(rk[hf][1], u0); unpack8(rk[hf][2], up);
#pragma unroll
            for (int e = 0; e < 8; ++e) { const int c = 128 + c16 + hf * 8 + e;
              qf[e] = 0.088388347648318440f * silu_f(cwl[c] * um[e] + cwl[256 + c] * u0[e] + cwl[512 + c] * up[e] + cwl[768 + c]);
              kf[hf * 8 + e] = qf[e]; }
            *(u32x4*)(Ks + r * 136 + c16 + hf * 8) = pack8(qf); }
          { const u32x4 wv4 = rv[hf];
            bf16_t* vd = VsT + (c16 + hf * 8) * 72 + r;
            vd[0 * 72] = (bf16_t)(wv4[0] & 0xffff); vd[1 * 72] = (bf16_t)(wv4[0] >> 16);
            vd[2 * 72] = (bf16_t)(wv4[1] & 0xffff); vd[3 * 72] = (bf16_t)(wv4[1] >> 16);
            vd[4 * 72] = (bf16_t)(wv4[2] & 0xffff); vd[5 * 72] = (bf16_t)(wv4[2] >> 16);
            vd[6 * 72] = (bf16_t)(wv4[3] & 0xffff); vd[7 * 72] = (bf16_t)(wv4[3] >> 16); }
        }
      }
      if (ch + 1 < c1) ML_LOADRAW(ch + 1);
      __syncthreads();
      const float M63 = scal[0], b63 = scal[1];
      sv_M = M63; sv_b = b63;
      const float m_new = b63 + M63;
      const float w_state = __expf(m - M63);
      {
        const float wt = __expf(av[lane] - M63);
        bf16_t* kd = KwT + (wv * 16) * 72 + lane;
#pragma unroll
        for (int e = 0; e < 16; ++e) kd[e * 72] = f2bf(kf[e] * wt);
      }
      __syncthreads();
      if (wid == 7 && ch + 1 < c1) ML_GATES((ch + 1) & 1, m_new);
      const int tb = wid & 1, vb = wid >> 1;
      if (do_out && wid < 4) {
        const int sb = wid >> 1;
        f32x16 s = {};
        if (sb <= tb) { s = mma_nt<64>(Qs + tb * 32 * 136, 136, Ks + sb * 32 * 136, 136, s, r32, hi); s = mma_nt<64>(Qs + tb * 32 * 136 + 64, 136, Ks + sb * 32 * 136 + 64, 136, s, r32, hi); }
        const int sc = sb * 32 + r32; const float as = av[sc];
#pragma unroll
        for (int r = 0; r < 16; ++r) {
          const int t = tb * 32 + crow(r, hi);
          float w = (sc <= t) ? s[r] * __expf(as - Mv[t]) : 0.f;
          Wb[t * 72 + sc] = f2bf(w);
        }
      }
      f32x16 inter = {};
      if (do_out) inter = mma_nt<64>(Qs + tb * 32 * 136, 136, Cb + vb * 32 * 136, 136, inter, r32, hi); if (do_out) inter = mma_nt<64>(Qs + tb * 32 * 136 + 64, 136, Cb + vb * 32 * 136 + 64, 136, inter, r32, hi);
      __syncthreads();
      if (do_out) {
        const int t = tid >> 3, part = tid & 7;
        float wsum[8]; unpack8(*(const u32x4*)(Wb + t * 72 + part * 8), wsum);
        float dw = 0.f;
#pragma unroll
        for (int e = 0; e < 8; ++e) dw += wsum[e];
        float q0[8], q1[8]; unpack8(*(const u32x4*)(Qs + t * 136 + part * 16), q0); unpack8(*(const u32x4*)(Qs + t * 136 + part * 16 + 8), q1);
        float dq = 0.f;
#pragma unroll
        for (int e = 0; e < 8; ++e) dq += q0[e] * nvec[part * 16 + e] + q1[e] * nvec[part * 16 + 8 + e];
        dw += __shfl_xor(dw, 1); dw += __shfl_xor(dw, 2); dw += __shfl_xor(dw, 4);
        dq += __shfl_xor(dq, 1); dq += __shfl_xor(dq, 2); dq += __shfl_xor(dq, 4);
        if (part == 0) {
          const float Mt = Mv[t];
          const float wint = __expf(m - Mt);
          const float den = wint * dq + dw;
          const float mt = bv[t] + Mt;
          sclv[t] = 1.f / fmaxf(fabsf(den), __expf(-mt));
          wintv[t] = wint;
        }
      }
      __syncthreads();
      if (do_out) {
        f32x16 num;
#pragma unroll
        for (int r = 0; r < 16; ++r) num[r] = inter[r] * wintv[tb * 32 + crow(r, hi)];
        num = mma_nt<64>(Wb + tb * 32 * 72, 72, VsT + vb * 32 * 72, 72, num, r32, hi);
        bf16_t* Hout = dir ? HB : HF;
#pragma unroll
        for (int r = 0; r < 16; ++r) {
          const int t = tb * 32 + crow(r, hi);
          const int tc = ch * 64 + t; const int pos = dir ? (L - 1 - tc) : tc;
          Hout[(rowbase + pos) * 1024 + h * 128 + vb * 32 + r32] = f2bf(num[r] * sclv[t]);
        }
      }
#pragma unroll
      for (int i = 0; i < 2; ++i) {
        const int kb = (wid & 1) * 2 + i;
#pragma unroll
        for (int r = 0; r < 16; ++r) cacc[i][r] *= w_state;
        cacc[i] = mma_nt<64>(VsT + vb2 * 32 * 72, 72, KwT + kb * 32 * 72, 72, cacc[i], r32, hi);
#pragma unroll
        for (int r = 0; r < 16; ++r) Cb[(vb2 * 32 + crow(r, hi)) * 136 + kb * 32 + r32] = f2bf(cacc[i][r]);
      }
      if (tid < 128) {
        float s = 0.f;
#pragma unroll
        for (int q = 0; q < 8; ++q) { float f[8]; unpack8(*(const u32x4*)(KwT + tid * 72 + q * 8), f);
#pragma unroll
          for (int e = 0; e < 8; ++e) s += f[e]; }
        nvec[tid] = w_state * nvec[tid] + s;
      }
      m = m_new;
      __syncthreads();
    }
    if (mode == 0) {
      float* Co = p.out + O_C + (long)((seq * 2 + dir) * 8 + h) * 16384;
#pragma unroll
      for (int i = 0; i < 2; ++i) { const int kb = (wid & 1) * 2 + i;
#pragma unroll
        for (int r = 0; r < 16; ++r) Co[(vb2 * 32 + crow(r, hi)) * 128 + kb * 32 + r32] = cacc[i][r]; }
      if (tid < 128) p.out[O_N + ((seq * 2 + dir) * 8 + h) * 128 + tid] = nvec[tid];
      if (tid == 0) p.out[O_M + (seq * 2 + dir) * 8 + h] = m;
    } else if (mode == 1) {
#pragma unroll
      for (int i = 0; i < 4; ++i) { const int id = tid + 512 * i, row = id >> 4, ck = id & 15;
        *(u32x4*)(DC + (long)su * 16384 + row * 128 + ck * 8) = *(const u32x4*)(Cb + row * 136 + ck * 8); }
      if (tid < 128) DN[su * 128 + tid] = nvec[tid];
      if (tid == 0) { SC[su * 4] = sv_M; SC[su * 4 + 1] = sv_b; }
    }
  }
  __syncthreads();
}

__device__ __forceinline__ void mlstm_scan(const int wv, const Params& p, const int zq, bf16_t* DC, float* DN, float* SC) {
  const int tidx = ltid(wv);
  for (int g = blockIdx.x * 512 + tidx; g < 32 * 4096; g += gridDim.x * 512) {
    const int sidx = g >> 12, e4 = (g & 4095) * 4;
    const int b = sidx >> 4, h = (sidx >> 1) & 7, dir = sidx & 1;
    const float4 c0 = *(const float4*)(p.in[zq + 4] + (long)((b * 2 + dir) * 8 + h) * 16384 + e4);
    float C0 = c0.x, C1 = c0.y, C2 = c0.z, C3 = c0.w;
    float m = p.in[zq + 6][(b * 2 + dir) * 8 + h];
#pragma unroll 4
    for (int c = 0; c < 32; ++c) {
      const int u = sidx * 32 + c;
      const float amax = SC[u * 4], b63 = SC[u * 4 + 1];
      const float Mc = fmaxf(m, amax);
      const float ws = __expf(m - Mc), wd = __expf(amax - Mc);
      u32x2* dp = (u32x2*)(DC + (long)u * 16384 + e4);
      const u32x2 d = *dp;
      u32x2 o = {cvtpk(C0, C1), cvtpk(C2, C3)};
      *dp = o;
      C0 = ws * C0 + wd * bflo(d[0]); C1 = ws * C1 + wd * bfhi(d[0]); C2 = ws * C2 + wd * bflo(d[1]); C3 = ws * C3 + wd * bfhi(d[1]);
      m = b63 + Mc;
    }
  }
  for (int g = blockIdx.x * 512 + tidx; g < 32 * 128; g += gridDim.x * 512) {
    const int sidx = g >> 7, k = g & 127;
    const int b = sidx >> 4, h = (sidx >> 1) & 7, dir = sidx & 1;
    float n = p.in[zq + 5][((b * 2 + dir) * 8 + h) * 128 + k];
    float m = p.in[zq + 6][(b * 2 + dir) * 8 + h];
    for (int c = 0; c < 32; ++c) {
      const int u = sidx * 32 + c;
      const float amax = SC[u * 4], b63 = SC[u * 4 + 1];
      const float Mc = fmaxf(m, amax);
      const float ws = __expf(m - Mc), wd = __expf(amax - Mc);
      const float dn = DN[u * 128 + k];
      DN[u * 128 + k] = n;
      if (k == 0) SC[u * 4 + 2] = m;
      n = ws * n + wd * dn;
      m = b63 + Mc;
    }
  }
}

#undef ML_LOADRAW
#undef ML_GATES
__device__ __forceinline__ void mlstm_post(const int wv, const Params& p, const int zq, const bf16_t* __restrict__ HF, const bf16_t* __restrict__ HB,
                                           const bf16_t* __restrict__ P1, bf16_t* __restrict__ A) {
  const int tidx = ltid(wv);
  const int wid = wv, lane = tidx & 63;
  const float* hn = p.in[zq + 37];
  for (int row = blockIdx.x * 8 + wid; row < T_TOK; row += gridDim.x * 8) {
    float hv[16], t0[8], t1[8];
    unpack8(*(const u32x4*)(HF + (long)row * 1024 + lane * 16), hv); unpack8(*(const u32x4*)(HF + (long)row * 1024 + lane * 16 + 8), hv + 8);
    unpack8(*(const u32x4*)(HB + (long)row * 1024 + lane * 16), t0); unpack8(*(const u32x4*)(HB + (long)row * 1024 + lane * 16 + 8), t1);
    float ss = 0.f;
#pragma unroll
    for (int e = 0; e < 8; ++e) { hv[e] += t0[e]; hv[8 + e] += t1[e]; }
#pragma unroll
    for (int e = 0; e < 16; ++e) ss += hv[e] * hv[e];
    ss += __shfl_xor(ss, 1); ss += __shfl_xor(ss, 2); ss += __shfl_xor(ss, 4);
    const float rs = rsqrtf(ss * (1.f / 128.f) + 1e-6f);
    float ov[16];
    unpack8(*(const u32x4*)(P1 + (long)row * 4096 + 3072 + lane * 16), ov); unpack8(*(const u32x4*)(P1 + (long)row * 4096 + 3072 + lane * 16 + 8), ov + 8);
    float y[16];
#pragma unroll
    for (int e = 0; e < 16; ++e) y[e] = hv[e] * rs * hn[lane * 16 + e] * (1.f / (1.f + __expf(-ov[e])));
    *(u32x4*)(A + (long)row * 1024 + lane * 16) = pack8(y);
    *(u32x4*)(A + (long)row * 1024 + lane * 16 + 8) = pack8(y + 8);
  }
}

__device__ __forceinline__ void gsync(const int wv, unsigned* bar, const unsigned k) {
  const int tidx = ltid(wv);
  asm volatile("s_waitcnt vmcnt(0)" ::: "memory");
  __syncthreads();
  if (tidx == 0) {
    __builtin_amdgcn_fence(__ATOMIC_RELEASE, "agent");
    asm volatile("s_waitcnt vmcnt(0)" ::: "memory");
    const unsigned g = blockIdx.x & 7u;
    const unsigned ng = (gridDim.x + 7u - g) >> 3;
    const unsigned ngroups = gridDim.x < 8u ? gridDim.x : 8u;
    const unsigned old = __hip_atomic_fetch_add(bar + g * 32, 1u, __ATOMIC_RELAXED, __HIP_MEMORY_SCOPE_AGENT);
    if (old + 1u == k * ng) {
      const unsigned o2 = __hip_atomic_fetch_add(bar + 256, 1u, __ATOMIC_RELAXED, __HIP_MEMORY_SCOPE_AGENT);
      if (o2 + 1u == k * ngroups) {
#pragma unroll
        for (int q = 0; q < 8; ++q) __hip_atomic_store(bar + 512 + q * 32, k, __ATOMIC_RELAXED, __HIP_MEMORY_SCOPE_AGENT);
      }
    }
    while (__hip_atomic_load(bar + 512 + g * 32, __ATOMIC_RELAXED, __HIP_MEMORY_SCOPE_AGENT) < k) __builtin_amdgcn_s_sleep(4);
    __builtin_amdgcn_fence(__ATOMIC_ACQUIRE, "agent");
    asm volatile("s_waitcnt vmcnt(0)" ::: "memory");
  }
  __syncthreads();
}

__global__ void __launch_bounds__(512) mega(Params p, int ph_lo, int ph_hi) {
  const int wv = __builtin_amdgcn_readfirstlane(threadIdx.x >> 6);
  if (ph_hi < 0) { cg::this_grid().sync(); }
  unsigned* bar = (unsigned*)(p.ws + WS_END);
  char* ws = p.ws;
  bf16_t* Wt_in0 = (bf16_t*)(ws + OFF_WIN0); bf16_t* Wt_out0 = (bf16_t*)(ws + OFF_WOUT0);
  bf16_t* Wt_up0 = (bf16_t*)(ws + OFF_WUP0); bf16_t* Wt_up1 = (bf16_t*)(ws + OFF_WUP1);
  bf16_t* Wt_dn0 = (bf16_t*)(ws + OFF_WDN0); bf16_t* Wt_dn1 = (bf16_t*)(ws + OFF_WDN1);
  bf16_t* Wt_in1 = (bf16_t*)(ws + OFF_WIN1); bf16_t* Wt_out1 = (bf16_t*)(ws + OFF_WOUT1);
  float* modv = (float*)(ws + OFF_MOD);
  char* Pr = ws + OFF_P; char* Gr = ws + OFF_G;
  bf16_t* Pb = (bf16_t*)Pr; bf16_t* R = (bf16_t*)Pr;
  bf16_t* QA = (bf16_t*)(Pr + P_QA); bf16_t* KA = (bf16_t*)(Pr + P_KA); bf16_t* VA = (bf16_t*)(Pr + P_VA); bf16_t* X0 = (bf16_t*)(Pr + P_X0);
  float* GT = (float*)(Pr + P_GT); bf16_t* A2 = (bf16_t*)(Pr + P_A2);
  bf16_t* A = (bf16_t*)Gr; bf16_t* Gb = (bf16_t*)Gr; float* VV = (float*)(Gr + G_VV);
  bf16_t* HF = (bf16_t*)Gr; bf16_t* HB = (bf16_t*)(Gr + G_HB);
  bf16_t* DCb = (bf16_t*)(Pr + P_A2); float* DNb = (float*)(Gr + 50331648); float* SCb = DNb + 1024 * 128;
  float* X = p.out;
  float* F256 = p.out + O_C + 512; float* F2048 = p.out + O_C + 512 * 512 + 512;
  const float* mod0 = modv; const float* mod1 = modv + 3 * 6144;
  unsigned bk = 0;
#define PH(i, ...) if (ph_lo <= (i) && (i) < ph_hi) { const int zq = opq(); __VA_ARGS__; if ((i) + 1 < ph_hi) gsync(wv, bar, ++bk); }
  PH(0, {
    conv_w(wv, p.in[zq + 19], Wt_in0, 1024, 2560, 2560);
    conv_w(wv, p.in[zq + 20], Wt_out0, 1024, 1024, 1024);
    mod_phase(wv, p, zq, modv);
    filt_phase(wv, p, zq, F256, F2048);
  })
  PH(1, (row_phase<true, false, true>(wv, p, zq, nullptr, nullptr, mod0, 0, nullptr, p.in[zq + 11], mod0, 0, A)))
  PH(2, (gemm_phase<0, 2560>(wv, A, Wt_in0, 2560, 1024, Pb, nullptr)))
  PH(3, post_inproj0(wv, p, zq, Pb, QA, KA, VA, VV, X0))
  PH(4, mix0_phase(wv, p, zq, QA, KA, VA, VV, X0, F256, F2048, A))
  PH(5, { gemm_phase<0, 1024>(wv, A, Wt_out0, 1024, 1024, R, nullptr);
    conv_w(wv, p.in[zq + 15], Wt_up0, 1024, 5632, 5632, gridDim.x > 192 ? 192 : 0); })
  PH(6, (row_phase<true, true, true>(wv, p, zq, R, p.in[zq + 12], mod0, 2, X, p.in[zq + 13], mod0, 3, A)))
  PH(7, { gemm_phase<0, 5632>(wv, A, Wt_up0, 5632, 1024, Pb, nullptr);
    const int ib = (int)(1056u % gridDim.x);
    conv_w(wv, p.in[zq + 18], Wt_dn0, 2816, 1024, 1024, ib);
    conv_w(wv, p.in[zq + 33], Wt_in1, 1024, 4128, 4352, ib); })
  PH(8, ffn_act_phase(wv, Pb, p.in[zq + 16], p.in[zq + 17], Gb))
  PH(9, { gemm_phase<0, 1024>(wv, Gb, Wt_dn0, 1024, 2816, R, nullptr);
    const int ib = gridDim.x > 192 ? 192 : 0;
    conv_w(wv, p.in[zq + 15] + (long)1024 * 5632, Wt_up1, 1024, 5632, 5632, ib);
    conv_w(wv, p.in[zq + 18] + (long)2816 * 1024, Wt_dn1, 2816, 1024, 1024, ib);
    conv_w(wv, p.in[zq + 38], Wt_out1, 1024, 1024, 1024, ib); })
  PH(10, (row_phase<false, true, true>(wv, p, zq, R, p.in[zq + 14], mod0, 5, X, p.in[zq + 11] + 1024, mod1, 0, A)))
  PH(11, { gemm_phase<0, 4096>(wv, A, Wt_in1, 4096, 1024, Pb, nullptr); gates_phase(wv, A, Wt_in1 + (long)4096 * 1024, GT); })
  PH(12, {
    mlstm_phase(wv, p, zq, Pb, GT, HF, HB, DCb, DNb, SCb, 0);
  })
  PH(13, mlstm_scan(wv, p, zq, DCb, DNb, SCb))
  PH(21, mlstm_phase(wv, p, zq, Pb, GT, HF, HB, DCb, DNb, SCb, 1))
  PH(14, mlstm_post(wv, p, zq, HF, HB, Pb, A2))
  PH(15, (gemm_phase<0, 1024>(wv, A2, Wt_out1, 1024, 1024, R, nullptr)))
  PH(16, (row_phase<false, true, true>(wv, p, zq, R, p.in[zq + 12] + 1024, mod1, 2, X, p.in[zq + 13] + 1024, mod1, 3, A)))
  PH(17, (gemm_phase<0, 5632>(wv, A, Wt_up1, 5632, 1024, Pb, nullptr)))
  PH(18, ffn_act_phase(wv, Pb, p.in[zq + 16] + 3 * 5632, p.in[zq + 17] + 5632, Gb))
  PH(19, (gemm_phase<0, 1024>(wv, Gb, Wt_dn1, 1024, 2816, R, nullptr)))
  PH(39, (row_phase<false, true, false>(wv, p, zq, R, p.in[zq + 14] + 1024, mod1, 5, X, nullptr, mod1, 0, nullptr)))
#undef PH
}

extern "C" void kernel_launch(void* const* d_in, const int* in_sizes, int n_in, void* d_out, int out_size, void* d_ws, size_t ws_size,
                              hipStream_t stream) {
  static int grid_blocks = 0;
  if (!grid_blocks) {
    if (ws_size < WS_END + 4096) fprintf(stderr, "kernel_launch: workspace too small: %zu < %zu\n", ws_size, (size_t)WS_END);
    hipFuncSetAttribute((const void*)mega, hipFuncAttributeMaxDynamicSharedMemorySize, LDS_BYTES);
    int dev = 0, cus = 0, per = 0;
    hipGetDevice(&dev);
    hipDeviceGetAttribute(&cus, hipDeviceAttributeMultiprocessorCount, dev);
    hipOccupancyMaxActiveBlocksPerMultiprocessor(&per, mega, 512, LDS_BYTES);
    if (per < 1) { fprintf(stderr, "kernel_launch: occupancy query returned %d\n", per); per = 1; }
    grid_blocks = cus;
  }
  Params p{};
  for (int i = 0; i < 39; ++i) p.in[i] = (const float*)d_in[i];
  p.out = (float*)d_out; p.ws = (char*)d_ws;
  int lo = 0, hi = NPH;
  (void)hipMemsetAsync((char*)d_ws + WS_END, 0, 4096, stream);
  void* args[] = {&p, &lo, &hi};
  hipError_t e = hipLaunchCooperativeKernel((void*)mega, dim3(grid_blocks), dim3(512), args, LDS_BYTES, stream);
  if (e != hipSuccess) fprintf(stderr, "cooperative launch failed: %s (grid %d)\n", hipGetErrorString(e), grid_blocks);
}
```
